# Optimizing an MI355X kernel written in HIP

```python
import jax
import jax.numpy as jnp
from jax import lax
import numpy as np

D_MODEL = 1024
BATCH = 8
SEQ = 4096
DEPTH = 2

CTX_LEN = 256
GRID_W = 64
N_MOD = 6
RMS_EPS = 1e-6
NEG_INF = -1e30
D_POOL = D_MODEL // 2
POOL_WINDOWS = (2, 4, 8, 16)
D_POOL_GROUP = D_POOL // len(POOL_WINDOWS)
NA_HEAD_DIM = 64
D_NA = D_MODEL - D_POOL
NA_HEADS = D_NA // NA_HEAD_DIM
WIN_R = 8
WIN_C = 16
D_IN_EVEN = D_POOL + 3 * D_NA
RW_HEAD = 64
RW_HEADS = D_MODEL // RW_HEAD
DECAY_LORA = 64
AAA_LORA = 64
GATE_LORA = 128
GN_EPS = 64e-5
D_FF = 4 * D_MODEL

kernel_name = "hybrid_pool_natten_rwkv7_prefix_dit"


def rms_norm(x, g):
    xf = x.astype(jnp.float32)
    y = xf * lax.rsqrt(jnp.mean(xf * xf, axis=-1, keepdims=True) + RMS_EPS)
    return (y * g.astype(jnp.float32)).astype(x.dtype)


def modulate(h, shift, scale):
    return h * (1 + scale) + shift


def squared_relu_mlp(h, w1, w2):
    return jnp.square(jax.nn.relu(h @ w1)) @ w2


def split_heads(t, n_heads, head_dim):
    return t.reshape(t.shape[0], t.shape[1], n_heads, head_dim)


def pool_mixer(u, pool_w, pool_scale):
    L = u.shape[1]
    uf = u.astype(jnp.float32)
    cs = jnp.concatenate([jnp.zeros_like(uf[:, :1]), jnp.cumsum(uf, axis=1)], axis=1)
    t = jnp.arange(L)
    outs = []
    for gi, w in enumerate(POOL_WINDOWS):
        lo = jnp.clip(t - w // 2, 0, L)
        hi = jnp.clip(t + w // 2, 0, L)
        sl = slice(gi * D_POOL_GROUP, (gi + 1) * D_POOL_GROUP)
        csg = cs[..., sl]
        mean = (jnp.take(csg, hi, axis=1) - jnp.take(csg, lo, axis=1)) / (hi - lo).astype(jnp.float32)[None, :, None]
        outs.append((mean - uf[..., sl]).astype(u.dtype) @ pool_w[gi])
    return jnp.concatenate(outs, axis=-1) * pool_scale


def context_attention(q, k, v):
    B, L = q.shape[:2]
    s = jnp.einsum('bqhd,bkhd->bhqk', q, k).astype(jnp.float32) * (NA_HEAD_DIM ** -0.5)
    p = jax.nn.softmax(s, axis=-1).astype(v.dtype)
    return jnp.einsum('bhqk,bkhd->bqhd', p, v).reshape(B, L, D_NA)


def neighbourhood_attention(q, k, v, k_ctx, v_ctx, rpb):
    B, L = q.shape[:2]
    rows = L // GRID_W
    kr = min(WIN_R, rows)
    scale = NA_HEAD_DIM ** -0.5
    grid = lambda t: t.reshape(B, rows, GRID_W, NA_HEADS, NA_HEAD_DIM)
    qg, kg, vg = grid(q), grid(k), grid(v)
    col = jnp.arange(GRID_W)
    c_start = jnp.clip(col - WIN_C // 2, 0, GRID_W - WIN_C)
    col_ok = (col[None, :] >= c_start[:, None]) & (col[None, :] < c_start[:, None] + WIN_C)
    dc_idx = jnp.clip(col[None, :] - col[:, None], -(WIN_C - 1), WIN_C - 1) + WIN_C - 1
    rpb_c = rpb.astype(jnp.float32)[:, :, dc_idx]

    def row_block(args):
        q_row, r = args
        start = jnp.clip(r - kr // 2, 0, rows - kr)
        k_band = lax.dynamic_slice_in_dim(kg, start, kr, axis=1)
        v_band = lax.dynamic_slice_in_dim(vg, start, kr, axis=1)
        s_lat = jnp.einsum('bqhd,brkhd->bhqrk', q_row, k_band).astype(jnp.float32) * scale
        dr_idx = start + jnp.arange(kr) - r + WIN_R - 1
        bias = jnp.take(rpb_c, dr_idx, axis=1).transpose(0, 2, 1, 3)
        s_lat = jnp.where(col_ok[:, None, :], s_lat + bias, NEG_INF)
        s_ctx = jnp.einsum('bqhd,bchd->bhqc', q_row, k_ctx).astype(jnp.float32) * scale
        s = jnp.concatenate([s_lat.reshape(B, NA_HEADS, GRID_W, kr * GRID_W), s_ctx], axis=-1)
        p = jax.nn.softmax(s, axis=-1).astype(v.dtype)
        p_lat = p[..., :kr * GRID_W].reshape(B, NA_HEADS, GRID_W, kr, GRID_W)
        p_ctx = p[..., kr * GRID_W:]
        return (jnp.einsum('bhqrk,brkhd->bqhd', p_lat, v_band)
                + jnp.einsum('bhqc,bchd->bqhd', p_ctx, v_ctx))

    out = lax.map(row_block, (jnp.moveaxis(qg, 1, 0), jnp.arange(rows)))
    return jnp.moveaxis(out, 0, 1).reshape(B, L, D_NA)


def even_mixer(h, hc, w_in, w_out, pool_w, pool_scale, rpb, with_ctx):
    heads = lambda t: split_heads(t, NA_HEADS, NA_HEAD_DIM)
    u = h @ w_in
    q = heads(u[..., D_POOL:D_POOL + D_NA])
    k = heads(u[..., D_POOL + D_NA:D_POOL + 2 * D_NA])
    v = heads(u[..., D_POOL + 2 * D_NA:])
    if with_ctx:
        uc = hc @ w_in
        kv_c = uc[..., D_POOL + D_NA:]
    else:
        kv_c = hc @ w_in[:, D_POOL + D_NA:]
    k_c, v_c = heads(kv_c[..., :D_NA]), heads(kv_c[..., D_NA:])
    y = jnp.concatenate([pool_mixer(u[..., :D_POOL], pool_w, pool_scale),
                         neighbourhood_attention(q, k, v, k_c, v_c, rpb)], axis=-1) @ w_out
    if with_ctx:
        yc = jnp.concatenate([pool_mixer(uc[..., :D_POOL], pool_w, pool_scale),
                              context_attention(heads(uc[..., D_POOL:D_POOL + D_NA]), k_c, v_c)], axis=-1) @ w_out
    else:
        yc = None
    return y, yc


def centred_shift(x):
    prev = jnp.pad(x[:, :-1], ((0, 0), (1, 0), (0, 0)))
    nxt = jnp.pad(x[:, 1:], ((0, 0), (0, 1), (0, 0)))
    return 0.5 * (prev + nxt) - x


def rwkv_features(h, mu, wr, wk, wv, w0, w1, w2, a0, a1, a2, g1, g2, k_k, k_a, with_rg):
    B, L, _ = h.shape
    heads = lambda t: split_heads(t, RW_HEADS, RW_HEAD).astype(jnp.float32)
    xx = centred_shift(h)
    mix = lambda j: h + xx * mu[j]
    xw, xk, xv, xa = mix(1), mix(2), mix(3), mix(4)
    k = xk @ wk
    v = heads(xv @ wv)
    kk = heads(k * k_k)
    kk = kk * lax.rsqrt(jnp.maximum(jnp.sum(kk * kk, axis=-1, keepdims=True), 1e-24))
    kh = heads(k)
    k_a_h = k_a.reshape(RW_HEADS, RW_HEAD).astype(jnp.float32)
    dirs = []
    for d in range(2):
        w_raw = heads(w0[d] + jnp.tanh(xw @ w1[d]) @ w2[d])
        decay = jnp.exp(-jnp.exp(-jax.nn.softplus(-w_raw) - 0.5))
        a = jax.nn.sigmoid(heads(a0[d] + (xa @ a1[d]) @ a2[d]))
        k_d = kh * (1 + (a - 1) * k_a_h)
        dirs.append((decay, k_d, a))
    if with_rg:
        r = heads(mix(0) @ wr)
        g = jax.nn.sigmoid(mix(5) @ g1) @ g2
    else:
        r, g = None, None
    return v, kk, dirs, r, g


def wkv_scan(s0, decay, k, v, kk, a, r, reverse):
    tm = lambda t: jnp.moveaxis(t.astype(jnp.float32), 1, 0)
    emit = r is not None
    xs = (tm(decay), tm(k), tm(v), tm(kk), tm(kk * a)) + ((tm(r),) if emit else ())

    def step(S, inp):
        w_t, k_t, v_t, kk_t, kka_t = inp[:5]
        S = (S * w_t[:, :, None, :]
             - jnp.einsum('bhij,bhj->bhi', S, kk_t)[..., None] * kka_t[:, :, None, :]
             + v_t[..., None] * k_t[:, :, None, :])
        y = jnp.einsum('bhij,bhj->bhi', S, inp[5]) if emit else None
        return S, y

    S, ys = lax.scan(step, s0, xs, reverse=reverse)
    return S, (jnp.moveaxis(ys, 0, 1) if emit else None)


def rwkv_readout(y, r, k_sum, v, g, r_k, ln_g, ln_b, wo, dtype):
    B, L = y.shape[:2]
    mean = jnp.mean(y, axis=-1, keepdims=True)
    var = jnp.mean(jnp.square(y - mean), axis=-1, keepdims=True)
    yn = ((y - mean) * lax.rsqrt(var + GN_EPS)).reshape(B, L, D_MODEL) * ln_g + ln_b
    bonus = (jnp.sum(r * k_sum * r_k.astype(jnp.float32), axis=-1, keepdims=True) * v).reshape(B, L, D_MODEL)
    return ((yn + bonus) * g).astype(dtype) @ wo


def odd_mixer(h, hc, mu, wr, wk, wv, wo, w0, w1, w2, a0, a1, a2, g1, g2, k_k, k_a, r_k, ln_g, ln_b, with_ctx):
    feat = lambda t, rg: rwkv_features(t, mu, wr, wk, wv, w0, w1, w2, a0, a1, a2, g1, g2, k_k, k_a, rg)
    v, kk, dirs, r, g = feat(h, True)
    v_c, kk_c, dirs_c, r_c, g_c = feat(hc, with_ctx)
    s0 = jnp.zeros((h.shape[0], RW_HEADS, RW_HEAD, RW_HEAD), jnp.float32)
    ys, ys_c = [], []
    for d, reverse in enumerate((False, True)):
        decay_c, k_dc, a_c = dirs_c[d]
        s_ctx, y_c = wkv_scan(s0, decay_c, k_dc, v_c, kk_c, a_c, r_c, reverse)
        decay, k_d, a = dirs[d]
        _, y_d = wkv_scan(s_ctx, decay, k_d, v, kk, a, r, reverse)
        ys.append(y_d)
        ys_c.append(y_c)
    y = rwkv_readout(ys[0] + ys[1], r, dirs[0][1] + dirs[1][1], v, g, r_k, ln_g, ln_b, wo, h.dtype)
    if with_ctx:
        yc = rwkv_readout(ys_c[0] + ys_c[1], r_c, dirs_c[0][1] + dirs_c[1][1], v_c, g_c, r_k, ln_g, ln_b, wo, hc.dtype)
    else:
        yc = None
    return y, yc


def setup_inputs(seed: int = 0) -> dict:
    key = jax.random.key(seed)
    ks = iter(jax.random.split(key, 40))
    n_even = (DEPTH + 1) // 2
    n_odd = DEPTH // 2
    D = D_MODEL
    nrm = lambda shape, s: jax.random.normal(next(ks), shape, jnp.float32) * s
    return {
        "x": nrm((BATCH, SEQ, D), 1.0),
        "c": nrm((BATCH, D), 1.0),
        "ctx": nrm((BATCH, CTX_LEN, D), 1.0),
        "c_ctx": nrm((D,), 1.0),
        "ada_w": nrm((DEPTH, D, N_MOD * D), 0.5 * D ** -0.5),
        "ada_b": nrm((DEPTH, N_MOD * D), 0.02),
        "norm_g": 1.0 + nrm((DEPTH, 4, D), 0.1),
        "mlp_w1": nrm((DEPTH, D, D_FF), D ** -0.5),
        "mlp_w2": nrm((DEPTH, D_FF, D), D_FF ** -0.5),
        "ev_w_in": nrm((n_even, D, D_IN_EVEN), D ** -0.5),
        "ev_w_out": nrm((n_even, D, D), D ** -0.5),
        "ev_pool_w": nrm((n_even, len(POOL_WINDOWS), D_POOL_GROUP, D_POOL_GROUP), D_POOL_GROUP ** -0.5),
        "ev_pool_scale": 1.0 + nrm((n_even, D_POOL), 0.1),
        "ev_rpb": nrm((n_even, NA_HEADS, 2 * WIN_R - 1, 2 * WIN_C - 1), 0.1),
        "rw_mu": jax.random.uniform(next(ks), (n_odd, 6, D), jnp.float32),
        "rw_wr": nrm((n_odd, D, D), D ** -0.5),
        "rw_wk": nrm((n_odd, D, D), D ** -0.5),
        "rw_wv": nrm((n_odd, D, D), D ** -0.5),
        "rw_wo": nrm((n_odd, D, D), D ** -0.5),
        "rw_w0": -2.0 + nrm((n_odd, 2, D), 0.5),
        "rw_w1": nrm((n_odd, 2, D, DECAY_LORA), D ** -0.5),
        "rw_w2": nrm((n_odd, 2, DECAY_LORA, D), 0.1 * DECAY_LORA ** -0.5),
        "rw_a0": nrm((n_odd, 2, D), 0.1),
        "rw_a1": nrm((n_odd, 2, D, AAA_LORA), D ** -0.5),
        "rw_a2": nrm((n_odd, 2, AAA_LORA, D), 0.1 * AAA_LORA ** -0.5),
        "rw_g1": nrm((n_odd, D, GATE_LORA), D ** -0.5),
        "rw_g2": nrm((n_odd, GATE_LORA, D), GATE_LORA ** -0.5),
        "rw_kk": 0.85 + nrm((n_odd, D), 0.05),
        "rw_ka": 1.0 + nrm((n_odd, D), 0.05),
        "rw_rk": nrm((n_odd, RW_HEADS, RW_HEAD), 0.1),
        "rw_lng": 1.0 + nrm((n_odd, D), 0.1),
        "rw_lnb": nrm((n_odd, D), 0.01),
    }


def reference(x, c, ctx, c_ctx, ada_w, ada_b, norm_g, mlp_w1, mlp_w2,
              ev_w_in, ev_w_out, ev_pool_w, ev_pool_scale, ev_rpb,
              rw_mu, rw_wr, rw_wk, rw_wv, rw_wo, rw_w0, rw_w1, rw_w2,
              rw_a0, rw_a1, rw_a2, rw_g1, rw_g2, rw_kk, rw_ka, rw_rk, rw_lng, rw_lnb):
    silu_c = jax.nn.silu(c)
    silu_cc = jax.nn.silu(c_ctx)
    for i in range(DEPTH):
        j = i // 2
        with_ctx = i < DEPTH - 1
        mod = (silu_c @ ada_w[i] + ada_b[i])[:, None, :]
        mod_c = silu_cc @ ada_w[i] + ada_b[i]
        sh1, sc1, gt1, sh2, sc2, gt2 = jnp.split(mod, N_MOD, axis=-1)
        sh1c, sc1c, gt1c, sh2c, sc2c, gt2c = jnp.split(mod_c, N_MOD, axis=-1)
        h = modulate(rms_norm(x, norm_g[i, 0]), sh1, sc1)
        hc = modulate(rms_norm(ctx, norm_g[i, 0]), sh1c, sc1c)
        if i % 2 == 0:
            y, yc = even_mixer(h, hc, ev_w_in[j], ev_w_out[j], ev_pool_w[j], ev_pool_scale[j], ev_rpb[j], with_ctx)
        else:
            y, yc = odd_mixer(h, hc, rw_mu[j], rw_wr[j], rw_wk[j], rw_wv[j], rw_wo[j],
                              rw_w0[j], rw_w1[j], rw_w2[j], rw_a0[j], rw_a1[j], rw_a2[j],
                              rw_g1[j], rw_g2[j], rw_kk[j], rw_ka[j], rw_rk[j], rw_lng[j], rw_lnb[j], with_ctx)
        x = x + gt1 * rms_norm(y, norm_g[i, 1])
        h = modulate(rms_norm(x, norm_g[i, 2]), sh2, sc2)
        x = x + gt2 * rms_norm(squared_relu_mlp(h, mlp_w1[i], mlp_w2[i]), norm_g[i, 3])
        if with_ctx:
            ctx = ctx + gt1c * rms_norm(yc, norm_g[i, 1])
            hc = modulate(rms_norm(ctx, norm_g[i, 2]), sh2c, sc2c)
            ctx = ctx + gt2c * rms_norm(squared_relu_mlp(hc, mlp_w1[i], mlp_w2[i]), norm_g[i, 3])
    return x
```

```cpp
#include <hip/hip_runtime.h>
#include <hip/hip_cooperative_groups.h>
#include <cstdio>
namespace cg = cooperative_groups;

typedef _Float16 half_t;
typedef _Float16 h8 __attribute__((ext_vector_type(8)));
typedef _Float16 h4 __attribute__((ext_vector_type(4)));
typedef _Float16 h2 __attribute__((ext_vector_type(2)));
typedef float f4 __attribute__((ext_vector_type(4)));

#define RL 32768
#define RC 2048
#define RT 34816
#define MIB (1ull << 20)
#define OFF_WIN (0 * MIB)
#define OFF_WOUT (4 * MIB)
#define OFF_M1 (7 * MIB)
#define OFF_M2 (23 * MIB)
#define OFF_WR (39 * MIB)
#define OFF_WK (41 * MIB)
#define OFF_WV (43 * MIB)
#define OFF_WO (45 * MIB)
#define OFF_L1 (47 * MIB)
#define OFF_W2 (48 * MIB)
#define OFF_A2 (48 * MIB + 256 * 1024)
#define OFF_G2 (48 * MIB + 512 * 1024)
#define OFF_MOD (49 * MIB)
#define OFF_BN (50 * MIB)
#define OFF_XC (54 * MIB)
#define OFF_A0 (62 * MIB)
#define OFF_A1 (130 * MIB)
#define OFF_BIG (198 * MIB)
#define OFF_U OFF_BIG
#define OFF_Z (334 * MIB)
#define OFF_F OFF_BIG
#define OFF_RR OFF_BIG
#define OFF_KK (266 * MIB)
#define OFF_VV (334 * MIB)
#define OFF_L (402 * MIB)
#define OFF_G OFF_BIG
#define OFF_Z1 (266 * MIB)

#define SMEM_BYTES 151552

struct P {
  const float *x, *c, *ctx, *c_ctx, *ada_w, *ada_b, *norm_g, *mlp_w1, *mlp_w2, *ev_w_in, *ev_w_out, *ev_pool_w,
      *ev_pool_scale, *ev_rpb, *rw_mu, *rw_wr, *rw_wk, *rw_wv, *rw_wo, *rw_w0, *rw_w1, *rw_w2, *rw_a0, *rw_a1, *rw_a2,
      *rw_g1, *rw_g2, *rw_kk, *rw_ka, *rw_rk, *rw_lng, *rw_lnb;
  float* out;
  char* ws;
};

__device__ __forceinline__ int tidx() { int v = threadIdx.x; asm volatile("" : "+v"(v)); return v; }
__device__ __forceinline__ int bidx() { int v = blockIdx.x; asm volatile("" : "+s"(v)); return v; }
__device__ __forceinline__ size_t opaque_zero() { size_t z = 0; asm volatile("" : "+s"(z)); return z; }
__device__ __forceinline__ float opaque_f(float v) { asm volatile("" : "+v"(v)); return v; }
__device__ __forceinline__ float sigm(float x) { return 1.f / (1.f + __expf(-x)); }
__device__ __forceinline__ float bperm(float v, int srclane) {
  return __builtin_bit_cast(float, __builtin_amdgcn_ds_bpermute(srclane << 2, __builtin_bit_cast(int, v)));
}
template <int CTRL>
__device__ __forceinline__ float dpp(float x) {
  return __builtin_bit_cast(float, __builtin_amdgcn_mov_dpp(__builtin_bit_cast(int, x), CTRL, 0xf, 0xf, true));
}
__device__ __forceinline__ float red4(float x) { x += dpp<0xB1>(x); x += dpp<0x4E>(x); return x; }
__device__ __forceinline__ float red8(float x) { x = red4(x); x += dpp<0x141>(x); return x; }
__device__ __forceinline__ float red16(float x) { x = red8(x); x += dpp<0x140>(x); return x; }
__device__ __forceinline__ float wave_sum(float v, int lane) {
  v = red16(v);
  v += bperm(v, lane ^ 16);
  v += bperm(v, lane ^ 32);
  return v;
}

struct GemmTile {
  const half_t* A; const half_t* A2; const float* mu; int lda;
  const half_t* Bt; int ldb; int K;
  half_t* C; int ldc; int epi;
};

template <bool MIX>
__device__ __forceinline__ void gemm_tile(const GemmTile& g, char* smem) {
  half_t* As = (half_t*)smem;
  half_t* Bs = (half_t*)(smem + 73728);
  const int tid = tidx(), lane = tid & 63, w = tid >> 6;
  const int wm = w >> 1, wn = w & 1, lr = lane & 15, lq = lane >> 4;
  const int ldr = tid >> 3, ldk = (tid & 7) * 8;
  f4 acc[4][4];
#pragma unroll
  for (int i = 0; i < 4; ++i)
#pragma unroll
    for (int j = 0; j < 4; ++j) acc[i][j] = (f4){0.f, 0.f, 0.f, 0.f};
  uint4 ra0, ra1, ra2, ra3, rb0, rb1;
  uint4 rx0, rx1, rx2, rx3;
  float4 mu0, mu1;
  const int nk = g.K >> 6;
  const half_t* Ap = g.A + (size_t)ldr * g.lda + ldk;
  const half_t* A2p = MIX ? g.A2 + (size_t)ldr * g.lda + ldk : nullptr;
  const float* mup = MIX ? g.mu + ldk : nullptr;
  const half_t* Bp = g.Bt + (size_t)ldr * g.ldb + ldk;
  const size_t astep = (size_t)64 * g.lda, bstep = (size_t)64 * g.ldb;
  half_t* asw = As + ldr * 72 + ldk;
  half_t* bsw = Bs + ldr * 72 + ldk;
  const half_t* asr = As + (wm * 64 + lr) * 72 + lq * 8;
  const half_t* bsr = Bs + (wn * 64 + lr) * 72 + lq * 8;

#define GLOAD(kt)                                              \
  {                                                            \
    const int k0 = (kt) * 64;                                  \
    ra0 = *(const uint4*)(Ap + k0);                            \
    ra1 = *(const uint4*)(Ap + astep + k0);                    \
    ra2 = *(const uint4*)(Ap + 2 * astep + k0);                \
    ra3 = *(const uint4*)(Ap + 3 * astep + k0);                \
    rb0 = *(const uint4*)(Bp + k0);                            \
    rb1 = *(const uint4*)(Bp + bstep + k0);                    \
    if (MIX) {                                                 \
      rx0 = *(const uint4*)(A2p + k0);                         \
      rx1 = *(const uint4*)(A2p + astep + k0);                 \
      rx2 = *(const uint4*)(A2p + 2 * astep + k0);             \
      rx3 = *(const uint4*)(A2p + 3 * astep + k0);             \
      mu0 = *(const float4*)(mup + k0);                        \
      mu1 = *(const float4*)(mup + k0 + 4);                    \
    }                                                          \
  }
#define MIXV(r, x) __builtin_bit_cast(uint4, (h8)(__builtin_bit_cast(h8, r) + __builtin_bit_cast(h8, x) * m))
#define SSTORE(buf)                                            \
  {                                                            \
    half_t* as = asw + (buf) * (256 * 72);                     \
    half_t* bs = bsw + (buf) * (128 * 72);                     \
    if (MIX) {                                                 \
      h8 m;                                                    \
      m[0] = (half_t)mu0.x; m[1] = (half_t)mu0.y; m[2] = (half_t)mu0.z; m[3] = (half_t)mu0.w; \
      m[4] = (half_t)mu1.x; m[5] = (half_t)mu1.y; m[6] = (half_t)mu1.z; m[7] = (half_t)mu1.w; \
      ra0 = MIXV(ra0, rx0); ra1 = MIXV(ra1, rx1); ra2 = MIXV(ra2, rx2); ra3 = MIXV(ra3, rx3); \
    }                                                          \
    *(uint4*)(as) = ra0;                                       \
    *(uint4*)(as + 64 * 72) = ra1;                             \
    *(uint4*)(as + 128 * 72) = ra2;                            \
    *(uint4*)(as + 192 * 72) = ra3;                            \
    *(uint4*)(bs) = rb0;                                       \
    *(uint4*)(bs + 64 * 72) = rb1;                             \
  }

  GLOAD(0);
  SSTORE(0);
  __syncthreads();
  for (int kt = 0; kt < nk; ++kt) {
    const bool more = kt + 1 < nk;
    if (more) GLOAD(kt + 1);
    __builtin_amdgcn_sched_barrier(0);
    {
      const half_t* as = asr + (kt & 1) * (256 * 72);
      const half_t* bs = bsr + (kt & 1) * (128 * 72);
#pragma unroll
      for (int ks = 0; ks < 2; ++ks) {
        h8 a[4], b[4];
#pragma unroll
        for (int i = 0; i < 4; ++i) {
          a[i] = *(const h8*)(as + i * 16 * 72 + ks * 32);
          b[i] = *(const h8*)(bs + i * 16 * 72 + ks * 32);
        }
#pragma unroll
        for (int mt = 0; mt < 4; ++mt)
#pragma unroll
          for (int nt = 0; nt < 4; ++nt)
            acc[mt][nt] = __builtin_amdgcn_mfma_f32_16x16x32_f16(b[nt], a[mt], acc[mt][nt], 0, 0, 0);
      }
    }
    if (more) SSTORE((kt + 1) & 1);
    __syncthreads();
  }
#undef GLOAD
#undef SSTORE
#undef MIXV
#pragma unroll
  for (int mt = 0; mt < 4; ++mt) {
    half_t* cp = g.C + (size_t)(wm * 64 + mt * 16 + lr) * g.ldc + wn * 64 + lq * 4;
#pragma unroll
    for (int nt = 0; nt < 4; ++nt) {
      h4 o;
#pragma unroll
      for (int j = 0; j < 4; ++j) {
        float v = acc[mt][nt][j];
        if (g.epi == 1) { v = fmaxf(v, 0.f); v = v * v; }
        else if (g.epi == 2) v = 1.f - 2.f / (__expf(2.f * v) + 1.f);
        else if (g.epi == 3) v = sigm(v);
        o[j] = (half_t)v;
      }
      *(h4*)(cp + nt * 16) = o;
    }
  }
}

__device__ __forceinline__ void gemm_tile2(const GemmTile& g, char* smem) {
  half_t* As = (half_t*)smem;
  half_t* Bs = (half_t*)(smem + 73728);
  const int tid = tidx(), lane = tid & 63, w = tid >> 6;
  const int wm = w >> 1, wn = w & 1, lr = lane & 15, lq = lane >> 4;
  const int ldr = tid >> 3, ldk = (tid & 7) * 8;
  f4 acc[4][4];
#pragma unroll
  for (int i = 0; i < 4; ++i)
#pragma unroll
    for (int j = 0; j < 4; ++j) acc[i][j] = (f4){0.f, 0.f, 0.f, 0.f};
  uint4 xa0, xa1, xa2, xa3, xb0, xb1;
  uint4 ya0, ya1, ya2, ya3, yb0, yb1;
  const int nk = g.K >> 6;
  const half_t* Ap = g.A + (size_t)ldr * g.lda + ldk;
  const half_t* Bp = g.Bt + (size_t)ldr * g.ldb + ldk;
  const size_t astep = (size_t)64 * g.lda, bstep = (size_t)64 * g.ldb;
  half_t* asw = As + ldr * 72 + ldk;
  half_t* bsw = Bs + ldr * 72 + ldk;
  const half_t* asr = As + (wm * 64 + lr) * 72 + lq * 8;
  const half_t* bsr = Bs + (wn * 64 + lr) * 72 + lq * 8;
#define GLD(S, kt)                                   \
  {                                                  \
    const int k0 = (kt) * 64;                        \
    S##a0 = *(const uint4*)(Ap + k0);                \
    S##a1 = *(const uint4*)(Ap + astep + k0);        \
    S##a2 = *(const uint4*)(Ap + 2 * astep + k0);    \
    S##a3 = *(const uint4*)(Ap + 3 * astep + k0);    \
    S##b0 = *(const uint4*)(Bp + k0);                \
    S##b1 = *(const uint4*)(Bp + bstep + k0);        \
  }
#define SST(S, buf)                                  \
  {                                                  \
    half_t* as = asw + (buf) * (256 * 72);           \
    half_t* bs = bsw + (buf) * (128 * 72);           \
    *(uint4*)(as) = S##a0;                           \
    *(uint4*)(as + 64 * 72) = S##a1;                 \
    *(uint4*)(as + 128 * 72) = S##a2;                \
    *(uint4*)(as + 192 * 72) = S##a3;                \
    *(uint4*)(bs) = S##b0;                           \
    *(uint4*)(bs + 64 * 72) = S##b1;                 \
  }
#define CMP(buf)                                                                                     \
  {                                                                                                  \
    const half_t* as = asr + (buf) * (256 * 72);                                                     \
    const half_t* bs = bsr + (buf) * (128 * 72);                                                     \
    _Pragma("unroll") for (int ks = 0; ks < 2; ++ks) {                                               \
      h8 a[4], b[4];                                                                                 \
      _Pragma("unroll") for (int i = 0; i < 4; ++i) {                                                \
        a[i] = *(const h8*)(as + i * 16 * 72 + ks * 32);                                             \
        b[i] = *(const h8*)(bs + i * 16 * 72 + ks * 32);                                             \
      }                                                                                              \
      _Pragma("unroll") for (int mt = 0; mt < 4; ++mt)                                               \
        _Pragma("unroll") for (int nt = 0; nt < 4; ++nt)                                             \
          acc[mt][nt] = __builtin_amdgcn_mfma_f32_16x16x32_f16(b[nt], a[mt], acc[mt][nt], 0, 0, 0);  \
    }                                                                                                \
  }
  GLD(x, 0);
  SST(x, 0);
  if (nk > 1) GLD(x, 1);
  if (nk > 2) GLD(y, 2);
  __syncthreads();
  for (int kt = 0; kt < nk; kt += 2) {
    CMP(0);
    if (kt + 1 < nk) SST(x, 1);
    if (kt + 3 < nk) GLD(x, kt + 3);
    __syncthreads();
    CMP(1);
    if (kt + 2 < nk) SST(y, 0);
    if (kt + 4 < nk) GLD(y, kt + 4);
    __syncthreads();
  }
#undef GLD
#undef SST
#undef CMP
#pragma unroll
  for (int mt = 0; mt < 4; ++mt) {
    half_t* cp = g.C + (size_t)(wm * 64 + mt * 16 + lr) * g.ldc + wn * 64 + lq * 4;
#pragma unroll
    for (int nt = 0; nt < 4; ++nt) {
      h4 o;
#pragma unroll
      for (int j = 0; j < 4; ++j) {
        float v = acc[mt][nt][j];
        if (g.epi == 1) { v = fmaxf(v, 0.f); v = v * v; }
        o[j] = (half_t)v;
      }
      *(h4*)(cp + nt * 16) = o;
    }
  }
}

__device__ __forceinline__ void gemm_tile3(const GemmTile& g, char* smem) {
  const int tid = tidx(), lane = tid & 63, w = tid >> 6;
  const int wm = w >> 1, wn = w & 1, lr = lane & 15, lq = lane >> 4;
  f4 acc[4][4];
#pragma unroll
  for (int i = 0; i < 4; ++i)
#pragma unroll
    for (int j = 0; j < 4; ++j) acc[i][j] = (f4){0.f, 0.f, 0.f, 0.f};
  const int nk = g.K >> 6;
  const int lrow = lane >> 3, lslot = lane & 7;
  const half_t* Ag[4];
  const half_t* Bg[2];
#pragma unroll
  for (int i = 0; i < 4; ++i) {
    const int row = (w * 4 + i) * 8 + lrow;
    Ag[i] = g.A + (size_t)row * g.lda + ((lslot ^ ((row >> 1) & 7)) * 8);
  }
#pragma unroll
  for (int i = 0; i < 2; ++i) {
    const int row = (w * 2 + i) * 8 + lrow;
    Bg[i] = g.Bt + (size_t)row * g.ldb + ((lslot ^ ((row >> 1) & 7)) * 8);
  }
  char* aw = smem + (w * 4) * 1024 + lane * 16;
  char* bw = smem + 32768 + (w * 2) * 1024 + lane * 16;
  const int swz = (lr >> 1) & 7;
  const int ko0 = ((0 + lq) ^ swz) * 16, ko1 = ((4 + lq) ^ swz) * 16;
  const char* ar = smem + (wm * 64 + lr) * 128;
  const char* br = smem + 32768 + (wn * 64 + lr) * 128;
#define ISSUE(kt, st)                                                                                      \
  {                                                                                                        \
    _Pragma("unroll") for (int i = 0; i < 4; ++i)                                                          \
      __builtin_amdgcn_global_load_lds((const unsigned*)(Ag[i] + (kt) * 64), (unsigned*)(aw + (st) * 49152 + i * 1024), 16, 0, 0); \
    _Pragma("unroll") for (int i = 0; i < 2; ++i)                                                          \
      __builtin_amdgcn_global_load_lds((const unsigned*)(Bg[i] + (kt) * 64), (unsigned*)(bw + (st) * 49152 + i * 1024), 16, 0, 0); \
  }
  ISSUE(0, 0);
  if (nk > 1) {
    ISSUE(1, 1);
    asm volatile("s_waitcnt vmcnt(6)" ::: "memory");
  } else {
    asm volatile("s_waitcnt vmcnt(0)" ::: "memory");
  }
  __builtin_amdgcn_s_barrier();
  asm volatile("" ::: "memory");
  h8 a0[4], b0[4], a1[4], b1[4];
#define LDF(fa, fb, stg, ko)                                             \
  {                                                                      \
    const char* as = ar + (stg) * 49152 + (ko);                          \
    const char* bs = br + (stg) * 49152 + (ko);                          \
    _Pragma("unroll") for (int i = 0; i < 4; ++i) {                      \
      fa[i] = *(const h8*)(as + i * 2048);                               \
      fb[i] = *(const h8*)(bs + i * 2048);                               \
    }                                                                    \
  }
#define MMA(fa, fb)                                                      \
  {                                                                      \
    _Pragma("unroll") for (int mt = 0; mt < 4; ++mt)                     \
      _Pragma("unroll") for (int nt = 0; nt < 4; ++nt)                   \
        acc[mt][nt] = __builtin_amdgcn_mfma_f32_16x16x32_f16(fb[nt], fa[mt], acc[mt][nt], 0, 0, 0); \
  }
  LDF(a0, b0, 0, ko0);
  int st = 0;
  for (int kt = 0; kt < nk; ++kt) {
    const bool more = kt + 2 < nk;
    int st1 = st + 1; if (st1 >= 3) st1 -= 3;
    int st2 = st + 2; if (st2 >= 3) st2 -= 3;
    if (more) ISSUE(kt + 2, st2);
    LDF(a1, b1, st, ko1);
    __builtin_amdgcn_sched_barrier(0);
    MMA(a0, b0);
    __builtin_amdgcn_sched_barrier(0);
    if (more) asm volatile("s_waitcnt vmcnt(6) lgkmcnt(0)" ::: "memory");
    else asm volatile("s_waitcnt vmcnt(0) lgkmcnt(0)" ::: "memory");
    __builtin_amdgcn_s_barrier();
    asm volatile("" ::: "memory");
    if (kt + 1 < nk) LDF(a0, b0, st1, ko0);
    __builtin_amdgcn_sched_barrier(0);
    MMA(a1, b1);
    __builtin_amdgcn_sched_barrier(0);
    st = st1;
  }
#undef LDF
#undef MMA
#undef ISSUE
  if (g.epi == 4) {
    half_t* vp = g.C + (size_t)((wm * 8 + wn) * 64) * 64 + lr;
#pragma unroll
    for (int mt = 0; mt < 4; ++mt)
#pragma unroll
      for (int nt = 0; nt < 4; ++nt)
#pragma unroll
        for (int j = 0; j < 4; ++j) vp[(nt * 16 + lq * 4 + j) * 64 + mt * 16] = (half_t)acc[mt][nt][j];
    return;
  }
#pragma unroll
  for (int mt = 0; mt < 4; ++mt) {
    half_t* cp = g.C + (size_t)(wm * 64 + mt * 16 + lr) * g.ldc + wn * 64 + lq * 4;
#pragma unroll
    for (int nt = 0; nt < 4; ++nt) {
      h4 o;
#pragma unroll
      for (int j = 0; j < 4; ++j) {
        float v = acc[mt][nt][j];
        if (g.epi == 1) { v = fmaxf(v, 0.f); v = v * v; }
        o[j] = (half_t)v;
      }
      *(h4*)(cp + nt * 16) = o;
    }
  }
}

__device__ __forceinline__ void gemm_tile4(const GemmTile& g, char* smem) {
  const int tid = tidx(), lane = tid & 63, w = tid >> 6;
  const int wm = w >> 1, wn = w & 1, lr = lane & 15, lq = lane >> 4;
  f4 acc[4][8];
#pragma unroll
  for (int i = 0; i < 4; ++i)
#pragma unroll
    for (int j = 0; j < 8; ++j) acc[i][j] = (f4){0.f, 0.f, 0.f, 0.f};
  const int nk = g.K >> 6;
  const int lrow = lane >> 3, lslot = lane & 7;
  const half_t* Ag[4];
  const half_t* Bg[4];
#pragma unroll
  for (int i = 0; i < 4; ++i) {
    const int row = (w * 4 + i) * 8 + lrow;
    const int so = (lslot ^ ((row >> 1) & 7)) * 8;
    Ag[i] = g.A + (size_t)row * g.lda + so;
    Bg[i] = g.Bt + (size_t)row * g.ldb + so;
  }
  char* aw = smem + (w * 4) * 1024 + lane * 16;
  char* bw = smem + 32768 + (w * 4) * 1024 + lane * 16;
  const int swz = (lr >> 1) & 7;
  const int ko0 = ((0 + lq) ^ swz) * 16, ko1 = ((4 + lq) ^ swz) * 16;
  const char* ar = smem + (wm * 64 + lr) * 128;
  const char* br = smem + 32768 + (wn * 128 + lr) * 128;
#define ISSUE4(kt, st)                                                                                     \
  {                                                                                                        \
    _Pragma("unroll") for (int i = 0; i < 4; ++i)                                                          \
      __builtin_amdgcn_global_load_lds((const unsigned*)(Ag[i] + (kt) * 64), (unsigned*)(aw + (st) * 65536 + i * 1024), 16, 0, 0); \
    _Pragma("unroll") for (int i = 0; i < 4; ++i)                                                          \
      __builtin_amdgcn_global_load_lds((const unsigned*)(Bg[i] + (kt) * 64), (unsigned*)(bw + (st) * 65536 + i * 1024), 16, 0, 0); \
  }
  ISSUE4(0, 0);
  asm volatile("s_waitcnt vmcnt(0)" ::: "memory");
  __builtin_amdgcn_s_barrier();
  asm volatile("" ::: "memory");
  for (int kt = 0; kt < nk; ++kt) {
    const int st = kt & 1;
    if (kt + 1 < nk) ISSUE4(kt + 1, st ^ 1);
    const char* as = ar + st * 65536;
    const char* bs = br + st * 65536;
#pragma unroll
    for (int ks = 0; ks < 2; ++ks) {
      const int ko = ks ? ko1 : ko0;
      h8 a[4], b[8];
#pragma unroll
      for (int i = 0; i < 4; ++i) a[i] = *(const h8*)(as + i * 2048 + ko);
#pragma unroll
      for (int i = 0; i < 8; ++i) b[i] = *(const h8*)(bs + i * 2048 + ko);
#pragma unroll
      for (int mt = 0; mt < 4; ++mt)
#pragma unroll
        for (int nt = 0; nt < 8; ++nt)
          acc[mt][nt] = __builtin_amdgcn_mfma_f32_16x16x32_f16(b[nt], a[mt], acc[mt][nt], 0, 0, 0);
    }
    asm volatile("s_waitcnt vmcnt(0) lgkmcnt(0)" ::: "memory");
    __builtin_amdgcn_s_barrier();
    asm volatile("" ::: "memory");
  }
#undef ISSUE4
  if (g.epi == 4) {
#pragma unroll
    for (int mt = 0; mt < 4; ++mt)
#pragma unroll
      for (int nt = 0; nt < 8; ++nt) {
        half_t* vp = g.C + (size_t)((wm * 8 + wn * 2 + (nt >> 2)) * 64) * 64 + lr;
#pragma unroll
        for (int j = 0; j < 4; ++j) vp[((nt & 3) * 16 + lq * 4 + j) * 64 + mt * 16] = (half_t)acc[mt][nt][j];
      }
    return;
  }
#pragma unroll
  for (int mt = 0; mt < 4; ++mt) {
    half_t* cp = g.C + (size_t)(wm * 64 + mt * 16 + lr) * g.ldc + wn * 128 + lq * 4;
#pragma unroll
    for (int nt = 0; nt < 8; ++nt) {
      h4 o;
#pragma unroll
      for (int j = 0; j < 4; ++j) {
        float v = acc[mt][nt][j];
        if (g.epi == 1) { v = fmaxf(v, 0.f); v = v * v; }
        o[j] = (half_t)v;
      }
      *(h4*)(cp + nt * 16) = o;
    }
  }
}

__device__ __forceinline__ int p8_lds_byte(int r, int c) {
  const int st = (r >> 4) * 2 + (c >> 5), rr = r & 15, cc = c & 31, ob = rr * 64 + cc * 2;
  return st * 1024 + (ob ^ (((ob >> 9) & 1) << 5));
}
__device__ __forceinline__ void p8_stage_rc(int b, int& R, int& C) {
  const int st = b / 1024, sb = b % 1024, swz = sb ^ (((sb >> 9) & 1) << 5);
  R = (st >> 1) * 16 + swz / 64;
  C = (st & 1) * 32 + (swz % 64) / 2;
}
__device__ __forceinline__ void gemm_tile8(const GemmTile& g, char* smem) {
  constexpr int HT = 128 * 64;
  half_t* shm = (half_t*)smem;
  const int tid = tidx();
  const int wid = tid >> 6, lane = tid & 63, wr = wid >> 2, wc = wid & 3, fr = lane & 15, fq = lane >> 4;
  const half_t* A = g.A;
  const half_t* Bt = g.Bt;
  const int lda = g.lda, ldb = g.lda;
#define P8_SA(b, h) (shm + ((b) * 2 + (h)) * HT)
#define P8_SB(b, h) (shm + (4 + (b) * 2 + (h)) * HT)
  int sr0, sc0, sr1, sc1;
  p8_stage_rc(tid * 16, sr0, sc0);
  p8_stage_rc(tid * 16 + 8192, sr1, sc1);
  const int ao0 = sr0 * lda + sc0, ao1 = sr1 * lda + sc1;
#define bo0 ao0
#define bo1 ao1
#define P8_STAGE_A(Pp, br, kt)                                                                                   \
  {                                                                                                              \
    const half_t* gb_ = A + (size_t)(br) * lda + (size_t)(kt) * 64;                                              \
    __builtin_amdgcn_global_load_lds((const unsigned*)(gb_ + ao0), (unsigned*)((char*)(Pp) + tid * 16), 16, 0, 0);        \
    __builtin_amdgcn_global_load_lds((const unsigned*)(gb_ + ao1), (unsigned*)((char*)(Pp) + tid * 16 + 8192), 16, 0, 0); \
  }
#define P8_STAGE_B(Pp, br, kt)                                                                                   \
  {                                                                                                              \
    const half_t* gb_ = Bt + (size_t)(br) * ldb + (size_t)(kt) * 64;                                             \
    __builtin_amdgcn_global_load_lds((const unsigned*)(gb_ + bo0), (unsigned*)((char*)(Pp) + tid * 16), 16, 0, 0);        \
    __builtin_amdgcn_global_load_lds((const unsigned*)(gb_ + bo1), (unsigned*)((char*)(Pp) + tid * 16 + 8192), 16, 0, 0); \
  }
  const char* abase = smem + p8_lds_byte(wr * 64 + fr, fq * 8);
  const char* bbase = smem + 4 * HT * 2 + p8_lds_byte(wc * 32 + fr, fq * 8);
#define P8_LDA(dst, b, h)                                                                                        \
  _Pragma("unroll") for (int m = 0; m < 4; ++m) _Pragma("unroll") for (int k = 0; k < 2; ++k)                    \
      dst[m][k] = *(const h8*)(abase + ((b) * 2 + (h)) * (HT * 2) + (m * 2 + k) * 1024);
#define P8_LDB(dst, b, h)                                                                                        \
  _Pragma("unroll") for (int n = 0; n < 2; ++n) _Pragma("unroll") for (int k = 0; k < 2; ++k)                    \
      dst[n][k] = *(const h8*)(bbase + ((b) * 2 + (h)) * (HT * 2) + (n * 2 + k) * 1024);
#define P8_MMA(ai, bj, Af, Bf)                                                                                   \
  {                                                                                                              \
    __builtin_amdgcn_s_setprio(1);                                                                               \
    _Pragma("unroll") for (int m = 0; m < 4; ++m) _Pragma("unroll") for (int n = 0; n < 2; ++n)                  \
        _Pragma("unroll") for (int k = 0; k < 2; ++k)                                                            \
            acc[ai][bj][m][n] = __builtin_amdgcn_mfma_f32_16x16x32_f16(Bf[n][k], Af[m][k], acc[ai][bj][m][n], 0, 0, 0); \
    __builtin_amdgcn_s_setprio(0);                                                                               \
  }
#define P8_WAIT_V(n) asm volatile("s_waitcnt vmcnt(" #n ")" ::: "memory")
#define P8_WAIT_L(n) asm volatile("s_waitcnt lgkmcnt(" #n ")" ::: "memory")
#define P8_BAR __builtin_amdgcn_s_barrier()
#define P8_SCHED __builtin_amdgcn_sched_barrier(0)

  f4 acc[2][2][4][2];
#pragma unroll
  for (int i0 = 0; i0 < 2; ++i0)
#pragma unroll
    for (int i1 = 0; i1 < 2; ++i1)
#pragma unroll
      for (int i2 = 0; i2 < 4; ++i2)
#pragma unroll
        for (int i3 = 0; i3 < 2; ++i3) acc[i0][i1][i2][i3] = (f4){0.f, 0.f, 0.f, 0.f};
  h8 At[4][2], B0[2][2], B1[2][2];
  const int nt = g.K >> 6;
  P8_STAGE_B(P8_SB(0, 0), 0, 0); P8_STAGE_A(P8_SA(0, 0), 0, 0);
  P8_STAGE_B(P8_SB(0, 1), 128, 0); P8_STAGE_A(P8_SA(0, 1), 128, 0);
  if (wr == 1) P8_BAR;
  P8_WAIT_V(4); P8_BAR;
  P8_STAGE_B(P8_SB(1, 0), 0, 1); P8_STAGE_A(P8_SA(1, 0), 0, 1); P8_STAGE_B(P8_SB(1, 1), 128, 1);
  P8_WAIT_V(6); P8_BAR;
  for (int t = 0; t < nt - 2; t += 2) {
    P8_LDB(B0, 0, 0); P8_SCHED; P8_LDA(At, 0, 0); P8_STAGE_A(P8_SA(1, 1), 128, t + 1);
    P8_WAIT_L(8); P8_BAR; P8_WAIT_L(0); P8_MMA(0, 0, At, B0); P8_BAR; P8_SCHED;
    P8_LDB(B1, 0, 1); P8_STAGE_B(P8_SB(0, 0), 0, t + 2);
    P8_BAR; P8_WAIT_L(0); P8_MMA(0, 1, At, B1); P8_BAR;
    P8_LDA(At, 0, 1); P8_STAGE_A(P8_SA(0, 0), 0, t + 2);
    P8_BAR; P8_WAIT_L(0); P8_MMA(1, 0, At, B0); P8_BAR; P8_SCHED;
    P8_STAGE_B(P8_SB(0, 1), 128, t + 2);
    P8_WAIT_V(6); P8_BAR; P8_MMA(1, 1, At, B1); P8_BAR;
    P8_LDB(B0, 1, 0); P8_SCHED; P8_LDA(At, 1, 0); P8_STAGE_A(P8_SA(0, 1), 128, t + 2);
    P8_WAIT_L(8); P8_BAR; P8_WAIT_L(0); P8_MMA(0, 0, At, B0); P8_BAR; P8_SCHED;
    P8_LDB(B1, 1, 1); P8_STAGE_B(P8_SB(1, 0), 0, t + 3);
    P8_BAR; P8_WAIT_L(0); P8_MMA(0, 1, At, B1); P8_BAR;
    P8_LDA(At, 1, 1); P8_STAGE_A(P8_SA(1, 0), 0, t + 3);
    P8_BAR; P8_WAIT_L(0); P8_MMA(1, 0, At, B0); P8_BAR; P8_SCHED;
    P8_STAGE_B(P8_SB(1, 1), 128, t + 3);
    P8_WAIT_V(6); P8_BAR; P8_MMA(1, 1, At, B1); P8_BAR;
  }
  {
    P8_LDB(B0, 0, 0); P8_LDA(At, 0, 0); P8_STAGE_A(P8_SA(1, 1), 128, nt - 1);
    P8_BAR; P8_WAIT_L(0); P8_MMA(0, 0, At, B0); P8_BAR;
    P8_LDB(B1, 0, 1); P8_BAR; P8_WAIT_L(0); P8_MMA(0, 1, At, B1); P8_BAR;
    P8_LDA(At, 0, 1); P8_WAIT_V(4); P8_BAR; P8_WAIT_L(0); P8_MMA(1, 0, At, B0); P8_MMA(1, 1, At, B1); P8_BAR;
  }
  {
    P8_LDB(B0, 1, 0); P8_LDA(At, 1, 0); P8_WAIT_V(2); P8_BAR; P8_WAIT_L(0); P8_MMA(0, 0, At, B0); P8_BAR;
    P8_LDB(B1, 1, 1); P8_WAIT_V(0); P8_BAR; P8_WAIT_L(0); P8_MMA(0, 1, At, B1); P8_BAR;
    P8_LDA(At, 1, 1); P8_BAR; P8_WAIT_L(0); P8_MMA(1, 0, At, B0); P8_MMA(1, 1, At, B1); P8_BAR;
  }
  if (wr == 0) P8_BAR;
  asm volatile("" ::: "memory");
#pragma unroll
  for (int ai = 0; ai < 2; ++ai)
#pragma unroll
    for (int m = 0; m < 4; ++m) {
      const int row = ai * 128 + wr * 64 + m * 16 + fr;
#pragma unroll
      for (int bj = 0; bj < 2; ++bj)
#pragma unroll
        for (int n = 0; n < 2; ++n) {
          const int col = bj * 128 + wc * 32 + n * 16 + fq * 4;
          if (g.epi == 4) {
            half_t* vp = g.C + (size_t)(((row >> 6) * 8 + (col >> 6)) * 64 + (col & 63)) * 64 + (row & 63);
#pragma unroll
            for (int j = 0; j < 4; ++j) vp[j * 64] = (half_t)acc[ai][bj][m][n][j];
          } else {
            h4 o;
#pragma unroll
            for (int j = 0; j < 4; ++j) {
              float v = acc[ai][bj][m][n][j];
              if (g.epi == 1) { v = fmaxf(v, 0.f); v = v * v; }
              o[j] = (half_t)v;
            }
            *(h4*)(g.C + (size_t)row * g.ldc + col) = o;
          }
        }
    }
#undef bo0
#undef bo1
#undef P8_SA
#undef P8_SB
#undef P8_STAGE_A
#undef P8_STAGE_B
#undef P8_LDA
#undef P8_LDB
#undef P8_MMA
#undef P8_WAIT_V
#undef P8_WAIT_L
#undef P8_BAR
#undef P8_SCHED
}

__device__ __forceinline__ void gemm_phase(const P& p, const half_t* A, int lda, const half_t* Bt, int ldb, int K, half_t* C, int ldc,
                                           int epi, int nMt, int nNt, int feat, char* smem) {
  char* ws = (p.ws + opaque_zero());
  for (int t = bidx(); t < nMt * nNt; t += gridDim.x) {
    const int gsz = 16 * nNt, first = (t / gsz) * 16, gm = min(nMt - first, 16);
    const int mt = first + (t % gsz) % gm, nt = (t % gsz) / gm;
    GemmTile g;
    g.A = A + (size_t)mt * 256 * lda; g.A2 = nullptr; g.mu = nullptr; g.lda = lda;
    const int tw = (feat >= 2) ? 256 : 128;
    g.Bt = Bt + (size_t)nt * tw * ldb; g.ldb = ldb; g.K = K;
    g.C = C + (size_t)mt * 256 * ldc + nt * tw; g.ldc = ldc; g.epi = epi;
    if (feat == 2 && nt >= 6) {
      g.epi = 4;
      g.C = (half_t*)(ws + OFF_A1) + ((size_t)(mt * 4) * 8 + (nt - 6) * 4) * 4096;
    }
    if (feat == 1) {
      g.A2 = (const half_t*)(ws + OFF_A1) + (size_t)mt * 256 * 1024;
      const int grp = nt >> 3, sub = nt & 7;
      int mixi;
      if (grp < 3) {
        mixi = grp == 0 ? 0 : (grp == 1 ? 2 : 3);
        g.Bt = (const half_t*)(ws + (grp == 0 ? OFF_WR : (grp == 1 ? OFF_WK : OFF_WV))) + (size_t)sub * 128 * 1024;
        g.C = (half_t*)(ws + (grp == 0 ? OFF_RR : (grp == 1 ? OFF_KK : OFF_VV))) + (size_t)mt * 256 * 1024 + sub * 128;
      } else {
        mixi = sub == 0 ? 1 : (sub == 1 ? 4 : 5);
        g.Bt = (const half_t*)(ws + OFF_L1) + (size_t)sub * 128 * 1024;
        g.C = (half_t*)(ws + OFF_L) + (size_t)mt * 256 * 384 + sub * 128;
        g.ldc = 384;
        g.epi = sub == 0 ? 2 : (sub == 1 ? 0 : 3);
      }
      g.mu = p.rw_mu + mixi * 1024;
    }
    if (feat == 1) gemm_tile<true>(g, smem); else if (feat >= 2) gemm_tile8(g, smem); else gemm_tile3(g, smem);
  }
}

__device__ void xpose_seg(const float* src, int ldsrc, int K, int N, half_t* dst, int lddst, int koff, int& base,
                          char* smem) {
  float* ts = (float*)smem;
  const int tid = tidx(), G = gridDim.x;
  const int tkn = K >> 6, tnn = N >> 6, cnt = tkn * tnn;
  int t0 = ((int)bidx() - (base % G) + G) % G;
  for (int t = t0; t < cnt; t += G) {
    const int k0 = (t % tkn) * 64, n0 = (t / tkn) * 64;
#pragma unroll
    for (int i = 0; i < 2; ++i) {
      const int c = tid + 512 * i, r = c >> 4, c4 = (c & 15) * 4;
      const float4 v = *(const float4*)(src + (size_t)(k0 + r) * ldsrc + n0 + c4);
      float* d = ts + r * 65 + c4;
      d[0] = v.x; d[1] = v.y; d[2] = v.z; d[3] = v.w;
    }
    __syncthreads();
    {
      const int n = tid >> 3, kc = (tid & 7) * 8;
      h8 o;
#pragma unroll
      for (int i = 0; i < 8; ++i) o[i] = (half_t)ts[(kc + i) * 65 + n];
      *(h8*)(dst + (size_t)(n0 + n) * lddst + koff + k0 + kc) = o;
    }
    __syncthreads();
  }
  base += cnt;
}

__device__ void phase_prep(const P& p, char* smem) {
  const int tid = tidx();
  char* ws = (p.ws + opaque_zero());
  float* MOD = (float*)(ws + OFF_MOD);
  if (bidx() < 192 || gridDim.x < 256) {
    float* sl = (float*)smem;
    for (int i = tid; i < 9216; i += 512) {
      const int b = i >> 10, k = i & 1023;
      const float cv = b < 8 ? p.c[b * 1024 + k] : p.c_ctx[k];
      sl[i] = cv / (1.f + __expf(-cv));
    }
    __syncthreads();
    float* red = sl + 9216;
    for (int item = bidx(); item < 192; item += gridDim.x) {
      const int l = item / 96, n0 = (item % 96) * 64, cn = tid & 63, kq = tid >> 6;
      float acc[9];
#pragma unroll
      for (int b = 0; b < 9; ++b) acc[b] = 0.f;
      const float* wp = p.ada_w + (size_t)l * 1024 * 6144 + n0 + cn;
#pragma unroll 4
      for (int k = kq * 128; k < kq * 128 + 128; ++k) {
        const float wv = wp[(size_t)k * 6144];
#pragma unroll
        for (int b = 0; b < 9; ++b) acc[b] += sl[b * 1024 + k] * wv;
      }
#pragma unroll
      for (int b = 0; b < 9; ++b) red[(kq * 9 + b) * 64 + cn] = acc[b];
      __syncthreads();
      for (int i = tid; i < 576; i += 512) {
        const int b = i >> 6, c = i & 63;
        float s = 0.f;
#pragma unroll
        for (int q = 0; q < 8; ++q) s += red[(q * 9 + b) * 64 + c];
        MOD[(size_t)(l * 9 + b) * 6144 + n0 + c] = s + p.ada_b[l * 6144 + n0 + c];
      }
      __syncthreads();
    }
  }
  for (int it = bidx(); it < 256; it += gridDim.x) {
    if (it < 192) continue;
    const int fi = it - 192, gi = fi >> 4, n0 = (fi & 15) * 64, n = tid & 63, ig = tid >> 6;
    float acc[16];
#pragma unroll
    for (int i = 0; i < 16; ++i) acc[i] = 0.f;
    for (int j = 0; j < 128; ++j) {
      const float wv = p.ev_w_out[(size_t)(gi * 128 + j) * 1024 + n0 + n] * p.ev_pool_scale[gi * 128 + j];
      const float* pw = p.ev_pool_w + ((size_t)gi * 128 + ig * 16) * 128 + j;
#pragma unroll
      for (int i = 0; i < 16; ++i) acc[i] += pw[i * 128] * wv;
    }
    h8 o0, o1;
#pragma unroll
    for (int i = 0; i < 8; ++i) { o0[i] = (half_t)acc[i]; o1[i] = (half_t)acc[8 + i]; }
    half_t* d = (half_t*)(ws + OFF_WOUT) + (size_t)(n0 + n) * 1024 + gi * 128 + ig * 16;
    *(h8*)d = o0;
    *(h8*)(d + 8) = o1;
  }
  __syncthreads();
  int base = 0;
  xpose_seg(p.ev_w_in, 2048, 1024, 2048, (half_t*)(ws + OFF_WIN), 1024, 0, base, smem);
  xpose_seg(p.ev_w_out + 512 * 1024, 1024, 512, 1024, (half_t*)(ws + OFF_WOUT), 1024, 512, base, smem);
  for (int l = 0; l < 2; ++l) {
    xpose_seg(p.mlp_w1 + (size_t)l * 1024 * 4096, 4096, 1024, 4096, (half_t*)(ws + OFF_M1 + l * 8 * MIB), 1024, 0, base, smem);
    xpose_seg(p.mlp_w2 + (size_t)l * 1024 * 4096, 1024, 4096, 1024, (half_t*)(ws + OFF_M2 + l * 8 * MIB), 4096, 0, base, smem);
  }
  xpose_seg(p.rw_wr, 1024, 1024, 1024, (half_t*)(ws + OFF_WR), 1024, 0, base, smem);
  xpose_seg(p.rw_wk, 1024, 1024, 1024, (half_t*)(ws + OFF_WK), 1024, 0, base, smem);
  xpose_seg(p.rw_wv, 1024, 1024, 1024, (half_t*)(ws + OFF_WV), 1024, 0, base, smem);
  xpose_seg(p.rw_wo, 1024, 1024, 1024, (half_t*)(ws + OFF_WO), 1024, 0, base, smem);
  for (int d = 0; d < 2; ++d) {
    xpose_seg(p.rw_w1 + (size_t)d * 1024 * 64, 64, 1024, 64, (half_t*)(ws + OFF_L1) + (size_t)(d * 64) * 1024, 1024, 0, base, smem);
    xpose_seg(p.rw_a1 + (size_t)d * 1024 * 64, 64, 1024, 64, (half_t*)(ws + OFF_L1) + (size_t)(128 + d * 64) * 1024, 1024, 0, base, smem);
    xpose_seg(p.rw_w2 + (size_t)d * 64 * 1024, 1024, 64, 1024, (half_t*)(ws + OFF_W2) + (size_t)d * 1024 * 64, 64, 0, base, smem);
    xpose_seg(p.rw_a2 + (size_t)d * 64 * 1024, 1024, 64, 1024, (half_t*)(ws + OFF_A2) + (size_t)d * 1024 * 64, 64, 0, base, smem);
  }
  xpose_seg(p.rw_g1, 128, 1024, 128, (half_t*)(ws + OFF_L1) + (size_t)256 * 1024, 1024, 0, base, smem);
  xpose_seg(p.rw_g2, 1024, 128, 1024, (half_t*)(ws + OFF_G2), 128, 0, base, smem);
}

__device__ void phase_rowwise(const P& p, int mode) {
  const int lane = tidx() & 63;
  const int gw = bidx() * 8 + (tidx() >> 6), nw = gridDim.x * 8;
  char* ws = (p.ws + opaque_zero());
  const float* MOD = (const float*)(ws + OFF_MOD);
  float* XC = (float*)(ws + OFF_XC);
  half_t* H = (half_t*)(ws + OFF_A0);
  const half_t* Y = (const half_t*)(ws + OFF_A1);
  const int nrows = (mode >= 3) ? RL : RT;
  const int per = (nrows + nw - 1) / nw;
  const int r0 = gw * per, r1 = min(r0 + per, nrows);
  if (r0 >= r1) return;
  const bool hasY = mode != 0, hasH = mode != 4;
  const float EPS = opaque_f(1e-6f);
  const int lyr = (mode <= 1) ? 0 : ((mode == 2) ? 0 : 1);
  const int gyi = (mode == 1) ? 1 : (mode == 2 ? 3 : (mode == 3 ? 5 : 7));
  const int gti = (mode == 1) ? 2 : (mode == 2 ? 5 : (mode == 3 ? 2 : 5));
  const int hl = (mode <= 1) ? 0 : 1;
  const int ghi = (mode == 0) ? 0 : (mode == 1 ? 2 : (mode == 2 ? 4 : 6));
  const int shi = (mode == 0 || mode == 2) ? 0 : 3;
  auto xsrc = [&](int row) -> const float* {
    if (mode <= 1) return row < RL ? p.x + (size_t)row * 1024 : p.ctx + (size_t)(row - RL) * 1024;
    return row < RL ? p.out + (size_t)row * 1024 : XC + (size_t)(row - RL) * 1024;
  };
  auto xdst = [&](int row) -> float* { return row < RL ? p.out + (size_t)row * 1024 : XC + (size_t)(row - RL) * 1024; };
  float4 gy[4], gt[4], gh[4], s1[4], s2[4];
  int cur_mi = -1;
  float4 nx[4];
  h4 ny[4];
  {
    const float* xs = xsrc(r0);
#pragma unroll
    for (int i = 0; i < 4; ++i) nx[i] = *(const float4*)(xs + i * 256 + lane * 4);
    if (hasY) {
#pragma unroll
      for (int i = 0; i < 4; ++i) ny[i] = *(const h4*)(Y + (size_t)r0 * 1024 + i * 256 + lane * 4);
    }
  }
  for (int row = r0; row < r1; ++row) {
    float xv[4][4];
    h4 yh[4];
#pragma unroll
    for (int i = 0; i < 4; ++i) { xv[i][0] = nx[i].x; xv[i][1] = nx[i].y; xv[i][2] = nx[i].z; xv[i][3] = nx[i].w; yh[i] = ny[i]; }
    if (row + 1 < r1) {
      const float* xs = xsrc(row + 1);
#pragma unroll
      for (int i = 0; i < 4; ++i) nx[i] = *(const float4*)(xs + i * 256 + lane * 4);
      if (hasY) {
#pragma unroll
        for (int i = 0; i < 4; ++i) ny[i] = *(const h4*)(Y + (size_t)(row + 1) * 1024 + i * 256 + lane * 4);
      }
    }
    const int mi = row < RL ? (row >> 12) : 8;
    if (mi != cur_mi) {
      cur_mi = mi;
      const float* mg = MOD + (size_t)(lyr * 9 + mi) * 6144;
      const float* mh = MOD + (size_t)(hl * 9 + mi) * 6144;
#pragma unroll
      for (int i = 0; i < 4; ++i) {
        const int o = i * 256 + lane * 4;
        if (hasY) { gy[i] = *(const float4*)(p.norm_g + gyi * 1024 + o); gt[i] = *(const float4*)(mg + gti * 1024 + o); }
        if (hasH) {
          gh[i] = *(const float4*)(p.norm_g + ghi * 1024 + o);
          s1[i] = *(const float4*)(mh + shi * 1024 + o);
          s2[i] = *(const float4*)(mh + (shi + 1) * 1024 + o);
        }
      }
    }
    if (hasY) {
      float yv[4][4];
      float ss = 0.f;
#pragma unroll
      for (int i = 0; i < 4; ++i)
#pragma unroll
        for (int k = 0; k < 4; ++k) { yv[i][k] = (float)yh[i][k]; ss += yv[i][k] * yv[i][k]; }
      ss = wave_sum(ss, lane);
      const float rs = rsqrtf(ss * (1.f / 1024.f) + EPS);
      float* xo = xdst(row);
#pragma unroll
      for (int i = 0; i < 4; ++i) {
        xv[i][0] += gt[i].x * (yv[i][0] * rs * gy[i].x);
        xv[i][1] += gt[i].y * (yv[i][1] * rs * gy[i].y);
        xv[i][2] += gt[i].z * (yv[i][2] * rs * gy[i].z);
        xv[i][3] += gt[i].w * (yv[i][3] * rs * gy[i].w);
        *(float4*)(xo + i * 256 + lane * 4) = make_float4(xv[i][0], xv[i][1], xv[i][2], xv[i][3]);
      }
    }
    if (hasH) {
      float ss = 0.f;
#pragma unroll
      for (int i = 0; i < 4; ++i)
#pragma unroll
        for (int k = 0; k < 4; ++k) ss += xv[i][k] * xv[i][k];
      ss = wave_sum(ss, lane);
      const float rs = rsqrtf(ss * (1.f / 1024.f) + EPS);
      half_t* ho = H + (size_t)row * 1024;
#pragma unroll
      for (int i = 0; i < 4; ++i) {
        h4 o;
        o[0] = (half_t)(xv[i][0] * rs * gh[i].x * (1.f + s2[i].x) + s1[i].x);
        o[1] = (half_t)(xv[i][1] * rs * gh[i].y * (1.f + s2[i].y) + s1[i].y);
        o[2] = (half_t)(xv[i][2] * rs * gh[i].z * (1.f + s2[i].z) + s1[i].z);
        o[3] = (half_t)(xv[i][3] * rs * gh[i].w * (1.f + s2[i].w) + s1[i].w);
        *(h4*)(ho + i * 256 + lane * 4) = o;
      }
    }
  }
}

__device__ __forceinline__ int clampi(int v, int lo, int hi) { return v < lo ? lo : (v > hi ? hi : v); }

__device__ void attn_item(const P& p, int item, char* smem) {
  half_t* Ks = (half_t*)smem;
  half_t* Vt = Ks + 2 * 64 * 72;
  float* rpbs = (float*)(smem + 36864);
  const int tid = tidx(), lane = tid & 63, w = tid >> 6, lr = lane & 15, lq = lane >> 4;
  const half_t* U = (const half_t*)((p.ws + opaque_zero()) + OFF_U);
  half_t* Z = (half_t*)((p.ws + opaque_zero()) + OFF_Z);
  const bool isctx = item >= 2048;
  int b, h, qrow, nlat = 0, start0 = 0, my_r = 0, my_start = 0, cw = 0, cs = 0, qcol = 0;
  if (!isctx) {
    b = item >> 8; h = (item >> 5) & 7;
    const int r0 = (item & 31) * 2;
    my_r = r0 + (w >> 2);
    const int cgp = w & 3;
    qcol = cgp * 16 + lr;
    qrow = b * 4096 + my_r * 64 + qcol;
    start0 = clampi(r0 - 4, 0, 56);
    const int start1 = clampi(r0 + 1 - 4, 0, 56);
    nlat = start1 + 8 - start0;
    my_start = clampi(my_r - 4, 0, 56);
    cw = clampi(cgp * 16 - 8, 0, 32);
    cs = clampi(qcol - 8, 0, 48);
  } else {
    const int it = item - 2048;
    b = it >> 4; h = (it >> 1) & 7;
    qrow = RL + b * 256 + (it & 1) * 128 + w * 16 + lr;
  }
  const int ntiles = nlat + 4;
  h8 qf[2];
#pragma unroll
  for (int ks = 0; ks < 2; ++ks) {
    h8 t = *(const h8*)(U + (size_t)qrow * 2048 + 512 + h * 64 + ks * 32 + lq * 8);
#pragma unroll
    for (int i = 0; i < 8; ++i) t[i] = t[i] * (half_t)0.125f;
    qf[ks] = t;
  }
  if (!isctx)
    for (int i = tid; i < 465; i += 512) rpbs[i] = p.ev_rpb[h * 465 + i];

  const int skey = tid >> 3, sd = (tid & 7) * 8;
  uint4 kA, vA, kB, vB;
  auto tile_row0 = [&](int i) -> int { return i < nlat ? b * 4096 + (start0 + i) * 64 : RL + b * 256 + (i - nlat) * 64; };
  const half_t* VTg = (const half_t*)((p.ws + opaque_zero()) + OFF_A1);
#define AT_GLOAD(kr, vr, i)                                                                            \
  {                                                                                                    \
    const int r0t = tile_row0(i);                                                                      \
    kr = *(const uint4*)(U + (size_t)(r0t + skey) * 2048 + 1024 + h * 64 + sd);                        \
    vr = *(const uint4*)(VTg + ((size_t)(r0t >> 6) * 8 + h) * 4096 + skey * 64 + sd);                  \
  }
#define AT_SSTORE(kr, vr, buf)                                                                         \
  {                                                                                                    \
    *(uint4*)(Ks + (buf) * 4608 + skey * 72 + sd) = kr;                                                \
    *(uint4*)(Vt + (buf) * 4608 + skey * 72 + sd) = vr;                                                \
  }
  f4 o[4];
#pragma unroll
  for (int i = 0; i < 4; ++i) o[i] = (f4){0.f, 0.f, 0.f, 0.f};
  const float NEG = opaque_f(-1e30f);
  float m = NEG, l = 0.f;

  AT_GLOAD(kA, vA, 0);
  AT_SSTORE(kA, vA, 0);
  AT_GLOAD(kA, vA, 1);
  AT_GLOAD(kB, vB, 2);
  __syncthreads();
  for (int i = 0; i < ntiles; ++i) {
    const int buf = i & 1;
    const bool lt = i < nlat;
    const int kr_abs = start0 + i;
    const bool active = !lt || (kr_abs >= my_start && kr_abs < my_start + 8);
    if (active) {
      const int npairs = lt ? 1 : 2;
      for (int pi = 0; pi < npairs; ++pi) {
        const int kb = lt ? cw : pi * 32;
        f4 s[2];
#pragma unroll
        for (int st = 0; st < 2; ++st) {
          f4 z = (f4){0.f, 0.f, 0.f, 0.f};
#pragma unroll
          for (int ks = 0; ks < 2; ++ks) {
            const h8 kf = *(const h8*)(Ks + buf * 4608 + (kb + st * 16 + lr) * 72 + ks * 32 + lq * 8);
            z = __builtin_amdgcn_mfma_f32_16x16x32_f16(kf, qf[ks], z, 0, 0, 0);
          }
          s[st] = z;
        }
        float tmax = NEG;
#pragma unroll
        for (int st = 0; st < 2; ++st)
#pragma unroll
          for (int j = 0; j < 4; ++j) {
            float v = s[st][j];
            if (lt) {
              const int kc = kb + st * 16 + lq * 4 + j;
              const bool ok = (kc >= cs) && (kc < cs + 16);
              const int dc = clampi(kc - qcol + 15, 0, 30);
              const int dr = kr_abs - my_r + 7;
              v = ok ? v + rpbs[dr * 31 + dc] : NEG;
            }
            s[st][j] = v;
            tmax = fmaxf(tmax, v);
          }
        tmax = fmaxf(tmax, bperm(tmax, lane ^ 16));
        tmax = fmaxf(tmax, bperm(tmax, lane ^ 32));
        const float mn = fmaxf(m, tmax);
        const float alpha = __expf(m - mn);
        m = mn;
        h8 pb;
        float ps = 0.f;
#pragma unroll
        for (int st = 0; st < 2; ++st)
#pragma unroll
          for (int j = 0; j < 4; ++j) {
            const float e = __expf(s[st][j] - mn);
            ps += e;
            pb[st * 4 + j] = (half_t)e;
          }
        l = l * alpha + ps;
#pragma unroll
        for (int dt = 0; dt < 4; ++dt) {
          o[dt] = o[dt] * alpha;
          const half_t* vp = Vt + buf * 4608 + (dt * 16 + lr) * 72 + kb + lq * 4;
          const h4 v0 = *(const h4*)vp;
          const h4 v1 = *(const h4*)(vp + 16);
          h8 vf;
          vf[0] = v0[0]; vf[1] = v0[1]; vf[2] = v0[2]; vf[3] = v0[3];
          vf[4] = v1[0]; vf[5] = v1[1]; vf[6] = v1[2]; vf[7] = v1[3];
          o[dt] = __builtin_amdgcn_mfma_f32_16x16x32_f16(vf, pb, o[dt], 0, 0, 0);
        }
      }
    }
    if (i + 1 < ntiles) {
      if ((i + 1) & 1) {
        AT_SSTORE(kA, vA, 1);
        if (i + 3 < ntiles) AT_GLOAD(kA, vA, i + 3);
      } else {
        AT_SSTORE(kB, vB, 0);
        if (i + 3 < ntiles) AT_GLOAD(kB, vB, i + 3);
      }
    }
    __syncthreads();
  }
#undef AT_GLOAD
#undef AT_SSTORE
  l += bperm(l, lane ^ 16);
  l += bperm(l, lane ^ 32);
  const float inv = 1.f / l;
#pragma unroll
  for (int dt = 0; dt < 4; ++dt) {
    h4 ov;
#pragma unroll
    for (int j = 0; j < 4; ++j) ov[j] = (half_t)(o[dt][j] * inv);
    *(h4*)(Z + (size_t)qrow * 1024 + 512 + h * 64 + dt * 16 + lq * 4) = ov;
  }
}

template <int HW>
__device__ __forceinline__ void pool_rows(const float (&pre)[4][25], int tl0, int L, half_t* zp) {
#pragma unroll
  for (int r = 0; r < 8; ++r) {
    const int tl = tl0 + r;
    const int lo = max(tl - HW, 0), hi = min(tl + HW, L);
    const float inv = 1.f / (float)(hi - lo);
    h4 o;
#pragma unroll
    for (int c = 0; c < 4; ++c) {
      const float sum = pre[c][8 + r + HW] - pre[c][8 + r - HW];
      const float cur = pre[c][8 + r + 1] - pre[c][8 + r];
      o[c] = (half_t)(sum * inv - cur);
    }
    *(h4*)(zp + (size_t)r * 1024) = o;
  }
}

__device__ void pool_item(const P& p, int item) {
  const half_t* U = (const half_t*)((p.ws + opaque_zero()) + OFF_U);
  half_t* Z = (half_t*)((p.ws + opaque_zero()) + OFF_Z);
  const int tid = tidx();
  const int c4 = (tid & 127) * 4, gi = c4 >> 7;
  const int row0 = item * 32 + (tid >> 7) * 8;
  int s0, L;
  if (row0 < RL) { s0 = row0 & ~4095; L = 4096; } else { s0 = RL + ((row0 - RL) & ~255); L = 256; }
  const int tl0 = row0 - s0;
  float pre[4][25];
#pragma unroll
  for (int c = 0; c < 4; ++c) pre[c][0] = 0.f;
#pragma unroll
  for (int i = 0; i < 24; ++i) {
    const int tl = tl0 - 8 + i;
    h4 v;
    v[0] = (half_t)0.f; v[1] = (half_t)0.f; v[2] = (half_t)0.f; v[3] = (half_t)0.f;
    if (tl >= 0 && tl < L) v = *(const h4*)(U + (size_t)(s0 + tl) * 2048 + c4);
#pragma unroll
    for (int c = 0; c < 4; ++c) pre[c][i + 1] = (float)v[c];
  }
#pragma unroll
  for (int i = 0; i < 24; ++i)
#pragma unroll
    for (int c = 0; c < 4; ++c) pre[c][i + 1] += pre[c][i];
  half_t* zp = Z + (size_t)row0 * 1024 + c4;
  if (gi == 0) pool_rows<1>(pre, tl0, L, zp);
  else if (gi == 1) pool_rows<2>(pre, tl0, L, zp);
  else if (gi == 2) pool_rows<4>(pre, tl0, L, zp);
  else pool_rows<8>(pre, tl0, L, zp);
}

__device__ void phase_shift(const P& p) {
  const half_t* H = (const half_t*)((p.ws + opaque_zero()) + OFF_A0);
  half_t* XX = (half_t*)((p.ws + opaque_zero()) + OFF_A1);
  const size_t total = (size_t)RT * 128;
  for (size_t idx = (size_t)bidx() * 512 + tidx(); idx < total; idx += (size_t)gridDim.x * 512) {
    const int row = (int)(idx >> 7), c = (int)(idx & 127) * 8;
    bool st, en;
    if (row < RL) { st = (row & 4095) == 0; en = (row & 4095) == 4095; }
    else { st = ((row - RL) & 255) == 0; en = ((row - RL) & 255) == 255; }
    const h8 cur = *(const h8*)(H + (size_t)row * 1024 + c);
    h8 pv, nx;
#pragma unroll
    for (int i = 0; i < 8; ++i) { pv[i] = (half_t)0.f; nx[i] = (half_t)0.f; }
    if (!st) pv = *(const h8*)(H + (size_t)(row - 1) * 1024 + c);
    if (!en) nx = *(const h8*)(H + (size_t)(row + 1) * 1024 + c);
    h8 o;
#pragma unroll
    for (int i = 0; i < 8; ++i) o[i] = (half_t)(0.5f * ((float)pv[i] + (float)nx[i]) - (float)cur[i]);
    *(h8*)(XX + (size_t)row * 1024 + c) = o;
  }
}

#define CS_BYTES 13312
#define CS_G 0
#define CS_R 2304
#define CS_AT 4608
#define CS_BT 6656
#define CS_VT 8704
#define CS_M 10752
#define CS_BM 11264
#define CS_CM 11776
#define CS_DM 12288
#define CS_PREF 12800
#define CS_PEND 13056
#define SCR_BASE 106496
#define SCR_BYTES 5632

__device__ void scan_item(const P& p, int item, char* smem) {
  const int tid = tidx(), lane = tid & 63, w = tid >> 6, lr = lane & 15, lq = lane >> 4;
  const int b = item >> 5, h = (item >> 1) & 15, dir = item & 1;
  char* ws = (p.ws + opaque_zero());
  const half_t* RRp = (const half_t*)(ws + OFF_RR);
  const half_t* KKp = (const half_t*)(ws + OFF_KK);
  const half_t* VVp = (const half_t*)(ws + OFF_VV);
  const half_t* Lp = (const half_t*)(ws + OFF_L);
  half_t* Yd = (half_t*)(ws + (dir ? OFF_A1 : OFF_A0));
  float* BN = (float*)(ws + OFF_BN) + (size_t)dir * RL * 16;

  auto grow = [&](int pp) -> int {
    if (pp < 256) return RL + b * 256 + (dir ? 255 - pp : pp);
    const int t = pp - 256;
    return b * 4096 + (dir ? 4095 - t : t);
  };

  auto prep = [&](int c) {
    char* cs = smem + w * CS_BYTES;
    half_t* G_ = (half_t*)(cs + CS_G);
    half_t* R_ = (half_t*)(cs + CS_R);
    half_t* AT = (half_t*)(cs + CS_AT);
    half_t* BT = (half_t*)(cs + CS_BT);
    half_t* VT = (half_t*)(cs + CS_VT);
    half_t* Mm = (half_t*)(cs + CS_M);
    half_t* Bm = (half_t*)(cs + CS_BM);
    half_t* Cm = (half_t*)(cs + CS_CM);
    half_t* Dm = (half_t*)(cs + CS_DM);
    float* Pref = (float*)(cs + CS_PREF);
    float* Pend = (float*)(cs + CS_PEND);
    char* scr = smem + SCR_BASE + w * SCR_BYTES;
    half_t* A_ = (half_t*)scr;
    half_t* B_ = (half_t*)(scr + 2304);
    float* Am = (float*)(scr + 4608);
    const bool lat = c >= 16;
    const int p0 = c * 16;
    const int rowA = grow(p0 + lr);
    const half_t* lp = Lp + (size_t)rowA * 384 + dir * 64 + lq * 8;
    const h8 aw0 = *(const h8*)(lp), aw1 = *(const h8*)(lp + 32);
    const h8 aa0 = *(const h8*)(lp + 128), aa1 = *(const h8*)(lp + 160);
    float ss[4], bp[4];
    int rows[4];
#pragma unroll
    for (int j = 0; j < 4; ++j) { ss[j] = 0.f; bp[j] = 0.f; rows[j] = grow(p0 + lq * 4 + j); }
#pragma unroll 1
    for (int nt = 0; nt < 4; ++nt) {
      const int ch = h * 64 + nt * 16 + lr;
      const float kkc = p.rw_kk[ch];
#pragma unroll
      for (int j = 0; j < 4; ++j) {
        const float k = (float)KKp[(size_t)rows[j] * 1024 + ch];
        ss[j] += (k * kkc) * (k * kkc);
      }
    }
    float inv[4];
#pragma unroll
    for (int j = 0; j < 4; ++j) inv[j] = rsqrtf(fmaxf(red16(ss[j]), 1e-24f));
    h8 n_bw0, n_bw1, n_ba0, n_ba1;
    float n_w0c, n_a0c, n_kkc, n_kac, n_rkc;
    h4 n_k, n_v, n_r;
#define P2_LOAD(nt_)                                                                                            \
    {                                                                                                           \
      const int ch_ = h * 64 + (nt_) * 16 + lr;                                                                 \
      const half_t* w2p = (const half_t*)(ws + OFF_W2) + (size_t)dir * 65536 + (size_t)ch_ * 64 + lq * 8;      \
      const half_t* a2p = (const half_t*)(ws + OFF_A2) + (size_t)dir * 65536 + (size_t)ch_ * 64 + lq * 8;      \
      n_bw0 = *(const h8*)(w2p); n_bw1 = *(const h8*)(w2p + 32);                                                \
      n_ba0 = *(const h8*)(a2p); n_ba1 = *(const h8*)(a2p + 32);                                                \
      n_w0c = p.rw_w0[dir * 1024 + ch_]; n_a0c = p.rw_a0[dir * 1024 + ch_];                                     \
      n_kkc = p.rw_kk[ch_]; n_kac = p.rw_ka[ch_]; n_rkc = p.rw_rk[ch_];                                         \
      _Pragma("unroll") for (int j = 0; j < 4; ++j) {                                                           \
        const size_t gi_ = (size_t)rows[j] * 1024 + ch_;                                                        \
        n_k[j] = KKp[gi_]; n_v[j] = VVp[gi_]; n_r[j] = RRp[gi_];                                                \
      }                                                                                                         \
    }
    P2_LOAD(0);
#pragma unroll 1
    for (int nt = 0; nt < 4; ++nt) {
      const h8 bw0 = n_bw0, bw1 = n_bw1, ba0 = n_ba0, ba1 = n_ba1;
      const float w0c = n_w0c, a0c = n_a0c, kkc = n_kkc, kac = n_kac, rkc = n_rkc;
      const h4 c_k = n_k, c_v = n_v, c_r = n_r;
      if (nt + 1 < 4) P2_LOAD(nt + 1);
      f4 cwv = (f4){0.f, 0.f, 0.f, 0.f}, cav = (f4){0.f, 0.f, 0.f, 0.f};
      cwv = __builtin_amdgcn_mfma_f32_16x16x32_f16(aw0, bw0, cwv, 0, 0, 0);
      cwv = __builtin_amdgcn_mfma_f32_16x16x32_f16(aw1, bw1, cwv, 0, 0, 0);
      cav = __builtin_amdgcn_mfma_f32_16x16x32_f16(aa0, ba0, cav, 0, 0, 0);
      cav = __builtin_amdgcn_mfma_f32_16x16x32_f16(aa1, ba1, cav, 0, 0, 0);
      h4 vq;
      float ev[4], avv[4], rv[4], kv[4];
#pragma unroll
      for (int j = 0; j < 4; ++j) {
        kv[j] = (float)c_k[j];
        vq[j] = c_v[j];
        rv[j] = lat ? (float)c_r[j] : 0.f;
        ev[j] = 0.60653066f * sigm(cwv[j] + w0c);
        avv[j] = sigm(cav[j] + a0c);
        bp[j] += rv[j] * kv[j] * rkc * (dir == 0 ? (2.f - 2.f * kac + kac * avv[j]) : kac * avv[j]);
      }
      *(h4*)(VT + (nt * 16 + lr) * 16 + lq * 4) = vq;
      float cum[4];
      cum[0] = ev[0];
      cum[1] = cum[0] + ev[1];
      cum[2] = cum[1] + ev[2];
      cum[3] = cum[2] + ev[3];
      const float t1 = bperm(cum[3], (lane - 16) & 63), t2 = bperm(cum[3], (lane - 32) & 63), t3 = bperm(cum[3], (lane - 48) & 63);
      const float off = (lq >= 1 ? t1 : 0.f) + (lq >= 2 ? t2 : 0.f) + (lq >= 3 ? t3 : 0.f);
#pragma unroll
      for (int j = 0; j < 4; ++j) cum[j] += off;
      const float ref = bperm(cum[3], 16 + lr);
      const float end = bperm(cum[3], 48 + lr);
      if (lq == 0) {
        Pref[nt * 16 + lr] = __expf(-ref);
        Pend[nt * 16 + lr] = __expf(-(end - ref));
      }
      h4 aq, bq;
#pragma unroll
      for (int j = 0; j < 4; ++j) {
        const float d = cum[j] - ref;
        const float E1 = __expf(d), E2 = __expf(-d), E3 = __expf(ev[j] - d);
        const float k = kv[j];
        const float kk = k * kkc * inv[j];
        const float kd = k * (1.f + (avv[j] - 1.f) * kac);
        const half_t ga = (half_t)(kk * E3);
        const half_t ro = (half_t)(rv[j] * E2);
        const half_t al = (half_t)(kk * avv[j] * E1);
        const half_t be = (half_t)(kd * E1);
        const int o = (lq * 4 + j) * 72 + nt * 16 + lr;
        G_[o] = ga; R_[o] = ro; A_[o] = al; B_[o] = be;
        aq[j] = al; bq[j] = be;
      }
      *(h4*)(AT + (nt * 16 + lr) * 16 + lq * 4) = aq;
      *(h4*)(BT + (nt * 16 + lr) * 16 + lq * 4) = bq;
    }
#undef P2_LOAD
#pragma unroll
    for (int j = 0; j < 4; ++j) {
      const float bpr = red16(bp[j]);
      if (lat && lr == 0) BN[(size_t)rows[j] * 16 + h] = bpr;
    }
    asm volatile("s_waitcnt lgkmcnt(0)" ::: "memory");
    f4 am = (f4){0.f, 0.f, 0.f, 0.f}, bm = am, cm = am, dm = am;
#pragma unroll
    for (int ks = 0; ks < 2; ++ks) {
      const h8 fa = *(const h8*)(A_ + lr * 72 + ks * 32 + lq * 8);
      const h8 fb = *(const h8*)(B_ + lr * 72 + ks * 32 + lq * 8);
      const h8 fg = *(const h8*)(G_ + lr * 72 + ks * 32 + lq * 8);
      const h8 fr = *(const h8*)(R_ + lr * 72 + ks * 32 + lq * 8);
      am = __builtin_amdgcn_mfma_f32_16x16x32_f16(fa, fg, am, 0, 0, 0);
      bm = __builtin_amdgcn_mfma_f32_16x16x32_f16(fb, fg, bm, 0, 0, 0);
      cm = __builtin_amdgcn_mfma_f32_16x16x32_f16(fa, fr, cm, 0, 0, 0);
      dm = __builtin_amdgcn_mfma_f32_16x16x32_f16(fb, fr, dm, 0, 0, 0);
    }
    h4 bmh, cmh, dmh;
#pragma unroll
    for (int j = 0; j < 4; ++j) {
      const int u = lq * 4 + j;
      am[j] = u < lr ? am[j] : 0.f;
      bmh[j] = (half_t)(u < lr ? bm[j] : 0.f);
      cmh[j] = (half_t)(u <= lr ? cm[j] : 0.f);
      dmh[j] = (half_t)(u <= lr ? dm[j] : 0.f);
    }
    *(h4*)(Bm + lr * 16 + lq * 4) = bmh;
    *(h4*)(Cm + lr * 16 + lq * 4) = cmh;
    *(h4*)(Dm + lr * 16 + lq * 4) = dmh;
    *(f4*)(Am + lr * 16 + lq * 4) = am;
    asm volatile("s_waitcnt lgkmcnt(0)" ::: "memory");
    float m[16];
#pragma unroll
    for (int t = 0; t < 16; ++t) {
      float acc = (t == lr) ? 1.f : 0.f;
#pragma unroll
      for (int u4 = 0; u4 < 4; ++u4) {
        if (u4 * 4 < t) {
          const f4 rw = *(const f4*)(Am + t * 16 + u4 * 4);
#pragma unroll
          for (int k = 0; k < 4; ++k)
            if (u4 * 4 + k < t) acc -= rw[k] * m[u4 * 4 + k];
        }
      }
      m[t] = acc;
    }
    if (lq == 0) {
#pragma unroll
      for (int t = 0; t < 16; ++t) Mm[t * 16 + lr] = (half_t)m[t];
    }
  };

  f4 Sacc[4];
#pragma unroll
  for (int jt = 0; jt < 4; ++jt) Sacc[jt] = (f4){0.f, 0.f, 0.f, 0.f};

  for (int sc = 0; sc < 34; ++sc) {
    prep(sc * 8 + w);
    __syncthreads();
    if (w < 4) {
      for (int cc = 0; cc < 8; ++cc) {
        const int c = sc * 8 + cc;
        const char* cs = smem + cc * CS_BYTES;
        const half_t* G_ = (const half_t*)(cs + CS_G);
        const half_t* R_ = (const half_t*)(cs + CS_R);
        const half_t* AT = (const half_t*)(cs + CS_AT);
        const half_t* BT = (const half_t*)(cs + CS_BT);
        const half_t* VT = (const half_t*)(cs + CS_VT);
        const half_t* Mm = (const half_t*)(cs + CS_M);
        const half_t* Bm = (const half_t*)(cs + CS_BM);
        const half_t* Cm = (const half_t*)(cs + CS_CM);
        const half_t* Dm = (const half_t*)(cs + CS_DM);
        const float* Pref = (const float*)(cs + CS_PREF);
        const float* Pend = (const float*)(cs + CS_PEND);
#pragma unroll
        for (int jt = 0; jt < 4; ++jt) Sacc[jt] = Sacc[jt] * *(const f4*)(Pref + jt * 16 + lq * 4);
        h8 bS[2];
#pragma unroll
        for (int ks = 0; ks < 2; ++ks)
#pragma unroll
          for (int k = 0; k < 4; ++k) {
            bS[ks][k] = (half_t)Sacc[2 * ks][k];
            bS[ks][4 + k] = (half_t)Sacc[2 * ks + 1][k];
          }
        const h4 vt = *(const h4*)(VT + (16 * w + lr) * 16 + lq * 4);
        f4 rhs = (f4){0.f, 0.f, 0.f, 0.f};
#pragma unroll
        for (int ks = 0; ks < 2; ++ks) {
          const h4 g0 = *(const h4*)(G_ + lr * 72 + (2 * ks) * 16 + lq * 4);
          const h4 g1 = *(const h4*)(G_ + lr * 72 + (2 * ks + 1) * 16 + lq * 4);
          h8 gf;
          gf[0] = g0[0]; gf[1] = g0[1]; gf[2] = g0[2]; gf[3] = g0[3];
          gf[4] = g1[0]; gf[5] = g1[1]; gf[6] = g1[2]; gf[7] = g1[3];
          rhs = __builtin_amdgcn_mfma_f32_16x16x32_f16(gf, bS[ks], rhs, 0, 0, 0);
        }
        {
          f4 r16 = (f4){0.f, 0.f, 0.f, 0.f};
          r16 = __builtin_amdgcn_mfma_f32_16x16x16f16(*(const h4*)(Bm + lr * 16 + lq * 4), vt, r16, 0, 0, 0);
          rhs = rhs + r16;
        }
        h4 rh;
#pragma unroll
        for (int k = 0; k < 4; ++k) rh[k] = (half_t)rhs[k];
        f4 av = (f4){0.f, 0.f, 0.f, 0.f};
        av = __builtin_amdgcn_mfma_f32_16x16x16f16(*(const h4*)(Mm + lr * 16 + lq * 4), rh, av, 0, 0, 0);
        h4 na;
#pragma unroll
        for (int k = 0; k < 4; ++k) na[k] = (half_t)(-av[k]);
        if (c >= 16) {
          f4 y = (f4){0.f, 0.f, 0.f, 0.f};
#pragma unroll
          for (int ks = 0; ks < 2; ++ks) {
            const h4 g0 = *(const h4*)(R_ + lr * 72 + (2 * ks) * 16 + lq * 4);
            const h4 g1 = *(const h4*)(R_ + lr * 72 + (2 * ks + 1) * 16 + lq * 4);
            h8 gf;
            gf[0] = g0[0]; gf[1] = g0[1]; gf[2] = g0[2]; gf[3] = g0[3];
            gf[4] = g1[0]; gf[5] = g1[1]; gf[6] = g1[2]; gf[7] = g1[3];
            y = __builtin_amdgcn_mfma_f32_16x16x32_f16(gf, bS[ks], y, 0, 0, 0);
          }
          f4 y16 = (f4){0.f, 0.f, 0.f, 0.f};
          y16 = __builtin_amdgcn_mfma_f32_16x16x16f16(*(const h4*)(Cm + lr * 16 + lq * 4), na, y16, 0, 0, 0);
          y16 = __builtin_amdgcn_mfma_f32_16x16x16f16(*(const h4*)(Dm + lr * 16 + lq * 4), vt, y16, 0, 0, 0);
          y = y + y16;
#pragma unroll
          for (int k = 0; k < 4; ++k) {
            const int row = grow(c * 16 + lq * 4 + k);
            Yd[(size_t)row * 1024 + h * 64 + 16 * w + lr] = (half_t)y[k];
          }
        }
#pragma unroll
        for (int jt = 0; jt < 4; ++jt) {
          Sacc[jt] = __builtin_amdgcn_mfma_f32_16x16x16f16(*(const h4*)(AT + (jt * 16 + lr) * 16 + lq * 4), na, Sacc[jt], 0, 0, 0);
          Sacc[jt] = __builtin_amdgcn_mfma_f32_16x16x16f16(*(const h4*)(BT + (jt * 16 + lr) * 16 + lq * 4), vt, Sacc[jt], 0, 0, 0);
          Sacc[jt] = Sacc[jt] * *(const f4*)(Pend + jt * 16 + lq * 4);
        }
      }
    }
    __syncthreads();
  }
}

__device__ void phase_readout(const P& p) {
  const int lane = tidx() & 63;
  const int gw = bidx() * 8 + (tidx() >> 6), stride = gridDim.x * 8;
  char* ws = (p.ws + opaque_zero());
  const half_t* Y0 = (const half_t*)(ws + OFF_A0);
  const half_t* Y1 = (const half_t*)(ws + OFF_A1);
  const half_t* VVp = (const half_t*)(ws + OFF_VV);
  const half_t* Gp = (const half_t*)(ws + OFF_G);
  const float* BN0 = (const float*)(ws + OFF_BN);
  const float* BN1 = BN0 + (size_t)RL * 16;
  half_t* Z1 = (half_t*)(ws + OFF_Z1);
  const int c0 = lane * 16, head = lane >> 2;
  for (int row = gw; row < RL; row += stride) {
    const size_t o = (size_t)row * 1024 + c0;
    float y[16], vv[16], gg[16];
#pragma unroll
    for (int hh = 0; hh < 2; ++hh) {
      const h8 a = *(const h8*)(Y0 + o + hh * 8);
      const h8 bq = *(const h8*)(Y1 + o + hh * 8);
      const h8 v = *(const h8*)(VVp + o + hh * 8);
      const h8 g = *(const h8*)(Gp + o + hh * 8);
#pragma unroll
      for (int i = 0; i < 8; ++i) {
        y[hh * 8 + i] = (float)a[i] + (float)bq[i];
        vv[hh * 8 + i] = (float)v[i];
        gg[hh * 8 + i] = (float)g[i];
      }
    }
    float s = 0.f;
#pragma unroll
    for (int i = 0; i < 16; ++i) s += y[i];
    s = red4(s);
    const float mean = s * (1.f / 64.f);
    float q = 0.f;
#pragma unroll
    for (int i = 0; i < 16; ++i) { const float d = y[i] - mean; q += d * d; }
    q = red4(q);
    const float rstd = rsqrtf(q * (1.f / 64.f) + 64e-5f);
    const float bonus = BN0[(size_t)row * 16 + head] + BN1[(size_t)row * 16 + head];
    h8 o0, o1;
#pragma unroll
    for (int i = 0; i < 16; ++i) {
      const float lg = p.rw_lng[c0 + i], lb = p.rw_lnb[c0 + i];
      const float r = ((y[i] - mean) * rstd * lg + lb + bonus * vv[i]) * gg[i];
      if (i < 8) o0[i] = (half_t)r; else o1[i - 8] = (half_t)r;
    }
    *(h8*)(Z1 + o) = o0;
    *(h8*)(Z1 + o + 8) = o1;
  }
}

#define NPHASE 19
__global__ void __launch_bounds__(512) mega(P p_in, int ph_lo, int ph_hi) {
  __shared__ __attribute__((aligned(16))) char smem[SMEM_BYTES];
  cg::grid_group grid = cg::this_grid();
  const P& p = p_in;
  for (int ph = ph_lo; ph < ph_hi; ++ph) {
    char* ws = p_in.ws + opaque_zero();
    int kind = 2, arg = 0;
    size_t oA = 0, oB = 0, oC = 0;
    int lda = 1024, ldb = 1024, K = 1024, ldc = 1024, epi = 0, nMt = 136, nNt = 8, feat = 0;
    switch (ph) {
      case 0: kind = 0; break;
      case 1: kind = 1; arg = 0; break;
      case 2: oA = OFF_A0; oB = OFF_WIN; oC = OFF_U; ldc = 2048; nNt = 8; feat = 2; break;
      case 3: kind = 3; break;
      case 4: oA = OFF_Z; oB = OFF_WOUT; oC = OFF_A1; nNt = 4; feat = 3; break;
      case 5: kind = 1; arg = 1; break;
      case 6: oA = OFF_A0; oB = OFF_M1; oC = OFF_F; ldc = 4096; nNt = 16; epi = 1; feat = 3; break;
      case 7: oA = OFF_F; lda = 4096; oB = OFF_M2; ldb = 4096; K = 4096; oC = OFF_A1; nNt = 4; feat = 3; break;
      case 8: kind = 1; arg = 2; break;
      case 9: kind = 4; break;
      case 10: oA = OFF_A0; oB = OFF_WR; oC = OFF_RR; nNt = 27; feat = 1; break;
      case 11: kind = 5; break;
      case 12: oA = OFF_L + 512; lda = 384; oB = OFF_G2; ldb = 128; K = 128; oC = OFF_G; nMt = 128; break;
      case 13: kind = 6; break;
      case 14: oA = OFF_Z1; oB = OFF_WO; oC = OFF_A1; nMt = 128; nNt = 4; feat = 3; break;
      case 15: kind = 1; arg = 3; break;
      case 16: oA = OFF_A0; oB = OFF_M1 + 8 * MIB; oC = OFF_F; ldc = 4096; nNt = 16; epi = 1; nMt = 128; feat = 3; break;
      case 17: oA = OFF_F; lda = 4096; oB = OFF_M2 + 8 * MIB; ldb = 4096; K = 4096; oC = OFF_A1; nMt = 128; nNt = 4; feat = 3; break;
      default: kind = 1; arg = 4; break;
    }
    if (kind == 2) {
      gemm_phase(p, (const half_t*)(ws + oA), lda, (const half_t*)(ws + oB), ldb, K, (half_t*)(ws + oC), ldc, epi, nMt, nNt, feat, smem);
    } else if (kind == 1) {
      phase_rowwise(p, arg);
    } else if (kind == 0) {
      phase_prep(p, smem);
    } else if (kind == 3) {
      for (int it = bidx(); it < 2176 + 1088; it += gridDim.x) {
        if (it < 2176) attn_item(p, it, smem); else pool_item(p, it - 2176);
      }
    } else if (kind == 4) {
      phase_shift(p);
    } else if (kind == 5) {
      for (int it = bidx(); it < 256; it += gridDim.x) scan_item(p, it, smem);
    } else {
      phase_readout(p);
    }
    if (ph + 1 < ph_hi) grid.sync();
  }
}

extern "C" void kernel_launch(void* const* d_in, const int* in_sizes, int n_in, void* d_out, int out_size, void* d_ws,
                              size_t ws_size, hipStream_t stream) {
  P p{};
  const float** pp = (const float**)&p;
  for (int i = 0; i < 32; ++i) pp[i] = (const float*)d_in[i];
  p.out = (float*)d_out;
  p.ws = (char*)d_ws;
  static int grid_blocks = 0;
  if (!grid_blocks) {
    int dev = 0, cus = 0, per_cu = 0;
    (void)hipGetDevice(&dev);
    (void)hipDeviceGetAttribute(&cus, hipDeviceAttributeMultiprocessorCount, dev);
    (void)hipOccupancyMaxActiveBlocksPerMultiprocessor(&per_cu, mega, 512, 0);
    if (per_cu < 1) per_cu = 1;
    grid_blocks = cus * per_cu;
  }
  int lo = 0, hi = NPHASE;
  void* args[] = {&p, &lo, &hi};
  hipError_t e = hipLaunchCooperativeKernel((void*)mega, dim3(grid_blocks), dim3(512), args, 0, stream);
  if (e != hipSuccess) fprintf(stderr, "cooperative launch failed: %s (grid %d)\n", hipGetErrorString(e), grid_blocks);
}
```

```cpp
#include <hip/hip_runtime.h>
#include <hip/hip_cooperative_groups.h>
#include <cstdio>
namespace cg = cooperative_groups;

typedef _Float16 half_t;
typedef _Float16 h8 __attribute__((ext_vector_type(8)));
typedef _Float16 h4 __attribute__((ext_vector_type(4)));
typedef _Float16 h2 __attribute__((ext_vector_type(2)));
typedef float f4 __attribute__((ext_vector_type(4)));

#define RL 32768
#define RC 2048
#define RT 34816
#define MIB (1ull << 20)
#define OFF_WIN (0 * MIB)
#define OFF_WOUT (4 * MIB)
#define OFF_M1 (7 * MIB)
#define OFF_M2 (23 * MIB)
#define OFF_WR (39 * MIB)
#define OFF_WK (41 * MIB)
#define OFF_WV (43 * MIB)
#define OFF_WO (45 * MIB)
#define OFF_L1 (47 * MIB)
#define OFF_W2 (48 * MIB)
#define OFF_A2 (48 * MIB + 256 * 1024)
#define OFF_G2 (48 * MIB + 512 * 1024)
#define OFF_MOD (49 * MIB)
#define OFF_BN (50 * MIB)
#define OFF_XC (54 * MIB)
#define OFF_A0 (62 * MIB)
#define OFF_A1 (130 * MIB)
#define OFF_BIG (198 * MIB)
#define OFF_U OFF_BIG
#define OFF_Z (334 * MIB)
#define OFF_F OFF_BIG
#define OFF_RR OFF_BIG
#define OFF_KK (266 * MIB)
#define OFF_VV (334 * MIB)
#define OFF_L (402 * MIB)
#define OFF_G OFF_BIG
#define OFF_Z1 (266 * MIB)

#define SMEM_BYTES 151552

struct P {
  const float *x, *c, *ctx, *c_ctx, *ada_w, *ada_b, *norm_g, *mlp_w1, *mlp_w2, *ev_w_in, *ev_w_out, *ev_pool_w,
      *ev_pool_scale, *ev_rpb, *rw_mu, *rw_wr, *rw_wk, *rw_wv, *rw_wo, *rw_w0, *rw_w1, *rw_w2, *rw_a0, *rw_a1, *rw_a2,
      *rw_g1, *rw_g2, *rw_kk, *rw_ka, *rw_rk, *rw_lng, *rw_lnb;
  float* out;
  char* ws;
};

__device__ __forceinline__ int tidx() { int v = threadIdx.x; asm volatile("" : "+v"(v)); return v; }
__device__ __forceinline__ int bidx() { int v = blockIdx.x; asm volatile("" : "+s"(v)); return v; }
__device__ __forceinline__ size_t opaque_zero() { size_t z = 0; asm volatile("" : "+s"(z)); return z; }
__device__ __forceinline__ float opaque_f(float v) { asm volatile("" : "+v"(v)); return v; }
__device__ __forceinline__ float sigm(float x) { return 1.f / (1.f + __expf(-x)); }
__device__ __forceinline__ float bperm(float v, int srclane) {
  return __builtin_bit_cast(float, __builtin_amdgcn_ds_bpermute(srclane << 2, __builtin_bit_cast(int, v)));
}
template <int CTRL>
__device__ __forceinline__ float dpp(float x) {
  return __builtin_bit_cast(float, __builtin_amdgcn_mov_dpp(__builtin_bit_cast(int, x), CTRL, 0xf, 0xf, true));
}
__device__ __forceinline__ float red4(float x) { x += dpp<0xB1>(x); x += dpp<0x4E>(x); return x; }
__device__ __forceinline__ float red8(float x) { x = red4(x); x += dpp<0x141>(x); return x; }
__device__ __forceinline__ float red16(float x) { x = red8(x); x += dpp<0x140>(x); return x; }
__device__ __forceinline__ float wave_sum(float v, int lane) {
  v = red16(v);
  v += bperm(v, lane ^ 16);
  v += bperm(v, lane ^ 32);
  return v;
}

struct GemmTile {
  const half_t* A; const half_t* A2; const float* mu; int lda;
  const half_t* Bt; int ldb; int K;
  half_t* C; int ldc; int epi;
};

template <bool MIX>
__device__ __forceinline__ void gemm_tile(const GemmTile& g, char* smem) {
  half_t* As = (half_t*)smem;
  half_t* Bs = (half_t*)(smem + 73728);
  const int tid = tidx(), lane = tid & 63, w = tid >> 6;
  const int wm = w >> 1, wn = w & 1, lr = lane & 15, lq = lane >> 4;
  const int ldr = tid >> 3, ldk = (tid & 7) * 8;
  f4 acc[4][4];
#pragma unroll
  for (int i = 0; i < 4; ++i)
#pragma unroll
    for (int j = 0; j < 4; ++j) acc[i][j] = (f4){0.f, 0.f, 0.f, 0.f};
  uint4 ra0, ra1, ra2, ra3, rb0, rb1;
  uint4 rx0, rx1, rx2, rx3;
  float4 mu0, mu1;
  const int nk = g.K >> 6;
  const half_t* Ap = g.A + (size_t)ldr * g.lda + ldk;
  const half_t* A2p = MIX ? g.A2 + (size_t)ldr * g.lda + ldk : nullptr;
  const float* mup = MIX ? g.mu + ldk : nullptr;
  const half_t* Bp = g.Bt + (size_t)ldr * g.ldb + ldk;
  const size_t astep = (size_t)64 * g.lda, bstep = (size_t)64 * g.ldb;
  half_t* asw = As + ldr * 72 + ldk;
  half_t* bsw = Bs + ldr * 72 + ldk;
  const half_t* asr = As + (wm * 64 + lr) * 72 + lq * 8;
  const half_t* bsr = Bs + (wn * 64 + lr) * 72 + lq * 8;

#define GLOAD(kt)                                              \
  {                                                            \
    const int k0 = (kt) * 64;                                  \
    ra0 = *(const uint4*)(Ap + k0);                            \
    ra1 = *(const uint4*)(Ap + astep + k0);                    \
    ra2 = *(const uint4*)(Ap + 2 * astep + k0);                \
    ra3 = *(const uint4*)(Ap + 3 * astep + k0);                \
    rb0 = *(const uint4*)(Bp + k0);                            \
    rb1 = *(const uint4*)(Bp + bstep + k0);                    \
    if (MIX) {                                                 \
      rx0 = *(const uint4*)(A2p + k0);                         \
      rx1 = *(const uint4*)(A2p + astep + k0);                 \
      rx2 = *(const uint4*)(A2p + 2 * astep + k0);             \
      rx3 = *(const uint4*)(A2p + 3 * astep + k0);             \
      mu0 = *(const float4*)(mup + k0);                        \
      mu1 = *(const float4*)(mup + k0 + 4);                    \
    }                                                          \
  }
#define MIXV(r, x) __builtin_bit_cast(uint4, (h8)(__builtin_bit_cast(h8, r) + __builtin_bit_cast(h8, x) * m))
#define SSTORE(buf)                                            \
  {                                                            \
    half_t* as = asw + (buf) * (256 * 72);                     \
    half_t* bs = bsw + (buf) * (128 * 72);                     \
    if (MIX) {                                                 \
      h8 m;                                                    \
      m[0] = (half_t)mu0.x; m[1] = (half_t)mu0.y; m[2] = (half_t)mu0.z; m[3] = (half_t)mu0.w; \
      m[4] = (half_t)mu1.x; m[5] = (half_t)mu1.y; m[6] = (half_t)mu1.z; m[7] = (half_t)mu1.w; \
      ra0 = MIXV(ra0, rx0); ra1 = MIXV(ra1, rx1); ra2 = MIXV(ra2, rx2); ra3 = MIXV(ra3, rx3); \
    }                                                          \
    *(uint4*)(as) = ra0;                                       \
    *(uint4*)(as + 64 * 72) = ra1;                             \
    *(uint4*)(as + 128 * 72) = ra2;                            \
    *(uint4*)(as + 192 * 72) = ra3;                            \
    *(uint4*)(bs) = rb0;                                       \
    *(uint4*)(bs + 64 * 72) = rb1;                             \
  }

  GLOAD(0);
  SSTORE(0);
  __syncthreads();
  for (int kt = 0; kt < nk; ++kt) {
    const bool more = kt + 1 < nk;
    if (more) GLOAD(kt + 1);
    __builtin_amdgcn_sched_barrier(0);
    {
      const half_t* as = asr + (kt & 1) * (256 * 72);
      const half_t* bs = bsr + (kt & 1) * (128 * 72);
#pragma unroll
      for (int ks = 0; ks < 2; ++ks) {
        h8 a[4], b[4];
#pragma unroll
        for (int i = 0; i < 4; ++i) {
          a[i] = *(const h8*)(as + i * 16 * 72 + ks * 32);
          b[i] = *(const h8*)(bs + i * 16 * 72 + ks * 32);
        }
#pragma unroll
        for (int mt = 0; mt < 4; ++mt)
#pragma unroll
          for (int nt = 0; nt < 4; ++nt)
            acc[mt][nt] = __builtin_amdgcn_mfma_f32_16x16x32_f16(b[nt], a[mt], acc[mt][nt], 0, 0, 0);
      }
    }
    if (more) SSTORE((kt + 1) & 1);
    __syncthreads();
  }
#undef GLOAD
#undef SSTORE
#undef MIXV
#pragma unroll
  for (int mt = 0; mt < 4; ++mt) {
    half_t* cp = g.C + (size_t)(wm * 64 + mt * 16 + lr) * g.ldc + wn * 64 + lq * 4;
#pragma unroll
    for (int nt = 0; nt < 4; ++nt) {
      h4 o;
#pragma unroll
      for (int j = 0; j < 4; ++j) {
        float v = acc[mt][nt][j];
        if (g.epi == 1) { v = fmaxf(v, 0.f); v = v * v; }
        else if (g.epi == 2) v = 1.f - 2.f / (__expf(2.f * v) + 1.f);
        else if (g.epi == 3) v = sigm(v);
        o[j] = (half_t)v;
      }
      *(h4*)(cp + nt * 16) = o;
    }
  }
}

__device__ __forceinline__ void gemm_tile2(const GemmTile& g, char* smem) {
  half_t* As = (half_t*)smem;
  half_t* Bs = (half_t*)(smem + 73728);
  const int tid = tidx(), lane = tid & 63, w = tid >> 6;
  const int wm = w >> 1, wn = w & 1, lr = lane & 15, lq = lane >> 4;
  const int ldr = tid >> 3, ldk = (tid & 7) * 8;
  f4 acc[4][4];
#pragma unroll
  for (int i = 0; i < 4; ++i)
#pragma unroll
    for (int j = 0; j < 4; ++j) acc[i][j] = (f4){0.f, 0.f, 0.f, 0.f};
  uint4 xa0, xa1, xa2, xa3, xb0, xb1;
  uint4 ya0, ya1, ya2, ya3, yb0, yb1;
  const int nk = g.K >> 6;
  const half_t* Ap = g.A + (size_t)ldr * g.lda + ldk;
  const half_t* Bp = g.Bt + (size_t)ldr * g.ldb + ldk;
  const size_t astep = (size_t)64 * g.lda, bstep = (size_t)64 * g.ldb;
  half_t* asw = As + ldr * 72 + ldk;
  half_t* bsw = Bs + ldr * 72 + ldk;
  const half_t* asr = As + (wm * 64 + lr) * 72 + lq * 8;
  const half_t* bsr = Bs + (wn * 64 + lr) * 72 + lq * 8;
#define GLD(S, kt)                                   \
  {                                                  \
    const int k0 = (kt) * 64;                        \
    S##a0 = *(const uint4*)(Ap + k0);                \
    S##a1 = *(const uint4*)(Ap + astep + k0);        \
    S##a2 = *(const uint4*)(Ap + 2 * astep + k0);    \
    S##a3 = *(const uint4*)(Ap + 3 * astep + k0);    \
    S##b0 = *(const uint4*)(Bp + k0);                \
    S##b1 = *(const uint4*)(Bp + bstep + k0);        \
  }
#define SST(S, buf)                                  \
  {                                                  \
    half_t* as = asw + (buf) * (256 * 72);           \
    half_t* bs = bsw + (buf) * (128 * 72);           \
    *(uint4*)(as) = S##a0;                           \
    *(uint4*)(as + 64 * 72) = S##a1;                 \
    *(uint4*)(as + 128 * 72) = S##a2;                \
    *(uint4*)(as + 192 * 72) = S##a3;                \
    *(uint4*)(bs) = S##b0;                           \
    *(uint4*)(bs + 64 * 72) = S##b1;                 \
  }
#define CMP(buf)                                                                                     \
  {                                                                                                  \
    const half_t* as = asr + (buf) * (256 * 72);                                                     \
    const half_t* bs = bsr + (buf) * (128 * 72);                                                     \
    _Pragma("unroll") for (int ks = 0; ks < 2; ++ks) {                                               \
      h8 a[4], b[4];                                                                                 \
      _Pragma("unroll") for (int i = 0; i < 4; ++i) {                                                \
        a[i] = *(const h8*)(as + i * 16 * 72 + ks * 32);                                             \
        b[i] = *(const h8*)(bs + i * 16 * 72 + ks * 32);                                             \
      }                                                                                              \
      _Pragma("unroll") for (int mt = 0; mt < 4; ++mt)                                               \
        _Pragma("unroll") for (int nt = 0; nt < 4; ++nt)                                             \
          acc[mt][nt] = __builtin_amdgcn_mfma_f32_16x16x32_f16(b[nt], a[mt], acc[mt][nt], 0, 0, 0);  \
    }                                                                                                \
  }
  GLD(x, 0);
  SST(x, 0);
  if (nk > 1) GLD(x, 1);
  if (nk > 2) GLD(y, 2);
  __syncthreads();
  for (int kt = 0; kt < nk; kt += 2) {
    CMP(0);
    if (kt + 1 < nk) SST(x, 1);
    if (kt + 3 < nk) GLD(x, kt + 3);
    __syncthreads();
    CMP(1);
    if (kt + 2 < nk) SST(y, 0);
    if (kt + 4 < nk) GLD(y, kt + 4);
    __syncthreads();
  }
#undef GLD
#undef SST
#undef CMP
#pragma unroll
  for (int mt = 0; mt < 4; ++mt) {
    half_t* cp = g.C + (size_t)(wm * 64 + mt * 16 + lr) * g.ldc + wn * 64 + lq * 4;
#pragma unroll
    for (int nt = 0; nt < 4; ++nt) {
      h4 o;
#pragma unroll
      for (int j = 0; j < 4; ++j) {
        float v = acc[mt][nt][j];
        if (g.epi == 1) { v = fmaxf(v, 0.f); v = v * v; }
        o[j] = (half_t)v;
      }
      *(h4*)(cp + nt * 16) = o;
    }
  }
}

__device__ __forceinline__ void gemm_tile3(const GemmTile& g, char* smem) {
  const int tid = tidx(), lane = tid & 63, w = tid >> 6;
  const int wm = w >> 1, wn = w & 1, lr = lane & 15, lq = lane >> 4;
  f4 acc[4][4];
#pragma unroll
  for (int i = 0; i < 4; ++i)
#pragma unroll
    for (int j = 0; j < 4; ++j) acc[i][j] = (f4){0.f, 0.f, 0.f, 0.f};
  const int nk = g.K >> 6;
  const int lrow = lane >> 3, lslot = lane & 7;
  const half_t* Ag[4];
  const half_t* Bg[2];
#pragma unroll
  for (int i = 0; i < 4; ++i) {
    const int row = (w * 4 + i) * 8 + lrow;
    Ag[i] = g.A + (size_t)row * g.lda + ((lslot ^ ((row >> 1) & 7)) * 8);
  }
#pragma unroll
  for (int i = 0; i < 2; ++i) {
    const int row = (w * 2 + i) * 8 + lrow;
    Bg[i] = g.Bt + (size_t)row * g.ldb + ((lslot ^ ((row >> 1) & 7)) * 8);
  }
  char* aw = smem + (w * 4) * 1024 + lane * 16;
  char* bw = smem + 32768 + (w * 2) * 1024 + lane * 16;
  const int swz = (lr >> 1) & 7;
  const int ko0 = ((0 + lq) ^ swz) * 16, ko1 = ((4 + lq) ^ swz) * 16;
  const char* ar = smem + (wm * 64 + lr) * 128;
  const char* br = smem + 32768 + (wn * 64 + lr) * 128;
#define ISSUE(kt, st)                                                                                      \
  {                                                                                                        \
    _Pragma("unroll") for (int i = 0; i < 4; ++i)                                                          \
      __builtin_amdgcn_global_load_lds((const unsigned*)(Ag[i] + (kt) * 64), (unsigned*)(aw + (st) * 49152 + i * 1024), 16, 0, 0); \
    _Pragma("unroll") for (int i = 0; i < 2; ++i)                                                          \
      __builtin_amdgcn_global_load_lds((const unsigned*)(Bg[i] + (kt) * 64), (unsigned*)(bw + (st) * 49152 + i * 1024), 16, 0, 0); \
  }
  ISSUE(0, 0);
  if (nk > 1) {
    ISSUE(1, 1);
    asm volatile("s_waitcnt vmcnt(6)" ::: "memory");
  } else {
    asm volatile("s_waitcnt vmcnt(0)" ::: "memory");
  }
  __builtin_amdgcn_s_barrier();
  asm volatile("" ::: "memory");
  h8 a0[4], b0[4], a1[4], b1[4];
#define LDF(fa, fb, stg, ko)                                             \
  {                                                                      \
    const char* as = ar + (stg) * 49152 + (ko);                          \
    const char* bs = br + (stg) * 49152 + (ko);                          \
    _Pragma("unroll") for (int i = 0; i < 4; ++i) {                      \
      fa[i] = *(const h8*)(as + i * 2048);                               \
      fb[i] = *(const h8*)(bs + i * 2048);                               \
    }                                                                    \
  }
#define MMA(fa, fb)                                                      \
  {                                                                      \
    _Pragma("unroll") for (int mt = 0; mt < 4; ++mt)                     \
      _Pragma("unroll") for (int nt = 0; nt < 4; ++nt)                   \
        acc[mt][nt] = __builtin_amdgcn_mfma_f32_16x16x32_f16(fb[nt], fa[mt], acc[mt][nt], 0, 0, 0); \
  }
  LDF(a0, b0, 0, ko0);
  int st = 0;
  for (int kt = 0; kt < nk; ++kt) {
    const bool more = kt + 2 < nk;
    int st1 = st + 1; if (st1 >= 3) st1 -= 3;
    int st2 = st + 2; if (st2 >= 3) st2 -= 3;
    if (more) ISSUE(kt + 2, st2);
    LDF(a1, b1, st, ko1);
    __builtin_amdgcn_sched_barrier(0);
    MMA(a0, b0);
    __builtin_amdgcn_sched_barrier(0);
    if (more) asm volatile("s_waitcnt vmcnt(6) lgkmcnt(0)" ::: "memory");
    else asm volatile("s_waitcnt vmcnt(0) lgkmcnt(0)" ::: "memory");
    __builtin_amdgcn_s_barrier();
    asm volatile("" ::: "memory");
    if (kt + 1 < nk) LDF(a0, b0, st1, ko0);
    __builtin_amdgcn_sched_barrier(0);
    MMA(a1, b1);
    __builtin_amdgcn_sched_barrier(0);
    st = st1;
  }
#undef LDF
#undef MMA
#undef ISSUE
  if (g.epi == 4) {
    half_t* vp = g.C + (size_t)((wm * 8 + wn) * 64) * 64 + lr;
#pragma unroll
    for (int mt = 0; mt < 4; ++mt)
#pragma unroll
      for (int nt = 0; nt < 4; ++nt)
#pragma unroll
        for (int j = 0; j < 4; ++j) vp[(nt * 16 + lq * 4 + j) * 64 + mt * 16] = (half_t)acc[mt][nt][j];
    return;
  }
#pragma unroll
  for (int mt = 0; mt < 4; ++mt) {
    half_t* cp = g.C + (size_t)(wm * 64 + mt * 16 + lr) * g.ldc + wn * 64 + lq * 4;
#pragma unroll
    for (int nt = 0; nt < 4; ++nt) {
      h4 o;
#pragma unroll
      for (int j = 0; j < 4; ++j) {
        float v = acc[mt][nt][j];
        if (g.epi == 1) { v = fmaxf(v, 0.f); v = v * v; }
        o[j] = (half_t)v;
      }
      *(h4*)(cp + nt * 16) = o;
    }
  }
}

__device__ __forceinline__ void gemm_tile4(const GemmTile& g, char* smem) {
  const int tid = tidx(), lane = tid & 63, w = tid >> 6;
  const int wm = w >> 1, wn = w & 1, lr = lane & 15, lq = lane >> 4;
  f4 acc[4][8];
#pragma unroll
  for (int i = 0; i < 4; ++i)
#pragma unroll
    for (int j = 0; j < 8; ++j) acc[i][j] = (f4){0.f, 0.f, 0.f, 0.f};
  const int nk = g.K >> 6;
  const int lrow = lane >> 3, lslot = lane & 7;
  const half_t* Ag[4];
  const half_t* Bg[4];
#pragma unroll
  for (int i = 0; i < 4; ++i) {
    const int row = (w * 4 + i) * 8 + lrow;
    const int so = (lslot ^ ((row >> 1) & 7)) * 8;
    Ag[i] = g.A + (size_t)row * g.lda + so;
    Bg[i] = g.Bt + (size_t)row * g.ldb + so;
  }
  char* aw = smem + (w * 4) * 1024 + lane * 16;
  char* bw = smem + 32768 + (w * 4) * 1024 + lane * 16;
  const int swz = (lr >> 1) & 7;
  const int ko0 = ((0 + lq) ^ swz) * 16, ko1 = ((4 + lq) ^ swz) * 16;
  const char* ar = smem + (wm * 64 + lr) * 128;
  const char* br = smem + 32768 + (wn * 128 + lr) * 128;
#define ISSUE4(kt, st)                                                                                     \
  {                                                                                                        \
    _Pragma("unroll") for (int i = 0; i < 4; ++i)                                                          \
      __builtin_amdgcn_global_load_lds((const unsigned*)(Ag[i] + (kt) * 64), (unsigned*)(aw + (st) * 65536 + i * 1024), 16, 0, 0); \
    _Pragma("unroll") for (int i = 0; i < 4; ++i)                                                          \
      __builtin_amdgcn_global_load_lds((const unsigned*)(Bg[i] + (kt) * 64), (unsigned*)(bw + (st) * 65536 + i * 1024), 16, 0, 0); \
  }
  ISSUE4(0, 0);
  asm volatile("s_waitcnt vmcnt(0)" ::: "memory");
  __builtin_amdgcn_s_barrier();
  asm volatile("" ::: "memory");
  for (int kt = 0; kt < nk; ++kt) {
    const int st = kt & 1;
    if (kt + 1 < nk) ISSUE4(kt + 1, st ^ 1);
    const char* as = ar + st * 65536;
    const char* bs = br + st * 65536;
#pragma unroll
    for (int ks = 0; ks < 2; ++ks) {
      const int ko = ks ? ko1 : ko0;
      h8 a[4], b[8];
#pragma unroll
      for (int i = 0; i < 4; ++i) a[i] = *(const h8*)(as + i * 2048 + ko);
#pragma unroll
      for (int i = 0; i < 8; ++i) b[i] = *(const h8*)(bs + i * 2048 + ko);
#pragma unroll
      for (int mt = 0; mt < 4; ++mt)
#pragma unroll
        for (int nt = 0; nt < 8; ++nt)
          acc[mt][nt] = __builtin_amdgcn_mfma_f32_16x16x32_f16(b[nt], a[mt], acc[mt][nt], 0, 0, 0);
    }
    asm volatile("s_waitcnt vmcnt(0) lgkmcnt(0)" ::: "memory");
    __builtin_amdgcn_s_barrier();
    asm volatile("" ::: "memory");
  }
#undef ISSUE4
  if (g.epi == 4) {
#pragma unroll
    for (int mt = 0; mt < 4; ++mt)
#pragma unroll
      for (int nt = 0; nt < 8; ++nt) {
        half_t* vp = g.C + (size_t)((wm * 8 + wn * 2 + (nt >> 2)) * 64) * 64 + lr;
#pragma unroll
        for (int j = 0; j < 4; ++j) vp[((nt & 3) * 16 + lq * 4 + j) * 64 + mt * 16] = (half_t)acc[mt][nt][j];
      }
    return;
  }
#pragma unroll
  for (int mt = 0; mt < 4; ++mt) {
    half_t* cp = g.C + (size_t)(wm * 64 + mt * 16 + lr) * g.ldc + wn * 128 + lq * 4;
#pragma unroll
    for (int nt = 0; nt < 8; ++nt) {
      h4 o;
#pragma unroll
      for (int j = 0; j < 4; ++j) {
        float v = acc[mt][nt][j];
        if (g.epi == 1) { v = fmaxf(v, 0.f); v = v * v; }
        o[j] = (half_t)v;
      }
      *(h4*)(cp + nt * 16) = o;
    }
  }
}

__device__ __forceinline__ int p8_lds_byte(int r, int c) {
  const int st = (r >> 4) * 2 + (c >> 5), rr = r & 15, cc = c & 31, ob = rr * 64 + cc * 2;
  return st * 1024 + (ob ^ (((ob >> 9) & 1) << 5));
}
__device__ __forceinline__ void p8_stage_rc(int b, int& R, int& C) {
  const int st = b / 1024, sb = b % 1024, swz = sb ^ (((sb >> 9) & 1) << 5);
  R = (st >> 1) * 16 + swz / 64;
  C = (st & 1) * 32 + (swz % 64) / 2;
}
__device__ __forceinline__ void gemm_tile8(const GemmTile& g, char* smem) {
  constexpr int HT = 128 * 64;
  half_t* shm = (half_t*)smem;
  const int tid = tidx();
  const int wid = tid >> 6, lane = tid & 63, wr = wid >> 2, wc = wid & 3, fr = lane & 15, fq = lane >> 4;
  const half_t* A = g.A;
  const half_t* Bt = g.Bt;
  const int lda = g.lda, ldb = g.lda;
#define P8_SA(b, h) (shm + ((b) * 2 + (h)) * HT)
#define P8_SB(b, h) (shm + (4 + (b) * 2 + (h)) * HT)
  int sr0, sc0, sr1, sc1;
  p8_stage_rc(tid * 16, sr0, sc0);
  p8_stage_rc(tid * 16 + 8192, sr1, sc1);
  const int ao0 = sr0 * lda + sc0, ao1 = sr1 * lda + sc1;
#define bo0 ao0
#define bo1 ao1
#define P8_STAGE_A(Pp, br, kt)                                                                                   \
  {                                                                                                              \
    const half_t* gb_ = A + (size_t)(br) * lda + (size_t)(kt) * 64;                                              \
    __builtin_amdgcn_global_load_lds((const unsigned*)(gb_ + ao0), (unsigned*)((char*)(Pp) + tid * 16), 16, 0, 0);        \
    __builtin_amdgcn_global_load_lds((const unsigned*)(gb_ + ao1), (unsigned*)((char*)(Pp) + tid * 16 + 8192), 16, 0, 0); \
  }
#define P8_STAGE_B(Pp, br, kt)                                                                                   \
  {                                                                                                              \
    const half_t* gb_ = Bt + (size_t)(br) * ldb + (size_t)(kt) * 64;                                             \
    __builtin_amdgcn_global_load_lds((const unsigned*)(gb_ + bo0), (unsigned*)((char*)(Pp) + tid * 16), 16, 0, 0);        \
    __builtin_amdgcn_global_load_lds((const unsigned*)(gb_ + bo1), (unsigned*)((char*)(Pp) + tid * 16 + 8192), 16, 0, 0); \
  }
  const char* abase = smem + p8_lds_byte(wr * 64 + fr, fq * 8);
  const char* bbase = smem + 4 * HT * 2 + p8_lds_byte(wc * 32 + fr, fq * 8);
#define P8_LDA(dst, b, h)                                                                                        \
  _Pragma("unroll") for (int m = 0; m < 4; ++m) _Pragma("unroll") for (int k = 0; k < 2; ++k)                    \
      dst[m][k] = *(const h8*)(abase + ((b) * 2 + (h)) * (HT * 2) + (m * 2 + k) * 1024);
#define P8_LDB(dst, b, h)                                                                                        \
  _Pragma("unroll") for (int n = 0; n < 2; ++n) _Pragma("unroll") for (int k = 0; k < 2; ++k)                    \
      dst[n][k] = *(const h8*)(bbase + ((b) * 2 + (h)) * (HT * 2) + (n * 2 + k) * 1024);
#define P8_MMA(ai, bj, Af, Bf)                                                                                   \
  {                                                                                                              \
    __builtin_amdgcn_s_setprio(1);                                                                               \
    _Pragma("unroll") for (int m = 0; m < 4; ++m) _Pragma("unroll") for (int n = 0; n < 2; ++n)                  \
        _Pragma("unroll") for (int k = 0; k < 2; ++k)                                                            \
            acc[ai][bj][m][n] = __builtin_amdgcn_mfma_f32_16x16x32_f16(Bf[n][k], Af[m][k], acc[ai][bj][m][n], 0, 0, 0); \
    __builtin_amdgcn_s_setprio(0);                                                                               \
  }
#define P8_WAIT_V(n) asm volatile("s_waitcnt vmcnt(" #n ")" ::: "memory")
#define P8_WAIT_L(n) asm volatile("s_waitcnt lgkmcnt(" #n ")" ::: "memory")
#define P8_BAR __builtin_amdgcn_s_barrier()
#define P8_SCHED __builtin_amdgcn_sched_barrier(0)

  f4 acc[2][2][4][2];
#pragma unroll
  for (int i0 = 0; i0 < 2; ++i0)
#pragma unroll
    for (int i1 = 0; i1 < 2; ++i1)
#pragma unroll
      for (int i2 = 0; i2 < 4; ++i2)
#pragma unroll
        for (int i3 = 0; i3 < 2; ++i3) acc[i0][i1][i2][i3] = (f4){0.f, 0.f, 0.f, 0.f};
  h8 At[4][2], B0[2][2], B1[2][2];
  const int nt = g.K >> 6;
  P8_STAGE_B(P8_SB(0, 0), 0, 0); P8_STAGE_A(P8_SA(0, 0), 0, 0);
  P8_STAGE_B(P8_SB(0, 1), 128, 0); P8_STAGE_A(P8_SA(0, 1), 128, 0);
  if (wr == 1) P8_BAR;
  P8_WAIT_V(4); P8_BAR;
  P8_STAGE_B(P8_SB(1, 0), 0, 1); P8_STAGE_A(P8_SA(1, 0), 0, 1); P8_STAGE_B(P8_SB(1, 1), 128, 1);
  P8_WAIT_V(6); P8_BAR;
  for (int t = 0; t < nt - 2; t += 2) {
    P8_LDB(B0, 0, 0); P8_SCHED; P8_LDA(At, 0, 0); P8_STAGE_A(P8_SA(1, 1), 128, t + 1);
    P8_WAIT_L(8); P8_BAR; P8_WAIT_L(0); P8_MMA(0, 0, At, B0); P8_BAR; P8_SCHED;
    P8_LDB(B1, 0, 1); P8_STAGE_B(P8_SB(0, 0), 0, t + 2);
    P8_BAR; P8_WAIT_L(0); P8_MMA(0, 1, At, B1); P8_BAR;
    P8_LDA(At, 0, 1); P8_STAGE_A(P8_SA(0, 0), 0, t + 2);
    P8_BAR; P8_WAIT_L(0); P8_MMA(1, 0, At, B0); P8_BAR; P8_SCHED;
    P8_STAGE_B(P8_SB(0, 1), 128, t + 2);
    P8_WAIT_V(6); P8_BAR; P8_MMA(1, 1, At, B1); P8_BAR;
    P8_LDB(B0, 1, 0); P8_SCHED; P8_LDA(At, 1, 0); P8_STAGE_A(P8_SA(0, 1), 128, t + 2);
    P8_WAIT_L(8); P8_BAR; P8_WAIT_L(0); P8_MMA(0, 0, At, B0); P8_BAR; P8_SCHED;
    P8_LDB(B1, 1, 1); P8_STAGE_B(P8_SB(1, 0), 0, t + 3);
    P8_BAR; P8_WAIT_L(0); P8_MMA(0, 1, At, B1); P8_BAR;
    P8_LDA(At, 1, 1); P8_STAGE_A(P8_SA(1, 0), 0, t + 3);
    P8_BAR; P8_WAIT_L(0); P8_MMA(1, 0, At, B0); P8_BAR; P8_SCHED;
    P8_STAGE_B(P8_SB(1, 1), 128, t + 3);
    P8_WAIT_V(6); P8_BAR; P8_MMA(1, 1, At, B1); P8_BAR;
  }
  {
    P8_LDB(B0, 0, 0); P8_LDA(At, 0, 0); P8_STAGE_A(P8_SA(1, 1), 128, nt - 1);
    P8_BAR; P8_WAIT_L(0); P8_MMA(0, 0, At, B0); P8_BAR;
    P8_LDB(B1, 0, 1); P8_BAR; P8_WAIT_L(0); P8_MMA(0, 1, At, B1); P8_BAR;
    P8_LDA(At, 0, 1); P8_WAIT_V(4); P8_BAR; P8_WAIT_L(0); P8_MMA(1, 0, At, B0); P8_MMA(1, 1, At, B1); P8_BAR;
  }
  {
    P8_LDB(B0, 1, 0); P8_LDA(At, 1, 0); P8_WAIT_V(2); P8_BAR; P8_WAIT_L(0); P8_MMA(0, 0, At, B0); P8_BAR;
    P8_LDB(B1, 1, 1); P8_WAIT_V(0); P8_BAR; P8_WAIT_L(0); P8_MMA(0, 1, At, B1); P8_BAR;
    P8_LDA(At, 1, 1); P8_BAR; P8_WAIT_L(0); P8_MMA(1, 0, At, B0); P8_MMA(1, 1, At, B1); P8_BAR;
  }
  if (wr == 0) P8_BAR;
  asm volatile("" ::: "memory");
#pragma unroll
  for (int ai = 0; ai < 2; ++ai)
#pragma unroll
    for (int m = 0; m < 4; ++m) {
      const int row = ai * 128 + wr * 64 + m * 16 + fr;
#pragma unroll
      for (int bj = 0; bj < 2; ++bj)
#pragma unroll
        for (int n = 0; n < 2; ++n) {
          const int col = bj * 128 + wc * 32 + n * 16 + fq * 4;
          if (g.epi == 4) {
            half_t* vp = g.C + (size_t)(((row >> 6) * 8 + (col >> 6)) * 64 + (col & 63)) * 64 + (row & 63);
#pragma unroll
            for (int j = 0; j < 4; ++j) vp[j * 64] = (half_t)acc[ai][bj][m][n][j];
          } else {
            h4 o;
#pragma unroll
            for (int j = 0; j < 4; ++j) {
              float v = acc[ai][bj][m][n][j];
              if (g.epi == 1) { v = fmaxf(v, 0.f); v = v * v; }
              o[j] = (half_t)v;
            }
            *(h4*)(g.C + (size_t)row * g.ldc + col) = o;
          }
        }
    }
#undef bo0
#undef bo1
#undef P8_SA
#undef P8_SB
#undef P8_STAGE_A
#undef P8_STAGE_B
#undef P8_LDA
#undef P8_LDB
#undef P8_MMA
#undef P8_WAIT_V
#undef P8_WAIT_L
#undef P8_BAR
#undef P8_SCHED
}

__device__ __forceinline__ void gemm_phase(const P& p, const half_t* A, int lda, const half_t* Bt, int ldb, int K, half_t* C, int ldc,
                                           int epi, int nMt, int nNt, int feat, char* smem) {
  char* ws = (p.ws + opaque_zero());
  const int total = nMt * nNt, G = gridDim.x, per_xcd = G >> 3;
  for (int t0 = bidx(); t0 < total + G; t0 += G) {
    const int rnd = t0 / G, bb = t0 - rnd * G;
    const int t = ((G & 7) == 0) ? rnd * G + (bb & 7) * per_xcd + (bb >> 3) : t0;
    if (t >= total) continue;
    const int gsz = 8 * nNt, first = (t / gsz) * 8, gm = min(nMt - first, 8);
    const int mt = first + (t % gsz) % gm, nt = (t % gsz) / gm;
    GemmTile g;
    g.A = A + (size_t)mt * 256 * lda; g.A2 = nullptr; g.mu = nullptr; g.lda = lda;
    const int tw = (feat >= 2) ? 256 : 128;
    g.Bt = Bt + (size_t)nt * tw * ldb; g.ldb = ldb; g.K = K;
    g.C = C + (size_t)mt * 256 * ldc + nt * tw; g.ldc = ldc; g.epi = epi;
    if (feat == 2 && nt >= 6) {
      g.epi = 4;
      g.C = (half_t*)(ws + OFF_A1) + ((size_t)(mt * 4) * 8 + (nt - 6) * 4) * 4096;
    }
    if (feat == 1) {
      g.A2 = (const half_t*)(ws + OFF_A1) + (size_t)mt * 256 * 1024;
      const int grp = nt >> 3, sub = nt & 7;
      int mixi;
      if (grp < 3) {
        mixi = grp == 0 ? 0 : (grp == 1 ? 2 : 3);
        g.Bt = (const half_t*)(ws + (grp == 0 ? OFF_WR : (grp == 1 ? OFF_WK : OFF_WV))) + (size_t)sub * 128 * 1024;
        g.C = (half_t*)(ws + (grp == 0 ? OFF_RR : (grp == 1 ? OFF_KK : OFF_VV))) + (size_t)mt * 256 * 1024 + sub * 128;
      } else {
        mixi = sub == 0 ? 1 : (sub == 1 ? 4 : 5);
        g.Bt = (const half_t*)(ws + OFF_L1) + (size_t)sub * 128 * 1024;
        g.C = (half_t*)(ws + OFF_L) + (size_t)mt * 256 * 384 + sub * 128;
        g.ldc = 384;
        g.epi = sub == 0 ? 2 : (sub == 1 ? 0 : 3);
      }
      g.mu = p.rw_mu + mixi * 1024;
    }
    if (feat == 1) gemm_tile<true>(g, smem); else if (feat >= 2) gemm_tile8(g, smem); else gemm_tile3(g, smem);
  }
}

__device__ void xpose_seg(const float* src, int ldsrc, int K, int N, half_t* dst, int lddst, int koff, int& base,
                          char* smem) {
  float* ts = (float*)smem;
  const int tid = tidx(), G = gridDim.x;
  const int tkn = K >> 6, tnn = N >> 6, cnt = tkn * tnn;
  int t0 = ((int)bidx() - (base % G) + G) % G;
  for (int t = t0; t < cnt; t += G) {
    const int k0 = (t % tkn) * 64, n0 = (t / tkn) * 64;
#pragma unroll
    for (int i = 0; i < 2; ++i) {
      const int c = tid + 512 * i, r = c >> 4, c4 = (c & 15) * 4;
      const float4 v = *(const float4*)(src + (size_t)(k0 + r) * ldsrc + n0 + c4);
      float* d = ts + r * 65 + c4;
      d[0] = v.x; d[1] = v.y; d[2] = v.z; d[3] = v.w;
    }
    __syncthreads();
    {
      const int n = tid >> 3, kc = (tid & 7) * 8;
      h8 o;
#pragma unroll
      for (int i = 0; i < 8; ++i) o[i] = (half_t)ts[(kc + i) * 65 + n];
      *(h8*)(dst + (size_t)(n0 + n) * lddst + koff + k0 + kc) = o;
    }
    __syncthreads();
  }
  base += cnt;
}

__device__ void phase_prep(const P& p, char* smem) {
  const int tid = tidx();
  char* ws = (p.ws + opaque_zero());
  float* MOD = (float*)(ws + OFF_MOD);
  if (bidx() < 192 || gridDim.x < 256) {
    float* sl = (float*)smem;
    for (int i = tid; i < 9216; i += 512) {
      const int b = i >> 10, k = i & 1023;
      const float cv = b < 8 ? p.c[b * 1024 + k] : p.c_ctx[k];
      sl[i] = cv / (1.f + __expf(-cv));
    }
    __syncthreads();
    float* red = sl + 9216;
    for (int item = bidx(); item < 192; item += gridDim.x) {
      const int l = item / 96, n0 = (item % 96) * 64, cn = tid & 63, kq = tid >> 6;
      float acc[9];
#pragma unroll
      for (int b = 0; b < 9; ++b) acc[b] = 0.f;
      const float* wp = p.ada_w + (size_t)l * 1024 * 6144 + n0 + cn;
#pragma unroll 4
      for (int k = kq * 128; k < kq * 128 + 128; ++k) {
        const float wv = wp[(size_t)k * 6144];
#pragma unroll
        for (int b = 0; b < 9; ++b) acc[b] += sl[b * 1024 + k] * wv;
      }
#pragma unroll
      for (int b = 0; b < 9; ++b) red[(kq * 9 + b) * 64 + cn] = acc[b];
      __syncthreads();
      for (int i = tid; i < 576; i += 512) {
        const int b = i >> 6, c = i & 63;
        float s = 0.f;
#pragma unroll
        for (int q = 0; q < 8; ++q) s += red[(q * 9 + b) * 64 + c];
        MOD[(size_t)(l * 9 + b) * 6144 + n0 + c] = s + p.ada_b[l * 6144 + n0 + c];
      }
      __syncthreads();
    }
  }
  for (int it = bidx(); it < 256; it += gridDim.x) {
    if (it < 192) continue;
    const int fi = it - 192, gi = fi >> 4, n0 = (fi & 15) * 64, n = tid & 63, ig = tid >> 6;
    float acc[16];
#pragma unroll
    for (int i = 0; i < 16; ++i) acc[i] = 0.f;
    for (int j = 0; j < 128; ++j) {
      const float wv = p.ev_w_out[(size_t)(gi * 128 + j) * 1024 + n0 + n] * p.ev_pool_scale[gi * 128 + j];
      const float* pw = p.ev_pool_w + ((size_t)gi * 128 + ig * 16) * 128 + j;
#pragma unroll
      for (int i = 0; i < 16; ++i) acc[i] += pw[i * 128] * wv;
    }
    h8 o0, o1;
#pragma unroll
    for (int i = 0; i < 8; ++i) { o0[i] = (half_t)acc[i]; o1[i] = (half_t)acc[8 + i]; }
    half_t* d = (half_t*)(ws + OFF_WOUT) + (size_t)(n0 + n) * 1024 + gi * 128 + ig * 16;
    *(h8*)d = o0;
    *(h8*)(d + 8) = o1;
  }
  __syncthreads();
  int base = 0;
  xpose_seg(p.ev_w_in, 2048, 1024, 2048, (half_t*)(ws + OFF_WIN), 1024, 0, base, smem);
  xpose_seg(p.ev_w_out + 512 * 1024, 1024, 512, 1024, (half_t*)(ws + OFF_WOUT), 1024, 512, base, smem);
  for (int l = 0; l < 2; ++l) {
    xpose_seg(p.mlp_w1 + (size_t)l * 1024 * 4096, 4096, 1024, 4096, (half_t*)(ws + OFF_M1 + l * 8 * MIB), 1024, 0, base, smem);
    xpose_seg(p.mlp_w2 + (size_t)l * 1024 * 4096, 1024, 4096, 1024, (half_t*)(ws + OFF_M2 + l * 8 * MIB), 4096, 0, base, smem);
  }
  xpose_seg(p.rw_wr, 1024, 1024, 1024, (half_t*)(ws + OFF_WR), 1024, 0, base, smem);
  xpose_seg(p.rw_wk, 1024, 1024, 1024, (half_t*)(ws + OFF_WK), 1024, 0, base, smem);
  xpose_seg(p.rw_wv, 1024, 1024, 1024, (half_t*)(ws + OFF_WV), 1024, 0, base, smem);
  xpose_seg(p.rw_wo, 1024, 1024, 1024, (half_t*)(ws + OFF_WO), 1024, 0, base, smem);
  for (int d = 0; d < 2; ++d) {
    xpose_seg(p.rw_w1 + (size_t)d * 1024 * 64, 64, 1024, 64, (half_t*)(ws + OFF_L1) + (size_t)(d * 64) * 1024, 1024, 0, base, smem);
    xpose_seg(p.rw_a1 + (size_t)d * 1024 * 64, 64, 1024, 64, (half_t*)(ws + OFF_L1) + (size_t)(128 + d * 64) * 1024, 1024, 0, base, smem);
    xpose_seg(p.rw_w2 + (size_t)d * 64 * 1024, 1024, 64, 1024, (half_t*)(ws + OFF_W2) + (size_t)d * 1024 * 64, 64, 0, base, smem);
    xpose_seg(p.rw_a2 + (size_t)d * 64 * 1024, 1024, 64, 1024, (half_t*)(ws + OFF_A2) + (size_t)d * 1024 * 64, 64, 0, base, smem);
  }
  xpose_seg(p.rw_g1, 128, 1024, 128, (half_t*)(ws + OFF_L1) + (size_t)256 * 1024, 1024, 0, base, smem);
  xpose_seg(p.rw_g2, 1024, 128, 1024, (half_t*)(ws + OFF_G2), 128, 0, base, smem);
}

__device__ void phase_rowwise(const P& p, int mode) {
  const int lane = tidx() & 63;
  const int gw = bidx() * 8 + (tidx() >> 6), nw = gridDim.x * 8;
  char* ws = (p.ws + opaque_zero());
  const float* MOD = (const float*)(ws + OFF_MOD);
  float* XC = (float*)(ws + OFF_XC);
  half_t* H = (half_t*)(ws + OFF_A0);
  const half_t* Y = (const half_t*)(ws + OFF_A1);
  const int nrows = (mode >= 3) ? RL : RT;
  const int per = (nrows + nw - 1) / nw;
  const int r0 = gw * per, r1 = min(r0 + per, nrows);
  if (r0 >= r1) return;
  const bool hasY = mode != 0, hasH = mode != 4;
  const float EPS = opaque_f(1e-6f);
  const int lyr = (mode <= 1) ? 0 : ((mode == 2) ? 0 : 1);
  const int gyi = (mode == 1) ? 1 : (mode == 2 ? 3 : (mode == 3 ? 5 : 7));
  const int gti = (mode == 1) ? 2 : (mode == 2 ? 5 : (mode == 3 ? 2 : 5));
  const int hl = (mode <= 1) ? 0 : 1;
  const int ghi = (mode == 0) ? 0 : (mode == 1 ? 2 : (mode == 2 ? 4 : 6));
  const int shi = (mode == 0 || mode == 2) ? 0 : 3;
  auto xsrc = [&](int row) -> const float* {
    if (mode <= 1) return row < RL ? p.x + (size_t)row * 1024 : p.ctx + (size_t)(row - RL) * 1024;
    return row < RL ? p.out + (size_t)row * 1024 : XC + (size_t)(row - RL) * 1024;
  };
  auto xdst = [&](int row) -> float* { return row < RL ? p.out + (size_t)row * 1024 : XC + (size_t)(row - RL) * 1024; };
  float4 gy[4], gt[4], gh[4], s1[4], s2[4];
  int cur_mi = -1;
  float4 nx[4];
  h4 ny[4];
  {
    const float* xs = xsrc(r0);
#pragma unroll
    for (int i = 0; i < 4; ++i) nx[i] = *(const float4*)(xs + i * 256 + lane * 4);
    if (hasY) {
#pragma unroll
      for (int i = 0; i < 4; ++i) ny[i] = *(const h4*)(Y + (size_t)r0 * 1024 + i * 256 + lane * 4);
    }
  }
  for (int row = r0; row < r1; ++row) {
    float xv[4][4];
    h4 yh[4];
#pragma unroll
    for (int i = 0; i < 4; ++i) { xv[i][0] = nx[i].x; xv[i][1] = nx[i].y; xv[i][2] = nx[i].z; xv[i][3] = nx[i].w; yh[i] = ny[i]; }
    if (row + 1 < r1) {
      const float* xs = xsrc(row + 1);
#pragma unroll
      for (int i = 0; i < 4; ++i) nx[i] = *(const float4*)(xs + i * 256 + lane * 4);
      if (hasY) {
#pragma unroll
        for (int i = 0; i < 4; ++i) ny[i] = *(const h4*)(Y + (size_t)(row + 1) * 1024 + i * 256 + lane * 4);
      }
    }
    const int mi = row < RL ? (row >> 12) : 8;
    if (mi != cur_mi) {
      cur_mi = mi;
      const float* mg = MOD + (size_t)(lyr * 9 + mi) * 6144;
      const float* mh = MOD + (size_t)(hl * 9 + mi) * 6144;
#pragma unroll
      for (int i = 0; i < 4; ++i) {
        const int o = i * 256 + lane * 4;
        if (hasY) { gy[i] = *(const float4*)(p.norm_g + gyi * 1024 + o); gt[i] = *(const float4*)(mg + gti * 1024 + o); }
        if (hasH) {
          gh[i] = *(const float4*)(p.norm_g + ghi * 1024 + o);
          s1[i] = *(const float4*)(mh + shi * 1024 + o);
          s2[i] = *(const float4*)(mh + (shi + 1) * 1024 + o);
        }
      }
    }
    if (hasY) {
      float yv[4][4];
      float ss = 0.f;
#pragma unroll
      for (int i = 0; i < 4; ++i)
#pragma unroll
        for (int k = 0; k < 4; ++k) { yv[i][k] = (float)yh[i][k]; ss += yv[i][k] * yv[i][k]; }
      ss = wave_sum(ss, lane);
      const float rs = rsqrtf(ss * (1.f / 1024.f) + EPS);
      float* xo = xdst(row);
#pragma unroll
      for (int i = 0; i < 4; ++i) {
        xv[i][0] += gt[i].x * (yv[i][0] * rs * gy[i].x);
        xv[i][1] += gt[i].y * (yv[i][1] * rs * gy[i].y);
        xv[i][2] += gt[i].z * (yv[i][2] * rs * gy[i].z);
        xv[i][3] += gt[i].w * (yv[i][3] * rs * gy[i].w);
        *(float4*)(xo + i * 256 + lane * 4) = make_float4(xv[i][0], xv[i][1], xv[i][2], xv[i][3]);
      }
    }
    if (hasH) {
      float ss = 0.f;
#pragma unroll
      for (int i = 0; i < 4; ++i)
#pragma unroll
        for (int k = 0; k < 4; ++k) ss += xv[i][k] * xv[i][k];
      ss = wave_sum(ss, lane);
      const float rs = rsqrtf(ss * (1.f / 1024.f) + EPS);
      half_t* ho = H + (size_t)row * 1024;
#pragma unroll
      for (int i = 0; i < 4; ++i) {
        h4 o;
        o[0] = (half_t)(xv[i][0] * rs * gh[i].x * (1.f + s2[i].x) + s1[i].x);
        o[1] = (half_t)(xv[i][1] * rs * gh[i].y * (1.f + s2[i].y) + s1[i].y);
        o[2] = (half_t)(xv[i][2] * rs * gh[i].z * (1.f + s2[i].z) + s1[i].z);
        o[3] = (half_t)(xv[i][3] * rs * gh[i].w * (1.f + s2[i].w) + s1[i].w);
        *(h4*)(ho + i * 256 + lane * 4) = o;
      }
    }
  }
}

__device__ __forceinline__ int clampi(int v, int lo, int hi) { return v < lo ? lo : (v > hi ? hi : v); }

__device__ void attn_item(const P& p, int item, char* smem) {
  half_t* Ks = (half_t*)smem;
  half_t* Vt = Ks + 2 * 64 * 72;
  float* rpbs = (float*)(smem + 36864);
  const int tid = tidx(), lane = tid & 63, w = tid >> 6, lr = lane & 15, lq = lane >> 4;
  const half_t* U = (const half_t*)((p.ws + opaque_zero()) + OFF_U);
  half_t* Z = (half_t*)((p.ws + opaque_zero()) + OFF_Z);
  const bool isctx = item >= 2048;
  int b, h, qrow, nlat = 0, start0 = 0, my_r = 0, my_start = 0, cw = 0, cs = 0, qcol = 0;
  if (!isctx) {
    b = item >> 8; h = (item >> 5) & 7;
    const int r0 = (item & 31) * 2;
    my_r = r0 + (w >> 2);
    const int cgp = w & 3;
    qcol = cgp * 16 + lr;
    qrow = b * 4096 + my_r * 64 + qcol;
    start0 = clampi(r0 - 4, 0, 56);
    const int start1 = clampi(r0 + 1 - 4, 0, 56);
    nlat = start1 + 8 - start0;
    my_start = clampi(my_r - 4, 0, 56);
    cw = clampi(cgp * 16 - 8, 0, 32);
    cs = clampi(qcol - 8, 0, 48);
  } else {
    const int it = item - 2048;
    b = it >> 4; h = (it >> 1) & 7;
    qrow = RL + b * 256 + (it & 1) * 128 + w * 16 + lr;
  }
  const int ntiles = nlat + 4;
  h8 qf[2];
#pragma unroll
  for (int ks = 0; ks < 2; ++ks) {
    h8 t = *(const h8*)(U + (size_t)qrow * 2048 + 512 + h * 64 + ks * 32 + lq * 8);
#pragma unroll
    for (int i = 0; i < 8; ++i) t[i] = t[i] * (half_t)0.125f;
    qf[ks] = t;
  }
  if (!isctx)
    for (int i = tid; i < 465; i += 512) rpbs[i] = p.ev_rpb[h * 465 + i];

  const int skey = tid >> 3, sd = (tid & 7) * 8;
  uint4 kA, vA, kB, vB;
  auto tile_row0 = [&](int i) -> int { return i < nlat ? b * 4096 + (start0 + i) * 64 : RL + b * 256 + (i - nlat) * 64; };
  const half_t* VTg = (const half_t*)((p.ws + opaque_zero()) + OFF_A1);
#define AT_GLOAD(kr, vr, i)                                                                            \
  {                                                                                                    \
    const int r0t = tile_row0(i);                                                                      \
    kr = *(const uint4*)(U + (size_t)(r0t + skey) * 2048 + 1024 + h * 64 + sd);                        \
    vr = *(const uint4*)(VTg + ((size_t)(r0t >> 6) * 8 + h) * 4096 + skey * 64 + sd);                  \
  }
#define AT_SSTORE(kr, vr, buf)                                                                         \
  {                                                                                                    \
    *(uint4*)(Ks + (buf) * 4608 + skey * 72 + sd) = kr;                                                \
    *(uint4*)(Vt + (buf) * 4608 + skey * 72 + sd) = vr;                                                \
  }
  f4 o[4];
#pragma unroll
  for (int i = 0; i < 4; ++i) o[i] = (f4){0.f, 0.f, 0.f, 0.f};
  const float NEG = opaque_f(-1e30f);
  float m = NEG, l = 0.f;

  AT_GLOAD(kA, vA, 0);
  AT_SSTORE(kA, vA, 0);
  AT_GLOAD(kA, vA, 1);
  AT_GLOAD(kB, vB, 2);
  __syncthreads();
  for (int i = 0; i < ntiles; ++i) {
    const int buf = i & 1;
    const bool lt = i < nlat;
    const int kr_abs = start0 + i;
    const bool active = !lt || (kr_abs >= my_start && kr_abs < my_start + 8);
    if (active) {
      const int npairs = lt ? 1 : 2;
      for (int pi = 0; pi < npairs; ++pi) {
        const int kb = lt ? cw : pi * 32;
        f4 s[2];
#pragma unroll
        for (int st = 0; st < 2; ++st) {
          f4 z = (f4){0.f, 0.f, 0.f, 0.f};
#pragma unroll
          for (int ks = 0; ks < 2; ++ks) {
            const h8 kf = *(const h8*)(Ks + buf * 4608 + (kb + st * 16 + lr) * 72 + ks * 32 + lq * 8);
            z = __builtin_amdgcn_mfma_f32_16x16x32_f16(kf, qf[ks], z, 0, 0, 0);
          }
          s[st] = z;
        }
        float tmax = NEG;
#pragma unroll
        for (int st = 0; st < 2; ++st)
#pragma unroll
          for (int j = 0; j < 4; ++j) {
            float v = s[st][j];
            if (lt) {
              const int kc = kb + st * 16 + lq * 4 + j;
              const bool ok = (kc >= cs) && (kc < cs + 16);
              const int dc = clampi(kc - qcol + 15, 0, 30);
              const int dr = kr_abs - my_r + 7;
              v = ok ? v + rpbs[dr * 31 + dc] : NEG;
            }
            s[st][j] = v;
            tmax = fmaxf(tmax, v);
          }
        tmax = fmaxf(tmax, bperm(tmax, lane ^ 16));
        tmax = fmaxf(tmax, bperm(tmax, lane ^ 32));
        const float mn = fmaxf(m, tmax);
        const float alpha = __expf(m - mn);
        m = mn;
        h8 pb;
        float ps = 0.f;
#pragma unroll
        for (int st = 0; st < 2; ++st)
#pragma unroll
          for (int j = 0; j < 4; ++j) {
            const float e = __expf(s[st][j] - mn);
            ps += e;
            pb[st * 4 + j] = (half_t)e;
          }
        l = l * alpha + ps;
#pragma unroll
        for (int dt = 0; dt < 4; ++dt) {
          o[dt] = o[dt] * alpha;
          const half_t* vp = Vt + buf * 4608 + (dt * 16 + lr) * 72 + kb + lq * 4;
          const h4 v0 = *(const h4*)vp;
          const h4 v1 = *(const h4*)(vp + 16);
          h8 vf;
          vf[0] = v0[0]; vf[1] = v0[1]; vf[2] = v0[2]; vf[3] = v0[3];
          vf[4] = v1[0]; vf[5] = v1[1]; vf[6] = v1[2]; vf[7] = v1[3];
          o[dt] = __builtin_amdgcn_mfma_f32_16x16x32_f16(vf, pb, o[dt], 0, 0, 0);
        }
      }
    }
    if (i + 1 < ntiles) {
      if ((i + 1) & 1) {
        AT_SSTORE(kA, vA, 1);
        if (i + 3 < ntiles) AT_GLOAD(kA, vA, i + 3);
      } else {
        AT_SSTORE(kB, vB, 0);
        if (i + 3 < ntiles) AT_GLOAD(kB, vB, i + 3);
      }
    }
    __syncthreads();
  }
#undef AT_GLOAD
#undef AT_SSTORE
  l += bperm(l, lane ^ 16);
  l += bperm(l, lane ^ 32);
  const float inv = 1.f / l;
#pragma unroll
  for (int dt = 0; dt < 4; ++dt) {
    h4 ov;
#pragma unroll
    for (int j = 0; j < 4; ++j) ov[j] = (half_t)(o[dt][j] * inv);
    *(h4*)(Z + (size_t)qrow * 1024 + 512 + h * 64 + dt * 16 + lq * 4) = ov;
  }
}

template <int HW>
__device__ __forceinline__ void pool_rows(const float (&pre)[4][25], int tl0, int L, half_t* zp) {
#pragma unroll
  for (int r = 0; r < 8; ++r) {
    const int tl = tl0 + r;
    const int lo = max(tl - HW, 0), hi = min(tl + HW, L);
    const float inv = 1.f / (float)(hi - lo);
    h4 o;
#pragma unroll
    for (int c = 0; c < 4; ++c) {
      const float sum = pre[c][8 + r + HW] - pre[c][8 + r - HW];
      const float cur = pre[c][8 + r + 1] - pre[c][8 + r];
      o[c] = (half_t)(sum * inv - cur);
    }
    *(h4*)(zp + (size_t)r * 1024) = o;
  }
}

__device__ void pool_item(const P& p, int item) {
  const half_t* U = (const half_t*)((p.ws + opaque_zero()) + OFF_U);
  half_t* Z = (half_t*)((p.ws + opaque_zero()) + OFF_Z);
  const int tid = tidx();
  const int c4 = (tid & 127) * 4, gi = c4 >> 7;
  const int row0 = item * 32 + (tid >> 7) * 8;
  int s0, L;
  if (row0 < RL) { s0 = row0 & ~4095; L = 4096; } else { s0 = RL + ((row0 - RL) & ~255); L = 256; }
  const int tl0 = row0 - s0;
  float pre[4][25];
#pragma unroll
  for (int c = 0; c < 4; ++c) pre[c][0] = 0.f;
#pragma unroll
  for (int i = 0; i < 24; ++i) {
    const int tl = tl0 - 8 + i;
    h4 v;
    v[0] = (half_t)0.f; v[1] = (half_t)0.f; v[2] = (half_t)0.f; v[3] = (half_t)0.f;
    if (tl >= 0 && tl < L) v = *(const h4*)(U + (size_t)(s0 + tl) * 2048 + c4);
#pragma unroll
    for (int c = 0; c < 4; ++c) pre[c][i + 1] = (float)v[c];
  }
#pragma unroll
  for (int i = 0; i < 24; ++i)
#pragma unroll
    for (int c = 0; c < 4; ++c) pre[c][i + 1] += pre[c][i];
  half_t* zp = Z + (size_t)row0 * 1024 + c4;
  if (gi == 0) pool_rows<1>(pre, tl0, L, zp);
  else if (gi == 1) pool_rows<2>(pre, tl0, L, zp);
  else if (gi == 2) pool_rows<4>(pre, tl0, L, zp);
  else pool_rows<8>(pre, tl0, L, zp);
}

__device__ void phase_shift(const P& p) {
  const half_t* H = (const half_t*)((p.ws + opaque_zero()) + OFF_A0);
  half_t* XX = (half_t*)((p.ws + opaque_zero()) + OFF_A1);
  const size_t total = (size_t)RT * 128;
  for (size_t idx = (size_t)bidx() * 512 + tidx(); idx < total; idx += (size_t)gridDim.x * 512) {
    const int row = (int)(idx >> 7), c = (int)(idx & 127) * 8;
    bool st, en;
    if (row < RL) { st = (row & 4095) == 0; en = (row & 4095) == 4095; }
    else { st = ((row - RL) & 255) == 0; en = ((row - RL) & 255) == 255; }
    const h8 cur = *(const h8*)(H + (size_t)row * 1024 + c);
    h8 pv, nx;
#pragma unroll
    for (int i = 0; i < 8; ++i) { pv[i] = (half_t)0.f; nx[i] = (half_t)0.f; }
    if (!st) pv = *(const h8*)(H + (size_t)(row - 1) * 1024 + c);
    if (!en) nx = *(const h8*)(H + (size_t)(row + 1) * 1024 + c);
    h8 o;
#pragma unroll
    for (int i = 0; i < 8; ++i) o[i] = (half_t)(0.5f * ((float)pv[i] + (float)nx[i]) - (float)cur[i]);
    *(h8*)(XX + (size_t)row * 1024 + c) = o;
  }
}

#define CS_BYTES 13312
#define CS_G 0
#define CS_R 2304
#define CS_AT 4608
#define CS_BT 6656
#define CS_VT 8704
#define CS_M 10752
#define CS_BM 11264
#define CS_CM 11776
#define CS_DM 12288
#define CS_PREF 12800
#define CS_PEND 13056
#define SCR_BASE 106496
#define SCR_BYTES 5632

__device__ void scan_item(const P& p, int item, char* smem) {
  const int tid = tidx(), lane = tid & 63, w = tid >> 6, lr = lane & 15, lq = lane >> 4;
  const int b = item >> 5, h = (item >> 1) & 15, dir = item & 1;
  char* ws = (p.ws + opaque_zero());
  const half_t* RRp = (const half_t*)(ws + OFF_RR);
  const half_t* KKp = (const half_t*)(ws + OFF_KK);
  const half_t* VVp = (const half_t*)(ws + OFF_VV);
  const half_t* Lp = (const half_t*)(ws + OFF_L);
  half_t* Yd = (half_t*)(ws + (dir ? OFF_A1 : OFF_A0));
  float* BN = (float*)(ws + OFF_BN) + (size_t)dir * RL * 16;

  auto grow = [&](int pp) -> int {
    if (pp < 256) return RL + b * 256 + (dir ? 255 - pp : pp);
    const int t = pp - 256;
    return b * 4096 + (dir ? 4095 - t : t);
  };

  auto prep = [&](int c) {
    char* cs = smem + w * CS_BYTES;
    half_t* G_ = (half_t*)(cs + CS_G);
    half_t* R_ = (half_t*)(cs + CS_R);
    half_t* AT = (half_t*)(cs + CS_AT);
    half_t* BT = (half_t*)(cs + CS_BT);
    half_t* VT = (half_t*)(cs + CS_VT);
    half_t* Mm = (half_t*)(cs + CS_M);
    half_t* Bm = (half_t*)(cs + CS_BM);
    half_t* Cm = (half_t*)(cs + CS_CM);
    half_t* Dm = (half_t*)(cs + CS_DM);
    float* Pref = (float*)(cs + CS_PREF);
    float* Pend = (float*)(cs + CS_PEND);
    char* scr = smem + SCR_BASE + w * SCR_BYTES;
    half_t* A_ = (half_t*)scr;
    half_t* B_ = (half_t*)(scr + 2304);
    float* Am = (float*)(scr + 4608);
    const bool lat = c >= 16;
    const int p0 = c * 16;
    const int rowA = grow(p0 + lr);
    const half_t* lp = Lp + (size_t)rowA * 384 + dir * 64 + lq * 8;
    const h8 aw0 = *(const h8*)(lp), aw1 = *(const h8*)(lp + 32);
    const h8 aa0 = *(const h8*)(lp + 128), aa1 = *(const h8*)(lp + 160);
    float ss[4], bp[4];
    int rows[4];
#pragma unroll
    for (int j = 0; j < 4; ++j) { ss[j] = 0.f; bp[j] = 0.f; rows[j] = grow(p0 + lq * 4 + j); }
#pragma unroll 1
    for (int nt = 0; nt < 4; ++nt) {
      const int ch = h * 64 + nt * 16 + lr;
      const float kkc = p.rw_kk[ch];
#pragma unroll
      for (int j = 0; j < 4; ++j) {
        const float k = (float)KKp[(size_t)rows[j] * 1024 + ch];
        ss[j] += (k * kkc) * (k * kkc);
      }
    }
    float inv[4];
#pragma unroll
    for (int j = 0; j < 4; ++j) inv[j] = rsqrtf(fmaxf(red16(ss[j]), 1e-24f));
#pragma unroll 1
    for (int nt = 0; nt < 4; ++nt) {
      const int ch = h * 64 + nt * 16 + lr;
      const half_t* w2p = (const half_t*)(ws + OFF_W2) + (size_t)dir * 65536 + (size_t)ch * 64 + lq * 8;
      const half_t* a2p = (const half_t*)(ws + OFF_A2) + (size_t)dir * 65536 + (size_t)ch * 64 + lq * 8;
      const h8 bw0 = *(const h8*)(w2p), bw1 = *(const h8*)(w2p + 32);
      const h8 ba0 = *(const h8*)(a2p), ba1 = *(const h8*)(a2p + 32);
      const float w0c = p.rw_w0[dir * 1024 + ch], a0c = p.rw_a0[dir * 1024 + ch];
      const float kkc = p.rw_kk[ch], kac = p.rw_ka[ch], rkc = p.rw_rk[ch];
      f4 cwv = (f4){0.f, 0.f, 0.f, 0.f}, cav = (f4){0.f, 0.f, 0.f, 0.f};
      cwv = __builtin_amdgcn_mfma_f32_16x16x32_f16(aw0, bw0, cwv, 0, 0, 0);
      cwv = __builtin_amdgcn_mfma_f32_16x16x32_f16(aw1, bw1, cwv, 0, 0, 0);
      cav = __builtin_amdgcn_mfma_f32_16x16x32_f16(aa0, ba0, cav, 0, 0, 0);
      cav = __builtin_amdgcn_mfma_f32_16x16x32_f16(aa1, ba1, cav, 0, 0, 0);
      h4 vq;
      float ev[4], avv[4], rv[4], kv[4];
#pragma unroll
      for (int j = 0; j < 4; ++j) {
        const size_t gi = (size_t)rows[j] * 1024 + ch;
        kv[j] = (float)KKp[gi];
        vq[j] = VVp[gi];
        rv[j] = lat ? (float)RRp[gi] : 0.f;
        ev[j] = 0.60653066f * sigm(cwv[j] + w0c);
        avv[j] = sigm(cav[j] + a0c);
        bp[j] += rv[j] * kv[j] * rkc * (dir == 0 ? (2.f - 2.f * kac + kac * avv[j]) : kac * avv[j]);
      }
      *(h4*)(VT + (nt * 16 + lr) * 16 + lq * 4) = vq;
      float cum[4];
      cum[0] = ev[0];
      cum[1] = cum[0] + ev[1];
      cum[2] = cum[1] + ev[2];
      cum[3] = cum[2] + ev[3];
      const float t1 = bperm(cum[3], (lane - 16) & 63), t2 = bperm(cum[3], (lane - 32) & 63), t3 = bperm(cum[3], (lane - 48) & 63);
      const float off = (lq >= 1 ? t1 : 0.f) + (lq >= 2 ? t2 : 0.f) + (lq >= 3 ? t3 : 0.f);
#pragma unroll
      for (int j = 0; j < 4; ++j) cum[j] += off;
      const float ref = bperm(cum[3], 16 + lr);
      const float end = bperm(cum[3], 48 + lr);
      if (lq == 0) {
        Pref[nt * 16 + lr] = __expf(-ref);
        Pend[nt * 16 + lr] = __expf(-(end - ref));
      }
      h4 aq, bq;
#pragma unroll
      for (int j = 0; j < 4; ++j) {
        const float d = cum[j] - ref;
        const float E1 = __expf(d), E2 = __expf(-d), E3 = __expf(ev[j] - d);
        const float k = kv[j];
        const float kk = k * kkc * inv[j];
        const float kd = k * (1.f + (avv[j] - 1.f) * kac);
        const half_t ga = (half_t)(kk * E3);
        const half_t ro = (half_t)(rv[j] * E2);
        const half_t al = (half_t)(kk * avv[j] * E1);
        const half_t be = (half_t)(kd * E1);
        const int o = (lq * 4 + j) * 72 + nt * 16 + lr;
        G_[o] = ga; R_[o] = ro; A_[o] = al; B_[o] = be;
        aq[j] = al; bq[j] = be;
      }
      *(h4*)(AT + (nt * 16 + lr) * 16 + lq * 4) = aq;
      *(h4*)(BT + (nt * 16 + lr) * 16 + lq * 4) = bq;
    }
#pragma unroll
    for (int j = 0; j < 4; ++j) {
      const float bpr = red16(bp[j]);
      if (lat && lr == 0) BN[(size_t)rows[j] * 16 + h] = bpr;
    }
    asm volatile("s_waitcnt lgkmcnt(0)" ::: "memory");
    f4 am = (f4){0.f, 0.f, 0.f, 0.f}, bm = am, cm = am, dm = am;
#pragma unroll
    for (int ks = 0; ks < 2; ++ks) {
      const h8 fa = *(const h8*)(A_ + lr * 72 + ks * 32 + lq * 8);
      const h8 fb = *(const h8*)(B_ + lr * 72 + ks * 32 + lq * 8);
      const h8 fg = *(const h8*)(G_ + lr * 72 + ks * 32 + lq * 8);
      const h8 fr = *(const h8*)(R_ + lr * 72 + ks * 32 + lq * 8);
      am = __builtin_amdgcn_mfma_f32_16x16x32_f16(fa, fg, am, 0, 0, 0);
      bm = __builtin_amdgcn_mfma_f32_16x16x32_f16(fb, fg, bm, 0, 0, 0);
      cm = __builtin_amdgcn_mfma_f32_16x16x32_f16(fa, fr, cm, 0, 0, 0);
      dm = __builtin_amdgcn_mfma_f32_16x16x32_f16(fb, fr, dm, 0, 0, 0);
    }
    h4 bmh, cmh, dmh;
#pragma unroll
    for (int j = 0; j < 4; ++j) {
      const int u = lq * 4 + j;
      am[j] = u < lr ? am[j] : 0.f;
      bmh[j] = (half_t)(u < lr ? bm[j] : 0.f);
      cmh[j] = (half_t)(u <= lr ? cm[j] : 0.f);
      dmh[j] = (half_t)(u <= lr ? dm[j] : 0.f);
    }
    *(h4*)(Bm + lr * 16 + lq * 4) = bmh;
    *(h4*)(Cm + lr * 16 + lq * 4) = cmh;
    *(h4*)(Dm + lr * 16 + lq * 4) = dmh;
    *(f4*)(Am + lr * 16 + lq * 4) = am;
    asm volatile("s_waitcnt lgkmcnt(0)" ::: "memory");
    float m[16];
#pragma unroll
    for (int t = 0; t < 16; ++t) {
      float acc = (t == lr) ? 1.f : 0.f;
#pragma unroll
      for (int u4 = 0; u4 < 4; ++u4) {
        if (u4 * 4 < t) {
          const f4 rw = *(const f4*)(Am + t * 16 + u4 * 4);
#pragma unroll
          for (int k = 0; k < 4; ++k)
            if (u4 * 4 + k < t) acc -= rw[k] * m[u4 * 4 + k];
        }
      }
      m[t] = acc;
    }
    if (lq == 0) {
#pragma unroll
      for (int t = 0; t < 16; ++t) Mm[t * 16 + lr] = (half_t)m[t];
    }
  };

  f4 Sacc[4];
#pragma unroll
  for (int jt = 0; jt < 4; ++jt) Sacc[jt] = (f4){0.f, 0.f, 0.f, 0.f};

  for (int sc = 0; sc < 34; ++sc) {
    prep(sc * 8 + w);
    __syncthreads();
    if (w < 4) {
      for (int cc = 0; cc < 8; ++cc) {
        const int c = sc * 8 + cc;
        const char* cs = smem + cc * CS_BYTES;
        const half_t* G_ = (const half_t*)(cs + CS_G);
        const half_t* R_ = (const half_t*)(cs + CS_R);
        const half_t* AT = (const half_t*)(cs + CS_AT);
        const half_t* BT = (const half_t*)(cs + CS_BT);
        const half_t* VT = (const half_t*)(cs + CS_VT);
        const half_t* Mm = (const half_t*)(cs + CS_M);
        const half_t* Bm = (const half_t*)(cs + CS_BM);
        const half_t* Cm = (const half_t*)(cs + CS_CM);
        const half_t* Dm = (const half_t*)(cs + CS_DM);
        const float* Pref = (const float*)(cs + CS_PREF);
        const float* Pend = (const float*)(cs + CS_PEND);
#pragma unroll
        for (int jt = 0; jt < 4; ++jt) Sacc[jt] = Sacc[jt] * *(const f4*)(Pref + jt * 16 + lq * 4);
        h8 bS[2];
#pragma unroll
        for (int ks = 0; ks < 2; ++ks)
#pragma unroll
          for (int k = 0; k < 4; ++k) {
            bS[ks][k] = (half_t)Sacc[2 * ks][k];
            bS[ks][4 + k] = (half_t)Sacc[2 * ks + 1][k];
          }
        const h4 vt = *(const h4*)(VT + (16 * w + lr) * 16 + lq * 4);
        f4 rhs = (f4){0.f, 0.f, 0.f, 0.f};
#pragma unroll
        for (int ks = 0; ks < 2; ++ks) {
          const h4 g0 = *(const h4*)(G_ + lr * 72 + (2 * ks) * 16 + lq * 4);
          const h4 g1 = *(const h4*)(G_ + lr * 72 + (2 * ks + 1) * 16 + lq * 4);
          h8 gf;
          gf[0] = g0[0]; gf[1] = g0[1]; gf[2] = g0[2]; gf[3] = g0[3];
          gf[4] = g1[0]; gf[5] = g1[1]; gf[6] = g1[2]; gf[7] = g1[3];
          rhs = __builtin_amdgcn_mfma_f32_16x16x32_f16(gf, bS[ks], rhs, 0, 0, 0);
        }
        {
          f4 r16 = (f4){0.f, 0.f, 0.f, 0.f};
          r16 = __builtin_amdgcn_mfma_f32_16x16x16f16(*(const h4*)(Bm + lr * 16 + lq * 4), vt, r16, 0, 0, 0);
          rhs = rhs + r16;
        }
        h4 rh;
#pragma unroll
        for (int k = 0; k < 4; ++k) rh[k] = (half_t)rhs[k];
        f4 av = (f4){0.f, 0.f, 0.f, 0.f};
        av = __builtin_amdgcn_mfma_f32_16x16x16f16(*(const h4*)(Mm + lr * 16 + lq * 4), rh, av, 0, 0, 0);
        h4 na;
#pragma unroll
        for (int k = 0; k < 4; ++k) na[k] = (half_t)(-av[k]);
        if (c >= 16) {
          f4 y = (f4){0.f, 0.f, 0.f, 0.f};
#pragma unroll
          for (int ks = 0; ks < 2; ++ks) {
            const h4 g0 = *(const h4*)(R_ + lr * 72 + (2 * ks) * 16 + lq * 4);
            const h4 g1 = *(const h4*)(R_ + lr * 72 + (2 * ks + 1) * 16 + lq * 4);
            h8 gf;
            gf[0] = g0[0]; gf[1] = g0[1]; gf[2] = g0[2]; gf[3] = g0[3];
            gf[4] = g1[0]; gf[5] = g1[1]; gf[6] = g1[2]; gf[7] = g1[3];
            y = __builtin_amdgcn_mfma_f32_16x16x32_f16(gf, bS[ks], y, 0, 0, 0);
          }
          f4 y16 = (f4){0.f, 0.f, 0.f, 0.f};
          y16 = __builtin_amdgcn_mfma_f32_16x16x16f16(*(const h4*)(Cm + lr * 16 + lq * 4), na, y16, 0, 0, 0);
          y16 = __builtin_amdgcn_mfma_f32_16x16x16f16(*(const h4*)(Dm + lr * 16 + lq * 4), vt, y16, 0, 0, 0);
          y = y + y16;
#pragma unroll
          for (int k = 0; k < 4; ++k) {
            const int row = grow(c * 16 + lq * 4 + k);
            Yd[(size_t)row * 1024 + h * 64 + 16 * w + lr] = (half_t)y[k];
          }
        }
#pragma unroll
        for (int jt = 0; jt < 4; ++jt) {
          Sacc[jt] = __builtin_amdgcn_mfma_f32_16x16x16f16(*(const h4*)(AT + (jt * 16 + lr) * 16 + lq * 4), na, Sacc[jt], 0, 0, 0);
          Sacc[jt] = __builtin_amdgcn_mfma_f32_16x16x16f16(*(const h4*)(BT + (jt * 16 + lr) * 16 + lq * 4), vt, Sacc[jt], 0, 0, 0);
          Sacc[jt] = Sacc[jt] * *(const f4*)(Pend + jt * 16 + lq * 4);
        }
      }
    }
    __syncthreads();
  }
}

__device__ void phase_readout(const P& p) {
  const int lane = tidx() & 63;
  const int gw = bidx() * 8 + (tidx() >> 6), stride = gridDim.x * 8;
  char* ws = (p.ws + opaque_zero());
  const half_t* Y0 = (const half_t*)(ws + OFF_A0);
  const half_t* Y1 = (const half_t*)(ws + OFF_A1);
  const half_t* VVp = (const half_t*)(ws + OFF_VV);
  const half_t* Gp = (const half_t*)(ws + OFF_G);
  const float* BN0 = (const float*)(ws + OFF_BN);
  const float* BN1 = BN0 + (size_t)RL * 16;
  half_t* Z1 = (half_t*)(ws + OFF_Z1);
  const int c0 = lane * 16, head = lane >> 2;
  for (int row = gw; row < RL; row += stride) {
    const size_t o = (size_t)row * 1024 + c0;
    float y[16], vv[16], gg[16];
#pragma unroll
    for (int hh = 0; hh < 2; ++hh) {
      const h8 a = *(const h8*)(Y0 + o + hh * 8);
      const h8 bq = *(const h8*)(Y1 + o + hh * 8);
      const h8 v = *(const h8*)(VVp + o + hh * 8);
      const h8 g = *(const h8*)(Gp + o + hh * 8);
#pragma unroll
      for (int i = 0; i < 8; ++i) {
        y[hh * 8 + i] = (float)a[i] + (float)bq[i];
        vv[hh * 8 + i] = (float)v[i];
        gg[hh * 8 + i] = (float)g[i];
      }
    }
    float s = 0.f;
#pragma unroll
    for (int i = 0; i < 16; ++i) s += y[i];
    s = red4(s);
    const float mean = s * (1.f / 64.f);
    float q = 0.f;
#pragma unroll
    for (int i = 0; i < 16; ++i) { const float d = y[i] - mean; q += d * d; }
    q = red4(q);
    const float rstd = rsqrtf(q * (1.f / 64.f) + 64e-5f);
    const float bonus = BN0[(size_t)row * 16 + head] + BN1[(size_t)row * 16 + head];
    h8 o0, o1;
#pragma unroll
    for (int i = 0; i < 16; ++i) {
      const float lg = p.rw_lng[c0 + i], lb = p.rw_lnb[c0 + i];
      const float r = ((y[i] - mean) * rstd * lg + lb + bonus * vv[i]) * gg[i];
      if (i < 8) o0[i] = (half_t)r; else o1[i - 8] = (half_t)r;
    }
    *(h8*)(Z1 + o) = o0;
    *(h8*)(Z1 + o + 8) = o1;
  }
}

#define NPHASE 19
__global__ void __launch_bounds__(512) mega(P p_in, int ph_lo, int ph_hi) {
  __shared__ __attribute__((aligned(16))) char smem[SMEM_BYTES];
  cg::grid_group grid = cg::this_grid();
  const P& p = p_in;
  for (int ph = ph_lo; ph < ph_hi; ++ph) {
    char* ws = p_in.ws + opaque_zero();
    int kind = 2, arg = 0;
    size_t oA = 0, oB = 0, oC = 0;
    int lda = 1024, ldb = 1024, K = 1024, ldc = 1024, epi = 0, nMt = 136, nNt = 8, feat = 0;
    switch (ph) {
      case 0: kind = 0; break;
      case 1: kind = 1; arg = 0; break;
      case 2: oA = OFF_A0; oB = OFF_WIN; oC = OFF_U; ldc = 2048; nNt = 8; feat = 2; break;
      case 3: kind = 3; break;
      case 4: oA = OFF_Z; oB = OFF_WOUT; oC = OFF_A1; nNt = 4; feat = 3; break;
      case 5: kind = 1; arg = 1; break;
      case 6: oA = OFF_A0; oB = OFF_M1; oC = OFF_F; ldc = 4096; nNt = 16; epi = 1; feat = 3; break;
      case 7: oA = OFF_F; lda = 4096; oB = OFF_M2; ldb = 4096; K = 4096; oC = OFF_A1; nNt = 4; feat = 3; break;
      case 8: kind = 1; arg = 2; break;
      case 9: kind = 4; break;
      case 10: oA = OFF_A0; oB = OFF_WR; oC = OFF_RR; nNt = 27; feat = 1; break;
      case 11: kind = 5; break;
      case 12: oA = OFF_L + 512; lda = 384; oB = OFF_G2; ldb = 128; K = 128; oC = OFF_G; nMt = 128; break;
      case 13: kind = 6; break;
      case 14: oA = OFF_Z1; oB = OFF_WO; oC = OFF_A1; nMt = 128; nNt = 4; feat = 3; break;
      case 15: kind = 1; arg = 3; break;
      case 16: oA = OFF_A0; oB = OFF_M1 + 8 * MIB; oC = OFF_F; ldc = 4096; nNt = 16; epi = 1; nMt = 128; feat = 3; break;
      case 17: oA = OFF_F; lda = 4096; oB = OFF_M2 + 8 * MIB; ldb = 4096; K = 4096; oC = OFF_A1; nMt = 128; nNt = 4; feat = 3; break;
      default: kind = 1; arg = 4; break;
    }
    if (kind == 2) {
      gemm_phase(p, (const half_t*)(ws + oA), lda, (const half_t*)(ws + oB), ldb, K, (half_t*)(ws + oC), ldc, epi, nMt, nNt, feat, smem);
    } else if (kind == 1) {
      phase_rowwise(p, arg);
    } else if (kind == 0) {
      phase_prep(p, smem);
    } else if (kind == 3) {
      for (int it = bidx(); it < 2176 + 1088; it += gridDim.x) {
        if (it < 2176) attn_item(p, it, smem); else pool_item(p, it - 2176);
      }
    } else if (kind == 4) {
      phase_shift(p);
    } else if (kind == 5) {
      for (int it = bidx(); it < 256; it += gridDim.x) scan_item(p, it, smem);
    } else {
      phase_readout(p);
    }
    if (ph + 1 < ph_hi) grid.sync();
  }
}

extern "C" void kernel_launch(void* const* d_in, const int* in_sizes, int n_in, void* d_out, int out_size, void* d_ws,
                              size_t ws_size, hipStream_t stream) {
  P p{};
  const float** pp = (const float**)&p;
  for (int i = 0; i < 32; ++i) pp[i] = (const float*)d_in[i];
  p.out = (float*)d_out;
  p.ws = (char*)d_ws;
  static int grid_blocks = 0;
  if (!grid_blocks) {
    int dev = 0, cus = 0, per_cu = 0;
    (void)hipGetDevice(&dev);
    (void)hipDeviceGetAttribute(&cus, hipDeviceAttributeMultiprocessorCount, dev);
    (void)hipOccupancyMaxActiveBlocksPerMultiprocessor(&per_cu, mega, 512, 0);
    if (per_cu < 1) per_cu = 1;
    grid_blocks = cus * per_cu;
  }
  int lo = 0, hi = NPHASE;
  void* args[] = {&p, &lo, &hi};
  hipError_t e = hipLaunchCooperativeKernel((void*)mega, dim3(grid_blocks), dim3(512), args, 0, stream);
  if (e != hipSuccess) fprintf(stderr, "cooperative launch failed: %s (grid %d)\n", hipGetErrorString(e), grid_blocks);
}
```

```cpp
#include <hip/hip_runtime.h>
#include <hip/hip_cooperative_groups.h>
#include <cstdio>
namespace cg = cooperative_groups;

typedef _Float16 half_t;
typedef _Float16 h8 __attribute__((ext_vector_type(8)));
typedef _Float16 h4 __attribute__((ext_vector_type(4)));
typedef _Float16 h2 __attribute__((ext_vector_type(2)));
typedef float f4 __attribute__((ext_vector_type(4)));

#define RL 32768
#define RC 2048
#define RT 34816
#define MIB (1ull << 20)
#define OFF_WIN (0 * MIB)
#define OFF_WOUT (4 * MIB)
#define OFF_M1 (7 * MIB)
#define OFF_M2 (23 * MIB)
#define OFF_WR (39 * MIB)
#define OFF_WK (41 * MIB)
#define OFF_WV (43 * MIB)
#define OFF_WO (45 * MIB)
#define OFF_L1 (47 * MIB)
#define OFF_W2 (48 * MIB)
#define OFF_A2 (48 * MIB + 256 * 1024)
#define OFF_G2 (48 * MIB + 512 * 1024)
#define OFF_MOD (49 * MIB)
#define OFF_BN (50 * MIB)
#define OFF_XC (54 * MIB)
#define OFF_A0 (62 * MIB)
#define OFF_A1 (130 * MIB)
#define OFF_BIG (198 * MIB)
#define OFF_U OFF_BIG
#define OFF_Z (334 * MIB)
#define OFF_F OFF_BIG
#define OFF_RR OFF_BIG
#define OFF_KK (266 * MIB)
#define OFF_VV (334 * MIB)
#define OFF_L (402 * MIB)
#define OFF_G OFF_BIG
#define OFF_Z1 (266 * MIB)

#define SMEM_BYTES 151552

struct P {
  const float *x, *c, *ctx, *c_ctx, *ada_w, *ada_b, *norm_g, *mlp_w1, *mlp_w2, *ev_w_in, *ev_w_out, *ev_pool_w,
      *ev_pool_scale, *ev_rpb, *rw_mu, *rw_wr, *rw_wk, *rw_wv, *rw_wo, *rw_w0, *rw_w1, *rw_w2, *rw_a0, *rw_a1, *rw_a2,
      *rw_g1, *rw_g2, *rw_kk, *rw_ka, *rw_rk, *rw_lng, *rw_lnb;
  float* out;
  char* ws;
};

__device__ __forceinline__ int tidx() { int v = threadIdx.x; asm volatile("" : "+v"(v)); return v; }
__device__ __forceinline__ int bidx() { int v = blockIdx.x; asm volatile("" : "+s"(v)); return v; }
__device__ __forceinline__ size_t opaque_zero() { size_t z = 0; asm volatile("" : "+s"(z)); return z; }
__device__ __forceinline__ float opaque_f(float v) { asm volatile("" : "+v"(v)); return v; }
__device__ __forceinline__ float sigm(float x) { return 1.f / (1.f + __expf(-x)); }
__device__ __forceinline__ float bperm(float v, int srclane) {
  return __builtin_bit_cast(float, __builtin_amdgcn_ds_bpermute(srclane << 2, __builtin_bit_cast(int, v)));
}
template <int CTRL>
__device__ __forceinline__ float dpp(float x) {
  return __builtin_bit_cast(float, __builtin_amdgcn_mov_dpp(__builtin_bit_cast(int, x), CTRL, 0xf, 0xf, true));
}
__device__ __forceinline__ float red4(float x) { x += dpp<0xB1>(x); x += dpp<0x4E>(x); return x; }
__device__ __forceinline__ float red8(float x) { x = red4(x); x += dpp<0x141>(x); return x; }
__device__ __forceinline__ float red16(float x) { x = red8(x); x += dpp<0x140>(x); return x; }
__device__ __forceinline__ float wave_sum(float v, int lane) {
  v = red16(v);
  v += bperm(v, lane ^ 16);
  v += bperm(v, lane ^ 32);
  return v;
}

struct GemmTile {
  const half_t* A; const half_t* A2; const float* mu; int lda;
  const half_t* Bt; int ldb; int K;
  half_t* C; int ldc; int epi;
  int row0, col0;
  const P* pp;
};

template <bool MIX>
__device__ __forceinline__ void gemm_tile(const GemmTile& g, char* smem) {
  half_t* As = (half_t*)smem;
  half_t* Bs = (half_t*)(smem + 73728);
  const int tid = tidx(), lane = tid & 63, w = tid >> 6;
  const int wm = w >> 1, wn = w & 1, lr = lane & 15, lq = lane >> 4;
  const int ldr = tid >> 3, ldk = (tid & 7) * 8;
  f4 acc[4][4];
#pragma unroll
  for (int i = 0; i < 4; ++i)
#pragma unroll
    for (int j = 0; j < 4; ++j) acc[i][j] = (f4){0.f, 0.f, 0.f, 0.f};
  uint4 ra0, ra1, ra2, ra3, rb0, rb1;
  uint4 rx0, rx1, rx2, rx3;
  float4 mu0, mu1;
  const int nk = g.K >> 6;
  const half_t* Ap = g.A + (size_t)ldr * g.lda + ldk;
  const half_t* A2p = MIX ? g.A2 + (size_t)ldr * g.lda + ldk : nullptr;
  const float* mup = MIX ? g.mu + ldk : nullptr;
  const half_t* Bp = g.Bt + (size_t)ldr * g.ldb + ldk;
  const size_t astep = (size_t)64 * g.lda, bstep = (size_t)64 * g.ldb;
  half_t* asw = As + ldr * 72 + ldk;
  half_t* bsw = Bs + ldr * 72 + ldk;
  const half_t* asr = As + (wm * 64 + lr) * 72 + lq * 8;
  const half_t* bsr = Bs + (wn * 64 + lr) * 72 + lq * 8;

#define GLOAD(kt)                                              \
  {                                                            \
    const int k0 = (kt) * 64;                                  \
    ra0 = *(const uint4*)(Ap + k0);                            \
    ra1 = *(const uint4*)(Ap + astep + k0);                    \
    ra2 = *(const uint4*)(Ap + 2 * astep + k0);                \
    ra3 = *(const uint4*)(Ap + 3 * astep + k0);                \
    rb0 = *(const uint4*)(Bp + k0);                            \
    rb1 = *(const uint4*)(Bp + bstep + k0);                    \
    if (MIX) {                                                 \
      rx0 = *(const uint4*)(A2p + k0);                         \
      rx1 = *(const uint4*)(A2p + astep + k0);                 \
      rx2 = *(const uint4*)(A2p + 2 * astep + k0);             \
      rx3 = *(const uint4*)(A2p + 3 * astep + k0);             \
      mu0 = *(const float4*)(mup + k0);                        \
      mu1 = *(const float4*)(mup + k0 + 4);                    \
    }                                                          \
  }
#define MIXV(r, x) __builtin_bit_cast(uint4, (h8)(__builtin_bit_cast(h8, r) + __builtin_bit_cast(h8, x) * m))
#define SSTORE(buf)                                            \
  {                                                            \
    half_t* as = asw + (buf) * (256 * 72);                     \
    half_t* bs = bsw + (buf) * (128 * 72);                     \
    if (MIX) {                                                 \
      h8 m;                                                    \
      m[0] = (half_t)mu0.x; m[1] = (half_t)mu0.y; m[2] = (half_t)mu0.z; m[3] = (half_t)mu0.w; \
      m[4] = (half_t)mu1.x; m[5] = (half_t)mu1.y; m[6] = (half_t)mu1.z; m[7] = (half_t)mu1.w; \
      ra0 = MIXV(ra0, rx0); ra1 = MIXV(ra1, rx1); ra2 = MIXV(ra2, rx2); ra3 = MIXV(ra3, rx3); \
    }                                                          \
    *(uint4*)(as) = ra0;                                       \
    *(uint4*)(as + 64 * 72) = ra1;                             \
    *(uint4*)(as + 128 * 72) = ra2;                            \
    *(uint4*)(as + 192 * 72) = ra3;                            \
    *(uint4*)(bs) = rb0;                                       \
    *(uint4*)(bs + 64 * 72) = rb1;                             \
  }

  GLOAD(0);
  SSTORE(0);
  __syncthreads();
  for (int kt = 0; kt < nk; ++kt) {
    const bool more = kt + 1 < nk;
    if (more) GLOAD(kt + 1);
    __builtin_amdgcn_sched_barrier(0);
    {
      const half_t* as = asr + (kt & 1) * (256 * 72);
      const half_t* bs = bsr + (kt & 1) * (128 * 72);
#pragma unroll
      for (int ks = 0; ks < 2; ++ks) {
        h8 a[4], b[4];
#pragma unroll
        for (int i = 0; i < 4; ++i) {
          a[i] = *(const h8*)(as + i * 16 * 72 + ks * 32);
          b[i] = *(const h8*)(bs + i * 16 * 72 + ks * 32);
        }
#pragma unroll
        for (int mt = 0; mt < 4; ++mt)
#pragma unroll
          for (int nt = 0; nt < 4; ++nt)
            acc[mt][nt] = __builtin_amdgcn_mfma_f32_16x16x32_f16(b[nt], a[mt], acc[mt][nt], 0, 0, 0);
      }
    }
    if (more) SSTORE((kt + 1) & 1);
    __syncthreads();
  }
#undef GLOAD
#undef SSTORE
#undef MIXV
#pragma unroll
  for (int mt = 0; mt < 4; ++mt) {
    half_t* cp = g.C + (size_t)(wm * 64 + mt * 16 + lr) * g.ldc + wn * 64 + lq * 4;
#pragma unroll
    for (int nt = 0; nt < 4; ++nt) {
      h4 o;
#pragma unroll
      for (int j = 0; j < 4; ++j) {
        float v = acc[mt][nt][j];
        if (g.epi == 1) { v = fmaxf(v, 0.f); v = v * v; }
        else if (g.epi == 2) v = 1.f - 2.f / (__expf(2.f * v) + 1.f);
        else if (g.epi == 3) v = sigm(v);
        o[j] = (half_t)v;
      }
      *(h4*)(cp + nt * 16) = o;
    }
  }
}

__device__ __forceinline__ void gemm_tile2(const GemmTile& g, char* smem) {
  half_t* As = (half_t*)smem;
  half_t* Bs = (half_t*)(smem + 73728);
  const int tid = tidx(), lane = tid & 63, w = tid >> 6;
  const int wm = w >> 1, wn = w & 1, lr = lane & 15, lq = lane >> 4;
  const int ldr = tid >> 3, ldk = (tid & 7) * 8;
  f4 acc[4][4];
#pragma unroll
  for (int i = 0; i < 4; ++i)
#pragma unroll
    for (int j = 0; j < 4; ++j) acc[i][j] = (f4){0.f, 0.f, 0.f, 0.f};
  uint4 xa0, xa1, xa2, xa3, xb0, xb1;
  uint4 ya0, ya1, ya2, ya3, yb0, yb1;
  const int nk = g.K >> 6;
  const half_t* Ap = g.A + (size_t)ldr * g.lda + ldk;
  const half_t* Bp = g.Bt + (size_t)ldr * g.ldb + ldk;
  const size_t astep = (size_t)64 * g.lda, bstep = (size_t)64 * g.ldb;
  half_t* asw = As + ldr * 72 + ldk;
  half_t* bsw = Bs + ldr * 72 + ldk;
  const half_t* asr = As + (wm * 64 + lr) * 72 + lq * 8;
  const half_t* bsr = Bs + (wn * 64 + lr) * 72 + lq * 8;
#define GLD(S, kt)                                   \
  {                                                  \
    const int k0 = (kt) * 64;                        \
    S##a0 = *(const uint4*)(Ap + k0);                \
    S##a1 = *(const uint4*)(Ap + astep + k0);        \
    S##a2 = *(const uint4*)(Ap + 2 * astep + k0);    \
    S##a3 = *(const uint4*)(Ap + 3 * astep + k0);    \
    S##b0 = *(const uint4*)(Bp + k0);                \
    S##b1 = *(const uint4*)(Bp + bstep + k0);        \
  }
#define SST(S, buf)                                  \
  {                                                  \
    half_t* as = asw + (buf) * (256 * 72);           \
    half_t* bs = bsw + (buf) * (128 * 72);           \
    *(uint4*)(as) = S##a0;                           \
    *(uint4*)(as + 64 * 72) = S##a1;                 \
    *(uint4*)(as + 128 * 72) = S##a2;                \
    *(uint4*)(as + 192 * 72) = S##a3;                \
    *(uint4*)(bs) = S##b0;                           \
    *(uint4*)(bs + 64 * 72) = S##b1;                 \
  }
#define CMP(buf)                                                                                     \
  {                                                                                                  \
    const half_t* as = asr + (buf) * (256 * 72);                                                     \
    const half_t* bs = bsr + (buf) * (128 * 72);                                                     \
    _Pragma("unroll") for (int ks = 0; ks < 2; ++ks) {                                               \
      h8 a[4], b[4];                                                                                 \
      _Pragma("unroll") for (int i = 0; i < 4; ++i) {                                                \
        a[i] = *(const h8*)(as + i * 16 * 72 + ks * 32);                                             \
        b[i] = *(const h8*)(bs + i * 16 * 72 + ks * 32);                                             \
      }                                                                                              \
      _Pragma("unroll") for (int mt = 0; mt < 4; ++mt)                                               \
        _Pragma("unroll") for (int nt = 0; nt < 4; ++nt)                                             \
          acc[mt][nt] = __builtin_amdgcn_mfma_f32_16x16x32_f16(b[nt], a[mt], acc[mt][nt], 0, 0, 0);  \
    }                                                                                                \
  }
  GLD(x, 0);
  SST(x, 0);
  if (nk > 1) GLD(x, 1);
  if (nk > 2) GLD(y, 2);
  __syncthreads();
  for (int kt = 0; kt < nk; kt += 2) {
    CMP(0);
    if (kt + 1 < nk) SST(x, 1);
    if (kt + 3 < nk) GLD(x, kt + 3);
    __syncthreads();
    CMP(1);
    if (kt + 2 < nk) SST(y, 0);
    if (kt + 4 < nk) GLD(y, kt + 4);
    __syncthreads();
  }
#undef GLD
#undef SST
#undef CMP
#pragma unroll
  for (int mt = 0; mt < 4; ++mt) {
    half_t* cp = g.C + (size_t)(wm * 64 + mt * 16 + lr) * g.ldc + wn * 64 + lq * 4;
#pragma unroll
    for (int nt = 0; nt < 4; ++nt) {
      h4 o;
#pragma unroll
      for (int j = 0; j < 4; ++j) {
        float v = acc[mt][nt][j];
        if (g.epi == 1) { v = fmaxf(v, 0.f); v = v * v; }
        o[j] = (half_t)v;
      }
      *(h4*)(cp + nt * 16) = o;
    }
  }
}

__device__ __forceinline__ void gemm_tile3(const GemmTile& g, char* smem) {
  const int tid = tidx(), lane = tid & 63, w = tid >> 6;
  const int wm = w >> 1, wn = w & 1, lr = lane & 15, lq = lane >> 4;
  f4 acc[4][4];
#pragma unroll
  for (int i = 0; i < 4; ++i)
#pragma unroll
    for (int j = 0; j < 4; ++j) acc[i][j] = (f4){0.f, 0.f, 0.f, 0.f};
  const int nk = g.K >> 6;
  const int lrow = lane >> 3, lslot = lane & 7;
  const half_t* Ag[4];
  const half_t* Bg[2];
#pragma unroll
  for (int i = 0; i < 4; ++i) {
    const int row = (w * 4 + i) * 8 + lrow;
    Ag[i] = g.A + (size_t)row * g.lda + ((lslot ^ ((row >> 1) & 7)) * 8);
  }
#pragma unroll
  for (int i = 0; i < 2; ++i) {
    const int row = (w * 2 + i) * 8 + lrow;
    Bg[i] = g.Bt + (size_t)row * g.ldb + ((lslot ^ ((row >> 1) & 7)) * 8);
  }
  char* aw = smem + (w * 4) * 1024 + lane * 16;
  char* bw = smem + 32768 + (w * 2) * 1024 + lane * 16;
  const int swz = (lr >> 1) & 7;
  const int ko0 = ((0 + lq) ^ swz) * 16, ko1 = ((4 + lq) ^ swz) * 16;
  const char* ar = smem + (wm * 64 + lr) * 128;
  const char* br = smem + 32768 + (wn * 64 + lr) * 128;
#define ISSUE(kt, st)                                                                                      \
  {                                                                                                        \
    _Pragma("unroll") for (int i = 0; i < 4; ++i)                                                          \
      __builtin_amdgcn_global_load_lds((const unsigned*)(Ag[i] + (kt) * 64), (unsigned*)(aw + (st) * 49152 + i * 1024), 16, 0, 0); \
    _Pragma("unroll") for (int i = 0; i < 2; ++i)                                                          \
      __builtin_amdgcn_global_load_lds((const unsigned*)(Bg[i] + (kt) * 64), (unsigned*)(bw + (st) * 49152 + i * 1024), 16, 0, 0); \
  }
  ISSUE(0, 0);
  if (nk > 1) {
    ISSUE(1, 1);
    asm volatile("s_waitcnt vmcnt(6)" ::: "memory");
  } else {
    asm volatile("s_waitcnt vmcnt(0)" ::: "memory");
  }
  __builtin_amdgcn_s_barrier();
  asm volatile("" ::: "memory");
  h8 a0[4], b0[4], a1[4], b1[4];
#define LDF(fa, fb, stg, ko)                                             \
  {                                                                      \
    const char* as = ar + (stg) * 49152 + (ko);                          \
    const char* bs = br + (stg) * 49152 + (ko);                          \
    _Pragma("unroll") for (int i = 0; i < 4; ++i) {                      \
      fa[i] = *(const h8*)(as + i * 2048);                               \
      fb[i] = *(const h8*)(bs + i * 2048);                               \
    }                                                                    \
  }
#define MMA(fa, fb)                                                      \
  {                                                                      \
    _Pragma("unroll") for (int mt = 0; mt < 4; ++mt)                     \
      _Pragma("unroll") for (int nt = 0; nt < 4; ++nt)                   \
        acc[mt][nt] = __builtin_amdgcn_mfma_f32_16x16x32_f16(fb[nt], fa[mt], acc[mt][nt], 0, 0, 0); \
  }
  LDF(a0, b0, 0, ko0);
  int st = 0;
  for (int kt = 0; kt < nk; ++kt) {
    const bool more = kt + 2 < nk;
    int st1 = st + 1; if (st1 >= 3) st1 -= 3;
    int st2 = st + 2; if (st2 >= 3) st2 -= 3;
    if (more) ISSUE(kt + 2, st2);
    LDF(a1, b1, st, ko1);
    __builtin_amdgcn_sched_barrier(0);
    MMA(a0, b0);
    __builtin_amdgcn_sched_barrier(0);
    if (more) asm volatile("s_waitcnt vmcnt(6) lgkmcnt(0)" ::: "memory");
    else asm volatile("s_waitcnt vmcnt(0) lgkmcnt(0)" ::: "memory");
    __builtin_amdgcn_s_barrier();
    asm volatile("" ::: "memory");
    if (kt + 1 < nk) LDF(a0, b0, st1, ko0);
    __builtin_amdgcn_sched_barrier(0);
    MMA(a1, b1);
    __builtin_amdgcn_sched_barrier(0);
    st = st1;
  }
#undef LDF
#undef MMA
#undef ISSUE
  if (g.epi == 5) {
    const P& p = *g.pp;
    char* ws = p.ws + opaque_zero();
    const half_t* Y0 = (const half_t*)(ws + OFF_A0);
    const half_t* Y1 = (const half_t*)(ws + OFF_A1);
    const half_t* VVp = (const half_t*)(ws + OFF_VV);
    const float* BN0 = (const float*)(ws + OFF_BN);
    const float* BN1 = BN0 + (size_t)RL * 16;
    half_t* Z1 = (half_t*)(ws + OFF_Z1);
    const int head = (g.col0 >> 6) + wn;
#pragma unroll 1
    for (int mt = 0; mt < 4; ++mt) {
      const int row = g.row0 + wm * 64 + mt * 16 + lr;
      const size_t base = (size_t)row * 1024 + head * 64 + lq * 4;
      float y[4][4], vv[4][4];
      float sm = 0.f;
#pragma unroll
      for (int nt = 0; nt < 4; ++nt) {
        const h4 ya = *(const h4*)(Y0 + base + nt * 16);
        const h4 yb = *(const h4*)(Y1 + base + nt * 16);
        const h4 vh = *(const h4*)(VVp + base + nt * 16);
#pragma unroll
        for (int j = 0; j < 4; ++j) { y[nt][j] = (float)ya[j] + (float)yb[j]; vv[nt][j] = (float)vh[j]; sm += y[nt][j]; }
      }
      sm += bperm(sm, lane ^ 16);
      sm += bperm(sm, lane ^ 32);
      const float mean = sm * (1.f / 64.f);
      float q = 0.f;
#pragma unroll
      for (int nt = 0; nt < 4; ++nt)
#pragma unroll
        for (int j = 0; j < 4; ++j) { const float d = y[nt][j] - mean; q += d * d; }
      q += bperm(q, lane ^ 16);
      q += bperm(q, lane ^ 32);
      const float rstd = rsqrtf(q * (1.f / 64.f) + 64e-5f);
      const float bonus = BN0[(size_t)row * 16 + head] + BN1[(size_t)row * 16 + head];
#pragma unroll
      for (int nt = 0; nt < 4; ++nt) {
        const int ch = head * 64 + nt * 16 + lq * 4;
        const float4 lg = *(const float4*)(p.rw_lng + ch);
        const float4 lb = *(const float4*)(p.rw_lnb + ch);
        const float lgv[4] = {lg.x, lg.y, lg.z, lg.w}, lbv[4] = {lb.x, lb.y, lb.z, lb.w};
        const f4 gv = mt == 0 ? acc[0][nt] : (mt == 1 ? acc[1][nt] : (mt == 2 ? acc[2][nt] : acc[3][nt]));
        h4 o;
#pragma unroll
        for (int j = 0; j < 4; ++j) o[j] = (half_t)(((y[nt][j] - mean) * rstd * lgv[j] + lbv[j] + bonus * vv[nt][j]) * gv[j]);
        *(h4*)(Z1 + base + nt * 16) = o;
      }
    }
    return;
  }
  if (g.epi == 4) {
    half_t* vp = g.C + (size_t)((wm * 8 + wn) * 64) * 64 + lr;
#pragma unroll
    for (int mt = 0; mt < 4; ++mt)
#pragma unroll
      for (int nt = 0; nt < 4; ++nt)
#pragma unroll
        for (int j = 0; j < 4; ++j) vp[(nt * 16 + lq * 4 + j) * 64 + mt * 16] = (half_t)acc[mt][nt][j];
    return;
  }
#pragma unroll
  for (int mt = 0; mt < 4; ++mt) {
    half_t* cp = g.C + (size_t)(wm * 64 + mt * 16 + lr) * g.ldc + wn * 64 + lq * 4;
#pragma unroll
    for (int nt = 0; nt < 4; ++nt) {
      h4 o;
#pragma unroll
      for (int j = 0; j < 4; ++j) {
        float v = acc[mt][nt][j];
        if (g.epi == 1) { v = fmaxf(v, 0.f); v = v * v; }
        o[j] = (half_t)v;
      }
      *(h4*)(cp + nt * 16) = o;
    }
  }
}

__device__ __forceinline__ void gemm_tile4(const GemmTile& g, char* smem) {
  const int tid = tidx(), lane = tid & 63, w = tid >> 6;
  const int wm = w >> 1, wn = w & 1, lr = lane & 15, lq = lane >> 4;
  f4 acc[4][8];
#pragma unroll
  for (int i = 0; i < 4; ++i)
#pragma unroll
    for (int j = 0; j < 8; ++j) acc[i][j] = (f4){0.f, 0.f, 0.f, 0.f};
  const int nk = g.K >> 6;
  const int lrow = lane >> 3, lslot = lane & 7;
  const half_t* Ag[4];
  const half_t* Bg[4];
#pragma unroll
  for (int i = 0; i < 4; ++i) {
    const int row = (w * 4 + i) * 8 + lrow;
    const int so = (lslot ^ ((row >> 1) & 7)) * 8;
    Ag[i] = g.A + (size_t)row * g.lda + so;
    Bg[i] = g.Bt + (size_t)row * g.ldb + so;
  }
  char* aw = smem + (w * 4) * 1024 + lane * 16;
  char* bw = smem + 32768 + (w * 4) * 1024 + lane * 16;
  const int swz = (lr >> 1) & 7;
  const int ko0 = ((0 + lq) ^ swz) * 16, ko1 = ((4 + lq) ^ swz) * 16;
  const char* ar = smem + (wm * 64 + lr) * 128;
  const char* br = smem + 32768 + (wn * 128 + lr) * 128;
#define ISSUE4(kt, st)                                                                                     \
  {                                                                                                        \
    _Pragma("unroll") for (int i = 0; i < 4; ++i)                                                          \
      __builtin_amdgcn_global_load_lds((const unsigned*)(Ag[i] + (kt) * 64), (unsigned*)(aw + (st) * 65536 + i * 1024), 16, 0, 0); \
    _Pragma("unroll") for (int i = 0; i < 4; ++i)                                                          \
      __builtin_amdgcn_global_load_lds((const unsigned*)(Bg[i] + (kt) * 64), (unsigned*)(bw + (st) * 65536 + i * 1024), 16, 0, 0); \
  }
  ISSUE4(0, 0);
  asm volatile("s_waitcnt vmcnt(0)" ::: "memory");
  __builtin_amdgcn_s_barrier();
  asm volatile("" ::: "memory");
  for (int kt = 0; kt < nk; ++kt) {
    const int st = kt & 1;
    if (kt + 1 < nk) ISSUE4(kt + 1, st ^ 1);
    const char* as = ar + st * 65536;
    const char* bs = br + st * 65536;
#pragma unroll
    for (int ks = 0; ks < 2; ++ks) {
      const int ko = ks ? ko1 : ko0;
      h8 a[4], b[8];
#pragma unroll
      for (int i = 0; i < 4; ++i) a[i] = *(const h8*)(as + i * 2048 + ko);
#pragma unroll
      for (int i = 0; i < 8; ++i) b[i] = *(const h8*)(bs + i * 2048 + ko);
#pragma unroll
      for (int mt = 0; mt < 4; ++mt)
#pragma unroll
        for (int nt = 0; nt < 8; ++nt)
          acc[mt][nt] = __builtin_amdgcn_mfma_f32_16x16x32_f16(b[nt], a[mt], acc[mt][nt], 0, 0, 0);
    }
    asm volatile("s_waitcnt vmcnt(0) lgkmcnt(0)" ::: "memory");
    __builtin_amdgcn_s_barrier();
    asm volatile("" ::: "memory");
  }
#undef ISSUE4
  if (g.epi == 4) {
#pragma unroll
    for (int mt = 0; mt < 4; ++mt)
#pragma unroll
      for (int nt = 0; nt < 8; ++nt) {
        half_t* vp = g.C + (size_t)((wm * 8 + wn * 2 + (nt >> 2)) * 64) * 64 + lr;
#pragma unroll
        for (int j = 0; j < 4; ++j) vp[((nt & 3) * 16 + lq * 4 + j) * 64 + mt * 16] = (half_t)acc[mt][nt][j];
      }
    return;
  }
#pragma unroll
  for (int mt = 0; mt < 4; ++mt) {
    half_t* cp = g.C + (size_t)(wm * 64 + mt * 16 + lr) * g.ldc + wn * 128 + lq * 4;
#pragma unroll
    for (int nt = 0; nt < 8; ++nt) {
      h4 o;
#pragma unroll
      for (int j = 0; j < 4; ++j) {
        float v = acc[mt][nt][j];
        if (g.epi == 1) { v = fmaxf(v, 0.f); v = v * v; }
        o[j] = (half_t)v;
      }
      *(h4*)(cp + nt * 16) = o;
    }
  }
}

__device__ __forceinline__ int p8_lds_byte(int r, int c) {
  const int st = (r >> 4) * 2 + (c >> 5), rr = r & 15, cc = c & 31, ob = rr * 64 + cc * 2;
  return st * 1024 + (ob ^ (((ob >> 9) & 1) << 5));
}
__device__ __forceinline__ void p8_stage_rc(int b, int& R, int& C) {
  const int st = b / 1024, sb = b % 1024, swz = sb ^ (((sb >> 9) & 1) << 5);
  R = (st >> 1) * 16 + swz / 64;
  C = (st & 1) * 32 + (swz % 64) / 2;
}
__device__ __forceinline__ void gemm_tile8(const GemmTile& g, char* smem) {
  constexpr int HT = 128 * 64;
  half_t* shm = (half_t*)smem;
  const int tid = tidx();
  const int wid = tid >> 6, lane = tid & 63, wr = wid >> 2, wc = wid & 3, fr = lane & 15, fq = lane >> 4;
  const half_t* A = g.A;
  const half_t* Bt = g.Bt;
  const int lda = g.lda, ldb = g.lda;
#define P8_SA(b, h) (shm + ((b) * 2 + (h)) * HT)
#define P8_SB(b, h) (shm + (4 + (b) * 2 + (h)) * HT)
  int sr0, sc0, sr1, sc1;
  p8_stage_rc(tid * 16, sr0, sc0);
  p8_stage_rc(tid * 16 + 8192, sr1, sc1);
  const int ao0 = sr0 * lda + sc0, ao1 = sr1 * lda + sc1;
#define bo0 ao0
#define bo1 ao1
#define P8_STAGE_A(Pp, br, kt)                                                                                   \
  {                                                                                                              \
    const half_t* gb_ = A + (size_t)(br) * lda + (size_t)(kt) * 64;                                              \
    __builtin_amdgcn_global_load_lds((const unsigned*)(gb_ + ao0), (unsigned*)((char*)(Pp) + tid * 16), 16, 0, 0);        \
    __builtin_amdgcn_global_load_lds((const unsigned*)(gb_ + ao1), (unsigned*)((char*)(Pp) + tid * 16 + 8192), 16, 0, 0); \
  }
#define P8_STAGE_B(Pp, br, kt)                                                                                   \
  {                                                                                                              \
    const half_t* gb_ = Bt + (size_t)(br) * ldb + (size_t)(kt) * 64;                                             \
    __builtin_amdgcn_global_load_lds((const unsigned*)(gb_ + bo0), (unsigned*)((char*)(Pp) + tid * 16), 16, 0, 0);        \
    __builtin_amdgcn_global_load_lds((const unsigned*)(gb_ + bo1), (unsigned*)((char*)(Pp) + tid * 16 + 8192), 16, 0, 0); \
  }
  const char* abase = smem + p8_lds_byte(wr * 64 + fr, fq * 8);
  const char* bbase = smem + 4 * HT * 2 + p8_lds_byte(wc * 32 + fr, fq * 8);
#define P8_LDA(dst, b, h)                                                                                        \
  _Pragma("unroll") for (int m = 0; m < 4; ++m) _Pragma("unroll") for (int k = 0; k < 2; ++k)                    \
      dst[m][k] = *(const h8*)(abase + ((b) * 2 + (h)) * (HT * 2) + (m * 2 + k) * 1024);
#define P8_LDB(dst, b, h)                                                                                        \
  _Pragma("unroll") for (int n = 0; n < 2; ++n) _Pragma("unroll") for (int k = 0; k < 2; ++k)                    \
      dst[n][k] = *(const h8*)(bbase + ((b) * 2 + (h)) * (HT * 2) + (n * 2 + k) * 1024);
#define P8_MMA(ai, bj, Af, Bf)                                                                                   \
  {                                                                                                              \
    __builtin_amdgcn_s_setprio(1);                                                                               \
    _Pragma("unroll") for (int m = 0; m < 4; ++m) _Pragma("unroll") for (int n = 0; n < 2; ++n)                  \
        _Pragma("unroll") for (int k = 0; k < 2; ++k)                                                            \
            acc[ai][bj][m][n] = __builtin_amdgcn_mfma_f32_16x16x32_f16(Bf[n][k], Af[m][k], acc[ai][bj][m][n], 0, 0, 0); \
    __builtin_amdgcn_s_setprio(0);                                                                               \
  }
#define P8_WAIT_V(n) asm volatile("s_waitcnt vmcnt(" #n ")" ::: "memory")
#define P8_WAIT_L(n) asm volatile("s_waitcnt lgkmcnt(" #n ")" ::: "memory")
#define P8_BAR __builtin_amdgcn_s_barrier()
#define P8_SCHED __builtin_amdgcn_sched_barrier(0)

  f4 acc[2][2][4][2];
#pragma unroll
  for (int i0 = 0; i0 < 2; ++i0)
#pragma unroll
    for (int i1 = 0; i1 < 2; ++i1)
#pragma unroll
      for (int i2 = 0; i2 < 4; ++i2)
#pragma unroll
        for (int i3 = 0; i3 < 2; ++i3) acc[i0][i1][i2][i3] = (f4){0.f, 0.f, 0.f, 0.f};
  h8 At[4][2], B0[2][2], B1[2][2];
  const int nt = g.K >> 6;
  P8_STAGE_B(P8_SB(0, 0), 0, 0); P8_STAGE_A(P8_SA(0, 0), 0, 0);
  P8_STAGE_B(P8_SB(0, 1), 128, 0); P8_STAGE_A(P8_SA(0, 1), 128, 0);
  if (wr == 1) P8_BAR;
  P8_WAIT_V(4); P8_BAR;
  P8_STAGE_B(P8_SB(1, 0), 0, 1); P8_STAGE_A(P8_SA(1, 0), 0, 1); P8_STAGE_B(P8_SB(1, 1), 128, 1);
  P8_WAIT_V(6); P8_BAR;
  for (int t = 0; t < nt - 2; t += 2) {
    P8_LDB(B0, 0, 0); P8_SCHED; P8_LDA(At, 0, 0); P8_STAGE_A(P8_SA(1, 1), 128, t + 1);
    P8_WAIT_L(8); P8_BAR; P8_WAIT_L(0); P8_MMA(0, 0, At, B0); P8_BAR; P8_SCHED;
    P8_LDB(B1, 0, 1); P8_STAGE_B(P8_SB(0, 0), 0, t + 2);
    P8_BAR; P8_WAIT_L(0); P8_MMA(0, 1, At, B1); P8_BAR;
    P8_LDA(At, 0, 1); P8_STAGE_A(P8_SA(0, 0), 0, t + 2);
    P8_BAR; P8_WAIT_L(0); P8_MMA(1, 0, At, B0); P8_BAR; P8_SCHED;
    P8_STAGE_B(P8_SB(0, 1), 128, t + 2);
    P8_WAIT_V(6); P8_BAR; P8_MMA(1, 1, At, B1); P8_BAR;
    P8_LDB(B0, 1, 0); P8_SCHED; P8_LDA(At, 1, 0); P8_STAGE_A(P8_SA(0, 1), 128, t + 2);
    P8_WAIT_L(8); P8_BAR; P8_WAIT_L(0); P8_MMA(0, 0, At, B0); P8_BAR; P8_SCHED;
    P8_LDB(B1, 1, 1); P8_STAGE_B(P8_SB(1, 0), 0, t + 3);
    P8_BAR; P8_WAIT_L(0); P8_MMA(0, 1, At, B1); P8_BAR;
    P8_LDA(At, 1, 1); P8_STAGE_A(P8_SA(1, 0), 0, t + 3);
    P8_BAR; P8_WAIT_L(0); P8_MMA(1, 0, At, B0); P8_BAR; P8_SCHED;
    P8_STAGE_B(P8_SB(1, 1), 128, t + 3);
    P8_WAIT_V(6); P8_BAR; P8_MMA(1, 1, At, B1); P8_BAR;
  }
  {
    P8_LDB(B0, 0, 0); P8_LDA(At, 0, 0); P8_STAGE_A(P8_SA(1, 1), 128, nt - 1);
    P8_BAR; P8_WAIT_L(0); P8_MMA(0, 0, At, B0); P8_BAR;
    P8_LDB(B1, 0, 1); P8_BAR; P8_WAIT_L(0); P8_MMA(0, 1, At, B1); P8_BAR;
    P8_LDA(At, 0, 1); P8_WAIT_V(4); P8_BAR; P8_WAIT_L(0); P8_MMA(1, 0, At, B0); P8_MMA(1, 1, At, B1); P8_BAR;
  }
  {
    P8_LDB(B0, 1, 0); P8_LDA(At, 1, 0); P8_WAIT_V(2); P8_BAR; P8_WAIT_L(0); P8_MMA(0, 0, At, B0); P8_BAR;
    P8_LDB(B1, 1, 1); P8_WAIT_V(0); P8_BAR; P8_WAIT_L(0); P8_MMA(0, 1, At, B1); P8_BAR;
    P8_LDA(At, 1, 1); P8_BAR; P8_WAIT_L(0); P8_MMA(1, 0, At, B0); P8_MMA(1, 1, At, B1); P8_BAR;
  }
  if (wr == 0) P8_BAR;
  asm volatile("" ::: "memory");
#pragma unroll
  for (int ai = 0; ai < 2; ++ai)
#pragma unroll
    for (int m = 0; m < 4; ++m) {
      const int row = ai * 128 + wr * 64 + m * 16 + fr;
#pragma unroll
      for (int bj = 0; bj < 2; ++bj)
#pragma unroll
        for (int n = 0; n < 2; ++n) {
          const int col = bj * 128 + wc * 32 + n * 16 + fq * 4;
          if (g.epi == 4) {
            half_t* vp = g.C + (size_t)(((row >> 6) * 8 + (col >> 6)) * 64 + (col & 63)) * 64 + (row & 63);
#pragma unroll
            for (int j = 0; j < 4; ++j) vp[j * 64] = (half_t)acc[ai][bj][m][n][j];
          } else {
            h4 o;
#pragma unroll
            for (int j = 0; j < 4; ++j) {
              float v = acc[ai][bj][m][n][j];
              if (g.epi == 1) { v = fmaxf(v, 0.f); v = v * v; }
              o[j] = (half_t)v;
            }
            *(h4*)(g.C + (size_t)row * g.ldc + col) = o;
          }
        }
    }
#undef bo0
#undef bo1
#undef P8_SA
#undef P8_SB
#undef P8_STAGE_A
#undef P8_STAGE_B
#undef P8_LDA
#undef P8_LDB
#undef P8_MMA
#undef P8_WAIT_V
#undef P8_WAIT_L
#undef P8_BAR
#undef P8_SCHED
}

__device__ __forceinline__ void gemm_phase(const P& p, const half_t* A, int lda, const half_t* Bt, int ldb, int K, half_t* C, int ldc,
                                           int epi, int nMt, int nNt, int feat, char* smem) {
  char* ws = (p.ws + opaque_zero());
  const int total = nMt * nNt, G = gridDim.x, per_xcd = G >> 3;
  for (int t0 = bidx(); t0 < total + G; t0 += G) {
    const int rnd = t0 / G, bb = t0 - rnd * G;
    const int t = ((G & 7) == 0) ? rnd * G + (bb & 7) * per_xcd + (bb >> 3) : t0;
    if (t >= total) continue;
    const int gsz = 8 * nNt, first = (t / gsz) * 8, gm = min(nMt - first, 8);
    const int mt = first + (t % gsz) % gm, nt = (t % gsz) / gm;
    GemmTile g;
    g.A = A + (size_t)mt * 256 * lda; g.A2 = nullptr; g.mu = nullptr; g.lda = lda;
    const int tw = (feat >= 2) ? 256 : 128;
    g.Bt = Bt + (size_t)nt * tw * ldb; g.ldb = ldb; g.K = K;
    g.C = C + (size_t)mt * 256 * ldc + nt * tw; g.ldc = ldc; g.epi = epi;
    g.row0 = mt * 256; g.col0 = nt * tw; g.pp = &p;
    if (feat == 2 && nt >= 6) {
      g.epi = 4;
      g.C = (half_t*)(ws + OFF_A1) + ((size_t)(mt * 4) * 8 + (nt - 6) * 4) * 4096;
    }
    if (feat == 1) {
      g.A2 = (const half_t*)(ws + OFF_A1) + (size_t)mt * 256 * 1024;
      const int grp = nt >> 3, sub = nt & 7;
      int mixi;
      if (grp < 3) {
        mixi = grp == 0 ? 0 : (grp == 1 ? 2 : 3);
        g.Bt = (const half_t*)(ws + (grp == 0 ? OFF_WR : (grp == 1 ? OFF_WK : OFF_WV))) + (size_t)sub * 128 * 1024;
        g.C = (half_t*)(ws + (grp == 0 ? OFF_RR : (grp == 1 ? OFF_KK : OFF_VV))) + (size_t)mt * 256 * 1024 + sub * 128;
      } else {
        mixi = sub == 0 ? 1 : (sub == 1 ? 4 : 5);
        g.Bt = (const half_t*)(ws + OFF_L1) + (size_t)sub * 128 * 1024;
        g.C = (half_t*)(ws + OFF_L) + (size_t)mt * 256 * 384 + sub * 128;
        g.ldc = 384;
        g.epi = sub == 0 ? 2 : (sub == 1 ? 0 : 3);
      }
      g.mu = p.rw_mu + mixi * 1024;
    }
    if (feat == 1) gemm_tile<true>(g, smem); else if (feat >= 2) gemm_tile8(g, smem); else gemm_tile3(g, smem);
  }
}

__device__ void xpose_seg(const float* src, int ldsrc, int K, int N, half_t* dst, int lddst, int koff, int& base,
                          char* smem) {
  float* ts = (float*)smem;
  const int tid = tidx(), G = gridDim.x;
  const int tkn = K >> 6, tnn = N >> 6, cnt = tkn * tnn;
  int t0 = ((int)bidx() - (base % G) + G) % G;
  for (int t = t0; t < cnt; t += G) {
    const int k0 = (t % tkn) * 64, n0 = (t / tkn) * 64;
#pragma unroll
    for (int i = 0; i < 2; ++i) {
      const int c = tid + 512 * i, r = c >> 4, c4 = (c & 15) * 4;
      const float4 v = *(const float4*)(src + (size_t)(k0 + r) * ldsrc + n0 + c4);
      float* d = ts + r * 65 + c4;
      d[0] = v.x; d[1] = v.y; d[2] = v.z; d[3] = v.w;
    }
    __syncthreads();
    {
      const int n = tid >> 3, kc = (tid & 7) * 8;
      h8 o;
#pragma unroll
      for (int i = 0; i < 8; ++i) o[i] = (half_t)ts[(kc + i) * 65 + n];
      *(h8*)(dst + (size_t)(n0 + n) * lddst + koff + k0 + kc) = o;
    }
    __syncthreads();
  }
  base += cnt;
}

__device__ void phase_prep(const P& p, char* smem) {
  const int tid = tidx();
  char* ws = (p.ws + opaque_zero());
  float* MOD = (float*)(ws + OFF_MOD);
  if (bidx() < 192 || gridDim.x < 256) {
    float* sl = (float*)smem;
    for (int i = tid; i < 9216; i += 512) {
      const int b = i >> 10, k = i & 1023;
      const float cv = b < 8 ? p.c[b * 1024 + k] : p.c_ctx[k];
      sl[i] = cv / (1.f + __expf(-cv));
    }
    __syncthreads();
    float* red = sl + 9216;
    for (int item = bidx(); item < 192; item += gridDim.x) {
      const int l = item / 96, n0 = (item % 96) * 64, cn = tid & 63, kq = tid >> 6;
      float acc[9];
#pragma unroll
      for (int b = 0; b < 9; ++b) acc[b] = 0.f;
      const float* wp = p.ada_w + (size_t)l * 1024 * 6144 + n0 + cn;
#pragma unroll 4
      for (int k = kq * 128; k < kq * 128 + 128; ++k) {
        const float wv = wp[(size_t)k * 6144];
#pragma unroll
        for (int b = 0; b < 9; ++b) acc[b] += sl[b * 1024 + k] * wv;
      }
#pragma unroll
      for (int b = 0; b < 9; ++b) red[(kq * 9 + b) * 64 + cn] = acc[b];
      __syncthreads();
      for (int i = tid; i < 576; i += 512) {
        const int b = i >> 6, c = i & 63;
        float s = 0.f;
#pragma unroll
        for (int q = 0; q < 8; ++q) s += red[(q * 9 + b) * 64 + c];
        MOD[(size_t)(l * 9 + b) * 6144 + n0 + c] = s + p.ada_b[l * 6144 + n0 + c];
      }
      __syncthreads();
    }
  }
  for (int it = bidx(); it < 256; it += gridDim.x) {
    if (it < 192) continue;
    const int fi = it - 192, gi = fi >> 4, n0 = (fi & 15) * 64, n = tid & 63, ig = tid >> 6;
    float acc[16];
#pragma unroll
    for (int i = 0; i < 16; ++i) acc[i] = 0.f;
    for (int j = 0; j < 128; ++j) {
      const float wv = p.ev_w_out[(size_t)(gi * 128 + j) * 1024 + n0 + n] * p.ev_pool_scale[gi * 128 + j];
      const float* pw = p.ev_pool_w + ((size_t)gi * 128 + ig * 16) * 128 + j;
#pragma unroll
      for (int i = 0; i < 16; ++i) acc[i] += pw[i * 128] * wv;
    }
    h8 o0, o1;
#pragma unroll
    for (int i = 0; i < 8; ++i) { o0[i] = (half_t)acc[i]; o1[i] = (half_t)acc[8 + i]; }
    half_t* d = (half_t*)(ws + OFF_WOUT) + (size_t)(n0 + n) * 1024 + gi * 128 + ig * 16;
    *(h8*)d = o0;
    *(h8*)(d + 8) = o1;
  }
  __syncthreads();
  int base = 0;
  xpose_seg(p.ev_w_in, 2048, 1024, 2048, (half_t*)(ws + OFF_WIN), 1024, 0, base, smem);
  xpose_seg(p.ev_w_out + 512 * 1024, 1024, 512, 1024, (half_t*)(ws + OFF_WOUT), 1024, 512, base, smem);
  for (int l = 0; l < 2; ++l) {
    xpose_seg(p.mlp_w1 + (size_t)l * 1024 * 4096, 4096, 1024, 4096, (half_t*)(ws + OFF_M1 + l * 8 * MIB), 1024, 0, base, smem);
    xpose_seg(p.mlp_w2 + (size_t)l * 1024 * 4096, 1024, 4096, 1024, (half_t*)(ws + OFF_M2 + l * 8 * MIB), 4096, 0, base, smem);
  }
  xpose_seg(p.rw_wr, 1024, 1024, 1024, (half_t*)(ws + OFF_WR), 1024, 0, base, smem);
  xpose_seg(p.rw_wk, 1024, 1024, 1024, (half_t*)(ws + OFF_WK), 1024, 0, base, smem);
  xpose_seg(p.rw_wv, 1024, 1024, 1024, (half_t*)(ws + OFF_WV), 1024, 0, base, smem);
  xpose_seg(p.rw_wo, 1024, 1024, 1024, (half_t*)(ws + OFF_WO), 1024, 0, base, smem);
  for (int d = 0; d < 2; ++d) {
    xpose_seg(p.rw_w1 + (size_t)d * 1024 * 64, 64, 1024, 64, (half_t*)(ws + OFF_L1) + (size_t)(d * 64) * 1024, 1024, 0, base, smem);
    xpose_seg(p.rw_a1 + (size_t)d * 1024 * 64, 64, 1024, 64, (half_t*)(ws + OFF_L1) + (size_t)(128 + d * 64) * 1024, 1024, 0, base, smem);
    xpose_seg(p.rw_w2 + (size_t)d * 64 * 1024, 1024, 64, 1024, (half_t*)(ws + OFF_W2) + (size_t)d * 1024 * 64, 64, 0, base, smem);
    xpose_seg(p.rw_a2 + (size_t)d * 64 * 1024, 1024, 64, 1024, (half_t*)(ws + OFF_A2) + (size_t)d * 1024 * 64, 64, 0, base, smem);
  }
  xpose_seg(p.rw_g1, 128, 1024, 128, (half_t*)(ws + OFF_L1) + (size_t)256 * 1024, 1024, 0, base, smem);
  xpose_seg(p.rw_g2, 1024, 128, 1024, (half_t*)(ws + OFF_G2), 128, 0, base, smem);
}

__device__ void phase_rowwise(const P& p, int mode) {
  const int lane = tidx() & 63;
  const int gw = bidx() * 8 + (tidx() >> 6), nw = gridDim.x * 8;
  char* ws = (p.ws + opaque_zero());
  const float* MOD = (const float*)(ws + OFF_MOD);
  float* XC = (float*)(ws + OFF_XC);
  half_t* H = (half_t*)(ws + OFF_A0);
  const half_t* Y = (const half_t*)(ws + OFF_A1);
  const int nrows = (mode >= 3) ? RL : RT;
  const int per = (nrows + nw - 1) / nw;
  const int r0 = gw * per, r1 = min(r0 + per, nrows);
  if (r0 >= r1) return;
  const bool hasY = mode != 0, hasH = mode != 4;
  const float EPS = opaque_f(1e-6f);
  const int lyr = (mode <= 1) ? 0 : ((mode == 2) ? 0 : 1);
  const int gyi = (mode == 1) ? 1 : (mode == 2 ? 3 : (mode == 3 ? 5 : 7));
  const int gti = (mode == 1) ? 2 : (mode == 2 ? 5 : (mode == 3 ? 2 : 5));
  const int hl = (mode <= 1) ? 0 : 1;
  const int ghi = (mode == 0) ? 0 : (mode == 1 ? 2 : (mode == 2 ? 4 : 6));
  const int shi = (mode == 0 || mode == 2) ? 0 : 3;
  auto xsrc = [&](int row) -> const float* {
    if (mode <= 1) return row < RL ? p.x + (size_t)row * 1024 : p.ctx + (size_t)(row - RL) * 1024;
    return row < RL ? p.out + (size_t)row * 1024 : XC + (size_t)(row - RL) * 1024;
  };
  auto xdst = [&](int row) -> float* { return row < RL ? p.out + (size_t)row * 1024 : XC + (size_t)(row - RL) * 1024; };
  float4 gy[4], gt[4], gh[4], s1[4], s2[4];
  int cur_mi = -1;
  float4 nx[4];
  h4 ny[4];
  {
    const float* xs = xsrc(r0);
#pragma unroll
    for (int i = 0; i < 4; ++i) nx[i] = *(const float4*)(xs + i * 256 + lane * 4);
    if (hasY) {
#pragma unroll
      for (int i = 0; i < 4; ++i) ny[i] = *(const h4*)(Y + (size_t)r0 * 1024 + i * 256 + lane * 4);
    }
  }
  for (int row = r0; row < r1; ++row) {
    float xv[4][4];
    h4 yh[4];
#pragma unroll
    for (int i = 0; i < 4; ++i) { xv[i][0] = nx[i].x; xv[i][1] = nx[i].y; xv[i][2] = nx[i].z; xv[i][3] = nx[i].w; yh[i] = ny[i]; }
    if (row + 1 < r1) {
      const float* xs = xsrc(row + 1);
#pragma unroll
      for (int i = 0; i < 4; ++i) nx[i] = *(const float4*)(xs + i * 256 + lane * 4);
      if (hasY) {
#pragma unroll
        for (int i = 0; i < 4; ++i) ny[i] = *(const h4*)(Y + (size_t)(row + 1) * 1024 + i * 256 + lane * 4);
      }
    }
    const int mi = row < RL ? (row >> 12) : 8;
    if (mi != cur_mi) {
      cur_mi = mi;
      const float* mg = MOD + (size_t)(lyr * 9 + mi) * 6144;
      const float* mh = MOD + (size_t)(hl * 9 + mi) * 6144;
#pragma unroll
      for (int i = 0; i < 4; ++i) {
        const int o = i * 256 + lane * 4;
        if (hasY) { gy[i] = *(const float4*)(p.norm_g + gyi * 1024 + o); gt[i] = *(const float4*)(mg + gti * 1024 + o); }
        if (hasH) {
          gh[i] = *(const float4*)(p.norm_g + ghi * 1024 + o);
          s1[i] = *(const float4*)(mh + shi * 1024 + o);
          s2[i] = *(const float4*)(mh + (shi + 1) * 1024 + o);
        }
      }
    }
    if (hasY) {
      float yv[4][4];
      float ss = 0.f;
#pragma unroll
      for (int i = 0; i < 4; ++i)
#pragma unroll
        for (int k = 0; k < 4; ++k) { yv[i][k] = (float)yh[i][k]; ss += yv[i][k] * yv[i][k]; }
      ss = wave_sum(ss, lane);
      const float rs = rsqrtf(ss * (1.f / 1024.f) + EPS);
      float* xo = xdst(row);
#pragma unroll
      for (int i = 0; i < 4; ++i) {
        xv[i][0] += gt[i].x * (yv[i][0] * rs * gy[i].x);
        xv[i][1] += gt[i].y * (yv[i][1] * rs * gy[i].y);
        xv[i][2] += gt[i].z * (yv[i][2] * rs * gy[i].z);
        xv[i][3] += gt[i].w * (yv[i][3] * rs * gy[i].w);
        *(float4*)(xo + i * 256 + lane * 4) = make_float4(xv[i][0], xv[i][1], xv[i][2], xv[i][3]);
      }
    }
    if (hasH) {
      float ss = 0.f;
#pragma unroll
      for (int i = 0; i < 4; ++i)
#pragma unroll
        for (int k = 0; k < 4; ++k) ss += xv[i][k] * xv[i][k];
      ss = wave_sum(ss, lane);
      const float rs = rsqrtf(ss * (1.f / 1024.f) + EPS);
      half_t* ho = H + (size_t)row * 1024;
#pragma unroll
      for (int i = 0; i < 4; ++i) {
        h4 o;
        o[0] = (half_t)(xv[i][0] * rs * gh[i].x * (1.f + s2[i].x) + s1[i].x);
        o[1] = (half_t)(xv[i][1] * rs * gh[i].y * (1.f + s2[i].y) + s1[i].y);
        o[2] = (half_t)(xv[i][2] * rs * gh[i].z * (1.f + s2[i].z) + s1[i].z);
        o[3] = (half_t)(xv[i][3] * rs * gh[i].w * (1.f + s2[i].w) + s1[i].w);
        *(h4*)(ho + i * 256 + lane * 4) = o;
      }
    }
  }
}

__device__ __forceinline__ int clampi(int v, int lo, int hi) { return v < lo ? lo : (v > hi ? hi : v); }

__device__ void attn_item(const P& p, int item, char* smem) {
  half_t* Ks = (half_t*)smem;
  half_t* Vt = Ks + 2 * 64 * 72;
  float* rpbs = (float*)(smem + 36864);
  const int tid = tidx(), lane = tid & 63, w = tid >> 6, lr = lane & 15, lq = lane >> 4;
  const half_t* U = (const half_t*)((p.ws + opaque_zero()) + OFF_U);
  half_t* Z = (half_t*)((p.ws + opaque_zero()) + OFF_Z);
  const bool isctx = item >= 2048;
  int b, h, qrow, nlat = 0, start0 = 0, my_r = 0, my_start = 0, cw = 0, cs = 0, qcol = 0;
  if (!isctx) {
    b = item >> 8; h = (item >> 5) & 7;
    const int r0 = (item & 31) * 2;
    my_r = r0 + (w >> 2);
    const int cgp = w & 3;
    qcol = cgp * 16 + lr;
    qrow = b * 4096 + my_r * 64 + qcol;
    start0 = clampi(r0 - 4, 0, 56);
    const int start1 = clampi(r0 + 1 - 4, 0, 56);
    nlat = start1 + 8 - start0;
    my_start = clampi(my_r - 4, 0, 56);
    cw = clampi(cgp * 16 - 8, 0, 32);
    cs = clampi(qcol - 8, 0, 48);
  } else {
    const int it = item - 2048;
    b = it >> 4; h = (it >> 1) & 7;
    qrow = RL + b * 256 + (it & 1) * 128 + w * 16 + lr;
  }
  const int ntiles = nlat + 4;
  h8 qf[2];
#pragma unroll
  for (int ks = 0; ks < 2; ++ks) {
    h8 t = *(const h8*)(U + (size_t)qrow * 2048 + 512 + h * 64 + ks * 32 + lq * 8);
#pragma unroll
    for (int i = 0; i < 8; ++i) t[i] = t[i] * (half_t)0.125f;
    qf[ks] = t;
  }
  if (!isctx)
    for (int i = tid; i < 465; i += 512) rpbs[i] = p.ev_rpb[h * 465 + i];

  const int skey = tid >> 3, sd = (tid & 7) * 8;
  uint4 kA, vA, kB, vB;
  auto tile_row0 = [&](int i) -> int { return i < nlat ? b * 4096 + (start0 + i) * 64 : RL + b * 256 + (i - nlat) * 64; };
  const half_t* VTg = (const half_t*)((p.ws + opaque_zero()) + OFF_A1);
#define AT_GLOAD(kr, vr, i)                                                                            \
  {                                                                                                    \
    const int r0t = tile_row0(i);                                                                      \
    kr = *(const uint4*)(U + (size_t)(r0t + skey) * 2048 + 1024 + h * 64 + sd);                        \
    vr = *(const uint4*)(VTg + ((size_t)(r0t >> 6) * 8 + h) * 4096 + skey * 64 + sd);                  \
  }
#define AT_SSTORE(kr, vr, buf)                                                                         \
  {                                                                                                    \
    *(uint4*)(Ks + (buf) * 4608 + skey * 72 + sd) = kr;                                                \
    *(uint4*)(Vt + (buf) * 4608 + skey * 72 + sd) = vr;                                                \
  }
  f4 o[4];
#pragma unroll
  for (int i = 0; i < 4; ++i) o[i] = (f4){0.f, 0.f, 0.f, 0.f};
  const float NEG = opaque_f(-1e30f);
  float m = NEG, l = 0.f;

  AT_GLOAD(kA, vA, 0);
  AT_SSTORE(kA, vA, 0);
  AT_GLOAD(kA, vA, 1);
  AT_GLOAD(kB, vB, 2);
  __syncthreads();
  for (int i = 0; i < ntiles; ++i) {
    const int buf = i & 1;
    const bool lt = i < nlat;
    const int kr_abs = start0 + i;
    const bool active = !lt || (kr_abs >= my_start && kr_abs < my_start + 8);
    if (active) {
      const int npairs = lt ? 1 : 2;
      for (int pi = 0; pi < npairs; ++pi) {
        const int kb = lt ? cw : pi * 32;
        f4 s[2];
#pragma unroll
        for (int st = 0; st < 2; ++st) {
          f4 z = (f4){0.f, 0.f, 0.f, 0.f};
#pragma unroll
          for (int ks = 0; ks < 2; ++ks) {
            const h8 kf = *(const h8*)(Ks + buf * 4608 + (kb + st * 16 + lr) * 72 + ks * 32 + lq * 8);
            z = __builtin_amdgcn_mfma_f32_16x16x32_f16(kf, qf[ks], z, 0, 0, 0);
          }
          s[st] = z;
        }
        float tmax = NEG;
#pragma unroll
        for (int st = 0; st < 2; ++st)
#pragma unroll
          for (int j = 0; j < 4; ++j) {
            float v = s[st][j];
            if (lt) {
              const int kc = kb + st * 16 + lq * 4 + j;
              const bool ok = (kc >= cs) && (kc < cs + 16);
              const int dc = clampi(kc - qcol + 15, 0, 30);
              const int dr = kr_abs - my_r + 7;
              v = ok ? v + rpbs[dr * 31 + dc] : NEG;
            }
            s[st][j] = v;
            tmax = fmaxf(tmax, v);
          }
        tmax = fmaxf(tmax, bperm(tmax, lane ^ 16));
        tmax = fmaxf(tmax, bperm(tmax, lane ^ 32));
        const float mn = fmaxf(m, tmax);
        const float alpha = __expf(m - mn);
        m = mn;
        h8 pb;
        float ps = 0.f;
#pragma unroll
        for (int st = 0; st < 2; ++st)
#pragma unroll
          for (int j = 0; j < 4; ++j) {
            const float e = __expf(s[st][j] - mn);
            ps += e;
            pb[st * 4 + j] = (half_t)e;
          }
        l = l * alpha + ps;
#pragma unroll
        for (int dt = 0; dt < 4; ++dt) {
          o[dt] = o[dt] * alpha;
          const half_t* vp = Vt + buf * 4608 + (dt * 16 + lr) * 72 + kb + lq * 4;
          const h4 v0 = *(const h4*)vp;
          const h4 v1 = *(const h4*)(vp + 16);
          h8 vf;
          vf[0] = v0[0]; vf[1] = v0[1]; vf[2] = v0[2]; vf[3] = v0[3];
          vf[4] = v1[0]; vf[5] = v1[1]; vf[6] = v1[2]; vf[7] = v1[3];
          o[dt] = __builtin_amdgcn_mfma_f32_16x16x32_f16(vf, pb, o[dt], 0, 0, 0);
        }
      }
    }
    if (i + 1 < ntiles) {
      if ((i + 1) & 1) {
        AT_SSTORE(kA, vA, 1);
        if (i + 3 < ntiles) AT_GLOAD(kA, vA, i + 3);
      } else {
        AT_SSTORE(kB, vB, 0);
        if (i + 3 < ntiles) AT_GLOAD(kB, vB, i + 3);
      }
    }
    __syncthreads();
  }
#undef AT_GLOAD
#undef AT_SSTORE
  l += bperm(l, lane ^ 16);
  l += bperm(l, lane ^ 32);
  const float inv = 1.f / l;
#pragma unroll
  for (int dt = 0; dt < 4; ++dt) {
    h4 ov;
#pragma unroll
    for (int j = 0; j < 4; ++j) ov[j] = (half_t)(o[dt][j] * inv);
    *(h4*)(Z + (size_t)qrow * 1024 + 512 + h * 64 + dt * 16 + lq * 4) = ov;
  }
}

template <int HW>
__device__ __forceinline__ void pool_rows(const float (&pre)[4][25], int tl0, int L, half_t* zp) {
#pragma unroll
  for (int r = 0; r < 8; ++r) {
    const int tl = tl0 + r;
    const int lo = max(tl - HW, 0), hi = min(tl + HW, L);
    const float inv = 1.f / (float)(hi - lo);
    h4 o;
#pragma unroll
    for (int c = 0; c < 4; ++c) {
      const float sum = pre[c][8 + r + HW] - pre[c][8 + r - HW];
      const float cur = pre[c][8 + r + 1] - pre[c][8 + r];
      o[c] = (half_t)(sum * inv - cur);
    }
    *(h4*)(zp + (size_t)r * 1024) = o;
  }
}

__device__ void pool_item(const P& p, int item) {
  const half_t* U = (const half_t*)((p.ws + opaque_zero()) + OFF_U);
  half_t* Z = (half_t*)((p.ws + opaque_zero()) + OFF_Z);
  const int tid = tidx();
  const int c4 = (tid & 127) * 4, gi = c4 >> 7;
  const int row0 = item * 32 + (tid >> 7) * 8;
  int s0, L;
  if (row0 < RL) { s0 = row0 & ~4095; L = 4096; } else { s0 = RL + ((row0 - RL) & ~255); L = 256; }
  const int tl0 = row0 - s0;
  float pre[4][25];
#pragma unroll
  for (int c = 0; c < 4; ++c) pre[c][0] = 0.f;
#pragma unroll
  for (int i = 0; i < 24; ++i) {
    const int tl = tl0 - 8 + i;
    h4 v;
    v[0] = (half_t)0.f; v[1] = (half_t)0.f; v[2] = (half_t)0.f; v[3] = (half_t)0.f;
    if (tl >= 0 && tl < L) v = *(const h4*)(U + (size_t)(s0 + tl) * 2048 + c4);
#pragma unroll
    for (int c = 0; c < 4; ++c) pre[c][i + 1] = (float)v[c];
  }
#pragma unroll
  for (int i = 0; i < 24; ++i)
#pragma unroll
    for (int c = 0; c < 4; ++c) pre[c][i + 1] += pre[c][i];
  half_t* zp = Z + (size_t)row0 * 1024 + c4;
  if (gi == 0) pool_rows<1>(pre, tl0, L, zp);
  else if (gi == 1) pool_rows<2>(pre, tl0, L, zp);
  else if (gi == 2) pool_rows<4>(pre, tl0, L, zp);
  else pool_rows<8>(pre, tl0, L, zp);
}

__device__ void phase_shift(const P& p) {
  const half_t* H = (const half_t*)((p.ws + opaque_zero()) + OFF_A0);
  half_t* XX = (half_t*)((p.ws + opaque_zero()) + OFF_A1);
  const size_t total = (size_t)RT * 128;
  for (size_t idx = (size_t)bidx() * 512 + tidx(); idx < total; idx += (size_t)gridDim.x * 512) {
    const int row = (int)(idx >> 7), c = (int)(idx & 127) * 8;
    bool st, en;
    if (row < RL) { st = (row & 4095) == 0; en = (row & 4095) == 4095; }
    else { st = ((row - RL) & 255) == 0; en = ((row - RL) & 255) == 255; }
    const h8 cur = *(const h8*)(H + (size_t)row * 1024 + c);
    h8 pv, nx;
#pragma unroll
    for (int i = 0; i < 8; ++i) { pv[i] = (half_t)0.f; nx[i] = (half_t)0.f; }
    if (!st) pv = *(const h8*)(H + (size_t)(row - 1) * 1024 + c);
    if (!en) nx = *(const h8*)(H + (size_t)(row + 1) * 1024 + c);
    h8 o;
#pragma unroll
    for (int i = 0; i < 8; ++i) o[i] = (half_t)(0.5f * ((float)pv[i] + (float)nx[i]) - (float)cur[i]);
    *(h8*)(XX + (size_t)row * 1024 + c) = o;
  }
}

#define CS_BYTES 13312
#define CS_G 0
#define CS_R 2304
#define CS_AT 4608
#define CS_BT 6656
#define CS_VT 8704
#define CS_M 10752
#define CS_BM 11264
#define CS_CM 11776
#define CS_DM 12288
#define CS_PREF 12800
#define CS_PEND 13056
#define SCR_BASE 106496
#define SCR_BYTES 5632

__device__ void scan_item(const P& p, int item, char* smem) {
  const int tid = tidx(), lane = tid & 63, w = tid >> 6, lr = lane & 15, lq = lane >> 4;
  const int b = item >> 5, h = (item >> 1) & 15, dir = item & 1;
  char* ws = (p.ws + opaque_zero());
  const half_t* RRp = (const half_t*)(ws + OFF_RR);
  const half_t* KKp = (const half_t*)(ws + OFF_KK);
  const half_t* VVp = (const half_t*)(ws + OFF_VV);
  const half_t* Lp = (const half_t*)(ws + OFF_L);
  half_t* Yd = (half_t*)(ws + (dir ? OFF_A1 : OFF_A0));
  float* BN = (float*)(ws + OFF_BN) + (size_t)dir * RL * 16;

  auto grow = [&](int pp) -> int {
    if (pp < 256) return RL + b * 256 + (dir ? 255 - pp : pp);
    const int t = pp - 256;
    return b * 4096 + (dir ? 4095 - t : t);
  };

  auto prep = [&](int c) {
    char* cs = smem + w * CS_BYTES;
    half_t* G_ = (half_t*)(cs + CS_G);
    half_t* R_ = (half_t*)(cs + CS_R);
    half_t* AT = (half_t*)(cs + CS_AT);
    half_t* BT = (half_t*)(cs + CS_BT);
    half_t* VT = (half_t*)(cs + CS_VT);
    half_t* Mm = (half_t*)(cs + CS_M);
    half_t* Bm = (half_t*)(cs + CS_BM);
    half_t* Cm = (half_t*)(cs + CS_CM);
    half_t* Dm = (half_t*)(cs + CS_DM);
    float* Pref = (float*)(cs + CS_PREF);
    float* Pend = (float*)(cs + CS_PEND);
    char* scr = smem + SCR_BASE + w * SCR_BYTES;
    half_t* A_ = (half_t*)scr;
    half_t* B_ = (half_t*)(scr + 2304);
    float* Am = (float*)(scr + 4608);
    const bool lat = c >= 16;
    const int p0 = c * 16;
    const int rowA = grow(p0 + lr);
    const half_t* lp = Lp + (size_t)rowA * 384 + dir * 64 + lq * 8;
    const h8 aw0 = *(const h8*)(lp), aw1 = *(const h8*)(lp + 32);
    const h8 aa0 = *(const h8*)(lp + 128), aa1 = *(const h8*)(lp + 160);
    float ss[4], bp[4];
    int rows[4];
#pragma unroll
    for (int j = 0; j < 4; ++j) { ss[j] = 0.f; bp[j] = 0.f; rows[j] = grow(p0 + lq * 4 + j); }
#pragma unroll 1
    for (int nt = 0; nt < 4; ++nt) {
      const int ch = h * 64 + nt * 16 + lr;
      const float kkc = p.rw_kk[ch];
#pragma unroll
      for (int j = 0; j < 4; ++j) {
        const float k = (float)KKp[(size_t)rows[j] * 1024 + ch];
        ss[j] += (k * kkc) * (k * kkc);
      }
    }
    float inv[4];
#pragma unroll
    for (int j = 0; j < 4; ++j) inv[j] = rsqrtf(fmaxf(red16(ss[j]), 1e-24f));
#pragma unroll 1
    for (int nt = 0; nt < 4; ++nt) {
      const int ch = h * 64 + nt * 16 + lr;
      const half_t* w2p = (const half_t*)(ws + OFF_W2) + (size_t)dir * 65536 + (size_t)ch * 64 + lq * 8;
      const half_t* a2p = (const half_t*)(ws + OFF_A2) + (size_t)dir * 65536 + (size_t)ch * 64 + lq * 8;
      const h8 bw0 = *(const h8*)(w2p), bw1 = *(const h8*)(w2p + 32);
      const h8 ba0 = *(const h8*)(a2p), ba1 = *(const h8*)(a2p + 32);
      const float w0c = p.rw_w0[dir * 1024 + ch], a0c = p.rw_a0[dir * 1024 + ch];
      const float kkc = p.rw_kk[ch], kac = p.rw_ka[ch], rkc = p.rw_rk[ch];
      f4 cwv = (f4){0.f, 0.f, 0.f, 0.f}, cav = (f4){0.f, 0.f, 0.f, 0.f};
      cwv = __builtin_amdgcn_mfma_f32_16x16x32_f16(aw0, bw0, cwv, 0, 0, 0);
      cwv = __builtin_amdgcn_mfma_f32_16x16x32_f16(aw1, bw1, cwv, 0, 0, 0);
      cav = __builtin_amdgcn_mfma_f32_16x16x32_f16(aa0, ba0, cav, 0, 0, 0);
      cav = __builtin_amdgcn_mfma_f32_16x16x32_f16(aa1, ba1, cav, 0, 0, 0);
      h4 vq;
      float ev[4], avv[4], rv[4], kv[4];
#pragma unroll
      for (int j = 0; j < 4; ++j) {
        const size_t gi = (size_t)rows[j] * 1024 + ch;
        kv[j] = (float)KKp[gi];
        vq[j] = VVp[gi];
        rv[j] = lat ? (float)RRp[gi] : 0.f;
        ev[j] = 0.60653066f * sigm(cwv[j] + w0c);
        avv[j] = sigm(cav[j] + a0c);
        bp[j] += rv[j] * kv[j] * rkc * (dir == 0 ? (2.f - 2.f * kac + kac * avv[j]) : kac * avv[j]);
      }
      *(h4*)(VT + (nt * 16 + lr) * 16 + lq * 4) = vq;
      float cum[4];
      cum[0] = ev[0];
      cum[1] = cum[0] + ev[1];
      cum[2] = cum[1] + ev[2];
      cum[3] = cum[2] + ev[3];
      const float t1 = bperm(cum[3], (lane - 16) & 63), t2 = bperm(cum[3], (lane - 32) & 63), t3 = bperm(cum[3], (lane - 48) & 63);
      const float off = (lq >= 1 ? t1 : 0.f) + (lq >= 2 ? t2 : 0.f) + (lq >= 3 ? t3 : 0.f);
#pragma unroll
      for (int j = 0; j < 4; ++j) cum[j] += off;
      const float ref = bperm(cum[3], 16 + lr);
      const float end = bperm(cum[3], 48 + lr);
      if (lq == 0) {
        Pref[nt * 16 + lr] = __expf(-ref);
        Pend[nt * 16 + lr] = __expf(-(end - ref));
      }
      h4 aq, bq;
#pragma unroll
      for (int j = 0; j < 4; ++j) {
        const float d = cum[j] - ref;
        const float E1 = __expf(d), E2 = __expf(-d), E3 = __expf(ev[j] - d);
        const float k = kv[j];
        const float kk = k * kkc * inv[j];
        const float kd = k * (1.f + (avv[j] - 1.f) * kac);
        const half_t ga = (half_t)(kk * E3);
        const half_t ro = (half_t)(rv[j] * E2);
        const half_t al = (half_t)(kk * avv[j] * E1);
        const half_t be = (half_t)(kd * E1);
        const int o = (lq * 4 + j) * 72 + nt * 16 + lr;
        G_[o] = ga; R_[o] = ro; A_[o] = al; B_[o] = be;
        aq[j] = al; bq[j] = be;
      }
      *(h4*)(AT + (nt * 16 + lr) * 16 + lq * 4) = aq;
      *(h4*)(BT + (nt * 16 + lr) * 16 + lq * 4) = bq;
    }
#pragma unroll
    for (int j = 0; j < 4; ++j) {
      const float bpr = red16(bp[j]);
      if (lat && lr == 0) BN[(size_t)rows[j] * 16 + h] = bpr;
    }
    asm volatile("s_waitcnt lgkmcnt(0)" ::: "memory");
    f4 am = (f4){0.f, 0.f, 0.f, 0.f}, bm = am, cm = am, dm = am;
#pragma unroll
    for (int ks = 0; ks < 2; ++ks) {
      const h8 fa = *(const h8*)(A_ + lr * 72 + ks * 32 + lq * 8);
      const h8 fb = *(const h8*)(B_ + lr * 72 + ks * 32 + lq * 8);
      const h8 fg = *(const h8*)(G_ + lr * 72 + ks * 32 + lq * 8);
      const h8 fr = *(const h8*)(R_ + lr * 72 + ks * 32 + lq * 8);
      am = __builtin_amdgcn_mfma_f32_16x16x32_f16(fa, fg, am, 0, 0, 0);
      bm = __builtin_amdgcn_mfma_f32_16x16x32_f16(fb, fg, bm, 0, 0, 0);
      cm = __builtin_amdgcn_mfma_f32_16x16x32_f16(fa, fr, cm, 0, 0, 0);
      dm = __builtin_amdgcn_mfma_f32_16x16x32_f16(fb, fr, dm, 0, 0, 0);
    }
    h4 bmh, cmh, dmh;
#pragma unroll
    for (int j = 0; j < 4; ++j) {
      const int u = lq * 4 + j;
      am[j] = u < lr ? am[j] : 0.f;
      bmh[j] = (half_t)(u < lr ? bm[j] : 0.f);
      cmh[j] = (half_t)(u <= lr ? cm[j] : 0.f);
      dmh[j] = (half_t)(u <= lr ? dm[j] : 0.f);
    }
    *(h4*)(Bm + lr * 16 + lq * 4) = bmh;
    *(h4*)(Cm + lr * 16 + lq * 4) = cmh;
    *(h4*)(Dm + lr * 16 + lq * 4) = dmh;
    *(f4*)(Am + lr * 16 + lq * 4) = am;
    asm volatile("s_waitcnt lgkmcnt(0)" ::: "memory");
    float m[16];
#pragma unroll
    for (int t = 0; t < 16; ++t) {
      float acc = (t == lr) ? 1.f : 0.f;
#pragma unroll
      for (int u4 = 0; u4 < 4; ++u4) {
        if (u4 * 4 < t) {
          const f4 rw = *(const f4*)(Am + t * 16 + u4 * 4);
#pragma unroll
          for (int k = 0; k < 4; ++k)
            if (u4 * 4 + k < t) acc -= rw[k] * m[u4 * 4 + k];
        }
      }
      m[t] = acc;
    }
    if (lq == 0) {
#pragma unroll
      for (int t = 0; t < 16; ++t) Mm[t * 16 + lr] = (half_t)m[t];
    }
  };

  f4 Sacc[4];
#pragma unroll
  for (int jt = 0; jt < 4; ++jt) Sacc[jt] = (f4){0.f, 0.f, 0.f, 0.f};

  for (int sc = 0; sc < 34; ++sc) {
    prep(sc * 8 + w);
    __syncthreads();
    if (w < 4) {
      for (int cc = 0; cc < 8; ++cc) {
        const int c = sc * 8 + cc;
        const char* cs = smem + cc * CS_BYTES;
        const half_t* G_ = (const half_t*)(cs + CS_G);
        const half_t* R_ = (const half_t*)(cs + CS_R);
        const half_t* AT = (const half_t*)(cs + CS_AT);
        const half_t* BT = (const half_t*)(cs + CS_BT);
        const half_t* VT = (const half_t*)(cs + CS_VT);
        const half_t* Mm = (const half_t*)(cs + CS_M);
        const half_t* Bm = (const half_t*)(cs + CS_BM);
        const half_t* Cm = (const half_t*)(cs + CS_CM);
        const half_t* Dm = (const half_t*)(cs + CS_DM);
        const float* Pref = (const float*)(cs + CS_PREF);
        const float* Pend = (const float*)(cs + CS_PEND);
#pragma unroll
        for (int jt = 0; jt < 4; ++jt) Sacc[jt] = Sacc[jt] * *(const f4*)(Pref + jt * 16 + lq * 4);
        h8 bS[2];
#pragma unroll
        for (int ks = 0; ks < 2; ++ks)
#pragma unroll
          for (int k = 0; k < 4; ++k) {
            bS[ks][k] = (half_t)Sacc[2 * ks][k];
            bS[ks][4 + k] = (half_t)Sacc[2 * ks + 1][k];
          }
        const h4 vt = *(const h4*)(VT + (16 * w + lr) * 16 + lq * 4);
        f4 rhs = (f4){0.f, 0.f, 0.f, 0.f};
#pragma unroll
        for (int ks = 0; ks < 2; ++ks) {
          const h4 g0 = *(const h4*)(G_ + lr * 72 + (2 * ks) * 16 + lq * 4);
          const h4 g1 = *(const h4*)(G_ + lr * 72 + (2 * ks + 1) * 16 + lq * 4);
          h8 gf;
          gf[0] = g0[0]; gf[1] = g0[1]; gf[2] = g0[2]; gf[3] = g0[3];
          gf[4] = g1[0]; gf[5] = g1[1]; gf[6] = g1[2]; gf[7] = g1[3];
          rhs = __builtin_amdgcn_mfma_f32_16x16x32_f16(gf, bS[ks], rhs, 0, 0, 0);
        }
        {
          f4 r16 = (f4){0.f, 0.f, 0.f, 0.f};
          r16 = __builtin_amdgcn_mfma_f32_16x16x16f16(*(const h4*)(Bm + lr * 16 + lq * 4), vt, r16, 0, 0, 0);
          rhs = rhs + r16;
        }
        h4 rh;
#pragma unroll
        for (int k = 0; k < 4; ++k) rh[k] = (half_t)rhs[k];
        f4 av = (f4){0.f, 0.f, 0.f, 0.f};
        av = __builtin_amdgcn_mfma_f32_16x16x16f16(*(const h4*)(Mm + lr * 16 + lq * 4), rh, av, 0, 0, 0);
        h4 na;
#pragma unroll
        for (int k = 0; k < 4; ++k) na[k] = (half_t)(-av[k]);
        if (c >= 16) {
          f4 y = (f4){0.f, 0.f, 0.f, 0.f};
#pragma unroll
          for (int ks = 0; ks < 2; ++ks) {
            const h4 g0 = *(const h4*)(R_ + lr * 72 + (2 * ks) * 16 + lq * 4);
            const h4 g1 = *(const h4*)(R_ + lr * 72 + (2 * ks + 1) * 16 + lq * 4);
            h8 gf;
            gf[0] = g0[0]; gf[1] = g0[1]; gf[2] = g0[2]; gf[3] = g0[3];
            gf[4] = g1[0]; gf[5] = g1[1]; gf[6] = g1[2]; gf[7] = g1[3];
            y = __builtin_amdgcn_mfma_f32_16x16x32_f16(gf, bS[ks], y, 0, 0, 0);
          }
          f4 y16 = (f4){0.f, 0.f, 0.f, 0.f};
          y16 = __builtin_amdgcn_mfma_f32_16x16x16f16(*(const h4*)(Cm + lr * 16 + lq * 4), na, y16, 0, 0, 0);
          y16 = __builtin_amdgcn_mfma_f32_16x16x16f16(*(const h4*)(Dm + lr * 16 + lq * 4), vt, y16, 0, 0, 0);
          y = y + y16;
#pragma unroll
          for (int k = 0; k < 4; ++k) {
            const int row = grow(c * 16 + lq * 4 + k);
            Yd[(size_t)row * 1024 + h * 64 + 16 * w + lr] = (half_t)y[k];
          }
        }
#pragma unroll
        for (int jt = 0; jt < 4; ++jt) {
          Sacc[jt] = __builtin_amdgcn_mfma_f32_16x16x16f16(*(const h4*)(AT + (jt * 16 + lr) * 16 + lq * 4), na, Sacc[jt], 0, 0, 0);
          Sacc[jt] = __builtin_amdgcn_mfma_f32_16x16x16f16(*(const h4*)(BT + (jt * 16 + lr) * 16 + lq * 4), vt, Sacc[jt], 0, 0, 0);
          Sacc[jt] = Sacc[jt] * *(const f4*)(Pend + jt * 16 + lq * 4);
        }
      }
    }
    __syncthreads();
  }
}

__device__ void phase_readout(const P& p) {
  const int lane = tidx() & 63;
  const int gw = bidx() * 8 + (tidx() >> 6), stride = gridDim.x * 8;
  char* ws = (p.ws + opaque_zero());
  const half_t* Y0 = (const half_t*)(ws + OFF_A0);
  const half_t* Y1 = (const half_t*)(ws + OFF_A1);
  const half_t* VVp = (const half_t*)(ws + OFF_VV);
  const half_t* Gp = (const half_t*)(ws + OFF_G);
  const float* BN0 = (const float*)(ws + OFF_BN);
  const float* BN1 = BN0 + (size_t)RL * 16;
  half_t* Z1 = (half_t*)(ws + OFF_Z1);
  const int c0 = lane * 16, head = lane >> 2;
  for (int row = gw; row < RL; row += stride) {
    const size_t o = (size_t)row * 1024 + c0;
    float y[16], vv[16], gg[16];
#pragma unroll
    for (int hh = 0; hh < 2; ++hh) {
      const h8 a = *(const h8*)(Y0 + o + hh * 8);
      const h8 bq = *(const h8*)(Y1 + o + hh * 8);
      const h8 v = *(const h8*)(VVp + o + hh * 8);
      const h8 g = *(const h8*)(Gp + o + hh * 8);
#pragma unroll
      for (int i = 0; i < 8; ++i) {
        y[hh * 8 + i] = (float)a[i] + (float)bq[i];
        vv[hh * 8 + i] = (float)v[i];
        gg[hh * 8 + i] = (float)g[i];
      }
    }
    float s = 0.f;
#pragma unroll
    for (int i = 0; i < 16; ++i) s += y[i];
    s = red4(s);
    const float mean = s * (1.f / 64.f);
    float q = 0.f;
#pragma unroll
    for (int i = 0; i < 16; ++i) { const float d = y[i] - mean; q += d * d; }
    q = red4(q);
    const float rstd = rsqrtf(q * (1.f / 64.f) + 64e-5f);
    const float bonus = BN0[(size_t)row * 16 + head] + BN1[(size_t)row * 16 + head];
    h8 o0, o1;
#pragma unroll
    for (int i = 0; i < 16; ++i) {
      const float lg = p.rw_lng[c0 + i], lb = p.rw_lnb[c0 + i];
      const float r = ((y[i] - mean) * rstd * lg + lb + bonus * vv[i]) * gg[i];
      if (i < 8) o0[i] = (half_t)r; else o1[i - 8] = (half_t)r;
    }
    *(h8*)(Z1 + o) = o0;
    *(h8*)(Z1 + o + 8) = o1;
  }
}

#define NPHASE 18
__global__ void __launch_bounds__(512) mega(P p_in, int ph_lo, int ph_hi) {
  __shared__ __attribute__((aligned(16))) char smem[SMEM_BYTES];
  cg::grid_group grid = cg::this_grid();
  const P& p = p_in;
  for (int ph = ph_lo; ph < ph_hi; ++ph) {
    char* ws = p_in.ws + opaque_zero();
    int kind = 2, arg = 0;
    size_t oA = 0, oB = 0, oC = 0;
    int lda = 1024, ldb = 1024, K = 1024, ldc = 1024, epi = 0, nMt = 136, nNt = 8, feat = 0;
    switch (ph) {
      case 0: kind = 0; break;
      case 1: kind = 1; arg = 0; break;
      case 2: oA = OFF_A0; oB = OFF_WIN; oC = OFF_U; ldc = 2048; nNt = 8; feat = 2; break;
      case 3: kind = 3; break;
      case 4: oA = OFF_Z; oB = OFF_WOUT; oC = OFF_A1; nNt = 4; feat = 3; break;
      case 5: kind = 1; arg = 1; break;
      case 6: oA = OFF_A0; oB = OFF_M1; oC = OFF_F; ldc = 4096; nNt = 16; epi = 1; feat = 3; break;
      case 7: oA = OFF_F; lda = 4096; oB = OFF_M2; ldb = 4096; K = 4096; oC = OFF_A1; nNt = 4; feat = 3; break;
      case 8: kind = 1; arg = 2; break;
      case 9: kind = 4; break;
      case 10: oA = OFF_A0; oB = OFF_WR; oC = OFF_RR; nNt = 27; feat = 1; break;
      case 11: kind = 5; break;
      case 12: oA = OFF_L + 512; lda = 384; oB = OFF_G2; ldb = 128; K = 128; oC = OFF_Z1; nMt = 128; epi = 5; break;
      case 13: oA = OFF_Z1; oB = OFF_WO; oC = OFF_A1; nMt = 128; nNt = 4; feat = 3; break;
      case 14: kind = 1; arg = 3; break;
      case 15: oA = OFF_A0; oB = OFF_M1 + 8 * MIB; oC = OFF_F; ldc = 4096; nNt = 16; epi = 1; nMt = 128; feat = 3; break;
      case 16: oA = OFF_F; lda = 4096; oB = OFF_M2 + 8 * MIB; ldb = 4096; K = 4096; oC = OFF_A1; nMt = 128; nNt = 4; feat = 3; break;
      default: kind = 1; arg = 4; break;
    }
    if (kind == 2) {
      gemm_phase(p, (const half_t*)(ws + oA), lda, (const half_t*)(ws + oB), ldb, K, (half_t*)(ws + oC), ldc, epi, nMt, nNt, feat, smem);
    } else if (kind == 1) {
      phase_rowwise(p, arg);
    } else if (kind == 0) {
      phase_prep(p, smem);
    } else if (kind == 3) {
      for (int it = bidx(); it < 2176 + 1088; it += gridDim.x) {
        if (it < 2176) attn_item(p, it, smem); else pool_item(p, it - 2176);
      }
    } else if (kind == 4) {
      phase_shift(p);
    } else if (kind == 5) {
      for (int it = bidx(); it < 256; it += gridDim.x) scan_item(p, it, smem);
    } else {
      phase_readout(p);
    }
    if (ph + 1 < ph_hi) grid.sync();
  }
}

extern "C" void kernel_launch(void* const* d_in, const int* in_sizes, int n_in, void* d_out, int out_size, void* d_ws,
                              size_t ws_size, hipStream_t stream) {
  P p{};
  const float** pp = (const float**)&p;
  for (int i = 0; i < 32; ++i) pp[i] = (const float*)d_in[i];
  p.out = (float*)d_out;
  p.ws = (char*)d_ws;
  static int grid_blocks = 0;
  if (!grid_blocks) {
    int dev = 0, cus = 0, per_cu = 0;
    (void)hipGetDevice(&dev);
    (void)hipDeviceGetAttribute(&cus, hipDeviceAttributeMultiprocessorCount, dev);
    (void)hipOccupancyMaxActiveBlocksPerMultiprocessor(&per_cu, mega, 512, 0);
    if (per_cu < 1) per_cu = 1;
    grid_blocks = cus * per_cu;
  }
  int lo = 0, hi = NPHASE;
  void* args[] = {&p, &lo, &hi};
  hipError_t e = hipLaunchCooperativeKernel((void*)mega, dim3(grid_blocks), dim3(512), args, 0, stream);
  if (e != hipSuccess) fprintf(stderr, "cooperative launch failed: %s (grid %d)\n", hipGetErrorString(e), grid_blocks);
}
```

```cpp
#include <hip/hip_runtime.h>
#include <hip/hip_cooperative_groups.h>
#include <cstdio>
namespace cg = cooperative_groups;

typedef _Float16 half_t;
typedef _Float16 h8 __attribute__((ext_vector_type(8)));
typedef _Float16 h4 __attribute__((ext_vector_type(4)));
typedef _Float16 h2 __attribute__((ext_vector_type(2)));
typedef float f4 __attribute__((ext_vector_type(4)));

#define RL 32768
#define RC 2048
#define RT 34816
#define MIB (1ull << 20)
#define OFF_WIN (0 * MIB)
#define OFF_WOUT (4 * MIB)
#define OFF_M1 (7 * MIB)
#define OFF_M2 (23 * MIB)
#define OFF_WR (39 * MIB)
#define OFF_WK (41 * MIB)
#define OFF_WV (43 * MIB)
#define OFF_WO (45 * MIB)
#define OFF_L1 (47 * MIB)
#define OFF_W2 (48 * MIB)
#define OFF_A2 (48 * MIB + 256 * 1024)
#define OFF_G2 (48 * MIB + 512 * 1024)
#define OFF_MOD (49 * MIB)
#define OFF_BN (50 * MIB)
#define OFF_XC (54 * MIB)
#define OFF_A0 (62 * MIB)
#define OFF_A1 (130 * MIB)
#define OFF_BIG (198 * MIB)
#define OFF_U OFF_BIG
#define OFF_Z (334 * MIB)
#define OFF_F OFF_BIG
#define OFF_RR OFF_BIG
#define OFF_KK (266 * MIB)
#define OFF_VV (334 * MIB)
#define OFF_L (402 * MIB)
#define OFF_G OFF_BIG
#define OFF_Z1 (266 * MIB)

#define SMEM_BYTES 151552

struct P {
  const float *x, *c, *ctx, *c_ctx, *ada_w, *ada_b, *norm_g, *mlp_w1, *mlp_w2, *ev_w_in, *ev_w_out, *ev_pool_w,
      *ev_pool_scale, *ev_rpb, *rw_mu, *rw_wr, *rw_wk, *rw_wv, *rw_wo, *rw_w0, *rw_w1, *rw_w2, *rw_a0, *rw_a1, *rw_a2,
      *rw_g1, *rw_g2, *rw_kk, *rw_ka, *rw_rk, *rw_lng, *rw_lnb;
  float* out;
  char* ws;
};

__device__ __forceinline__ int tidx() { int v = threadIdx.x; asm volatile("" : "+v"(v)); return v; }
__device__ __forceinline__ int bidx() { int v = blockIdx.x; asm volatile("" : "+s"(v)); return v; }
__device__ __forceinline__ size_t opaque_zero() { size_t z = 0; asm volatile("" : "+s"(z)); return z; }
__device__ __forceinline__ float opaque_f(float v) { asm volatile("" : "+v"(v)); return v; }
__device__ __forceinline__ float sigm(float x) { return 1.f / (1.f + __expf(-x)); }
__device__ __forceinline__ float bperm(float v, int srclane) {
  return __builtin_bit_cast(float, __builtin_amdgcn_ds_bpermute(srclane << 2, __builtin_bit_cast(int, v)));
}
template <int CTRL>
__device__ __forceinline__ float dpp(float x) {
  return __builtin_bit_cast(float, __builtin_amdgcn_mov_dpp(__builtin_bit_cast(int, x), CTRL, 0xf, 0xf, true));
}
__device__ __forceinline__ float red4(float x) { x += dpp<0xB1>(x); x += dpp<0x4E>(x); return x; }
__device__ __forceinline__ float red8(float x) { x = red4(x); x += dpp<0x141>(x); return x; }
__device__ __forceinline__ float red16(float x) { x = red8(x); x += dpp<0x140>(x); return x; }
__device__ __forceinline__ float wave_sum(float v, int lane) {
  v = red16(v);
  v += bperm(v, lane ^ 16);
  v += bperm(v, lane ^ 32);
  return v;
}

struct GemmTile {
  const half_t* A; const half_t* A2; const float* mu; int lda;
  const half_t* Bt; int ldb; int K;
  half_t* C; int ldc; int epi;
  int row0, col0;
  const P* pp;
};

template <bool MIX>
__device__ __forceinline__ void gemm_tile(const GemmTile& g, char* smem) {
  half_t* As = (half_t*)smem;
  half_t* Bs = (half_t*)(smem + 73728);
  const int tid = tidx(), lane = tid & 63, w = tid >> 6;
  const int wm = w >> 1, wn = w & 1, lr = lane & 15, lq = lane >> 4;
  const int ldr = tid >> 3, ldk = (tid & 7) * 8;
  f4 acc[4][4];
#pragma unroll
  for (int i = 0; i < 4; ++i)
#pragma unroll
    for (int j = 0; j < 4; ++j) acc[i][j] = (f4){0.f, 0.f, 0.f, 0.f};
  uint4 ra0, ra1, ra2, ra3, rb0, rb1;
  uint4 rx0, rx1, rx2, rx3;
  float4 mu0, mu1;
  const int nk = g.K >> 6;
  const half_t* Ap = g.A + (size_t)ldr * g.lda + ldk;
  const half_t* A2p = MIX ? g.A2 + (size_t)ldr * g.lda + ldk : nullptr;
  const float* mup = MIX ? g.mu + ldk : nullptr;
  const half_t* Bp = g.Bt + (size_t)ldr * g.ldb + ldk;
  const size_t astep = (size_t)64 * g.lda, bstep = (size_t)64 * g.ldb;
  half_t* asw = As + ldr * 72 + ldk;
  half_t* bsw = Bs + ldr * 72 + ldk;
  const half_t* asr = As + (wm * 64 + lr) * 72 + lq * 8;
  const half_t* bsr = Bs + (wn * 64 + lr) * 72 + lq * 8;

#define GLOAD(kt)                                              \
  {                                                            \
    const int k0 = (kt) * 64;                                  \
    ra0 = *(const uint4*)(Ap + k0);                            \
    ra1 = *(const uint4*)(Ap + astep + k0);                    \
    ra2 = *(const uint4*)(Ap + 2 * astep + k0);                \
    ra3 = *(const uint4*)(Ap + 3 * astep + k0);                \
    rb0 = *(const uint4*)(Bp + k0);                            \
    rb1 = *(const uint4*)(Bp + bstep + k0);                    \
    if (MIX) {                                                 \
      rx0 = *(const uint4*)(A2p + k0);                         \
      rx1 = *(const uint4*)(A2p + astep + k0);                 \
      rx2 = *(const uint4*)(A2p + 2 * astep + k0);             \
      rx3 = *(const uint4*)(A2p + 3 * astep + k0);             \
      mu0 = *(const float4*)(mup + k0);                        \
      mu1 = *(const float4*)(mup + k0 + 4);                    \
    }                                                          \
  }
#define MIXV(r, x) __builtin_bit_cast(uint4, (h8)(__builtin_bit_cast(h8, r) + __builtin_bit_cast(h8, x) * m))
#define SSTORE(buf)                                            \
  {                                                            \
    half_t* as = asw + (buf) * (256 * 72);                     \
    half_t* bs = bsw + (buf) * (128 * 72);                     \
    if (MIX) {                                                 \
      h8 m;                                                    \
      m[0] = (half_t)mu0.x; m[1] = (half_t)mu0.y; m[2] = (half_t)mu0.z; m[3] = (half_t)mu0.w; \
      m[4] = (half_t)mu1.x; m[5] = (half_t)mu1.y; m[6] = (half_t)mu1.z; m[7] = (half_t)mu1.w; \
      ra0 = MIXV(ra0, rx0); ra1 = MIXV(ra1, rx1); ra2 = MIXV(ra2, rx2); ra3 = MIXV(ra3, rx3); \
    }                                                          \
    *(uint4*)(as) = ra0;                                       \
    *(uint4*)(as + 64 * 72) = ra1;                             \
    *(uint4*)(as + 128 * 72) = ra2;                            \
    *(uint4*)(as + 192 * 72) = ra3;                            \
    *(uint4*)(bs) = rb0;                                       \
    *(uint4*)(bs + 64 * 72) = rb1;                             \
  }

  GLOAD(0);
  SSTORE(0);
  __syncthreads();
  for (int kt = 0; kt < nk; ++kt) {
    const bool more = kt + 1 < nk;
    if (more) GLOAD(kt + 1);
    __builtin_amdgcn_sched_barrier(0);
    {
      const half_t* as = asr + (kt & 1) * (256 * 72);
      const half_t* bs = bsr + (kt & 1) * (128 * 72);
#pragma unroll
      for (int ks = 0; ks < 2; ++ks) {
        h8 a[4], b[4];
#pragma unroll
        for (int i = 0; i < 4; ++i) {
          a[i] = *(const h8*)(as + i * 16 * 72 + ks * 32);
          b[i] = *(const h8*)(bs + i * 16 * 72 + ks * 32);
        }
#pragma unroll
        for (int mt = 0; mt < 4; ++mt)
#pragma unroll
          for (int nt = 0; nt < 4; ++nt)
            acc[mt][nt] = __builtin_amdgcn_mfma_f32_16x16x32_f16(b[nt], a[mt], acc[mt][nt], 0, 0, 0);
      }
    }
    if (more) SSTORE((kt + 1) & 1);
    __syncthreads();
  }
#undef GLOAD
#undef SSTORE
#undef MIXV
#pragma unroll
  for (int mt = 0; mt < 4; ++mt) {
    half_t* cp = g.C + (size_t)(wm * 64 + mt * 16 + lr) * g.ldc + wn * 64 + lq * 4;
#pragma unroll
    for (int nt = 0; nt < 4; ++nt) {
      h4 o;
#pragma unroll
      for (int j = 0; j < 4; ++j) {
        float v = acc[mt][nt][j];
        if (g.epi == 1) { v = fmaxf(v, 0.f); v = v * v; }
        else if (g.epi == 2) v = 1.f - 2.f / (__expf(2.f * v) + 1.f);
        else if (g.epi == 3) v = sigm(v);
        o[j] = (half_t)v;
      }
      *(h4*)(cp + nt * 16) = o;
    }
  }
}

__device__ __forceinline__ void gemm_tile2(const GemmTile& g, char* smem) {
  half_t* As = (half_t*)smem;
  half_t* Bs = (half_t*)(smem + 73728);
  const int tid = tidx(), lane = tid & 63, w = tid >> 6;
  const int wm = w >> 1, wn = w & 1, lr = lane & 15, lq = lane >> 4;
  const int ldr = tid >> 3, ldk = (tid & 7) * 8;
  f4 acc[4][4];
#pragma unroll
  for (int i = 0; i < 4; ++i)
#pragma unroll
    for (int j = 0; j < 4; ++j) acc[i][j] = (f4){0.f, 0.f, 0.f, 0.f};
  uint4 xa0, xa1, xa2, xa3, xb0, xb1;
  uint4 ya0, ya1, ya2, ya3, yb0, yb1;
  const int nk = g.K >> 6;
  const half_t* Ap = g.A + (size_t)ldr * g.lda + ldk;
  const half_t* Bp = g.Bt + (size_t)ldr * g.ldb + ldk;
  const size_t astep = (size_t)64 * g.lda, bstep = (size_t)64 * g.ldb;
  half_t* asw = As + ldr * 72 + ldk;
  half_t* bsw = Bs + ldr * 72 + ldk;
  const half_t* asr = As + (wm * 64 + lr) * 72 + lq * 8;
  const half_t* bsr = Bs + (wn * 64 + lr) * 72 + lq * 8;
#define GLD(S, kt)                                   \
  {                                                  \
    const int k0 = (kt) * 64;                        \
    S##a0 = *(const uint4*)(Ap + k0);                \
    S##a1 = *(const uint4*)(Ap + astep + k0);        \
    S##a2 = *(const uint4*)(Ap + 2 * astep + k0);    \
    S##a3 = *(const uint4*)(Ap + 3 * astep + k0);    \
    S##b0 = *(const uint4*)(Bp + k0);                \
    S##b1 = *(const uint4*)(Bp + bstep + k0);        \
  }
#define SST(S, buf)                                  \
  {                                                  \
    half_t* as = asw + (buf) * (256 * 72);           \
    half_t* bs = bsw + (buf) * (128 * 72);           \
    *(uint4*)(as) = S##a0;                           \
    *(uint4*)(as + 64 * 72) = S##a1;                 \
    *(uint4*)(as + 128 * 72) = S##a2;                \
    *(uint4*)(as + 192 * 72) = S##a3;                \
    *(uint4*)(bs) = S##b0;                           \
    *(uint4*)(bs + 64 * 72) = S##b1;                 \
  }
#define CMP(buf)                                                                                     \
  {                                                                                                  \
    const half_t* as = asr + (buf) * (256 * 72);                                                     \
    const half_t* bs = bsr + (buf) * (128 * 72);                                                     \
    _Pragma("unroll") for (int ks = 0; ks < 2; ++ks) {                                               \
      h8 a[4], b[4];                                                                                 \
      _Pragma("unroll") for (int i = 0; i < 4; ++i) {                                                \
        a[i] = *(const h8*)(as + i * 16 * 72 + ks * 32);                                             \
        b[i] = *(const h8*)(bs + i * 16 * 72 + ks * 32);                                             \
      }                                                                                              \
      _Pragma("unroll") for (int mt = 0; mt < 4; ++mt)                                               \
        _Pragma("unroll") for (int nt = 0; nt < 4; ++nt)                                             \
          acc[mt][nt] = __builtin_amdgcn_mfma_f32_16x16x32_f16(b[nt], a[mt], acc[mt][nt], 0, 0, 0);  \
    }                                                                                                \
  }
  GLD(x, 0);
  SST(x, 0);
  if (nk > 1) GLD(x, 1);
  if (nk > 2) GLD(y, 2);
  __syncthreads();
  for (int kt = 0; kt < nk; kt += 2) {
    CMP(0);
    if (kt + 1 < nk) SST(x, 1);
    if (kt + 3 < nk) GLD(x, kt + 3);
    __syncthreads();
    CMP(1);
    if (kt + 2 < nk) SST(y, 0);
    if (kt + 4 < nk) GLD(y, kt + 4);
    __syncthreads();
  }
#undef GLD
#undef SST
#undef CMP
#pragma unroll
  for (int mt = 0; mt < 4; ++mt) {
    half_t* cp = g.C + (size_t)(wm * 64 + mt * 16 + lr) * g.ldc + wn * 64 + lq * 4;
#pragma unroll
    for (int nt = 0; nt < 4; ++nt) {
      h4 o;
#pragma unroll
      for (int j = 0; j < 4; ++j) {
        float v = acc[mt][nt][j];
        if (g.epi == 1) { v = fmaxf(v, 0.f); v = v * v; }
        o[j] = (half_t)v;
      }
      *(h4*)(cp + nt * 16) = o;
    }
  }
}

__device__ __forceinline__ void gemm_tile3(const GemmTile& g, char* smem) {
  const int tid = tidx(), lane = tid & 63, w = tid >> 6;
  const int wm = w >> 1, wn = w & 1, lr = lane & 15, lq = lane >> 4;
  f4 acc[4][4];
#pragma unroll
  for (int i = 0; i < 4; ++i)
#pragma unroll
    for (int j = 0; j < 4; ++j) acc[i][j] = (f4){0.f, 0.f, 0.f, 0.f};
  const int nk = g.K >> 6;
  const int lrow = lane >> 3, lslot = lane & 7;
  const half_t* Ag[4];
  const half_t* Bg[2];
#pragma unroll
  for (int i = 0; i < 4; ++i) {
    const int row = (w * 4 + i) * 8 + lrow;
    Ag[i] = g.A + (size_t)row * g.lda + ((lslot ^ ((row >> 1) & 7)) * 8);
  }
#pragma unroll
  for (int i = 0; i < 2; ++i) {
    const int row = (w * 2 + i) * 8 + lrow;
    Bg[i] = g.Bt + (size_t)row * g.ldb + ((lslot ^ ((row >> 1) & 7)) * 8);
  }
  char* aw = smem + (w * 4) * 1024 + lane * 16;
  char* bw = smem + 32768 + (w * 2) * 1024 + lane * 16;
  const int swz = (lr >> 1) & 7;
  const int ko0 = ((0 + lq) ^ swz) * 16, ko1 = ((4 + lq) ^ swz) * 16;
  const char* ar = smem + (wm * 64 + lr) * 128;
  const char* br = smem + 32768 + (wn * 64 + lr) * 128;
#define ISSUE(kt, st)                                                                                      \
  {                                                                                                        \
    _Pragma("unroll") for (int i = 0; i < 4; ++i)                                                          \
      __builtin_amdgcn_global_load_lds((const unsigned*)(Ag[i] + (kt) * 64), (unsigned*)(aw + (st) * 49152 + i * 1024), 16, 0, 0); \
    _Pragma("unroll") for (int i = 0; i < 2; ++i)                                                          \
      __builtin_amdgcn_global_load_lds((const unsigned*)(Bg[i] + (kt) * 64), (unsigned*)(bw + (st) * 49152 + i * 1024), 16, 0, 0); \
  }
  ISSUE(0, 0);
  if (nk > 1) {
    ISSUE(1, 1);
    asm volatile("s_waitcnt vmcnt(6)" ::: "memory");
  } else {
    asm volatile("s_waitcnt vmcnt(0)" ::: "memory");
  }
  __builtin_amdgcn_s_barrier();
  asm volatile("" ::: "memory");
  h8 a0[4], b0[4], a1[4], b1[4];
#define LDF(fa, fb, stg, ko)                                             \
  {                                                                      \
    const char* as = ar + (stg) * 49152 + (ko);                          \
    const char* bs = br + (stg) * 49152 + (ko);                          \
    _Pragma("unroll") for (int i = 0; i < 4; ++i) {                      \
      fa[i] = *(const h8*)(as + i * 2048);                               \
      fb[i] = *(const h8*)(bs + i * 2048);                               \
    }                                                                    \
  }
#define MMA(fa, fb)                                                      \
  {                                                                      \
    _Pragma("unroll") for (int mt = 0; mt < 4; ++mt)                     \
      _Pragma("unroll") for (int nt = 0; nt < 4; ++nt)                   \
        acc[mt][nt] = __builtin_amdgcn_mfma_f32_16x16x32_f16(fb[nt], fa[mt], acc[mt][nt], 0, 0, 0); \
  }
  LDF(a0, b0, 0, ko0);
  int st = 0;
  for (int kt = 0; kt < nk; ++kt) {
    const bool more = kt + 2 < nk;
    int st1 = st + 1; if (st1 >= 3) st1 -= 3;
    int st2 = st + 2; if (st2 >= 3) st2 -= 3;
    if (more) ISSUE(kt + 2, st2);
    LDF(a1, b1, st, ko1);
    __builtin_amdgcn_sched_barrier(0);
    MMA(a0, b0);
    __builtin_amdgcn_sched_barrier(0);
    if (more) asm volatile("s_waitcnt vmcnt(6) lgkmcnt(0)" ::: "memory");
    else asm volatile("s_waitcnt vmcnt(0) lgkmcnt(0)" ::: "memory");
    __builtin_amdgcn_s_barrier();
    asm volatile("" ::: "memory");
    if (kt + 1 < nk) LDF(a0, b0, st1, ko0);
    __builtin_amdgcn_sched_barrier(0);
    MMA(a1, b1);
    __builtin_amdgcn_sched_barrier(0);
    st = st1;
  }
#undef LDF
#undef MMA
#undef ISSUE
  if (g.epi == 5) {
    const P& p = *g.pp;
    char* ws = p.ws + opaque_zero();
    const half_t* Y0 = (const half_t*)(ws + OFF_A0);
    const half_t* Y1 = (const half_t*)(ws + OFF_A1);
    const half_t* VVp = (const half_t*)(ws + OFF_VV);
    const float* BN0 = (const float*)(ws + OFF_BN);
    const float* BN1 = BN0 + (size_t)RL * 16;
    half_t* Z1 = (half_t*)(ws + OFF_Z1);
    const int head = (g.col0 >> 6) + wn;
#pragma unroll 1
    for (int mt = 0; mt < 4; ++mt) {
      const int row = g.row0 + wm * 64 + mt * 16 + lr;
      const size_t base = (size_t)row * 1024 + head * 64 + lq * 4;
      float y[4][4], vv[4][4];
      float sm = 0.f;
#pragma unroll
      for (int nt = 0; nt < 4; ++nt) {
        const h4 ya = *(const h4*)(Y0 + base + nt * 16);
        const h4 yb = *(const h4*)(Y1 + base + nt * 16);
        const h4 vh = *(const h4*)(VVp + base + nt * 16);
#pragma unroll
        for (int j = 0; j < 4; ++j) { y[nt][j] = (float)ya[j] + (float)yb[j]; vv[nt][j] = (float)vh[j]; sm += y[nt][j]; }
      }
      sm += bperm(sm, lane ^ 16);
      sm += bperm(sm, lane ^ 32);
      const float mean = sm * (1.f / 64.f);
      float q = 0.f;
#pragma unroll
      for (int nt = 0; nt < 4; ++nt)
#pragma unroll
        for (int j = 0; j < 4; ++j) { const float d = y[nt][j] - mean; q += d * d; }
      q += bperm(q, lane ^ 16);
      q += bperm(q, lane ^ 32);
      const float rstd = rsqrtf(q * (1.f / 64.f) + 64e-5f);
      const float bonus = BN0[(size_t)row * 16 + head] + BN1[(size_t)row * 16 + head];
#pragma unroll
      for (int nt = 0; nt < 4; ++nt) {
        const int ch = head * 64 + nt * 16 + lq * 4;
        const float4 lg = *(const float4*)(p.rw_lng + ch);
        const float4 lb = *(const float4*)(p.rw_lnb + ch);
        const float lgv[4] = {lg.x, lg.y, lg.z, lg.w}, lbv[4] = {lb.x, lb.y, lb.z, lb.w};
        const f4 gv = mt == 0 ? acc[0][nt] : (mt == 1 ? acc[1][nt] : (mt == 2 ? acc[2][nt] : acc[3][nt]));
        h4 o;
#pragma unroll
        for (int j = 0; j < 4; ++j) o[j] = (half_t)(((y[nt][j] - mean) * rstd * lgv[j] + lbv[j] + bonus * vv[nt][j]) * gv[j]);
        *(h4*)(Z1 + base + nt * 16) = o;
      }
    }
    return;
  }
  if (g.epi == 4) {
    half_t* vp = g.C + (size_t)((wm * 8 + wn) * 64) * 64 + lr;
#pragma unroll
    for (int mt = 0; mt < 4; ++mt)
#pragma unroll
      for (int nt = 0; nt < 4; ++nt)
#pragma unroll
        for (int j = 0; j < 4; ++j) vp[(nt * 16 + lq * 4 + j) * 64 + mt * 16] = (half_t)acc[mt][nt][j];
    return;
  }
#pragma unroll
  for (int mt = 0; mt < 4; ++mt) {
    half_t* cp = g.C + (size_t)(wm * 64 + mt * 16 + lr) * g.ldc + wn * 64 + lq * 4;
#pragma unroll
    for (int nt = 0; nt < 4; ++nt) {
      h4 o;
#pragma unroll
      for (int j = 0; j < 4; ++j) {
        float v = acc[mt][nt][j];
        if (g.epi == 1) { v = fmaxf(v, 0.f); v = v * v; }
        o[j] = (half_t)v;
      }
      *(h4*)(cp + nt * 16) = o;
    }
  }
}

__device__ __forceinline__ void gemm_tile4(const GemmTile& g, char* smem) {
  const int tid = tidx(), lane = tid & 63, w = tid >> 6;
  const int wm = w >> 1, wn = w & 1, lr = lane & 15, lq = lane >> 4;
  f4 acc[4][8];
#pragma unroll
  for (int i = 0; i < 4; ++i)
#pragma unroll
    for (int j = 0; j < 8; ++j) acc[i][j] = (f4){0.f, 0.f, 0.f, 0.f};
  const int nk = g.K >> 6;
  const int lrow = lane >> 3, lslot = lane & 7;
  const half_t* Ag[4];
  const half_t* Bg[4];
#pragma unroll
  for (int i = 0; i < 4; ++i) {
    const int row = (w * 4 + i) * 8 + lrow;
    const int so = (lslot ^ ((row >> 1) & 7)) * 8;
    Ag[i] = g.A + (size_t)row * g.lda + so;
    Bg[i] = g.Bt + (size_t)row * g.ldb + so;
  }
  char* aw = smem + (w * 4) * 1024 + lane * 16;
  char* bw = smem + 32768 + (w * 4) * 1024 + lane * 16;
  const int swz = (lr >> 1) & 7;
  const int ko0 = ((0 + lq) ^ swz) * 16, ko1 = ((4 + lq) ^ swz) * 16;
  const char* ar = smem + (wm * 64 + lr) * 128;
  const char* br = smem + 32768 + (wn * 128 + lr) * 128;
#define ISSUE4(kt, st)                                                                                     \
  {                                                                                                        \
    _Pragma("unroll") for (int i = 0; i < 4; ++i)                                                          \
      __builtin_amdgcn_global_load_lds((const unsigned*)(Ag[i] + (kt) * 64), (unsigned*)(aw + (st) * 65536 + i * 1024), 16, 0, 0); \
    _Pragma("unroll") for (int i = 0; i < 4; ++i)                                                          \
      __builtin_amdgcn_global_load_lds((const unsigned*)(Bg[i] + (kt) * 64), (unsigned*)(bw + (st) * 65536 + i * 1024), 16, 0, 0); \
  }
  ISSUE4(0, 0);
  asm volatile("s_waitcnt vmcnt(0)" ::: "memory");
  __builtin_amdgcn_s_barrier();
  asm volatile("" ::: "memory");
  for (int kt = 0; kt < nk; ++kt) {
    const int st = kt & 1;
    if (kt + 1 < nk) ISSUE4(kt + 1, st ^ 1);
    const char* as = ar + st * 65536;
    const char* bs = br + st * 65536;
#pragma unroll
    for (int ks = 0; ks < 2; ++ks) {
      const int ko = ks ? ko1 : ko0;
      h8 a[4], b[8];
#pragma unroll
      for (int i = 0; i < 4; ++i) a[i] = *(const h8*)(as + i * 2048 + ko);
#pragma unroll
      for (int i = 0; i < 8; ++i) b[i] = *(const h8*)(bs + i * 2048 + ko);
#pragma unroll
      for (int mt = 0; mt < 4; ++mt)
#pragma unroll
        for (int nt = 0; nt < 8; ++nt)
          acc[mt][nt] = __builtin_amdgcn_mfma_f32_16x16x32_f16(b[nt], a[mt], acc[mt][nt], 0, 0, 0);
    }
    asm volatile("s_waitcnt vmcnt(0) lgkmcnt(0)" ::: "memory");
    __builtin_amdgcn_s_barrier();
    asm volatile("" ::: "memory");
  }
#undef ISSUE4
  if (g.epi == 4) {
#pragma unroll
    for (int mt = 0; mt < 4; ++mt)
#pragma unroll
      for (int nt = 0; nt < 8; ++nt) {
        half_t* vp = g.C + (size_t)((wm * 8 + wn * 2 + (nt >> 2)) * 64) * 64 + lr;
#pragma unroll
        for (int j = 0; j < 4; ++j) vp[((nt & 3) * 16 + lq * 4 + j) * 64 + mt * 16] = (half_t)acc[mt][nt][j];
      }
    return;
  }
#pragma unroll
  for (int mt = 0; mt < 4; ++mt) {
    half_t* cp = g.C + (size_t)(wm * 64 + mt * 16 + lr) * g.ldc + wn * 128 + lq * 4;
#pragma unroll
    for (int nt = 0; nt < 8; ++nt) {
      h4 o;
#pragma unroll
      for (int j = 0; j < 4; ++j) {
        float v = acc[mt][nt][j];
        if (g.epi == 1) { v = fmaxf(v, 0.f); v = v * v; }
        o[j] = (half_t)v;
      }
      *(h4*)(cp + nt * 16) = o;
    }
  }
}

__device__ __forceinline__ int p8_lds_byte(int r, int c) {
  const int st = (r >> 4) * 2 + (c >> 5), rr = r & 15, cc = c & 31, ob = rr * 64 + cc * 2;
  return st * 1024 + (ob ^ (((ob >> 9) & 1) << 5));
}
__device__ __forceinline__ void p8_stage_rc(int b, int& R, int& C) {
  const int st = b / 1024, sb = b % 1024, swz = sb ^ (((sb >> 9) & 1) << 5);
  R = (st >> 1) * 16 + swz / 64;
  C = (st & 1) * 32 + (swz % 64) / 2;
}
__device__ __forceinline__ void gemm_tile8(const GemmTile& g, char* smem) {
  constexpr int HT = 128 * 64;
  half_t* shm = (half_t*)smem;
  const int tid = tidx();
  const int wid = tid >> 6, lane = tid & 63, wr = wid >> 2, wc = wid & 3, fr = lane & 15, fq = lane >> 4;
  const half_t* A = g.A;
  const half_t* Bt = g.Bt;
  const int lda = g.lda, ldb = g.lda;
#define P8_SA(b, h) (shm + ((b) * 2 + (h)) * HT)
#define P8_SB(b, h) (shm + (4 + (b) * 2 + (h)) * HT)
  int sr0, sc0, sr1, sc1;
  p8_stage_rc(tid * 16, sr0, sc0);
  p8_stage_rc(tid * 16 + 8192, sr1, sc1);
  const int ao0 = sr0 * lda + sc0, ao1 = sr1 * lda + sc1;
#define bo0 ao0
#define bo1 ao1
#define P8_STAGE_A(Pp, br, kt)                                                                                   \
  {                                                                                                              \
    const half_t* gb_ = A + (size_t)(br) * lda + (size_t)(kt) * 64;                                              \
    __builtin_amdgcn_global_load_lds((const unsigned*)(gb_ + ao0), (unsigned*)((char*)(Pp) + tid * 16), 16, 0, 0);        \
    __builtin_amdgcn_global_load_lds((const unsigned*)(gb_ + ao1), (unsigned*)((char*)(Pp) + tid * 16 + 8192), 16, 0, 0); \
  }
#define P8_STAGE_B(Pp, br, kt)                                                                                   \
  {                                                                                                              \
    const half_t* gb_ = Bt + (size_t)(br) * ldb + (size_t)(kt) * 64;                                             \
    __builtin_amdgcn_global_load_lds((const unsigned*)(gb_ + bo0), (unsigned*)((char*)(Pp) + tid * 16), 16, 0, 0);        \
    __builtin_amdgcn_global_load_lds((const unsigned*)(gb_ + bo1), (unsigned*)((char*)(Pp) + tid * 16 + 8192), 16, 0, 0); \
  }
  const char* abase = smem + p8_lds_byte(wr * 64 + fr, fq * 8);
  const char* bbase = smem + 4 * HT * 2 + p8_lds_byte(wc * 32 + fr, fq * 8);
#define P8_LDA(dst, b, h)                                                                                        \
  _Pragma("unroll") for (int m = 0; m < 4; ++m) _Pragma("unroll") for (int k = 0; k < 2; ++k)                    \
      dst[m][k] = *(const h8*)(abase + ((b) * 2 + (h)) * (HT * 2) + (m * 2 + k) * 1024);
#define P8_LDB(dst, b, h)                                                                                        \
  _Pragma("unroll") for (int n = 0; n < 2; ++n) _Pragma("unroll") for (int k = 0; k < 2; ++k)                    \
      dst[n][k] = *(const h8*)(bbase + ((b) * 2 + (h)) * (HT * 2) + (n * 2 + k) * 1024);
#define P8_MMA(ai, bj, Af, Bf)                                                                                   \
  {                                                                                                              \
    __builtin_amdgcn_s_setprio(1);                                                                               \
    _Pragma("unroll") for (int m = 0; m < 4; ++m) _Pragma("unroll") for (int n = 0; n < 2; ++n)                  \
        _Pragma("unroll") for (int k = 0; k < 2; ++k)                                                            \
            acc[ai][bj][m][n] = __builtin_amdgcn_mfma_f32_16x16x32_f16(Bf[n][k], Af[m][k], acc[ai][bj][m][n], 0, 0, 0); \
    __builtin_amdgcn_s_setprio(0);                                                                               \
  }
#define P8_WAIT_V(n) asm volatile("s_waitcnt vmcnt(" #n ")" ::: "memory")
#define P8_WAIT_L(n) asm volatile("s_waitcnt lgkmcnt(" #n ")" ::: "memory")
#define P8_BAR __builtin_amdgcn_s_barrier()
#define P8_SCHED __builtin_amdgcn_sched_barrier(0)

  f4 acc[2][2][4][2];
#pragma unroll
  for (int i0 = 0; i0 < 2; ++i0)
#pragma unroll
    for (int i1 = 0; i1 < 2; ++i1)
#pragma unroll
      for (int i2 = 0; i2 < 4; ++i2)
#pragma unroll
        for (int i3 = 0; i3 < 2; ++i3) acc[i0][i1][i2][i3] = (f4){0.f, 0.f, 0.f, 0.f};
  h8 At[4][2], B0[2][2], B1[2][2];
  const int nt = g.K >> 6;
  P8_STAGE_B(P8_SB(0, 0), 0, 0); P8_STAGE_A(P8_SA(0, 0), 0, 0);
  P8_STAGE_B(P8_SB(0, 1), 128, 0); P8_STAGE_A(P8_SA(0, 1), 128, 0);
  if (wr == 1) P8_BAR;
  P8_WAIT_V(4); P8_BAR;
  P8_STAGE_B(P8_SB(1, 0), 0, 1); P8_STAGE_A(P8_SA(1, 0), 0, 1); P8_STAGE_B(P8_SB(1, 1), 128, 1);
  P8_WAIT_V(6); P8_BAR;
  for (int t = 0; t < nt - 2; t += 2) {
    P8_LDB(B0, 0, 0); P8_SCHED; P8_LDA(At, 0, 0); P8_STAGE_A(P8_SA(1, 1), 128, t + 1);
    P8_WAIT_L(8); P8_BAR; P8_WAIT_L(0); P8_MMA(0, 0, At, B0); P8_BAR; P8_SCHED;
    P8_LDB(B1, 0, 1); P8_STAGE_B(P8_SB(0, 0), 0, t + 2);
    P8_BAR; P8_WAIT_L(0); P8_MMA(0, 1, At, B1); P8_BAR;
    P8_LDA(At, 0, 1); P8_STAGE_A(P8_SA(0, 0), 0, t + 2);
    P8_BAR; P8_WAIT_L(0); P8_MMA(1, 0, At, B0); P8_BAR; P8_SCHED;
    P8_STAGE_B(P8_SB(0, 1), 128, t + 2);
    P8_WAIT_V(6); P8_BAR; P8_MMA(1, 1, At, B1); P8_BAR;
    P8_LDB(B0, 1, 0); P8_SCHED; P8_LDA(At, 1, 0); P8_STAGE_A(P8_SA(0, 1), 128, t + 2);
    P8_WAIT_L(8); P8_BAR; P8_WAIT_L(0); P8_MMA(0, 0, At, B0); P8_BAR; P8_SCHED;
    P8_LDB(B1, 1, 1); P8_STAGE_B(P8_SB(1, 0), 0, t + 3);
    P8_BAR; P8_WAIT_L(0); P8_MMA(0, 1, At, B1); P8_BAR;
    P8_LDA(At, 1, 1); P8_STAGE_A(P8_SA(1, 0), 0, t + 3);
    P8_BAR; P8_WAIT_L(0); P8_MMA(1, 0, At, B0); P8_BAR; P8_SCHED;
    P8_STAGE_B(P8_SB(1, 1), 128, t + 3);
    P8_WAIT_V(6); P8_BAR; P8_MMA(1, 1, At, B1); P8_BAR;
  }
  {
    P8_LDB(B0, 0, 0); P8_LDA(At, 0, 0); P8_STAGE_A(P8_SA(1, 1), 128, nt - 1);
    P8_BAR; P8_WAIT_L(0); P8_MMA(0, 0, At, B0); P8_BAR;
    P8_LDB(B1, 0, 1); P8_BAR; P8_WAIT_L(0); P8_MMA(0, 1, At, B1); P8_BAR;
    P8_LDA(At, 0, 1); P8_WAIT_V(4); P8_BAR; P8_WAIT_L(0); P8_MMA(1, 0, At, B0); P8_MMA(1, 1, At, B1); P8_BAR;
  }
  {
    P8_LDB(B0, 1, 0); P8_LDA(At, 1, 0); P8_WAIT_V(2); P8_BAR; P8_WAIT_L(0); P8_MMA(0, 0, At, B0); P8_BAR;
    P8_LDB(B1, 1, 1); P8_WAIT_V(0); P8_BAR; P8_WAIT_L(0); P8_MMA(0, 1, At, B1); P8_BAR;
    P8_LDA(At, 1, 1); P8_BAR; P8_WAIT_L(0); P8_MMA(1, 0, At, B0); P8_MMA(1, 1, At, B1); P8_BAR;
  }
  if (wr == 0) P8_BAR;
  asm volatile("" ::: "memory");
#pragma unroll
  for (int ai = 0; ai < 2; ++ai)
#pragma unroll
    for (int m = 0; m < 4; ++m) {
      const int row = ai * 128 + wr * 64 + m * 16 + fr;
#pragma unroll
      for (int bj = 0; bj < 2; ++bj)
#pragma unroll
        for (int n = 0; n < 2; ++n) {
          const int col = bj * 128 + wc * 32 + n * 16 + fq * 4;
          if (g.epi == 4) {
            half_t* vp = g.C + (size_t)(((row >> 6) * 8 + (col >> 6)) * 64 + (col & 63)) * 64 + (row & 63);
#pragma unroll
            for (int j = 0; j < 4; ++j) vp[j * 64] = (half_t)acc[ai][bj][m][n][j];
          } else {
            h4 o;
#pragma unroll
            for (int j = 0; j < 4; ++j) {
              float v = acc[ai][bj][m][n][j];
              if (g.epi == 1) { v = fmaxf(v, 0.f); v = v * v; }
              o[j] = (half_t)v;
            }
            *(h4*)(g.C + (size_t)row * g.ldc + col) = o;
          }
        }
    }
#undef bo0
#undef bo1
#undef P8_SA
#undef P8_SB
#undef P8_STAGE_A
#undef P8_STAGE_B
#undef P8_LDA
#undef P8_LDB
#undef P8_MMA
#undef P8_WAIT_V
#undef P8_WAIT_L
#undef P8_BAR
#undef P8_SCHED
}

__device__ __forceinline__ void gemm_phase(const P& p, const half_t* A, int lda, const half_t* Bt, int ldb, int K, half_t* C, int ldc,
                                           int epi, int nMt, int nNt, int feat, char* smem) {
  char* ws = (p.ws + opaque_zero());
  if (feat == 4) nMt = 128;
  const int nbig = nMt * nNt;
  const int total = nbig + (feat == 4 ? 64 : 0), G = gridDim.x, per_xcd = G >> 3;
  for (int t0 = bidx(); t0 < total + G; t0 += G) {
    const int rnd = t0 / G, bb = t0 - rnd * G;
    const int t = ((G & 7) == 0) ? rnd * G + (bb & 7) * per_xcd + (bb >> 3) : t0;
    if (t >= total) continue;
    const bool small = t >= nbig;
    const int gsz = 8 * nNt, first = (t / gsz) * 8, gm = min(nMt - first, 8);
    const int mt = small ? 128 + ((t - nbig) & 7) : first + (t % gsz) % gm;
    const int nt = small ? (t - nbig) >> 3 : (t % gsz) / gm;
    GemmTile g;
    g.A = A + (size_t)mt * 256 * lda; g.A2 = nullptr; g.mu = nullptr; g.lda = lda;
    const int tw = (feat >= 2 && !small) ? 256 : 128;
    g.Bt = Bt + (size_t)nt * tw * ldb; g.ldb = ldb; g.K = K;
    g.C = C + (size_t)mt * 256 * ldc + nt * tw; g.ldc = ldc; g.epi = epi;
    g.row0 = mt * 256; g.col0 = nt * tw; g.pp = &p;
    if (feat == 2 && nt >= 6) {
      g.epi = 4;
      g.C = (half_t*)(ws + OFF_A1) + ((size_t)(mt * 4) * 8 + (nt - 6) * 4) * 4096;
    }
    if (feat == 1) {
      g.A2 = (const half_t*)(ws + OFF_A1) + (size_t)mt * 256 * 1024;
      const int grp = nt >> 3, sub = nt & 7;
      int mixi;
      if (grp < 3) {
        mixi = grp == 0 ? 0 : (grp == 1 ? 2 : 3);
        g.Bt = (const half_t*)(ws + (grp == 0 ? OFF_WR : (grp == 1 ? OFF_WK : OFF_WV))) + (size_t)sub * 128 * 1024;
        g.C = (half_t*)(ws + (grp == 0 ? OFF_RR : (grp == 1 ? OFF_KK : OFF_VV))) + (size_t)mt * 256 * 1024 + sub * 128;
      } else {
        mixi = sub == 0 ? 1 : (sub == 1 ? 4 : 5);
        g.Bt = (const half_t*)(ws + OFF_L1) + (size_t)sub * 128 * 1024;
        g.C = (half_t*)(ws + OFF_L) + (size_t)mt * 256 * 384 + sub * 128;
        g.ldc = 384;
        g.epi = sub == 0 ? 2 : (sub == 1 ? 0 : 3);
      }
      g.mu = p.rw_mu + mixi * 1024;
    }
    if (feat == 1) gemm_tile<true>(g, smem); else if (feat >= 2 && !small) gemm_tile8(g, smem); else gemm_tile3(g, smem);
  }
}

__device__ void xpose_seg(const float* src, int ldsrc, int K, int N, half_t* dst, int lddst, int koff, int& base,
                          char* smem) {
  float* ts = (float*)smem;
  const int tid = tidx(), G = gridDim.x;
  const int tkn = K >> 6, tnn = N >> 6, cnt = tkn * tnn;
  int t0 = ((int)bidx() - (base % G) + G) % G;
  for (int t = t0; t < cnt; t += G) {
    const int k0 = (t % tkn) * 64, n0 = (t / tkn) * 64;
#pragma unroll
    for (int i = 0; i < 2; ++i) {
      const int c = tid + 512 * i, r = c >> 4, c4 = (c & 15) * 4;
      const float4 v = *(const float4*)(src + (size_t)(k0 + r) * ldsrc + n0 + c4);
      float* d = ts + r * 65 + c4;
      d[0] = v.x; d[1] = v.y; d[2] = v.z; d[3] = v.w;
    }
    __syncthreads();
    {
      const int n = tid >> 3, kc = (tid & 7) * 8;
      h8 o;
#pragma unroll
      for (int i = 0; i < 8; ++i) o[i] = (half_t)ts[(kc + i) * 65 + n];
      *(h8*)(dst + (size_t)(n0 + n) * lddst + koff + k0 + kc) = o;
    }
    __syncthreads();
  }
  base += cnt;
}

__device__ void phase_prep(const P& p, char* smem) {
  const int tid = tidx();
  char* ws = (p.ws + opaque_zero());
  float* MOD = (float*)(ws + OFF_MOD);
  if (bidx() < 192 || gridDim.x < 256) {
    float* sl = (float*)smem;
    for (int i = tid; i < 9216; i += 512) {
      const int b = i >> 10, k = i & 1023;
      const float cv = b < 8 ? p.c[b * 1024 + k] : p.c_ctx[k];
      sl[i] = cv / (1.f + __expf(-cv));
    }
    __syncthreads();
    float* red = sl + 9216;
    for (int item = bidx(); item < 192; item += gridDim.x) {
      const int l = item / 96, n0 = (item % 96) * 64, cn = tid & 63, kq = tid >> 6;
      float acc[9];
#pragma unroll
      for (int b = 0; b < 9; ++b) acc[b] = 0.f;
      const float* wp = p.ada_w + (size_t)l * 1024 * 6144 + n0 + cn;
#pragma unroll 4
      for (int k = kq * 128; k < kq * 128 + 128; ++k) {
        const float wv = wp[(size_t)k * 6144];
#pragma unroll
        for (int b = 0; b < 9; ++b) acc[b] += sl[b * 1024 + k] * wv;
      }
#pragma unroll
      for (int b = 0; b < 9; ++b) red[(kq * 9 + b) * 64 + cn] = acc[b];
      __syncthreads();
      for (int i = tid; i < 576; i += 512) {
        const int b = i >> 6, c = i & 63;
        float s = 0.f;
#pragma unroll
        for (int q = 0; q < 8; ++q) s += red[(q * 9 + b) * 64 + c];
        MOD[(size_t)(l * 9 + b) * 6144 + n0 + c] = s + p.ada_b[l * 6144 + n0 + c];
      }
      __syncthreads();
    }
  }
  for (int it = bidx(); it < 256; it += gridDim.x) {
    if (it < 192) continue;
    const int fi = it - 192, gi = fi >> 4, n0 = (fi & 15) * 64, n = tid & 63, ig = tid >> 6;
    float acc[16];
#pragma unroll
    for (int i = 0; i < 16; ++i) acc[i] = 0.f;
    for (int j = 0; j < 128; ++j) {
      const float wv = p.ev_w_out[(size_t)(gi * 128 + j) * 1024 + n0 + n] * p.ev_pool_scale[gi * 128 + j];
      const float* pw = p.ev_pool_w + ((size_t)gi * 128 + ig * 16) * 128 + j;
#pragma unroll
      for (int i = 0; i < 16; ++i) acc[i] += pw[i * 128] * wv;
    }
    h8 o0, o1;
#pragma unroll
    for (int i = 0; i < 8; ++i) { o0[i] = (half_t)acc[i]; o1[i] = (half_t)acc[8 + i]; }
    half_t* d = (half_t*)(ws + OFF_WOUT) + (size_t)(n0 + n) * 1024 + gi * 128 + ig * 16;
    *(h8*)d = o0;
    *(h8*)(d + 8) = o1;
  }
  __syncthreads();
  int base = 0;
  xpose_seg(p.ev_w_in, 2048, 1024, 2048, (half_t*)(ws + OFF_WIN), 1024, 0, base, smem);
  xpose_seg(p.ev_w_out + 512 * 1024, 1024, 512, 1024, (half_t*)(ws + OFF_WOUT), 1024, 512, base, smem);
  for (int l = 0; l < 2; ++l) {
    xpose_seg(p.mlp_w1 + (size_t)l * 1024 * 4096, 4096, 1024, 4096, (half_t*)(ws + OFF_M1 + l * 8 * MIB), 1024, 0, base, smem);
    xpose_seg(p.mlp_w2 + (size_t)l * 1024 * 4096, 1024, 4096, 1024, (half_t*)(ws + OFF_M2 + l * 8 * MIB), 4096, 0, base, smem);
  }
  xpose_seg(p.rw_wr, 1024, 1024, 1024, (half_t*)(ws + OFF_WR), 1024, 0, base, smem);
  xpose_seg(p.rw_wk, 1024, 1024, 1024, (half_t*)(ws + OFF_WK), 1024, 0, base, smem);
  xpose_seg(p.rw_wv, 1024, 1024, 1024, (half_t*)(ws + OFF_WV), 1024, 0, base, smem);
  xpose_seg(p.rw_wo, 1024, 1024, 1024, (half_t*)(ws + OFF_WO), 1024, 0, base, smem);
  for (int d = 0; d < 2; ++d) {
    xpose_seg(p.rw_w1 + (size_t)d * 1024 * 64, 64, 1024, 64, (half_t*)(ws + OFF_L1) + (size_t)(d * 64) * 1024, 1024, 0, base, smem);
    xpose_seg(p.rw_a1 + (size_t)d * 1024 * 64, 64, 1024, 64, (half_t*)(ws + OFF_L1) + (size_t)(128 + d * 64) * 1024, 1024, 0, base, smem);
    xpose_seg(p.rw_w2 + (size_t)d * 64 * 1024, 1024, 64, 1024, (half_t*)(ws + OFF_W2) + (size_t)d * 1024 * 64, 64, 0, base, smem);
    xpose_seg(p.rw_a2 + (size_t)d * 64 * 1024, 1024, 64, 1024, (half_t*)(ws + OFF_A2) + (size_t)d * 1024 * 64, 64, 0, base, smem);
  }
  xpose_seg(p.rw_g1, 128, 1024, 128, (half_t*)(ws + OFF_L1) + (size_t)256 * 1024, 1024, 0, base, smem);
  xpose_seg(p.rw_g2, 1024, 128, 1024, (half_t*)(ws + OFF_G2), 128, 0, base, smem);
}

__device__ void phase_rowwise(const P& p, int mode) {
  const int lane = tidx() & 63;
  const int gw = bidx() * 8 + (tidx() >> 6), nw = gridDim.x * 8;
  char* ws = (p.ws + opaque_zero());
  const float* MOD = (const float*)(ws + OFF_MOD);
  float* XC = (float*)(ws + OFF_XC);
  half_t* H = (half_t*)(ws + OFF_A0);
  const half_t* Y = (const half_t*)(ws + OFF_A1);
  const int nrows = (mode >= 3) ? RL : RT;
  const int per = (nrows + nw - 1) / nw;
  const int r0 = gw * per, r1 = min(r0 + per, nrows);
  if (r0 >= r1) return;
  const bool hasY = mode != 0, hasH = mode != 4;
  const float EPS = opaque_f(1e-6f);
  const int lyr = (mode <= 1) ? 0 : ((mode == 2) ? 0 : 1);
  const int gyi = (mode == 1) ? 1 : (mode == 2 ? 3 : (mode == 3 ? 5 : 7));
  const int gti = (mode == 1) ? 2 : (mode == 2 ? 5 : (mode == 3 ? 2 : 5));
  const int hl = (mode <= 1) ? 0 : 1;
  const int ghi = (mode == 0) ? 0 : (mode == 1 ? 2 : (mode == 2 ? 4 : 6));
  const int shi = (mode == 0 || mode == 2) ? 0 : 3;
  auto xsrc = [&](int row) -> const float* {
    if (mode <= 1) return row < RL ? p.x + (size_t)row * 1024 : p.ctx + (size_t)(row - RL) * 1024;
    return row < RL ? p.out + (size_t)row * 1024 : XC + (size_t)(row - RL) * 1024;
  };
  auto xdst = [&](int row) -> float* { return row < RL ? p.out + (size_t)row * 1024 : XC + (size_t)(row - RL) * 1024; };
  float4 gy[4], gt[4], gh[4], s1[4], s2[4];
  int cur_mi = -1;
  float4 nx[4];
  h4 ny[4];
  {
    const float* xs = xsrc(r0);
#pragma unroll
    for (int i = 0; i < 4; ++i) nx[i] = *(const float4*)(xs + i * 256 + lane * 4);
    if (hasY) {
#pragma unroll
      for (int i = 0; i < 4; ++i) ny[i] = *(const h4*)(Y + (size_t)r0 * 1024 + i * 256 + lane * 4);
    }
  }
  for (int row = r0; row < r1; ++row) {
    float xv[4][4];
    h4 yh[4];
#pragma unroll
    for (int i = 0; i < 4; ++i) { xv[i][0] = nx[i].x; xv[i][1] = nx[i].y; xv[i][2] = nx[i].z; xv[i][3] = nx[i].w; yh[i] = ny[i]; }
    if (row + 1 < r1) {
      const float* xs = xsrc(row + 1);
#pragma unroll
      for (int i = 0; i < 4; ++i) nx[i] = *(const float4*)(xs + i * 256 + lane * 4);
      if (hasY) {
#pragma unroll
        for (int i = 0; i < 4; ++i) ny[i] = *(const h4*)(Y + (size_t)(row + 1) * 1024 + i * 256 + lane * 4);
      }
    }
    const int mi = row < RL ? (row >> 12) : 8;
    if (mi != cur_mi) {
      cur_mi = mi;
      const float* mg = MOD + (size_t)(lyr * 9 + mi) * 6144;
      const float* mh = MOD + (size_t)(hl * 9 + mi) * 6144;
#pragma unroll
      for (int i = 0; i < 4; ++i) {
        const int o = i * 256 + lane * 4;
        if (hasY) { gy[i] = *(const float4*)(p.norm_g + gyi * 1024 + o); gt[i] = *(const float4*)(mg + gti * 1024 + o); }
        if (hasH) {
          gh[i] = *(const float4*)(p.norm_g + ghi * 1024 + o);
          s1[i] = *(const float4*)(mh + shi * 1024 + o);
          s2[i] = *(const float4*)(mh + (shi + 1) * 1024 + o);
        }
      }
    }
    if (hasY) {
      float yv[4][4];
      float ss = 0.f;
#pragma unroll
      for (int i = 0; i < 4; ++i)
#pragma unroll
        for (int k = 0; k < 4; ++k) { yv[i][k] = (float)yh[i][k]; ss += yv[i][k] * yv[i][k]; }
      ss = wave_sum(ss, lane);
      const float rs = rsqrtf(ss * (1.f / 1024.f) + EPS);
      float* xo = xdst(row);
#pragma unroll
      for (int i = 0; i < 4; ++i) {
        xv[i][0] += gt[i].x * (yv[i][0] * rs * gy[i].x);
        xv[i][1] += gt[i].y * (yv[i][1] * rs * gy[i].y);
        xv[i][2] += gt[i].z * (yv[i][2] * rs * gy[i].z);
        xv[i][3] += gt[i].w * (yv[i][3] * rs * gy[i].w);
        *(float4*)(xo + i * 256 + lane * 4) = make_float4(xv[i][0], xv[i][1], xv[i][2], xv[i][3]);
      }
    }
    if (hasH) {
      float ss = 0.f;
#pragma unroll
      for (int i = 0; i < 4; ++i)
#pragma unroll
        for (int k = 0; k < 4; ++k) ss += xv[i][k] * xv[i][k];
      ss = wave_sum(ss, lane);
      const float rs = rsqrtf(ss * (1.f / 1024.f) + EPS);
      half_t* ho = H + (size_t)row * 1024;
#pragma unroll
      for (int i = 0; i < 4; ++i) {
        h4 o;
        o[0] = (half_t)(xv[i][0] * rs * gh[i].x * (1.f + s2[i].x) + s1[i].x);
        o[1] = (half_t)(xv[i][1] * rs * gh[i].y * (1.f + s2[i].y) + s1[i].y);
        o[2] = (half_t)(xv[i][2] * rs * gh[i].z * (1.f + s2[i].z) + s1[i].z);
        o[3] = (half_t)(xv[i][3] * rs * gh[i].w * (1.f + s2[i].w) + s1[i].w);
        *(h4*)(ho + i * 256 + lane * 4) = o;
      }
    }
  }
}

__device__ __forceinline__ int clampi(int v, int lo, int hi) { return v < lo ? lo : (v > hi ? hi : v); }

__device__ void attn_item(const P& p, int item, char* smem) {
  half_t* Ks = (half_t*)smem;
  half_t* Vt = Ks + 2 * 64 * 72;
  float* rpbs = (float*)(smem + 36864);
  const int tid = tidx(), lane = tid & 63, w = tid >> 6, lr = lane & 15, lq = lane >> 4;
  const half_t* U = (const half_t*)((p.ws + opaque_zero()) + OFF_U);
  half_t* Z = (half_t*)((p.ws + opaque_zero()) + OFF_Z);
  const bool isctx = item >= 2048;
  int b, h, qrow, nlat = 0, start0 = 0, my_r = 0, my_start = 0, cw = 0, cs = 0, qcol = 0;
  if (!isctx) {
    b = item >> 8; h = (item >> 5) & 7;
    const int r0 = (item & 31) * 2;
    my_r = r0 + (w >> 2);
    const int cgp = w & 3;
    qcol = cgp * 16 + lr;
    qrow = b * 4096 + my_r * 64 + qcol;
    start0 = clampi(r0 - 4, 0, 56);
    const int start1 = clampi(r0 + 1 - 4, 0, 56);
    nlat = start1 + 8 - start0;
    my_start = clampi(my_r - 4, 0, 56);
    cw = clampi(cgp * 16 - 8, 0, 32);
    cs = clampi(qcol - 8, 0, 48);
  } else {
    const int it = item - 2048;
    b = it >> 4; h = (it >> 1) & 7;
    qrow = RL + b * 256 + (it & 1) * 128 + w * 16 + lr;
  }
  const int ntiles = nlat + 4;
  h8 qf[2];
#pragma unroll
  for (int ks = 0; ks < 2; ++ks) {
    h8 t = *(const h8*)(U + (size_t)qrow * 2048 + 512 + h * 64 + ks * 32 + lq * 8);
#pragma unroll
    for (int i = 0; i < 8; ++i) t[i] = t[i] * (half_t)0.125f;
    qf[ks] = t;
  }
  if (!isctx)
    for (int i = tid; i < 465; i += 512) rpbs[i] = p.ev_rpb[h * 465 + i];

  const int skey = tid >> 3, sd = (tid & 7) * 8;
  uint4 kA, vA, kB, vB;
  auto tile_row0 = [&](int i) -> int { return i < nlat ? b * 4096 + (start0 + i) * 64 : RL + b * 256 + (i - nlat) * 64; };
  const half_t* VTg = (const half_t*)((p.ws + opaque_zero()) + OFF_A1);
#define AT_GLOAD(kr, vr, i)                                                                            \
  {                                                                                                    \
    const int r0t = tile_row0(i);                                                                      \
    kr = *(const uint4*)(U + (size_t)(r0t + skey) * 2048 + 1024 + h * 64 + sd);                        \
    vr = *(const uint4*)(VTg + ((size_t)(r0t >> 6) * 8 + h) * 4096 + skey * 64 + sd);                  \
  }
#define AT_SSTORE(kr, vr, buf)                                                                         \
  {                                                                                                    \
    *(uint4*)(Ks + (buf) * 4608 + skey * 72 + sd) = kr;                                                \
    *(uint4*)(Vt + (buf) * 4608 + skey * 72 + sd) = vr;                                                \
  }
  f4 o[4];
#pragma unroll
  for (int i = 0; i < 4; ++i) o[i] = (f4){0.f, 0.f, 0.f, 0.f};
  const float NEG = opaque_f(-1e30f);
  float m = NEG, l = 0.f;

  AT_GLOAD(kA, vA, 0);
  AT_SSTORE(kA, vA, 0);
  AT_GLOAD(kA, vA, 1);
  AT_GLOAD(kB, vB, 2);
  __syncthreads();
  for (int i = 0; i < ntiles; ++i) {
    const int buf = i & 1;
    const bool lt = i < nlat;
    const int kr_abs = start0 + i;
    const bool active = !lt || (kr_abs >= my_start && kr_abs < my_start + 8);
    if (active) {
      const int npairs = lt ? 1 : 2;
      for (int pi = 0; pi < npairs; ++pi) {
        const int kb = lt ? cw : pi * 32;
        f4 s[2];
#pragma unroll
        for (int st = 0; st < 2; ++st) {
          f4 z = (f4){0.f, 0.f, 0.f, 0.f};
#pragma unroll
          for (int ks = 0; ks < 2; ++ks) {
            const h8 kf = *(const h8*)(Ks + buf * 4608 + (kb + st * 16 + lr) * 72 + ks * 32 + lq * 8);
            z = __builtin_amdgcn_mfma_f32_16x16x32_f16(kf, qf[ks], z, 0, 0, 0);
          }
          s[st] = z;
        }
        float tmax = NEG;
#pragma unroll
        for (int st = 0; st < 2; ++st)
#pragma unroll
          for (int j = 0; j < 4; ++j) {
            float v = s[st][j];
            if (lt) {
              const int kc = kb + st * 16 + lq * 4 + j;
              const bool ok = (kc >= cs) && (kc < cs + 16);
              const int dc = clampi(kc - qcol + 15, 0, 30);
              const int dr = kr_abs - my_r + 7;
              v = ok ? v + rpbs[dr * 31 + dc] : NEG;
            }
            s[st][j] = v;
            tmax = fmaxf(tmax, v);
          }
        tmax = fmaxf(tmax, bperm(tmax, lane ^ 16));
        tmax = fmaxf(tmax, bperm(tmax, lane ^ 32));
        const float mn = fmaxf(m, tmax);
        const float alpha = __expf(m - mn);
        m = mn;
        h8 pb;
        float ps = 0.f;
#pragma unroll
        for (int st = 0; st < 2; ++st)
#pragma unroll
          for (int j = 0; j < 4; ++j) {
            const float e = __expf(s[st][j] - mn);
            ps += e;
            pb[st * 4 + j] = (half_t)e;
          }
        l = l * alpha + ps;
#pragma unroll
        for (int dt = 0; dt < 4; ++dt) {
          o[dt] = o[dt] * alpha;
          const half_t* vp = Vt + buf * 4608 + (dt * 16 + lr) * 72 + kb + lq * 4;
          const h4 v0 = *(const h4*)vp;
          const h4 v1 = *(const h4*)(vp + 16);
          h8 vf;
          vf[0] = v0[0]; vf[1] = v0[1]; vf[2] = v0[2]; vf[3] = v0[3];
          vf[4] = v1[0]; vf[5] = v1[1]; vf[6] = v1[2]; vf[7] = v1[3];
          o[dt] = __builtin_amdgcn_mfma_f32_16x16x32_f16(vf, pb, o[dt], 0, 0, 0);
        }
      }
    }
    if (i + 1 < ntiles) {
      if ((i + 1) & 1) {
        AT_SSTORE(kA, vA, 1);
        if (i + 3 < ntiles) AT_GLOAD(kA, vA, i + 3);
      } else {
        AT_SSTORE(kB, vB, 0);
        if (i + 3 < ntiles) AT_GLOAD(kB, vB, i + 3);
      }
    }
    __syncthreads();
  }
#undef AT_GLOAD
#undef AT_SSTORE
  l += bperm(l, lane ^ 16);
  l += bperm(l, lane ^ 32);
  const float inv = 1.f / l;
#pragma unroll
  for (int dt = 0; dt < 4; ++dt) {
    h4 ov;
#pragma unroll
    for (int j = 0; j < 4; ++j) ov[j] = (half_t)(o[dt][j] * inv);
    *(h4*)(Z + (size_t)qrow * 1024 + 512 + h * 64 + dt * 16 + lq * 4) = ov;
  }
}

template <int HW>
__device__ __forceinline__ void pool_rows(const float (&pre)[4][25], int tl0, int L, half_t* zp) {
#pragma unroll
  for (int r = 0; r < 8; ++r) {
    const int tl = tl0 + r;
    const int lo = max(tl - HW, 0), hi = min(tl + HW, L);
    const float inv = 1.f / (float)(hi - lo);
    h4 o;
#pragma unroll
    for (int c = 0; c < 4; ++c) {
      const float sum = pre[c][8 + r + HW] - pre[c][8 + r - HW];
      const float cur = pre[c][8 + r + 1] - pre[c][8 + r];
      o[c] = (half_t)(sum * inv - cur);
    }
    *(h4*)(zp + (size_t)r * 1024) = o;
  }
}

__device__ void pool_item(const P& p, int item) {
  const half_t* U = (const half_t*)((p.ws + opaque_zero()) + OFF_U);
  half_t* Z = (half_t*)((p.ws + opaque_zero()) + OFF_Z);
  const int tid = tidx();
  const int c4 = (tid & 127) * 4, gi = c4 >> 7;
  const int row0 = item * 32 + (tid >> 7) * 8;
  int s0, L;
  if (row0 < RL) { s0 = row0 & ~4095; L = 4096; } else { s0 = RL + ((row0 - RL) & ~255); L = 256; }
  const int tl0 = row0 - s0;
  float pre[4][25];
#pragma unroll
  for (int c = 0; c < 4; ++c) pre[c][0] = 0.f;
#pragma unroll
  for (int i = 0; i < 24; ++i) {
    const int tl = tl0 - 8 + i;
    h4 v;
    v[0] = (half_t)0.f; v[1] = (half_t)0.f; v[2] = (half_t)0.f; v[3] = (half_t)0.f;
    if (tl >= 0 && tl < L) v = *(const h4*)(U + (size_t)(s0 + tl) * 2048 + c4);
#pragma unroll
    for (int c = 0; c < 4; ++c) pre[c][i + 1] = (float)v[c];
  }
#pragma unroll
  for (int i = 0; i < 24; ++i)
#pragma unroll
    for (int c = 0; c < 4; ++c) pre[c][i + 1] += pre[c][i];
  half_t* zp = Z + (size_t)row0 * 1024 + c4;
  if (gi == 0) pool_rows<1>(pre, tl0, L, zp);
  else if (gi == 1) pool_rows<2>(pre, tl0, L, zp);
  else if (gi == 2) pool_rows<4>(pre, tl0, L, zp);
  else pool_rows<8>(pre, tl0, L, zp);
}

__device__ void phase_shift(const P& p) {
  const half_t* H = (const half_t*)((p.ws + opaque_zero()) + OFF_A0);
  half_t* XX = (half_t*)((p.ws + opaque_zero()) + OFF_A1);
  const size_t total = (size_t)RT * 128;
  for (size_t idx = (size_t)bidx() * 512 + tidx(); idx < total; idx += (size_t)gridDim.x * 512) {
    const int row = (int)(idx >> 7), c = (int)(idx & 127) * 8;
    bool st, en;
    if (row < RL) { st = (row & 4095) == 0; en = (row & 4095) == 4095; }
    else { st = ((row - RL) & 255) == 0; en = ((row - RL) & 255) == 255; }
    const h8 cur = *(const h8*)(H + (size_t)row * 1024 + c);
    h8 pv, nx;
#pragma unroll
    for (int i = 0; i < 8; ++i) { pv[i] = (half_t)0.f; nx[i] = (half_t)0.f; }
    if (!st) pv = *(const h8*)(H + (size_t)(row - 1) * 1024 + c);
    if (!en) nx = *(const h8*)(H + (size_t)(row + 1) * 1024 + c);
    h8 o;
#pragma unroll
    for (int i = 0; i < 8; ++i) o[i] = (half_t)(0.5f * ((float)pv[i] + (float)nx[i]) - (float)cur[i]);
    *(h8*)(XX + (size_t)row * 1024 + c) = o;
  }
}

#define CS_BYTES 13312
#define CS_G 0
#define CS_R 2304
#define CS_AT 4608
#define CS_BT 6656
#define CS_VT 8704
#define CS_M 10752
#define CS_BM 11264
#define CS_CM 11776
#define CS_DM 12288
#define CS_PREF 12800
#define CS_PEND 13056
#define SCR_BASE 106496
#define SCR_BYTES 5632

__device__ void scan_item(const P& p, int item, char* smem) {
  const int tid = tidx(), lane = tid & 63, w = tid >> 6, lr = lane & 15, lq = lane >> 4;
  const int b = item >> 5, h = (item >> 1) & 15, dir = item & 1;
  char* ws = (p.ws + opaque_zero());
  const half_t* RRp = (const half_t*)(ws + OFF_RR);
  const half_t* KKp = (const half_t*)(ws + OFF_KK);
  const half_t* VVp = (const half_t*)(ws + OFF_VV);
  const half_t* Lp = (const half_t*)(ws + OFF_L);
  half_t* Yd = (half_t*)(ws + (dir ? OFF_A1 : OFF_A0));
  float* BN = (float*)(ws + OFF_BN) + (size_t)dir * RL * 16;

  auto grow = [&](int pp) -> int {
    if (pp < 256) return RL + b * 256 + (dir ? 255 - pp : pp);
    const int t = pp - 256;
    return b * 4096 + (dir ? 4095 - t : t);
  };

  auto prep = [&](int c) {
    char* cs = smem + w * CS_BYTES;
    half_t* G_ = (half_t*)(cs + CS_G);
    half_t* R_ = (half_t*)(cs + CS_R);
    half_t* AT = (half_t*)(cs + CS_AT);
    half_t* BT = (half_t*)(cs + CS_BT);
    half_t* VT = (half_t*)(cs + CS_VT);
    half_t* Mm = (half_t*)(cs + CS_M);
    half_t* Bm = (half_t*)(cs + CS_BM);
    half_t* Cm = (half_t*)(cs + CS_CM);
    half_t* Dm = (half_t*)(cs + CS_DM);
    float* Pref = (float*)(cs + CS_PREF);
    float* Pend = (float*)(cs + CS_PEND);
    char* scr = smem + SCR_BASE + w * SCR_BYTES;
    half_t* A_ = (half_t*)scr;
    half_t* B_ = (half_t*)(scr + 2304);
    float* Am = (float*)(scr + 4608);
    const bool lat = c >= 16;
    const int p0 = c * 16;
    const int rowA = grow(p0 + lr);
    const half_t* lp = Lp + (size_t)rowA * 384 + dir * 64 + lq * 8;
    const h8 aw0 = *(const h8*)(lp), aw1 = *(const h8*)(lp + 32);
    const h8 aa0 = *(const h8*)(lp + 128), aa1 = *(const h8*)(lp + 160);
    float ss[4], bp[4];
    int rows[4];
#pragma unroll
    for (int j = 0; j < 4; ++j) { ss[j] = 0.f; bp[j] = 0.f; rows[j] = grow(p0 + lq * 4 + j); }
#pragma unroll 1
    for (int nt = 0; nt < 4; ++nt) {
      const int ch = h * 64 + nt * 16 + lr;
      const float kkc = p.rw_kk[ch];
#pragma unroll
      for (int j = 0; j < 4; ++j) {
        const float k = (float)KKp[(size_t)rows[j] * 1024 + ch];
        ss[j] += (k * kkc) * (k * kkc);
      }
    }
    float inv[4];
#pragma unroll
    for (int j = 0; j < 4; ++j) inv[j] = rsqrtf(fmaxf(red16(ss[j]), 1e-24f));
#pragma unroll 1
    for (int nt = 0; nt < 4; ++nt) {
      const int ch = h * 64 + nt * 16 + lr;
      const half_t* w2p = (const half_t*)(ws + OFF_W2) + (size_t)dir * 65536 + (size_t)ch * 64 + lq * 8;
      const half_t* a2p = (const half_t*)(ws + OFF_A2) + (size_t)dir * 65536 + (size_t)ch * 64 + lq * 8;
      const h8 bw0 = *(const h8*)(w2p), bw1 = *(const h8*)(w2p + 32);
      const h8 ba0 = *(const h8*)(a2p), ba1 = *(const h8*)(a2p + 32);
      const float w0c = p.rw_w0[dir * 1024 + ch], a0c = p.rw_a0[dir * 1024 + ch];
      const float kkc = p.rw_kk[ch], kac = p.rw_ka[ch], rkc = p.rw_rk[ch];
      f4 cwv = (f4){0.f, 0.f, 0.f, 0.f}, cav = (f4){0.f, 0.f, 0.f, 0.f};
      cwv = __builtin_amdgcn_mfma_f32_16x16x32_f16(aw0, bw0, cwv, 0, 0, 0);
      cwv = __builtin_amdgcn_mfma_f32_16x16x32_f16(aw1, bw1, cwv, 0, 0, 0);
      cav = __builtin_amdgcn_mfma_f32_16x16x32_f16(aa0, ba0, cav, 0, 0, 0);
      cav = __builtin_amdgcn_mfma_f32_16x16x32_f16(aa1, ba1, cav, 0, 0, 0);
      h4 vq;
      float ev[4], avv[4], rv[4], kv[4];
#pragma unroll
      for (int j = 0; j < 4; ++j) {
        const size_t gi = (size_t)rows[j] * 1024 + ch;
        kv[j] = (float)KKp[gi];
        vq[j] = VVp[gi];
        rv[j] = lat ? (float)RRp[gi] : 0.f;
        ev[j] = 0.60653066f * sigm(cwv[j] + w0c);
        avv[j] = sigm(cav[j] + a0c);
        bp[j] += rv[j] * kv[j] * rkc * (dir == 0 ? (2.f - 2.f * kac + kac * avv[j]) : kac * avv[j]);
      }
      *(h4*)(VT + (nt * 16 + lr) * 16 + lq * 4) = vq;
      float cum[4];
      cum[0] = ev[0];
      cum[1] = cum[0] + ev[1];
      cum[2] = cum[1] + ev[2];
      cum[3] = cum[2] + ev[3];
      const float t1 = bperm(cum[3], (lane - 16) & 63), t2 = bperm(cum[3], (lane - 32) & 63), t3 = bperm(cum[3], (lane - 48) & 63);
      const float off = (lq >= 1 ? t1 : 0.f) + (lq >= 2 ? t2 : 0.f) + (lq >= 3 ? t3 : 0.f);
#pragma unroll
      for (int j = 0; j < 4; ++j) cum[j] += off;
      const float ref = bperm(cum[3], 16 + lr);
      const float end = bperm(cum[3], 48 + lr);
      if (lq == 0) {
        Pref[nt * 16 + lr] = __expf(-ref);
        Pend[nt * 16 + lr] = __expf(-(end - ref));
      }
      h4 aq, bq;
#pragma unroll
      for (int j = 0; j < 4; ++j) {
        const float d = cum[j] - ref;
        const float E1 = __expf(d), E2 = __expf(-d), E3 = __expf(ev[j] - d);
        const float k = kv[j];
        const float kk = k * kkc * inv[j];
        const float kd = k * (1.f + (avv[j] - 1.f) * kac);
        const half_t ga = (half_t)(kk * E3);
        const half_t ro = (half_t)(rv[j] * E2);
        const half_t al = (half_t)(kk * avv[j] * E1);
        const half_t be = (half_t)(kd * E1);
        const int o = (lq * 4 + j) * 72 + nt * 16 + lr;
        G_[o] = ga; R_[o] = ro; A_[o] = al; B_[o] = be;
        aq[j] = al; bq[j] = be;
      }
      *(h4*)(AT + (nt * 16 + lr) * 16 + lq * 4) = aq;
      *(h4*)(BT + (nt * 16 + lr) * 16 + lq * 4) = bq;
    }
#pragma unroll
    for (int j = 0; j < 4; ++j) {
      const float bpr = red16(bp[j]);
      if (lat && lr == 0) BN[(size_t)rows[j] * 16 + h] = bpr;
    }
    asm volatile("s_waitcnt lgkmcnt(0)" ::: "memory");
    f4 am = (f4){0.f, 0.f, 0.f, 0.f}, bm = am, cm = am, dm = am;
#pragma unroll
    for (int ks = 0; ks < 2; ++ks) {
      const h8 fa = *(const h8*)(A_ + lr * 72 + ks * 32 + lq * 8);
      const h8 fb = *(const h8*)(B_ + lr * 72 + ks * 32 + lq * 8);
      const h8 fg = *(const h8*)(G_ + lr * 72 + ks * 32 + lq * 8);
      const h8 fr = *(const h8*)(R_ + lr * 72 + ks * 32 + lq * 8);
      am = __builtin_amdgcn_mfma_f32_16x16x32_f16(fa, fg, am, 0, 0, 0);
      bm = __builtin_amdgcn_mfma_f32_16x16x32_f16(fb, fg, bm, 0, 0, 0);
      cm = __builtin_amdgcn_mfma_f32_16x16x32_f16(fa, fr, cm, 0, 0, 0);
      dm = __builtin_amdgcn_mfma_f32_16x16x32_f16(fb, fr, dm, 0, 0, 0);
    }
    h4 bmh, cmh, dmh;
#pragma unroll
    for (int j = 0; j < 4; ++j) {
      const int u = lq * 4 + j;
      am[j] = u < lr ? am[j] : 0.f;
      bmh[j] = (half_t)(u < lr ? bm[j] : 0.f);
      cmh[j] = (half_t)(u <= lr ? cm[j] : 0.f);
      dmh[j] = (half_t)(u <= lr ? dm[j] : 0.f);
    }
    *(h4*)(Bm + lr * 16 + lq * 4) = bmh;
    *(h4*)(Cm + lr * 16 + lq * 4) = cmh;
    *(h4*)(Dm + lr * 16 + lq * 4) = dmh;
    *(f4*)(Am + lr * 16 + lq * 4) = am;
    asm volatile("s_waitcnt lgkmcnt(0)" ::: "memory");
    float m[16];
#pragma unroll
    for (int t = 0; t < 16; ++t) {
      float acc = (t == lr) ? 1.f : 0.f;
#pragma unroll
      for (int u4 = 0; u4 < 4; ++u4) {
        if (u4 * 4 < t) {
          const f4 rw = *(const f4*)(Am + t * 16 + u4 * 4);
#pragma unroll
          for (int k = 0; k < 4; ++k)
            if (u4 * 4 + k < t) acc -= rw[k] * m[u4 * 4 + k];
        }
      }
      m[t] = acc;
    }
    if (lq == 0) {
#pragma unroll
      for (int t = 0; t < 16; ++t) Mm[t * 16 + lr] = (half_t)m[t];
    }
  };

  f4 Sacc[4];
#pragma unroll
  for (int jt = 0; jt < 4; ++jt) Sacc[jt] = (f4){0.f, 0.f, 0.f, 0.f};

  for (int sc = 0; sc < 34; ++sc) {
    prep(sc * 8 + w);
    __syncthreads();
    if (w < 4) {
      for (int cc = 0; cc < 8; ++cc) {
        const int c = sc * 8 + cc;
        const char* cs = smem + cc * CS_BYTES;
        const half_t* G_ = (const half_t*)(cs + CS_G);
        const half_t* R_ = (const half_t*)(cs + CS_R);
        const half_t* AT = (const half_t*)(cs + CS_AT);
        const half_t* BT = (const half_t*)(cs + CS_BT);
        const half_t* VT = (const half_t*)(cs + CS_VT);
        const half_t* Mm = (const half_t*)(cs + CS_M);
        const half_t* Bm = (const half_t*)(cs + CS_BM);
        const half_t* Cm = (const half_t*)(cs + CS_CM);
        const half_t* Dm = (const half_t*)(cs + CS_DM);
        const float* Pref = (const float*)(cs + CS_PREF);
        const float* Pend = (const float*)(cs + CS_PEND);
#pragma unroll
        for (int jt = 0; jt < 4; ++jt) Sacc[jt] = Sacc[jt] * *(const f4*)(Pref + jt * 16 + lq * 4);
        h8 bS[2];
#pragma unroll
        for (int ks = 0; ks < 2; ++ks)
#pragma unroll
          for (int k = 0; k < 4; ++k) {
            bS[ks][k] = (half_t)Sacc[2 * ks][k];
            bS[ks][4 + k] = (half_t)Sacc[2 * ks + 1][k];
          }
        const h4 vt = *(const h4*)(VT + (16 * w + lr) * 16 + lq * 4);
        f4 rhs = (f4){0.f, 0.f, 0.f, 0.f};
#pragma unroll
        for (int ks = 0; ks < 2; ++ks) {
          const h4 g0 = *(const h4*)(G_ + lr * 72 + (2 * ks) * 16 + lq * 4);
          const h4 g1 = *(const h4*)(G_ + lr * 72 + (2 * ks + 1) * 16 + lq * 4);
          h8 gf;
          gf[0] = g0[0]; gf[1] = g0[1]; gf[2] = g0[2]; gf[3] = g0[3];
          gf[4] = g1[0]; gf[5] = g1[1]; gf[6] = g1[2]; gf[7] = g1[3];
          rhs = __builtin_amdgcn_mfma_f32_16x16x32_f16(gf, bS[ks], rhs, 0, 0, 0);
        }
        {
          f4 r16 = (f4){0.f, 0.f, 0.f, 0.f};
          r16 = __builtin_amdgcn_mfma_f32_16x16x16f16(*(const h4*)(Bm + lr * 16 + lq * 4), vt, r16, 0, 0, 0);
          rhs = rhs + r16;
        }
        h4 rh;
#pragma unroll
        for (int k = 0; k < 4; ++k) rh[k] = (half_t)rhs[k];
        f4 av = (f4){0.f, 0.f, 0.f, 0.f};
        av = __builtin_amdgcn_mfma_f32_16x16x16f16(*(const h4*)(Mm + lr * 16 + lq * 4), rh, av, 0, 0, 0);
        h4 na;
#pragma unroll
        for (int k = 0; k < 4; ++k) na[k] = (half_t)(-av[k]);
        if (c >= 16) {
          f4 y = (f4){0.f, 0.f, 0.f, 0.f};
#pragma unroll
          for (int ks = 0; ks < 2; ++ks) {
            const h4 g0 = *(const h4*)(R_ + lr * 72 + (2 * ks) * 16 + lq * 4);
            const h4 g1 = *(const h4*)(R_ + lr * 72 + (2 * ks + 1) * 16 + lq * 4);
            h8 gf;
            gf[0] = g0[0]; gf[1] = g0[1]; gf[2] = g0[2]; gf[3] = g0[3];
            gf[4] = g1[0]; gf[5] = g1[1]; gf[6] = g1[2]; gf[7] = g1[3];
            y = __builtin_amdgcn_mfma_f32_16x16x32_f16(gf, bS[ks], y, 0, 0, 0);
          }
          f4 y16 = (f4){0.f, 0.f, 0.f, 0.f};
          y16 = __builtin_amdgcn_mfma_f32_16x16x16f16(*(const h4*)(Cm + lr * 16 + lq * 4), na, y16, 0, 0, 0);
          y16 = __builtin_amdgcn_mfma_f32_16x16x16f16(*(const h4*)(Dm + lr * 16 + lq * 4), vt, y16, 0, 0, 0);
          y = y + y16;
#pragma unroll
          for (int k = 0; k < 4; ++k) {
            const int row = grow(c * 16 + lq * 4 + k);
            Yd[(size_t)row * 1024 + h * 64 + 16 * w + lr] = (half_t)y[k];
          }
        }
#pragma unroll
        for (int jt = 0; jt < 4; ++jt) {
          Sacc[jt] = __builtin_amdgcn_mfma_f32_16x16x16f16(*(const h4*)(AT + (jt * 16 + lr) * 16 + lq * 4), na, Sacc[jt], 0, 0, 0);
          Sacc[jt] = __builtin_amdgcn_mfma_f32_16x16x16f16(*(const h4*)(BT + (jt * 16 + lr) * 16 + lq * 4), vt, Sacc[jt], 0, 0, 0);
          Sacc[jt] = Sacc[jt] * *(const f4*)(Pend + jt * 16 + lq * 4);
        }
      }
    }
    __syncthreads();
  }
}

__device__ void phase_readout(const P& p) {
  const int lane = tidx() & 63;
  const int gw = bidx() * 8 + (tidx() >> 6), stride = gridDim.x * 8;
  char* ws = (p.ws + opaque_zero());
  const half_t* Y0 = (const half_t*)(ws + OFF_A0);
  const half_t* Y1 = (const half_t*)(ws + OFF_A1);
  const half_t* VVp = (const half_t*)(ws + OFF_VV);
  const half_t* Gp = (const half_t*)(ws + OFF_G);
  const float* BN0 = (const float*)(ws + OFF_BN);
  const float* BN1 = BN0 + (size_t)RL * 16;
  half_t* Z1 = (half_t*)(ws + OFF_Z1);
  const int c0 = lane * 16, head = lane >> 2;
  for (int row = gw; row < RL; row += stride) {
    const size_t o = (size_t)row * 1024 + c0;
    float y[16], vv[16], gg[16];
#pragma unroll
    for (int hh = 0; hh < 2; ++hh) {
      const h8 a = *(const h8*)(Y0 + o + hh * 8);
      const h8 bq = *(const h8*)(Y1 + o + hh * 8);
      const h8 v = *(const h8*)(VVp + o + hh * 8);
      const h8 g = *(const h8*)(Gp + o + hh * 8);
#pragma unroll
      for (int i = 0; i < 8; ++i) {
        y[hh * 8 + i] = (float)a[i] + (float)bq[i];
        vv[hh * 8 + i] = (float)v[i];
        gg[hh * 8 + i] = (float)g[i];
      }
    }
    float s = 0.f;
#pragma unroll
    for (int i = 0; i < 16; ++i) s += y[i];
    s = red4(s);
    const float mean = s * (1.f / 64.f);
    float q = 0.f;
#pragma unroll
    for (int i = 0; i < 16; ++i) { const float d = y[i] - mean; q += d * d; }
    q = red4(q);
    const float rstd = rsqrtf(q * (1.f / 64.f) + 64e-5f);
    const float bonus = BN0[(size_t)row * 16 + head] + BN1[(size_t)row * 16 + head];
    h8 o0, o1;
#pragma unroll
    for (int i = 0; i < 16; ++i) {
      const float lg = p.rw_lng[c0 + i], lb = p.rw_lnb[c0 + i];
      const float r = ((y[i] - mean) * rstd * lg + lb + bonus * vv[i]) * gg[i];
      if (i < 8) o0[i] = (half_t)r; else o1[i - 8] = (half_t)r;
    }
    *(h8*)(Z1 + o) = o0;
    *(h8*)(Z1 + o + 8) = o1;
  }
}

#define NPHASE 18
__global__ void __launch_bounds__(512) mega(P p_in, int ph_lo, int ph_hi) {
  __shared__ __attribute__((aligned(16))) char smem[SMEM_BYTES];
  cg::grid_group grid = cg::this_grid();
  const P& p = p_in;
  for (int ph = ph_lo; ph < ph_hi; ++ph) {
    char* ws = p_in.ws + opaque_zero();
    int kind = 2, arg = 0;
    size_t oA = 0, oB = 0, oC = 0;
    int lda = 1024, ldb = 1024, K = 1024, ldc = 1024, epi = 0, nMt = 136, nNt = 8, feat = 0;
    switch (ph) {
      case 0: kind = 0; break;
      case 1: kind = 1; arg = 0; break;
      case 2: oA = OFF_A0; oB = OFF_WIN; oC = OFF_U; ldc = 2048; nNt = 8; feat = 2; break;
      case 3: kind = 3; break;
      case 4: oA = OFF_Z; oB = OFF_WOUT; oC = OFF_A1; nNt = 4; feat = 4; break;
      case 5: kind = 1; arg = 1; break;
      case 6: oA = OFF_A0; oB = OFF_M1; oC = OFF_F; ldc = 4096; nNt = 16; epi = 1; feat = 3; break;
      case 7: oA = OFF_F; lda = 4096; oB = OFF_M2; ldb = 4096; K = 4096; oC = OFF_A1; nNt = 4; feat = 4; break;
      case 8: kind = 1; arg = 2; break;
      case 9: kind = 4; break;
      case 10: oA = OFF_A0; oB = OFF_WR; oC = OFF_RR; nNt = 27; feat = 1; break;
      case 11: kind = 5; break;
      case 12: oA = OFF_L + 512; lda = 384; oB = OFF_G2; ldb = 128; K = 128; oC = OFF_Z1; nMt = 128; epi = 5; break;
      case 13: oA = OFF_Z1; oB = OFF_WO; oC = OFF_A1; nMt = 128; nNt = 4; feat = 3; break;
      case 14: kind = 1; arg = 3; break;
      case 15: oA = OFF_A0; oB = OFF_M1 + 8 * MIB; oC = OFF_F; ldc = 4096; nNt = 16; epi = 1; nMt = 128; feat = 3; break;
      case 16: oA = OFF_F; lda = 4096; oB = OFF_M2 + 8 * MIB; ldb = 4096; K = 4096; oC = OFF_A1; nMt = 128; nNt = 4; feat = 3; break;
      default: kind = 1; arg = 4; break;
    }
    if (kind == 2) {
      gemm_phase(p, (const half_t*)(ws + oA), lda, (const half_t*)(ws + oB), ldb, K, (half_t*)(ws + oC), ldc, epi, nMt, nNt, feat, smem);
    } else if (kind == 1) {
      phase_rowwise(p, arg);
    } else if (kind == 0) {
      phase_prep(p, smem);
    } else if (kind == 3) {
      for (int it = bidx(); it < 2176 + 1088; it += gridDim.x) {
        if (it < 2176) attn_item(p, it, smem); else pool_item(p, it - 2176);
      }
    } else if (kind == 4) {
      phase_shift(p);
    } else if (kind == 5) {
      for (int it = bidx(); it < 256; it += gridDim.x) scan_item(p, it, smem);
    } else {
      phase_readout(p);
    }
    if (ph + 1 < ph_hi) grid.sync();
  }
}

extern "C" void kernel_launch(void* const* d_in, const int* in_sizes, int n_in, void* d_out, int out_size, void* d_ws,
                              size_t ws_size, hipStream_t stream) {
  P p{};
  const float** pp = (const float**)&p;
  for (int i = 0; i < 32; ++i) pp[i] = (const float*)d_in[i];
  p.out = (float*)d_out;
  p.ws = (char*)d_ws;
  static int grid_blocks = 0;
  if (!grid_blocks) {
    int dev = 0, cus = 0, per_cu = 0;
    (void)hipGetDevice(&dev);
    (void)hipDeviceGetAttribute(&cus, hipDeviceAttributeMultiprocessorCount, dev);
    (void)hipOccupancyMaxActiveBlocksPerMultiprocessor(&per_cu, mega, 512, 0);
    if (per_cu < 1) per_cu = 1;
    grid_blocks = cus * per_cu;
  }
  int lo = 0, hi = NPHASE;
  void* args[] = {&p, &lo, &hi};
  hipError_t e = hipLaunchCooperativeKernel((void*)mega, dim3(grid_blocks), dim3(512), args, 0, stream);
  if (e != hipSuccess) fprintf(stderr, "cooperative launch failed: %s (grid %d)\n", hipGetErrorString(e), grid_blocks);
}
```

```cpp
#include <hip/hip_runtime.h>
#include <hip/hip_cooperative_groups.h>
#include <cstdio>
namespace cg = cooperative_groups;

typedef _Float16 half_t;
typedef _Float16 h8 __attribute__((ext_vector_type(8)));
typedef _Float16 h4 __attribute__((ext_vector_type(4)));
typedef _Float16 h2 __attribute__((ext_vector_type(2)));
typedef float f4 __attribute__((ext_vector_type(4)));

#define RL 32768
#define RC 2048
#define RT 34816
#define MIB (1ull << 20)
#define OFF_WIN (0 * MIB)
#define OFF_WOUT (4 * MIB)
#define OFF_M1 (7 * MIB)
#define OFF_M2 (23 * MIB)
#define OFF_WR (39 * MIB)
#define OFF_WK (41 * MIB)
#define OFF_WV (43 * MIB)
#define OFF_WO (45 * MIB)
#define OFF_L1 (47 * MIB)
#define OFF_W2 (48 * MIB)
#define OFF_A2 (48 * MIB + 256 * 1024)
#define OFF_G2 (48 * MIB + 512 * 1024)
#define OFF_MOD (49 * MIB)
#define OFF_BN (50 * MIB)
#define OFF_XC (54 * MIB)
#define OFF_A0 (62 * MIB)
#define OFF_A1 (130 * MIB)
#define OFF_BIG (198 * MIB)
#define OFF_U OFF_BIG
#define OFF_Z (334 * MIB)
#define OFF_F OFF_BIG
#define OFF_RR OFF_BIG
#define OFF_KK (266 * MIB)
#define OFF_VV (334 * MIB)
#define OFF_L (402 * MIB)
#define OFF_G OFF_BIG
#define OFF_Z1 (266 * MIB)

#define SMEM_BYTES 151552

struct P {
  const float *x, *c, *ctx, *c_ctx, *ada_w, *ada_b, *norm_g, *mlp_w1, *mlp_w2, *ev_w_in, *ev_w_out, *ev_pool_w,
      *ev_pool_scale, *ev_rpb, *rw_mu, *rw_wr, *rw_wk, *rw_wv, *rw_wo, *rw_w0, *rw_w1, *rw_w2, *rw_a0, *rw_a1, *rw_a2,
      *rw_g1, *rw_g2, *rw_kk, *rw_ka, *rw_rk, *rw_lng, *rw_lnb;
  float* out;
  char* ws;
};

__device__ __forceinline__ int tidx() { int v = threadIdx.x; asm volatile("" : "+v"(v)); return v; }
__device__ __forceinline__ int bidx() { int v = blockIdx.x; asm volatile("" : "+s"(v)); return v; }
__device__ __forceinline__ size_t opaque_zero() { size_t z = 0; asm volatile("" : "+s"(z)); return z; }
__device__ __forceinline__ float opaque_f(float v) { asm volatile("" : "+v"(v)); return v; }
__device__ __forceinline__ float sigm(float x) { return 1.f / (1.f + __expf(-x)); }
__device__ __forceinline__ float bperm(float v, int srclane) {
  return __builtin_bit_cast(float, __builtin_amdgcn_ds_bpermute(srclane << 2, __builtin_bit_cast(int, v)));
}
template <int CTRL>
__device__ __forceinline__ float dpp(float x) {
  return __builtin_bit_cast(float, __builtin_amdgcn_mov_dpp(__builtin_bit_cast(int, x), CTRL, 0xf, 0xf, true));
}
__device__ __forceinline__ float red4(float x) { x += dpp<0xB1>(x); x += dpp<0x4E>(x); return x; }
__device__ __forceinline__ float red8(float x) { x = red4(x); x += dpp<0x141>(x); return x; }
__device__ __forceinline__ float red16(float x) { x = red8(x); x += dpp<0x140>(x); return x; }
__device__ __forceinline__ float wave_sum(float v, int lane) {
  v = red16(v);
  v += bperm(v, lane ^ 16);
  v += bperm(v, lane ^ 32);
  return v;
}

struct GemmTile {
  const half_t* A; const half_t* A2; const float* mu; int lda;
  const half_t* Bt; int ldb; int K;
  half_t* C; int ldc; int epi;
  int row0, col0;
  const P* pp;
};

template <bool MIX>
__device__ __forceinline__ void gemm_tile(const GemmTile& g, char* smem) {
  half_t* As = (half_t*)smem;
  half_t* Bs = (half_t*)(smem + 73728);
  const int tid = tidx(), lane = tid & 63, w = tid >> 6;
  const int wm = w >> 1, wn = w & 1, lr = lane & 15, lq = lane >> 4;
  const int ldr = tid >> 3, ldk = (tid & 7) * 8;
  f4 acc[4][4];
#pragma unroll
  for (int i = 0; i < 4; ++i)
#pragma unroll
    for (int j = 0; j < 4; ++j) acc[i][j] = (f4){0.f, 0.f, 0.f, 0.f};
  uint4 ra0, ra1, ra2, ra3, rb0, rb1;
  uint4 rx0, rx1, rx2, rx3;
  float4 mu0, mu1;
  const int nk = g.K >> 6;
  const half_t* Ap = g.A + (size_t)ldr * g.lda + ldk;
  const half_t* A2p = MIX ? g.A2 + (size_t)ldr * g.lda + ldk : nullptr;
  const float* mup = MIX ? g.mu + ldk : nullptr;
  const half_t* Bp = g.Bt + (size_t)ldr * g.ldb + ldk;
  const size_t astep = (size_t)64 * g.lda, bstep = (size_t)64 * g.ldb;
  half_t* asw = As + ldr * 72 + ldk;
  half_t* bsw = Bs + ldr * 72 + ldk;
  const half_t* asr = As + (wm * 64 + lr) * 72 + lq * 8;
  const half_t* bsr = Bs + (wn * 64 + lr) * 72 + lq * 8;

#define GLOAD(kt)                                              \
  {                                                            \
    const int k0 = (kt) * 64;                                  \
    ra0 = *(const uint4*)(Ap + k0);                            \
    ra1 = *(const uint4*)(Ap + astep + k0);                    \
    ra2 = *(const uint4*)(Ap + 2 * astep + k0);                \
    ra3 = *(const uint4*)(Ap + 3 * astep + k0);                \
    rb0 = *(const uint4*)(Bp + k0);                            \
    rb1 = *(const uint4*)(Bp + bstep + k0);                    \
    if (MIX) {                                                 \
      rx0 = *(const uint4*)(A2p + k0);                         \
      rx1 = *(const uint4*)(A2p + astep + k0);                 \
      rx2 = *(const uint4*)(A2p + 2 * astep + k0);             \
      rx3 = *(const uint4*)(A2p + 3 * astep + k0);             \
      mu0 = *(const float4*)(mup + k0);                        \
      mu1 = *(const float4*)(mup + k0 + 4);                    \
    }                                                          \
  }
#define MIXV(r, x) __builtin_bit_cast(uint4, (h8)(__builtin_bit_cast(h8, r) + __builtin_bit_cast(h8, x) * m))
#define SSTORE(buf)                                            \
  {                                                            \
    half_t* as = asw + (buf) * (256 * 72);                     \
    half_t* bs = bsw + (buf) * (128 * 72);                     \
    if (MIX) {                                                 \
      h8 m;                                                    \
      m[0] = (half_t)mu0.x; m[1] = (half_t)mu0.y; m[2] = (half_t)mu0.z; m[3] = (half_t)mu0.w; \
      m[4] = (half_t)mu1.x; m[5] = (half_t)mu1.y; m[6] = (half_t)mu1.z; m[7] = (half_t)mu1.w; \
      ra0 = MIXV(ra0, rx0); ra1 = MIXV(ra1, rx1); ra2 = MIXV(ra2, rx2); ra3 = MIXV(ra3, rx3); \
    }                                                          \
    *(uint4*)(as) = ra0;                                       \
    *(uint4*)(as + 64 * 72) = ra1;                             \
    *(uint4*)(as + 128 * 72) = ra2;                            \
    *(uint4*)(as + 192 * 72) = ra3;                            \
    *(uint4*)(bs) = rb0;                                       \
    *(uint4*)(bs + 64 * 72) = rb1;                             \
  }

  GLOAD(0);
  SSTORE(0);
  __syncthreads();
  for (int kt = 0; kt < nk; ++kt) {
    const bool more = kt + 1 < nk;
    if (more) GLOAD(kt + 1);
    __builtin_amdgcn_sched_barrier(0);
    {
      const half_t* as = asr + (kt & 1) * (256 * 72);
      const half_t* bs = bsr + (kt & 1) * (128 * 72);
#pragma unroll
      for (int ks = 0; ks < 2; ++ks) {
        h8 a[4], b[4];
#pragma unroll
        for (int i = 0; i < 4; ++i) {
          a[i] = *(const h8*)(as + i * 16 * 72 + ks * 32);
          b[i] = *(const h8*)(bs + i * 16 * 72 + ks * 32);
        }
#pragma unroll
        for (int mt = 0; mt < 4; ++mt)
#pragma unroll
          for (int nt = 0; nt < 4; ++nt)
            acc[mt][nt] = __builtin_amdgcn_mfma_f32_16x16x32_f16(b[nt], a[mt], acc[mt][nt], 0, 0, 0);
      }
    }
    if (more) SSTORE((kt + 1) & 1);
    __syncthreads();
  }
#undef GLOAD
#undef SSTORE
#undef MIXV
#pragma unroll
  for (int mt = 0; mt < 4; ++mt) {
    half_t* cp = g.C + (size_t)(wm * 64 + mt * 16 + lr) * g.ldc + wn * 64 + lq * 4;
#pragma unroll
    for (int nt = 0; nt < 4; ++nt) {
      h4 o;
#pragma unroll
      for (int j = 0; j < 4; ++j) {
        float v = acc[mt][nt][j];
        if (g.epi == 1) { v = fmaxf(v, 0.f); v = v * v; }
        else if (g.epi == 2) v = 1.f - 2.f / (__expf(2.f * v) + 1.f);
        else if (g.epi == 3) v = sigm(v);
        o[j] = (half_t)v;
      }
      *(h4*)(cp + nt * 16) = o;
    }
  }
}

__device__ __forceinline__ void gemm_tile2(const GemmTile& g, char* smem) {
  half_t* As = (half_t*)smem;
  half_t* Bs = (half_t*)(smem + 73728);
  const int tid = tidx(), lane = tid & 63, w = tid >> 6;
  const int wm = w >> 1, wn = w & 1, lr = lane & 15, lq = lane >> 4;
  const int ldr = tid >> 3, ldk = (tid & 7) * 8;
  f4 acc[4][4];
#pragma unroll
  for (int i = 0; i < 4; ++i)
#pragma unroll
    for (int j = 0; j < 4; ++j) acc[i][j] = (f4){0.f, 0.f, 0.f, 0.f};
  uint4 xa0, xa1, xa2, xa3, xb0, xb1;
  uint4 ya0, ya1, ya2, ya3, yb0, yb1;
  const int nk = g.K >> 6;
  const half_t* Ap = g.A + (size_t)ldr * g.lda + ldk;
  const half_t* Bp = g.Bt + (size_t)ldr * g.ldb + ldk;
  const size_t astep = (size_t)64 * g.lda, bstep = (size_t)64 * g.ldb;
  half_t* asw = As + ldr * 72 + ldk;
  half_t* bsw = Bs + ldr * 72 + ldk;
  const half_t* asr = As + (wm * 64 + lr) * 72 + lq * 8;
  const half_t* bsr = Bs + (wn * 64 + lr) * 72 + lq * 8;
#define GLD(S, kt)                                   \
  {                                                  \
    const int k0 = (kt) * 64;                        \
    S##a0 = *(const uint4*)(Ap + k0);                \
    S##a1 = *(const uint4*)(Ap + astep + k0);        \
    S##a2 = *(const uint4*)(Ap + 2 * astep + k0);    \
    S##a3 = *(const uint4*)(Ap + 3 * astep + k0);    \
    S##b0 = *(const uint4*)(Bp + k0);                \
    S##b1 = *(const uint4*)(Bp + bstep + k0);        \
  }
#define SST(S, buf)                                  \
  {                                                  \
    half_t* as = asw + (buf) * (256 * 72);           \
    half_t* bs = bsw + (buf) * (128 * 72);           \
    *(uint4*)(as) = S##a0;                           \
    *(uint4*)(as + 64 * 72) = S##a1;                 \
    *(uint4*)(as + 128 * 72) = S##a2;                \
    *(uint4*)(as + 192 * 72) = S##a3;                \
    *(uint4*)(bs) = S##b0;                           \
    *(uint4*)(bs + 64 * 72) = S##b1;                 \
  }
#define CMP(buf)                                                                                     \
  {                                                                                                  \
    const half_t* as = asr + (buf) * (256 * 72);                                                     \
    const half_t* bs = bsr + (buf) * (128 * 72);                                                     \
    _Pragma("unroll") for (int ks = 0; ks < 2; ++ks) {                                               \
      h8 a[4], b[4];                                                                                 \
      _Pragma("unroll") for (int i = 0; i < 4; ++i) {                                                \
        a[i] = *(const h8*)(as + i * 16 * 72 + ks * 32);                                             \
        b[i] = *(const h8*)(bs + i * 16 * 72 + ks * 32);                                             \
      }                                                                                              \
      _Pragma("unroll") for (int mt = 0; mt < 4; ++mt)                                               \
        _Pragma("unroll") for (int nt = 0; nt < 4; ++nt)                                             \
          acc[mt][nt] = __builtin_amdgcn_mfma_f32_16x16x32_f16(b[nt], a[mt], acc[mt][nt], 0, 0, 0);  \
    }                                                                                                \
  }
  GLD(x, 0);
  SST(x, 0);
  if (nk > 1) GLD(x, 1);
  if (nk > 2) GLD(y, 2);
  __syncthreads();
  for (int kt = 0; kt < nk; kt += 2) {
    CMP(0);
    if (kt + 1 < nk) SST(x, 1);
    if (kt + 3 < nk) GLD(x, kt + 3);
    __syncthreads();
    CMP(1);
    if (kt + 2 < nk) SST(y, 0);
    if (kt + 4 < nk) GLD(y, kt + 4);
    __syncthreads();
  }
#undef GLD
#undef SST
#undef CMP
#pragma unroll
  for (int mt = 0; mt < 4; ++mt) {
    half_t* cp = g.C + (size_t)(wm * 64 + mt * 16 + lr) * g.ldc + wn * 64 + lq * 4;
#pragma unroll
    for (int nt = 0; nt < 4; ++nt) {
      h4 o;
#pragma unroll
      for (int j = 0; j < 4; ++j) {
        float v = acc[mt][nt][j];
        if (g.epi == 1) { v = fmaxf(v, 0.f); v = v * v; }
        o[j] = (half_t)v;
      }
      *(h4*)(cp + nt * 16) = o;
    }
  }
}

__device__ __forceinline__ void gemm_tile3(const GemmTile& g, char* smem) {
  const int tid = tidx(), lane = tid & 63, w = tid >> 6;
  const int wm = w >> 1, wn = w & 1, lr = lane & 15, lq = lane >> 4;
  f4 acc[4][4];
#pragma unroll
  for (int i = 0; i < 4; ++i)
#pragma unroll
    for (int j = 0; j < 4; ++j) acc[i][j] = (f4){0.f, 0.f, 0.f, 0.f};
  const int nk = g.K >> 6;
  const int lrow = lane >> 3, lslot = lane & 7;
  const half_t* Ag[4];
  const half_t* Bg[2];
#pragma unroll
  for (int i = 0; i < 4; ++i) {
    const int row = (w * 4 + i) * 8 + lrow;
    Ag[i] = g.A + (size_t)row * g.lda + ((lslot ^ ((row >> 1) & 7)) * 8);
  }
#pragma unroll
  for (int i = 0; i < 2; ++i) {
    const int row = (w * 2 + i) * 8 + lrow;
    Bg[i] = g.Bt + (size_t)row * g.ldb + ((lslot ^ ((row >> 1) & 7)) * 8);
  }
  char* aw = smem + (w * 4) * 1024 + lane * 16;
  char* bw = smem + 32768 + (w * 2) * 1024 + lane * 16;
  const int swz = (lr >> 1) & 7;
  const int ko0 = ((0 + lq) ^ swz) * 16, ko1 = ((4 + lq) ^ swz) * 16;
  const char* ar = smem + (wm * 64 + lr) * 128;
  const char* br = smem + 32768 + (wn * 64 + lr) * 128;
#define ISSUE(kt, st)                                                                                      \
  {                                                                                                        \
    _Pragma("unroll") for (int i = 0; i < 4; ++i)                                                          \
      __builtin_amdgcn_global_load_lds((const unsigned*)(Ag[i] + (kt) * 64), (unsigned*)(aw + (st) * 49152 + i * 1024), 16, 0, 0); \
    _Pragma("unroll") for (int i = 0; i < 2; ++i)                                                          \
      __builtin_amdgcn_global_load_lds((const unsigned*)(Bg[i] + (kt) * 64), (unsigned*)(bw + (st) * 49152 + i * 1024), 16, 0, 0); \
  }
  ISSUE(0, 0);
  if (nk > 1) {
    ISSUE(1, 1);
    asm volatile("s_waitcnt vmcnt(6)" ::: "memory");
  } else {
    asm volatile("s_waitcnt vmcnt(0)" ::: "memory");
  }
  __builtin_amdgcn_s_barrier();
  asm volatile("" ::: "memory");
  h8 a0[4], b0[4], a1[4], b1[4];
#define LDF(fa, fb, stg, ko)                                             \
  {                                                                      \
    const char* as = ar + (stg) * 49152 + (ko);                          \
    const char* bs = br + (stg) * 49152 + (ko);                          \
    _Pragma("unroll") for (int i = 0; i < 4; ++i) {                      \
      fa[i] = *(const h8*)(as + i * 2048);                               \
      fb[i] = *(const h8*)(bs + i * 2048);                               \
    }                                                                    \
  }
#define MMA(fa, fb)                                                      \
  {                                                                      \
    _Pragma("unroll") for (int mt = 0; mt < 4; ++mt)                     \
      _Pragma("unroll") for (int nt = 0; nt < 4; ++nt)                   \
        acc[mt][nt] = __builtin_amdgcn_mfma_f32_16x16x32_f16(fb[nt], fa[mt], acc[mt][nt], 0, 0, 0); \
  }
  LDF(a0, b0, 0, ko0);
  int st = 0;
  for (int kt = 0; kt < nk; ++kt) {
    const bool more = kt + 2 < nk;
    int st1 = st + 1; if (st1 >= 3) st1 -= 3;
    int st2 = st + 2; if (st2 >= 3) st2 -= 3;
    if (more) ISSUE(kt + 2, st2);
    LDF(a1, b1, st, ko1);
    __builtin_amdgcn_sched_barrier(0);
    MMA(a0, b0);
    __builtin_amdgcn_sched_barrier(0);
    if (more) asm volatile("s_waitcnt vmcnt(6) lgkmcnt(0)" ::: "memory");
    else asm volatile("s_waitcnt vmcnt(0) lgkmcnt(0)" ::: "memory");
    __builtin_amdgcn_s_barrier();
    asm volatile("" ::: "memory");
    if (kt + 1 < nk) LDF(a0, b0, st1, ko0);
    __builtin_amdgcn_sched_barrier(0);
    MMA(a1, b1);
    __builtin_amdgcn_sched_barrier(0);
    st = st1;
  }
#undef LDF
#undef MMA
#undef ISSUE
  if (g.epi == 5) {
    const P& p = *g.pp;
    char* ws = p.ws + opaque_zero();
    const half_t* Y0 = (const half_t*)(ws + OFF_A0);
    const half_t* Y1 = (const half_t*)(ws + OFF_A1);
    const half_t* VVp = (const half_t*)(ws + OFF_VV);
    const float* BN0 = (const float*)(ws + OFF_BN);
    const float* BN1 = BN0 + (size_t)RL * 16;
    half_t* Z1 = (half_t*)(ws + OFF_Z1);
    const int head = (g.col0 >> 6) + wn;
#pragma unroll 1
    for (int mt = 0; mt < 4; ++mt) {
      const int row = g.row0 + wm * 64 + mt * 16 + lr;
      const size_t base = (size_t)row * 1024 + head * 64 + lq * 4;
      float y[4][4], vv[4][4];
      float sm = 0.f;
#pragma unroll
      for (int nt = 0; nt < 4; ++nt) {
        const h4 ya = *(const h4*)(Y0 + base + nt * 16);
        const h4 yb = *(const h4*)(Y1 + base + nt * 16);
        const h4 vh = *(const h4*)(VVp + base + nt * 16);
#pragma unroll
        for (int j = 0; j < 4; ++j) { y[nt][j] = (float)ya[j] + (float)yb[j]; vv[nt][j] = (float)vh[j]; sm += y[nt][j]; }
      }
      sm += bperm(sm, lane ^ 16);
      sm += bperm(sm, lane ^ 32);
      const float mean = sm * (1.f / 64.f);
      float q = 0.f;
#pragma unroll
      for (int nt = 0; nt < 4; ++nt)
#pragma unroll
        for (int j = 0; j < 4; ++j) { const float d = y[nt][j] - mean; q += d * d; }
      q += bperm(q, lane ^ 16);
      q += bperm(q, lane ^ 32);
      const float rstd = rsqrtf(q * (1.f / 64.f) + 64e-5f);
      const float bonus = BN0[(size_t)row * 16 + head] + BN1[(size_t)row * 16 + head];
#pragma unroll
      for (int nt = 0; nt < 4; ++nt) {
        const int ch = head * 64 + nt * 16 + lq * 4;
        const float4 lg = *(const float4*)(p.rw_lng + ch);
        const float4 lb = *(const float4*)(p.rw_lnb + ch);
        const float lgv[4] = {lg.x, lg.y, lg.z, lg.w}, lbv[4] = {lb.x, lb.y, lb.z, lb.w};
        const f4 gv = mt == 0 ? acc[0][nt] : (mt == 1 ? acc[1][nt] : (mt == 2 ? acc[2][nt] : acc[3][nt]));
        h4 o;
#pragma unroll
        for (int j = 0; j < 4; ++j) o[j] = (half_t)(((y[nt][j] - mean) * rstd * lgv[j] + lbv[j] + bonus * vv[nt][j]) * gv[j]);
        *(h4*)(Z1 + base + nt * 16) = o;
      }
    }
    return;
  }
  if (g.epi == 4) {
    half_t* vp = g.C + (size_t)((wm * 8 + wn) * 64) * 64 + lr;
#pragma unroll
    for (int mt = 0; mt < 4; ++mt)
#pragma unroll
      for (int nt = 0; nt < 4; ++nt)
#pragma unroll
        for (int j = 0; j < 4; ++j) vp[(nt * 16 + lq * 4 + j) * 64 + mt * 16] = (half_t)acc[mt][nt][j];
    return;
  }
#pragma unroll
  for (int mt = 0; mt < 4; ++mt) {
    half_t* cp = g.C + (size_t)(wm * 64 + mt * 16 + lr) * g.ldc + wn * 64 + lq * 4;
#pragma unroll
    for (int nt = 0; nt < 4; ++nt) {
      h4 o;
#pragma unroll
      for (int j = 0; j < 4; ++j) {
        float v = acc[mt][nt][j];
        if (g.epi == 1) { v = fmaxf(v, 0.f); v = v * v; }
        o[j] = (half_t)v;
      }
      *(h4*)(cp + nt * 16) = o;
    }
  }
}

__device__ __forceinline__ void gemm_tile4(const GemmTile& g, char* smem) {
  const int tid = tidx(), lane = tid & 63, w = tid >> 6;
  const int wm = w >> 1, wn = w & 1, lr = lane & 15, lq = lane >> 4;
  f4 acc[4][8];
#pragma unroll
  for (int i = 0; i < 4; ++i)
#pragma unroll
    for (int j = 0; j < 8; ++j) acc[i][j] = (f4){0.f, 0.f, 0.f, 0.f};
  const int nk = g.K >> 6;
  const int lrow = lane >> 3, lslot = lane & 7;
  const half_t* Ag[4];
  const half_t* Bg[4];
#pragma unroll
  for (int i = 0; i < 4; ++i) {
    const int row = (w * 4 + i) * 8 + lrow;
    const int so = (lslot ^ ((row >> 1) & 7)) * 8;
    Ag[i] = g.A + (size_t)row * g.lda + so;
    Bg[i] = g.Bt + (size_t)row * g.ldb + so;
  }
  char* aw = smem + (w * 4) * 1024 + lane * 16;
  char* bw = smem + 32768 + (w * 4) * 1024 + lane * 16;
  const int swz = (lr >> 1) & 7;
  const int ko0 = ((0 + lq) ^ swz) * 16, ko1 = ((4 + lq) ^ swz) * 16;
  const char* ar = smem + (wm * 64 + lr) * 128;
  const char* br = smem + 32768 + (wn * 128 + lr) * 128;
#define ISSUE4(kt, st)                                                                                     \
  {                                                                                                        \
    _Pragma("unroll") for (int i = 0; i < 4; ++i)                                                          \
      __builtin_amdgcn_global_load_lds((const unsigned*)(Ag[i] + (kt) * 64), (unsigned*)(aw + (st) * 65536 + i * 1024), 16, 0, 0); \
    _Pragma("unroll") for (int i = 0; i < 4; ++i)                                                          \
      __builtin_amdgcn_global_load_lds((const unsigned*)(Bg[i] + (kt) * 64), (unsigned*)(bw + (st) * 65536 + i * 1024), 16, 0, 0); \
  }
  ISSUE4(0, 0);
  asm volatile("s_waitcnt vmcnt(0)" ::: "memory");
  __builtin_amdgcn_s_barrier();
  asm volatile("" ::: "memory");
  for (int kt = 0; kt < nk; ++kt) {
    const int st = kt & 1;
    if (kt + 1 < nk) ISSUE4(kt + 1, st ^ 1);
    const char* as = ar + st * 65536;
    const char* bs = br + st * 65536;
#pragma unroll
    for (int ks = 0; ks < 2; ++ks) {
      const int ko = ks ? ko1 : ko0;
      h8 a[4], b[8];
#pragma unroll
      for (int i = 0; i < 4; ++i) a[i] = *(const h8*)(as + i * 2048 + ko);
#pragma unroll
      for (int i = 0; i < 8; ++i) b[i] = *(const h8*)(bs + i * 2048 + ko);
#pragma unroll
      for (int mt = 0; mt < 4; ++mt)
#pragma unroll
        for (int nt = 0; nt < 8; ++nt)
          acc[mt][nt] = __builtin_amdgcn_mfma_f32_16x16x32_f16(b[nt], a[mt], acc[mt][nt], 0, 0, 0);
    }
    asm volatile("s_waitcnt vmcnt(0) lgkmcnt(0)" ::: "memory");
    __builtin_amdgcn_s_barrier();
    asm volatile("" ::: "memory");
  }
#undef ISSUE4
  if (g.epi == 4) {
#pragma unroll
    for (int mt = 0; mt < 4; ++mt)
#pragma unroll
      for (int nt = 0; nt < 8; ++nt) {
        half_t* vp = g.C + (size_t)((wm * 8 + wn * 2 + (nt >> 2)) * 64) * 64 + lr;
#pragma unroll
        for (int j = 0; j < 4; ++j) vp[((nt & 3) * 16 + lq * 4 + j) * 64 + mt * 16] = (half_t)acc[mt][nt][j];
      }
    return;
  }
#pragma unroll
  for (int mt = 0; mt < 4; ++mt) {
    half_t* cp = g.C + (size_t)(wm * 64 + mt * 16 + lr) * g.ldc + wn * 128 + lq * 4;
#pragma unroll
    for (int nt = 0; nt < 8; ++nt) {
      h4 o;
#pragma unroll
      for (int j = 0; j < 4; ++j) {
        float v = acc[mt][nt][j];
        if (g.epi == 1) { v = fmaxf(v, 0.f); v = v * v; }
        o[j] = (half_t)v;
      }
      *(h4*)(cp + nt * 16) = o;
    }
  }
}

__device__ __forceinline__ int p8_lds_byte(int r, int c) {
  const int st = (r >> 4) * 2 + (c >> 5), rr = r & 15, cc = c & 31, ob = rr * 64 + cc * 2;
  return st * 1024 + (ob ^ (((ob >> 9) & 1) << 5));
}
__device__ __forceinline__ void p8_stage_rc(int b, int& R, int& C) {
  const int st = b / 1024, sb = b % 1024, swz = sb ^ (((sb >> 9) & 1) << 5);
  R = (st >> 1) * 16 + swz / 64;
  C = (st & 1) * 32 + (swz % 64) / 2;
}
__device__ __forceinline__ void gemm_tile8(const GemmTile& g, char* smem) {
  constexpr int HT = 128 * 64;
  half_t* shm = (half_t*)smem;
  const int tid = tidx();
  const int wid = tid >> 6, lane = tid & 63, wr = wid >> 2, wc = wid & 3, fr = lane & 15, fq = lane >> 4;
  const half_t* A = g.A;
  const half_t* Bt = g.Bt;
  const int lda = g.lda, ldb = g.lda;
#define P8_SA(b, h) (shm + ((b) * 2 + (h)) * HT)
#define P8_SB(b, h) (shm + (4 + (b) * 2 + (h)) * HT)
  int sr0, sc0, sr1, sc1;
  p8_stage_rc(tid * 16, sr0, sc0);
  p8_stage_rc(tid * 16 + 8192, sr1, sc1);
  const int ao0 = sr0 * lda + sc0, ao1 = sr1 * lda + sc1;
#define bo0 ao0
#define bo1 ao1
#define P8_STAGE_A(Pp, br, kt)                                                                                   \
  {                                                                                                              \
    const half_t* gb_ = A + (size_t)(br) * lda + (size_t)(kt) * 64;                                              \
    __builtin_amdgcn_global_load_lds((const unsigned*)(gb_ + ao0), (unsigned*)((char*)(Pp) + tid * 16), 16, 0, 0);        \
    __builtin_amdgcn_global_load_lds((const unsigned*)(gb_ + ao1), (unsigned*)((char*)(Pp) + tid * 16 + 8192), 16, 0, 0); \
  }
#define P8_STAGE_B(Pp, br, kt)                                                                                   \
  {                                                                                                              \
    const half_t* gb_ = Bt + (size_t)(br) * ldb + (size_t)(kt) * 64;                                             \
    __builtin_amdgcn_global_load_lds((const unsigned*)(gb_ + bo0), (unsigned*)((char*)(Pp) + tid * 16), 16, 0, 0);        \
    __builtin_amdgcn_global_load_lds((const unsigned*)(gb_ + bo1), (unsigned*)((char*)(Pp) + tid * 16 + 8192), 16, 0, 0); \
  }
  const char* abase = smem + p8_lds_byte(wr * 64 + fr, fq * 8);
  const char* bbase = smem + 4 * HT * 2 + p8_lds_byte(wc * 32 + fr, fq * 8);
#define P8_LDA(dst, b, h)                                                                                        \
  _Pragma("unroll") for (int m = 0; m < 4; ++m) _Pragma("unroll") for (int k = 0; k < 2; ++k)                    \
      dst[m][k] = *(const h8*)(abase + ((b) * 2 + (h)) * (HT * 2) + (m * 2 + k) * 1024);
#define P8_LDB(dst, b, h)                                                                                        \
  _Pragma("unroll") for (int n = 0; n < 2; ++n) _Pragma("unroll") for (int k = 0; k < 2; ++k)                    \
      dst[n][k] = *(const h8*)(bbase + ((b) * 2 + (h)) * (HT * 2) + (n * 2 + k) * 1024);
#define P8_MMA(ai, bj, Af, Bf)                                                                                   \
  {                                                                                                              \
    __builtin_amdgcn_s_setprio(1);                                                                               \
    _Pragma("unroll") for (int m = 0; m < 4; ++m) _Pragma("unroll") for (int n = 0; n < 2; ++n)                  \
        _Pragma("unroll") for (int k = 0; k < 2; ++k)                                                            \
            acc[ai][bj][m][n] = __builtin_amdgcn_mfma_f32_16x16x32_f16(Bf[n][k], Af[m][k], acc[ai][bj][m][n], 0, 0, 0); \
    __builtin_amdgcn_s_setprio(0);                                                                               \
  }
#define P8_WAIT_V(n) asm volatile("s_waitcnt vmcnt(" #n ")" ::: "memory")
#define P8_WAIT_L(n) asm volatile("s_waitcnt lgkmcnt(" #n ")" ::: "memory")
#define P8_BAR __builtin_amdgcn_s_barrier()
#define P8_SCHED __builtin_amdgcn_sched_barrier(0)

  f4 acc[2][2][4][2];
#pragma unroll
  for (int i0 = 0; i0 < 2; ++i0)
#pragma unroll
    for (int i1 = 0; i1 < 2; ++i1)
#pragma unroll
      for (int i2 = 0; i2 < 4; ++i2)
#pragma unroll
        for (int i3 = 0; i3 < 2; ++i3) acc[i0][i1][i2][i3] = (f4){0.f, 0.f, 0.f, 0.f};
  h8 At[4][2], B0[2][2], B1[2][2];
  const int nt = g.K >> 6;
  P8_STAGE_B(P8_SB(0, 0), 0, 0); P8_STAGE_A(P8_SA(0, 0), 0, 0);
  P8_STAGE_B(P8_SB(0, 1), 128, 0); P8_STAGE_A(P8_SA(0, 1), 128, 0);
  if (wr == 1) P8_BAR;
  P8_WAIT_V(4); P8_BAR;
  P8_STAGE_B(P8_SB(1, 0), 0, 1); P8_STAGE_A(P8_SA(1, 0), 0, 1); P8_STAGE_B(P8_SB(1, 1), 128, 1);
  P8_WAIT_V(6); P8_BAR;
  for (int t = 0; t < nt - 2; t += 2) {
    P8_LDB(B0, 0, 0); P8_SCHED; P8_LDA(At, 0, 0); P8_STAGE_A(P8_SA(1, 1), 128, t + 1);
    P8_WAIT_L(8); P8_BAR; P8_WAIT_L(0); P8_MMA(0, 0, At, B0); P8_BAR; P8_SCHED;
    P8_LDB(B1, 0, 1); P8_STAGE_B(P8_SB(0, 0), 0, t + 2);
    P8_BAR; P8_WAIT_L(0); P8_MMA(0, 1, At, B1); P8_BAR;
    P8_LDA(At, 0, 1); P8_STAGE_A(P8_SA(0, 0), 0, t + 2);
    P8_BAR; P8_WAIT_L(0); P8_MMA(1, 0, At, B0); P8_BAR; P8_SCHED;
    P8_STAGE_B(P8_SB(0, 1), 128, t + 2);
    P8_WAIT_V(6); P8_BAR; P8_MMA(1, 1, At, B1); P8_BAR;
    P8_LDB(B0, 1, 0); P8_SCHED; P8_LDA(At, 1, 0); P8_STAGE_A(P8_SA(0, 1), 128, t + 2);
    P8_WAIT_L(8); P8_BAR; P8_WAIT_L(0); P8_MMA(0, 0, At, B0); P8_BAR; P8_SCHED;
    P8_LDB(B1, 1, 1); P8_STAGE_B(P8_SB(1, 0), 0, t + 3);
    P8_BAR; P8_WAIT_L(0); P8_MMA(0, 1, At, B1); P8_BAR;
    P8_LDA(At, 1, 1); P8_STAGE_A(P8_SA(1, 0), 0, t + 3);
    P8_BAR; P8_WAIT_L(0); P8_MMA(1, 0, At, B0); P8_BAR; P8_SCHED;
    P8_STAGE_B(P8_SB(1, 1), 128, t + 3);
    P8_WAIT_V(6); P8_BAR; P8_MMA(1, 1, At, B1); P8_BAR;
  }
  {
    P8_LDB(B0, 0, 0); P8_LDA(At, 0, 0); P8_STAGE_A(P8_SA(1, 1), 128, nt - 1);
    P8_BAR; P8_WAIT_L(0); P8_MMA(0, 0, At, B0); P8_BAR;
    P8_LDB(B1, 0, 1); P8_BAR; P8_WAIT_L(0); P8_MMA(0, 1, At, B1); P8_BAR;
    P8_LDA(At, 0, 1); P8_WAIT_V(4); P8_BAR; P8_WAIT_L(0); P8_MMA(1, 0, At, B0); P8_MMA(1, 1, At, B1); P8_BAR;
  }
  {
    P8_LDB(B0, 1, 0); P8_LDA(At, 1, 0); P8_WAIT_V(2); P8_BAR; P8_WAIT_L(0); P8_MMA(0, 0, At, B0); P8_BAR;
    P8_LDB(B1, 1, 1); P8_WAIT_V(0); P8_BAR; P8_WAIT_L(0); P8_MMA(0, 1, At, B1); P8_BAR;
    P8_LDA(At, 1, 1); P8_BAR; P8_WAIT_L(0); P8_MMA(1, 0, At, B0); P8_MMA(1, 1, At, B1); P8_BAR;
  }
  if (wr == 0) P8_BAR;
  asm volatile("" ::: "memory");
#pragma unroll
  for (int ai = 0; ai < 2; ++ai)
#pragma unroll
    for (int m = 0; m < 4; ++m) {
      const int row = ai * 128 + wr * 64 + m * 16 + fr;
#pragma unroll
      for (int bj = 0; bj < 2; ++bj)
#pragma unroll
        for (int n = 0; n < 2; ++n) {
          const int col = bj * 128 + wc * 32 + n * 16 + fq * 4;
          if (g.epi == 4) {
            half_t* vp = g.C + (size_t)(((row >> 6) * 8 + (col >> 6)) * 64 + (col & 63)) * 64 + (row & 63);
#pragma unroll
            for (int j = 0; j < 4; ++j) vp[j * 64] = (half_t)acc[ai][bj][m][n][j];
          } else {
            h4 o;
#pragma unroll
            for (int j = 0; j < 4; ++j) {
              float v = acc[ai][bj][m][n][j];
              if (g.epi == 1) { v = fmaxf(v, 0.f); v = v * v; }
              o[j] = (half_t)v;
            }
            *(h4*)(g.C + (size_t)row * g.ldc + col) = o;
          }
        }
    }
#undef bo0
#undef bo1
#undef P8_SA
#undef P8_SB
#undef P8_STAGE_A
#undef P8_STAGE_B
#undef P8_LDA
#undef P8_LDB
#undef P8_MMA
#undef P8_WAIT_V
#undef P8_WAIT_L
#undef P8_BAR
#undef P8_SCHED
}

__device__ __forceinline__ void gemm_phase(const P& p, const half_t* A, int lda, const half_t* Bt, int ldb, int K, half_t* C, int ldc,
                                           int epi, int nMt, int nNt, int feat, char* smem) {
  char* ws = (p.ws + opaque_zero());
  const bool split = (feat >= 2 && nMt == 136);
  if (split) nMt = 128;
  const int nbig = nMt * nNt;
  const int total = nbig + (split ? 16 * nNt : 0), G = gridDim.x, per_xcd = G >> 3;
  for (int t0 = bidx(); t0 < total + G; t0 += G) {
    const int rnd = t0 / G, bb = t0 - rnd * G;
    const int t = ((G & 7) == 0) ? rnd * G + (bb & 7) * per_xcd + (bb >> 3) : t0;
    if (t >= total) continue;
    const bool small = t >= nbig;
    const int gsz = 8 * nNt, first = (t / gsz) * 8, gm = min(nMt - first, 8);
    const int mt = small ? 128 + ((t - nbig) & 7) : first + (t % gsz) % gm;
    const int nt = small ? (t - nbig) >> 3 : (t % gsz) / gm;
    GemmTile g;
    g.A = A + (size_t)mt * 256 * lda; g.A2 = nullptr; g.mu = nullptr; g.lda = lda;
    const int tw = (feat >= 2 && !small) ? 256 : 128;
    g.Bt = Bt + (size_t)nt * tw * ldb; g.ldb = ldb; g.K = K;
    g.C = C + (size_t)mt * 256 * ldc + nt * tw; g.ldc = ldc; g.epi = epi;
    g.row0 = mt * 256; g.col0 = nt * tw; g.pp = &p;
    if (feat == 2 && !small && nt >= 6) {
      g.epi = 4;
      g.C = (half_t*)(ws + OFF_A1) + ((size_t)(mt * 4) * 8 + (nt - 6) * 4) * 4096;
    }
    if (feat == 2 && small && nt >= 12) {
      g.epi = 4;
      g.C = (half_t*)(ws + OFF_A1) + ((size_t)(mt * 4) * 8 + (nt - 12) * 2) * 4096;
    }
    if (feat == 1) {
      g.A2 = (const half_t*)(ws + OFF_A1) + (size_t)mt * 256 * 1024;
      const int grp = nt >> 3, sub = nt & 7;
      int mixi;
      if (grp < 3) {
        mixi = grp == 0 ? 0 : (grp == 1 ? 2 : 3);
        g.Bt = (const half_t*)(ws + (grp == 0 ? OFF_WR : (grp == 1 ? OFF_WK : OFF_WV))) + (size_t)sub * 128 * 1024;
        g.C = (half_t*)(ws + (grp == 0 ? OFF_RR : (grp == 1 ? OFF_KK : OFF_VV))) + (size_t)mt * 256 * 1024 + sub * 128;
      } else {
        mixi = sub == 0 ? 1 : (sub == 1 ? 4 : 5);
        g.Bt = (const half_t*)(ws + OFF_L1) + (size_t)sub * 128 * 1024;
        g.C = (half_t*)(ws + OFF_L) + (size_t)mt * 256 * 384 + sub * 128;
        g.ldc = 384;
        g.epi = sub == 0 ? 2 : (sub == 1 ? 0 : 3);
      }
      g.mu = p.rw_mu + mixi * 1024;
    }
    if (feat == 1) gemm_tile<true>(g, smem); else if (feat >= 2 && !small) gemm_tile8(g, smem); else gemm_tile3(g, smem);
  }
}

__device__ void xpose_seg(const float* src, int ldsrc, int K, int N, half_t* dst, int lddst, int koff, int& base,
                          char* smem) {
  float* ts = (float*)smem;
  const int tid = tidx(), G = gridDim.x;
  const int tkn = K >> 6, tnn = N >> 6, cnt = tkn * tnn;
  int t0 = ((int)bidx() - (base % G) + G) % G;
  for (int t = t0; t < cnt; t += G) {
    const int k0 = (t % tkn) * 64, n0 = (t / tkn) * 64;
#pragma unroll
    for (int i = 0; i < 2; ++i) {
      const int c = tid + 512 * i, r = c >> 4, c4 = (c & 15) * 4;
      const float4 v = *(const float4*)(src + (size_t)(k0 + r) * ldsrc + n0 + c4);
      float* d = ts + r * 65 + c4;
      d[0] = v.x; d[1] = v.y; d[2] = v.z; d[3] = v.w;
    }
    __syncthreads();
    {
      const int n = tid >> 3, kc = (tid & 7) * 8;
      h8 o;
#pragma unroll
      for (int i = 0; i < 8; ++i) o[i] = (half_t)ts[(kc + i) * 65 + n];
      *(h8*)(dst + (size_t)(n0 + n) * lddst + koff + k0 + kc) = o;
    }
    __syncthreads();
  }
  base += cnt;
}

__device__ void phase_prep(const P& p, char* smem) {
  const int tid = tidx();
  char* ws = (p.ws + opaque_zero());
  float* MOD = (float*)(ws + OFF_MOD);
  if (bidx() < 192 || gridDim.x < 256) {
    float* sl = (float*)smem;
    for (int i = tid; i < 9216; i += 512) {
      const int b = i >> 10, k = i & 1023;
      const float cv = b < 8 ? p.c[b * 1024 + k] : p.c_ctx[k];
      sl[i] = cv / (1.f + __expf(-cv));
    }
    __syncthreads();
    float* red = sl + 9216;
    for (int item = bidx(); item < 192; item += gridDim.x) {
      const int l = item / 96, n0 = (item % 96) * 64, cn = tid & 63, kq = tid >> 6;
      float acc[9];
#pragma unroll
      for (int b = 0; b < 9; ++b) acc[b] = 0.f;
      const float* wp = p.ada_w + (size_t)l * 1024 * 6144 + n0 + cn;
#pragma unroll 4
      for (int k = kq * 128; k < kq * 128 + 128; ++k) {
        const float wv = wp[(size_t)k * 6144];
#pragma unroll
        for (int b = 0; b < 9; ++b) acc[b] += sl[b * 1024 + k] * wv;
      }
#pragma unroll
      for (int b = 0; b < 9; ++b) red[(kq * 9 + b) * 64 + cn] = acc[b];
      __syncthreads();
      for (int i = tid; i < 576; i += 512) {
        const int b = i >> 6, c = i & 63;
        float s = 0.f;
#pragma unroll
        for (int q = 0; q < 8; ++q) s += red[(q * 9 + b) * 64 + c];
        MOD[(size_t)(l * 9 + b) * 6144 + n0 + c] = s + p.ada_b[l * 6144 + n0 + c];
      }
      __syncthreads();
    }
  }
  for (int it = bidx(); it < 256; it += gridDim.x) {
    if (it < 192) continue;
    const int fi = it - 192, gi = fi >> 4, n0 = (fi & 15) * 64, n = tid & 63, ig = tid >> 6;
    float acc[16];
#pragma unroll
    for (int i = 0; i < 16; ++i) acc[i] = 0.f;
    for (int j = 0; j < 128; ++j) {
      const float wv = p.ev_w_out[(size_t)(gi * 128 + j) * 1024 + n0 + n] * p.ev_pool_scale[gi * 128 + j];
      const float* pw = p.ev_pool_w + ((size_t)gi * 128 + ig * 16) * 128 + j;
#pragma unroll
      for (int i = 0; i < 16; ++i) acc[i] += pw[i * 128] * wv;
    }
    h8 o0, o1;
#pragma unroll
    for (int i = 0; i < 8; ++i) { o0[i] = (half_t)acc[i]; o1[i] = (half_t)acc[8 + i]; }
    half_t* d = (half_t*)(ws + OFF_WOUT) + (size_t)(n0 + n) * 1024 + gi * 128 + ig * 16;
    *(h8*)d = o0;
    *(h8*)(d + 8) = o1;
  }
  __syncthreads();
  int base = 0;
  xpose_seg(p.ev_w_in, 2048, 1024, 2048, (half_t*)(ws + OFF_WIN), 1024, 0, base, smem);
  xpose_seg(p.ev_w_out + 512 * 1024, 1024, 512, 1024, (half_t*)(ws + OFF_WOUT), 1024, 512, base, smem);
  for (int l = 0; l < 2; ++l) {
    xpose_seg(p.mlp_w1 + (size_t)l * 1024 * 4096, 4096, 1024, 4096, (half_t*)(ws + OFF_M1 + l * 8 * MIB), 1024, 0, base, smem);
    xpose_seg(p.mlp_w2 + (size_t)l * 1024 * 4096, 1024, 4096, 1024, (half_t*)(ws + OFF_M2 + l * 8 * MIB), 4096, 0, base, smem);
  }
  xpose_seg(p.rw_wr, 1024, 1024, 1024, (half_t*)(ws + OFF_WR), 1024, 0, base, smem);
  xpose_seg(p.rw_wk, 1024, 1024, 1024, (half_t*)(ws + OFF_WK), 1024, 0, base, smem);
  xpose_seg(p.rw_wv, 1024, 1024, 1024, (half_t*)(ws + OFF_WV), 1024, 0, base, smem);
  xpose_seg(p.rw_wo, 1024, 1024, 1024, (half_t*)(ws + OFF_WO), 1024, 0, base, smem);
  for (int d = 0; d < 2; ++d) {
    xpose_seg(p.rw_w1 + (size_t)d * 1024 * 64, 64, 1024, 64, (half_t*)(ws + OFF_L1) + (size_t)(d * 64) * 1024, 1024, 0, base, smem);
    xpose_seg(p.rw_a1 + (size_t)d * 1024 * 64, 64, 1024, 64, (half_t*)(ws + OFF_L1) + (size_t)(128 + d * 64) * 1024, 1024, 0, base, smem);
    xpose_seg(p.rw_w2 + (size_t)d * 64 * 1024, 1024, 64, 1024, (half_t*)(ws + OFF_W2) + (size_t)d * 1024 * 64, 64, 0, base, smem);
    xpose_seg(p.rw_a2 + (size_t)d * 64 * 1024, 1024, 64, 1024, (half_t*)(ws + OFF_A2) + (size_t)d * 1024 * 64, 64, 0, base, smem);
  }
  xpose_seg(p.rw_g1, 128, 1024, 128, (half_t*)(ws + OFF_L1) + (size_t)256 * 1024, 1024, 0, base, smem);
  xpose_seg(p.rw_g2, 1024, 128, 1024, (half_t*)(ws + OFF_G2), 128, 0, base, smem);
}

__device__ void phase_rowwise(const P& p, int mode) {
  const int lane = tidx() & 63;
  const int gw = bidx() * 8 + (tidx() >> 6), nw = gridDim.x * 8;
  char* ws = (p.ws + opaque_zero());
  const float* MOD = (const float*)(ws + OFF_MOD);
  float* XC = (float*)(ws + OFF_XC);
  half_t* H = (half_t*)(ws + OFF_A0);
  const half_t* Y = (const half_t*)(ws + OFF_A1);
  const int nrows = (mode >= 3) ? RL : RT;
  const int per = (nrows + nw - 1) / nw;
  const int r0 = gw * per, r1 = min(r0 + per, nrows);
  if (r0 >= r1) return;
  const bool hasY = mode != 0, hasH = mode != 4;
  const float EPS = opaque_f(1e-6f);
  const int lyr = (mode <= 1) ? 0 : ((mode == 2) ? 0 : 1);
  const int gyi = (mode == 1) ? 1 : (mode == 2 ? 3 : (mode == 3 ? 5 : 7));
  const int gti = (mode == 1) ? 2 : (mode == 2 ? 5 : (mode == 3 ? 2 : 5));
  const int hl = (mode <= 1) ? 0 : 1;
  const int ghi = (mode == 0) ? 0 : (mode == 1 ? 2 : (mode == 2 ? 4 : 6));
  const int shi = (mode == 0 || mode == 2) ? 0 : 3;
  auto xsrc = [&](int row) -> const float* {
    if (mode <= 1) return row < RL ? p.x + (size_t)row * 1024 : p.ctx + (size_t)(row - RL) * 1024;
    return row < RL ? p.out + (size_t)row * 1024 : XC + (size_t)(row - RL) * 1024;
  };
  auto xdst = [&](int row) -> float* { return row < RL ? p.out + (size_t)row * 1024 : XC + (size_t)(row - RL) * 1024; };
  float4 gy[4], gt[4], gh[4], s1[4], s2[4];
  int cur_mi = -1;
  float4 nx[4];
  h4 ny[4];
  {
    const float* xs = xsrc(r0);
#pragma unroll
    for (int i = 0; i < 4; ++i) nx[i] = *(const float4*)(xs + i * 256 + lane * 4);
    if (hasY) {
#pragma unroll
      for (int i = 0; i < 4; ++i) ny[i] = *(const h4*)(Y + (size_t)r0 * 1024 + i * 256 + lane * 4);
    }
  }
  for (int row = r0; row < r1; ++row) {
    float xv[4][4];
    h4 yh[4];
#pragma unroll
    for (int i = 0; i < 4; ++i) { xv[i][0] = nx[i].x; xv[i][1] = nx[i].y; xv[i][2] = nx[i].z; xv[i][3] = nx[i].w; yh[i] = ny[i]; }
    if (row + 1 < r1) {
      const float* xs = xsrc(row + 1);
#pragma unroll
      for (int i = 0; i < 4; ++i) nx[i] = *(const float4*)(xs + i * 256 + lane * 4);
      if (hasY) {
#pragma unroll
        for (int i = 0; i < 4; ++i) ny[i] = *(const h4*)(Y + (size_t)(row + 1) * 1024 + i * 256 + lane * 4);
      }
    }
    const int mi = row < RL ? (row >> 12) : 8;
    if (mi != cur_mi) {
      cur_mi = mi;
      const float* mg = MOD + (size_t)(lyr * 9 + mi) * 6144;
      const float* mh = MOD + (size_t)(hl * 9 + mi) * 6144;
#pragma unroll
      for (int i = 0; i < 4; ++i) {
        const int o = i * 256 + lane * 4;
        if (hasY) { gy[i] = *(const float4*)(p.norm_g + gyi * 1024 + o); gt[i] = *(const float4*)(mg + gti * 1024 + o); }
        if (hasH) {
          gh[i] = *(const float4*)(p.norm_g + ghi * 1024 + o);
          s1[i] = *(const float4*)(mh + shi * 1024 + o);
          s2[i] = *(const float4*)(mh + (shi + 1) * 1024 + o);
        }
      }
    }
    if (hasY) {
      float yv[4][4];
      float ss = 0.f;
#pragma unroll
      for (int i = 0; i < 4; ++i)
#pragma unroll
        for (int k = 0; k < 4; ++k) { yv[i][k] = (float)yh[i][k]; ss += yv[i][k] * yv[i][k]; }
      ss = wave_sum(ss, lane);
      const float rs = rsqrtf(ss * (1.f / 1024.f) + EPS);
      float* xo = xdst(row);
#pragma unroll
      for (int i = 0; i < 4; ++i) {
        xv[i][0] += gt[i].x * (yv[i][0] * rs * gy[i].x);
        xv[i][1] += gt[i].y * (yv[i][1] * rs * gy[i].y);
        xv[i][2] += gt[i].z * (yv[i][2] * rs * gy[i].z);
        xv[i][3] += gt[i].w * (yv[i][3] * rs * gy[i].w);
        *(float4*)(xo + i * 256 + lane * 4) = make_float4(xv[i][0], xv[i][1], xv[i][2], xv[i][3]);
      }
    }
    if (hasH) {
      float ss = 0.f;
#pragma unroll
      for (int i = 0; i < 4; ++i)
#pragma unroll
        for (int k = 0; k < 4; ++k) ss += xv[i][k] * xv[i][k];
      ss = wave_sum(ss, lane);
      const float rs = rsqrtf(ss * (1.f / 1024.f) + EPS);
      half_t* ho = H + (size_t)row * 1024;
#pragma unroll
      for (int i = 0; i < 4; ++i) {
        h4 o;
        o[0] = (half_t)(xv[i][0] * rs * gh[i].x * (1.f + s2[i].x) + s1[i].x);
        o[1] = (half_t)(xv[i][1] * rs * gh[i].y * (1.f + s2[i].y) + s1[i].y);
        o[2] = (half_t)(xv[i][2] * rs * gh[i].z * (1.f + s2[i].z) + s1[i].z);
        o[3] = (half_t)(xv[i][3] * rs * gh[i].w * (1.f + s2[i].w) + s1[i].w);
        *(h4*)(ho + i * 256 + lane * 4) = o;
      }
    }
  }
}

__device__ __forceinline__ int clampi(int v, int lo, int hi) { return v < lo ? lo : (v > hi ? hi : v); }

__device__ void attn_item(const P& p, int item, char* smem) {
  half_t* Ks = (half_t*)smem;
  half_t* Vt = Ks + 2 * 64 * 72;
  float* rpbs = (float*)(smem + 36864);
  const int tid = tidx(), lane = tid & 63, w = tid >> 6, lr = lane & 15, lq = lane >> 4;
  const half_t* U = (const half_t*)((p.ws + opaque_zero()) + OFF_U);
  half_t* Z = (half_t*)((p.ws + opaque_zero()) + OFF_Z);
  const bool isctx = item >= 2048;
  int b, h, qrow, nlat = 0, start0 = 0, my_r = 0, my_start = 0, cw = 0, cs = 0, qcol = 0;
  if (!isctx) {
    b = item >> 8; h = (item >> 5) & 7;
    const int r0 = (item & 31) * 2;
    my_r = r0 + (w >> 2);
    const int cgp = w & 3;
    qcol = cgp * 16 + lr;
    qrow = b * 4096 + my_r * 64 + qcol;
    start0 = clampi(r0 - 4, 0, 56);
    const int start1 = clampi(r0 + 1 - 4, 0, 56);
    nlat = start1 + 8 - start0;
    my_start = clampi(my_r - 4, 0, 56);
    cw = clampi(cgp * 16 - 8, 0, 32);
    cs = clampi(qcol - 8, 0, 48);
  } else {
    const int it = item - 2048;
    b = it >> 4; h = (it >> 1) & 7;
    qrow = RL + b * 256 + (it & 1) * 128 + w * 16 + lr;
  }
  const int ntiles = nlat + 4;
  h8 qf[2];
#pragma unroll
  for (int ks = 0; ks < 2; ++ks) {
    h8 t = *(const h8*)(U + (size_t)qrow * 2048 + 512 + h * 64 + ks * 32 + lq * 8);
#pragma unroll
    for (int i = 0; i < 8; ++i) t[i] = t[i] * (half_t)0.125f;
    qf[ks] = t;
  }
  if (!isctx)
    for (int i = tid; i < 465; i += 512) rpbs[i] = p.ev_rpb[h * 465 + i];

  const int skey = tid >> 3, sd = (tid & 7) * 8;
  uint4 kA, vA, kB, vB;
  auto tile_row0 = [&](int i) -> int { return i < nlat ? b * 4096 + (start0 + i) * 64 : RL + b * 256 + (i - nlat) * 64; };
  const half_t* VTg = (const half_t*)((p.ws + opaque_zero()) + OFF_A1);
#define AT_GLOAD(kr, vr, i)                                                                            \
  {                                                                                                    \
    const int r0t = tile_row0(i);                                                                      \
    kr = *(const uint4*)(U + (size_t)(r0t + skey) * 2048 + 1024 + h * 64 + sd);                        \
    vr = *(const uint4*)(VTg + ((size_t)(r0t >> 6) * 8 + h) * 4096 + skey * 64 + sd);                  \
  }
#define AT_SSTORE(kr, vr, buf)                                                                         \
  {                                                                                                    \
    *(uint4*)(Ks + (buf) * 4608 + skey * 72 + sd) = kr;                                                \
    *(uint4*)(Vt + (buf) * 4608 + skey * 72 + sd) = vr;                                                \
  }
  f4 o[4];
#pragma unroll
  for (int i = 0; i < 4; ++i) o[i] = (f4){0.f, 0.f, 0.f, 0.f};
  const float NEG = opaque_f(-1e30f);
  float m = NEG, l = 0.f;

  AT_GLOAD(kA, vA, 0);
  AT_SSTORE(kA, vA, 0);
  AT_GLOAD(kA, vA, 1);
  AT_GLOAD(kB, vB, 2);
  __syncthreads();
  for (int i = 0; i < ntiles; ++i) {
    const int buf = i & 1;
    const bool lt = i < nlat;
    const int kr_abs = start0 + i;
    const bool active = !lt || (kr_abs >= my_start && kr_abs < my_start + 8);
    if (active) {
      const int npairs = lt ? 1 : 2;
      for (int pi = 0; pi < npairs; ++pi) {
        const int kb = lt ? cw : pi * 32;
        f4 s[2];
#pragma unroll
        for (int st = 0; st < 2; ++st) {
          f4 z = (f4){0.f, 0.f, 0.f, 0.f};
#pragma unroll
          for (int ks = 0; ks < 2; ++ks) {
            const h8 kf = *(const h8*)(Ks + buf * 4608 + (kb + st * 16 + lr) * 72 + ks * 32 + lq * 8);
            z = __builtin_amdgcn_mfma_f32_16x16x32_f16(kf, qf[ks], z, 0, 0, 0);
          }
          s[st] = z;
        }
        float tmax = NEG;
#pragma unroll
        for (int st = 0; st < 2; ++st)
#pragma unroll
          for (int j = 0; j < 4; ++j) {
            float v = s[st][j];
            if (lt) {
              const int kc = kb + st * 16 + lq * 4 + j;
              const bool ok = (kc >= cs) && (kc < cs + 16);
              const int dc = clampi(kc - qcol + 15, 0, 30);
              const int dr = kr_abs - my_r + 7;
              v = ok ? v + rpbs[dr * 31 + dc] : NEG;
            }
            s[st][j] = v;
            tmax = fmaxf(tmax, v);
          }
        tmax = fmaxf(tmax, bperm(tmax, lane ^ 16));
        tmax = fmaxf(tmax, bperm(tmax, lane ^ 32));
        const float mn = fmaxf(m, tmax);
        const float alpha = __expf(m - mn);
        m = mn;
        h8 pb;
        float ps = 0.f;
#pragma unroll
        for (int st = 0; st < 2; ++st)
#pragma unroll
          for (int j = 0; j < 4; ++j) {
            const float e = __expf(s[st][j] - mn);
            ps += e;
            pb[st * 4 + j] = (half_t)e;
          }
        l = l * alpha + ps;
#pragma unroll
        for (int dt = 0; dt < 4; ++dt) {
          o[dt] = o[dt] * alpha;
          const half_t* vp = Vt + buf * 4608 + (dt * 16 + lr) * 72 + kb + lq * 4;
          const h4 v0 = *(const h4*)vp;
          const h4 v1 = *(const h4*)(vp + 16);
          h8 vf;
          vf[0] = v0[0]; vf[1] = v0[1]; vf[2] = v0[2]; vf[3] = v0[3];
          vf[4] = v1[0]; vf[5] = v1[1]; vf[6] = v1[2]; vf[7] = v1[3];
          o[dt] = __builtin_amdgcn_mfma_f32_16x16x32_f16(vf, pb, o[dt], 0, 0, 0);
        }
      }
    }
    if (i + 1 < ntiles) {
      if ((i + 1) & 1) {
        AT_SSTORE(kA, vA, 1);
        if (i + 3 < ntiles) AT_GLOAD(kA, vA, i + 3);
      } else {
        AT_SSTORE(kB, vB, 0);
        if (i + 3 < ntiles) AT_GLOAD(kB, vB, i + 3);
      }
    }
    __syncthreads();
  }
#undef AT_GLOAD
#undef AT_SSTORE
  l += bperm(l, lane ^ 16);
  l += bperm(l, lane ^ 32);
  const float inv = 1.f / l;
#pragma unroll
  for (int dt = 0; dt < 4; ++dt) {
    h4 ov;
#pragma unroll
    for (int j = 0; j < 4; ++j) ov[j] = (half_t)(o[dt][j] * inv);
    *(h4*)(Z + (size_t)qrow * 1024 + 512 + h * 64 + dt * 16 + lq * 4) = ov;
  }
}

template <int HW>
__device__ __forceinline__ void pool_rows(const float (&pre)[4][25], int tl0, int L, half_t* zp) {
#pragma unroll
  for (int r = 0; r < 8; ++r) {
    const int tl = tl0 + r;
    const int lo = max(tl - HW, 0), hi = min(tl + HW, L);
    const float inv = 1.f / (float)(hi - lo);
    h4 o;
#pragma unroll
    for (int c = 0; c < 4; ++c) {
      const float sum = pre[c][8 + r + HW] - pre[c][8 + r - HW];
      const float cur = pre[c][8 + r + 1] - pre[c][8 + r];
      o[c] = (half_t)(sum * inv - cur);
    }
    *(h4*)(zp + (size_t)r * 1024) = o;
  }
}

__device__ void pool_item(const P& p, int item) {
  const half_t* U = (const half_t*)((p.ws + opaque_zero()) + OFF_U);
  half_t* Z = (half_t*)((p.ws + opaque_zero()) + OFF_Z);
  const int tid = tidx();
  const int c4 = (tid & 127) * 4, gi = c4 >> 7;
  const int row0 = item * 32 + (tid >> 7) * 8;
  int s0, L;
  if (row0 < RL) { s0 = row0 & ~4095; L = 4096; } else { s0 = RL + ((row0 - RL) & ~255); L = 256; }
  const int tl0 = row0 - s0;
  float pre[4][25];
#pragma unroll
  for (int c = 0; c < 4; ++c) pre[c][0] = 0.f;
#pragma unroll
  for (int i = 0; i < 24; ++i) {
    const int tl = tl0 - 8 + i;
    h4 v;
    v[0] = (half_t)0.f; v[1] = (half_t)0.f; v[2] = (half_t)0.f; v[3] = (half_t)0.f;
    if (tl >= 0 && tl < L) v = *(const h4*)(U + (size_t)(s0 + tl) * 2048 + c4);
#pragma unroll
    for (int c = 0; c < 4; ++c) pre[c][i + 1] = (float)v[c];
  }
#pragma unroll
  for (int i = 0; i < 24; ++i)
#pragma unroll
    for (int c = 0; c < 4; ++c) pre[c][i + 1] += pre[c][i];
  half_t* zp = Z + (size_t)row0 * 1024 + c4;
  if (gi == 0) pool_rows<1>(pre, tl0, L, zp);
  else if (gi == 1) pool_rows<2>(pre, tl0, L, zp);
  else if (gi == 2) pool_rows<4>(pre, tl0, L, zp);
  else pool_rows<8>(pre, tl0, L, zp);
}

__device__ void phase_shift(const P& p) {
  const half_t* H = (const half_t*)((p.ws + opaque_zero()) + OFF_A0);
  half_t* XX = (half_t*)((p.ws + opaque_zero()) + OFF_A1);
  const size_t total = (size_t)RT * 128;
  for (size_t idx = (size_t)bidx() * 512 + tidx(); idx < total; idx += (size_t)gridDim.x * 512) {
    const int row = (int)(idx >> 7), c = (int)(idx & 127) * 8;
    bool st, en;
    if (row < RL) { st = (row & 4095) == 0; en = (row & 4095) == 4095; }
    else { st = ((row - RL) & 255) == 0; en = ((row - RL) & 255) == 255; }
    const h8 cur = *(const h8*)(H + (size_t)row * 1024 + c);
    h8 pv, nx;
#pragma unroll
    for (int i = 0; i < 8; ++i) { pv[i] = (half_t)0.f; nx[i] = (half_t)0.f; }
    if (!st) pv = *(const h8*)(H + (size_t)(row - 1) * 1024 + c);
    if (!en) nx = *(const h8*)(H + (size_t)(row + 1) * 1024 + c);
    h8 o;
#pragma unroll
    for (int i = 0; i < 8; ++i) o[i] = (half_t)(0.5f * ((float)pv[i] + (float)nx[i]) - (float)cur[i]);
    *(h8*)(XX + (size_t)row * 1024 + c) = o;
  }
}

#define CS_BYTES 13312
#define CS_G 0
#define CS_R 2304
#define CS_AT 4608
#define CS_BT 6656
#define CS_VT 8704
#define CS_M 10752
#define CS_BM 11264
#define CS_CM 11776
#define CS_DM 12288
#define CS_PREF 12800
#define CS_PEND 13056
#define SCR_BASE 106496
#define SCR_BYTES 5632

__device__ void scan_item(const P& p, int item, char* smem) {
  const int tid = tidx(), lane = tid & 63, w = tid >> 6, lr = lane & 15, lq = lane >> 4;
  const int b = item >> 5, h = (item >> 1) & 15, dir = item & 1;
  char* ws = (p.ws + opaque_zero());
  const half_t* RRp = (const half_t*)(ws + OFF_RR);
  const half_t* KKp = (const half_t*)(ws + OFF_KK);
  const half_t* VVp = (const half_t*)(ws + OFF_VV);
  const half_t* Lp = (const half_t*)(ws + OFF_L);
  half_t* Yd = (half_t*)(ws + (dir ? OFF_A1 : OFF_A0));
  float* BN = (float*)(ws + OFF_BN) + (size_t)dir * RL * 16;

  auto grow = [&](int pp) -> int {
    if (pp < 256) return RL + b * 256 + (dir ? 255 - pp : pp);
    const int t = pp - 256;
    return b * 4096 + (dir ? 4095 - t : t);
  };

  auto prep = [&](int c) {
    char* cs = smem + w * CS_BYTES;
    half_t* G_ = (half_t*)(cs + CS_G);
    half_t* R_ = (half_t*)(cs + CS_R);
    half_t* AT = (half_t*)(cs + CS_AT);
    half_t* BT = (half_t*)(cs + CS_BT);
    half_t* VT = (half_t*)(cs + CS_VT);
    half_t* Mm = (half_t*)(cs + CS_M);
    half_t* Bm = (half_t*)(cs + CS_BM);
    half_t* Cm = (half_t*)(cs + CS_CM);
    half_t* Dm = (half_t*)(cs + CS_DM);
    float* Pref = (float*)(cs + CS_PREF);
    float* Pend = (float*)(cs + CS_PEND);
    char* scr = smem + SCR_BASE + w * SCR_BYTES;
    half_t* A_ = (half_t*)scr;
    half_t* B_ = (half_t*)(scr + 2304);
    float* Am = (float*)(scr + 4608);
    const bool lat = c >= 16;
    const int p0 = c * 16;
    const int rowA = grow(p0 + lr);
    const half_t* lp = Lp + (size_t)rowA * 384 + dir * 64 + lq * 8;
    const h8 aw0 = *(const h8*)(lp), aw1 = *(const h8*)(lp + 32);
    const h8 aa0 = *(const h8*)(lp + 128), aa1 = *(const h8*)(lp + 160);
    float ss[4], bp[4];
    int rows[4];
#pragma unroll
    for (int j = 0; j < 4; ++j) { ss[j] = 0.f; bp[j] = 0.f; rows[j] = grow(p0 + lq * 4 + j); }
#pragma unroll 1
    for (int nt = 0; nt < 4; ++nt) {
      const int ch = h * 64 + nt * 16 + lr;
      const float kkc = p.rw_kk[ch];
#pragma unroll
      for (int j = 0; j < 4; ++j) {
        const float k = (float)KKp[(size_t)rows[j] * 1024 + ch];
        ss[j] += (k * kkc) * (k * kkc);
      }
    }
    float inv[4];
#pragma unroll
    for (int j = 0; j < 4; ++j) inv[j] = rsqrtf(fmaxf(red16(ss[j]), 1e-24f));
#pragma unroll 1
    for (int nt = 0; nt < 4; ++nt) {
      const int ch = h * 64 + nt * 16 + lr;
      const half_t* w2p = (const half_t*)(ws + OFF_W2) + (size_t)dir * 65536 + (size_t)ch * 64 + lq * 8;
      const half_t* a2p = (const half_t*)(ws + OFF_A2) + (size_t)dir * 65536 + (size_t)ch * 64 + lq * 8;
      const h8 bw0 = *(const h8*)(w2p), bw1 = *(const h8*)(w2p + 32);
      const h8 ba0 = *(const h8*)(a2p), ba1 = *(const h8*)(a2p + 32);
      const float w0c = p.rw_w0[dir * 1024 + ch], a0c = p.rw_a0[dir * 1024 + ch];
      const float kkc = p.rw_kk[ch], kac = p.rw_ka[ch], rkc = p.rw_rk[ch];
      f4 cwv = (f4){0.f, 0.f, 0.f, 0.f}, cav = (f4){0.f, 0.f, 0.f, 0.f};
      cwv = __builtin_amdgcn_mfma_f32_16x16x32_f16(aw0, bw0, cwv, 0, 0, 0);
      cwv = __builtin_amdgcn_mfma_f32_16x16x32_f16(aw1, bw1, cwv, 0, 0, 0);
      cav = __builtin_amdgcn_mfma_f32_16x16x32_f16(aa0, ba0, cav, 0, 0, 0);
      cav = __builtin_amdgcn_mfma_f32_16x16x32_f16(aa1, ba1, cav, 0, 0, 0);
      h4 vq;
      float ev[4], avv[4], rv[4], kv[4];
#pragma unroll
      for (int j = 0; j < 4; ++j) {
        const size_t gi = (size_t)rows[j] * 1024 + ch;
        kv[j] = (float)KKp[gi];
        vq[j] = VVp[gi];
        rv[j] = lat ? (float)RRp[gi] : 0.f;
        ev[j] = 0.60653066f * sigm(cwv[j] + w0c);
        avv[j] = sigm(cav[j] + a0c);
        bp[j] += rv[j] * kv[j] * rkc * (dir == 0 ? (2.f - 2.f * kac + kac * avv[j]) : kac * avv[j]);
      }
      *(h4*)(VT + (nt * 16 + lr) * 16 + lq * 4) = vq;
      float cum[4];
      cum[0] = ev[0];
      cum[1] = cum[0] + ev[1];
      cum[2] = cum[1] + ev[2];
      cum[3] = cum[2] + ev[3];
      const float t1 = bperm(cum[3], (lane - 16) & 63), t2 = bperm(cum[3], (lane - 32) & 63), t3 = bperm(cum[3], (lane - 48) & 63);
      const float off = (lq >= 1 ? t1 : 0.f) + (lq >= 2 ? t2 : 0.f) + (lq >= 3 ? t3 : 0.f);
#pragma unroll
      for (int j = 0; j < 4; ++j) cum[j] += off;
      const float ref = bperm(cum[3], 16 + lr);
      const float end = bperm(cum[3], 48 + lr);
      if (lq == 0) {
        Pref[nt * 16 + lr] = __expf(-ref);
        Pend[nt * 16 + lr] = __expf(-(end - ref));
      }
      h4 aq, bq;
#pragma unroll
      for (int j = 0; j < 4; ++j) {
        const float d = cum[j] - ref;
        const float E1 = __expf(d), E2 = __expf(-d), E3 = __expf(ev[j] - d);
        const float k = kv[j];
        const float kk = k * kkc * inv[j];
        const float kd = k * (1.f + (avv[j] - 1.f) * kac);
        const half_t ga = (half_t)(kk * E3);
        const half_t ro = (half_t)(rv[j] * E2);
        const half_t al = (half_t)(kk * avv[j] * E1);
        const half_t be = (half_t)(kd * E1);
        const int o = (lq * 4 + j) * 72 + nt * 16 + lr;
        G_[o] = ga; R_[o] = ro; A_[o] = al; B_[o] = be;
        aq[j] = al; bq[j] = be;
      }
      *(h4*)(AT + (nt * 16 + lr) * 16 + lq * 4) = aq;
      *(h4*)(BT + (nt * 16 + lr) * 16 + lq * 4) = bq;
    }
#pragma unroll
    for (int j = 0; j < 4; ++j) {
      const float bpr = red16(bp[j]);
      if (lat && lr == 0) BN[(size_t)rows[j] * 16 + h] = bpr;
    }
    asm volatile("s_waitcnt lgkmcnt(0)" ::: "memory");
    f4 am = (f4){0.f, 0.f, 0.f, 0.f}, bm = am, cm = am, dm = am;
#pragma unroll
    for (int ks = 0; ks < 2; ++ks) {
      const h8 fa = *(const h8*)(A_ + lr * 72 + ks * 32 + lq * 8);
      const h8 fb = *(const h8*)(B_ + lr * 72 + ks * 32 + lq * 8);
      const h8 fg = *(const h8*)(G_ + lr * 72 + ks * 32 + lq * 8);
      const h8 fr = *(const h8*)(R_ + lr * 72 + ks * 32 + lq * 8);
      am = __builtin_amdgcn_mfma_f32_16x16x32_f16(fa, fg, am, 0, 0, 0);
      bm = __builtin_amdgcn_mfma_f32_16x16x32_f16(fb, fg, bm, 0, 0, 0);
      cm = __builtin_amdgcn_mfma_f32_16x16x32_f16(fa, fr, cm, 0, 0, 0);
      dm = __builtin_amdgcn_mfma_f32_16x16x32_f16(fb, fr, dm, 0, 0, 0);
    }
    h4 bmh, cmh, dmh;
#pragma unroll
    for (int j = 0; j < 4; ++j) {
      const int u = lq * 4 + j;
      am[j] = u < lr ? am[j] : 0.f;
      bmh[j] = (half_t)(u < lr ? bm[j] : 0.f);
      cmh[j] = (half_t)(u <= lr ? cm[j] : 0.f);
      dmh[j] = (half_t)(u <= lr ? dm[j] : 0.f);
    }
    *(h4*)(Bm + lr * 16 + lq * 4) = bmh;
    *(h4*)(Cm + lr * 16 + lq * 4) = cmh;
    *(h4*)(Dm + lr * 16 + lq * 4) = dmh;
    *(f4*)(Am + lr * 16 + lq * 4) = am;
    asm volatile("s_waitcnt lgkmcnt(0)" ::: "memory");
    float m[16];
#pragma unroll
    for (int t = 0; t < 16; ++t) {
      float acc = (t == lr) ? 1.f : 0.f;
#pragma unroll
      for (int u4 = 0; u4 < 4; ++u4) {
        if (u4 * 4 < t) {
          const f4 rw = *(const f4*)(Am + t * 16 + u4 * 4);
#pragma unroll
          for (int k = 0; k < 4; ++k)
            if (u4 * 4 + k < t) acc -= rw[k] * m[u4 * 4 + k];
        }
      }
      m[t] = acc;
    }
    if (lq == 0) {
#pragma unroll
      for (int t = 0; t < 16; ++t) Mm[t * 16 + lr] = (half_t)m[t];
    }
  };

  f4 Sacc[4];
#pragma unroll
  for (int jt = 0; jt < 4; ++jt) Sacc[jt] = (f4){0.f, 0.f, 0.f, 0.f};

  for (int sc = 0; sc < 34; ++sc) {
    prep(sc * 8 + w);
    __syncthreads();
    if (w < 4) {
      for (int cc = 0; cc < 8; ++cc) {
        const int c = sc * 8 + cc;
        const char* cs = smem + cc * CS_BYTES;
        const half_t* G_ = (const half_t*)(cs + CS_G);
        const half_t* R_ = (const half_t*)(cs + CS_R);
        const half_t* AT = (const half_t*)(cs + CS_AT);
        const half_t* BT = (const half_t*)(cs + CS_BT);
        const half_t* VT = (const half_t*)(cs + CS_VT);
        const half_t* Mm = (const half_t*)(cs + CS_M);
        const half_t* Bm = (const half_t*)(cs + CS_BM);
        const half_t* Cm = (const half_t*)(cs + CS_CM);
        const half_t* Dm = (const half_t*)(cs + CS_DM);
        const float* Pref = (const float*)(cs + CS_PREF);
        const float* Pend = (const float*)(cs + CS_PEND);
#pragma unroll
        for (int jt = 0; jt < 4; ++jt) Sacc[jt] = Sacc[jt] * *(const f4*)(Pref + jt * 16 + lq * 4);
        h8 bS[2];
#pragma unroll
        for (int ks = 0; ks < 2; ++ks)
#pragma unroll
          for (int k = 0; k < 4; ++k) {
            bS[ks][k] = (half_t)Sacc[2 * ks][k];
            bS[ks][4 + k] = (half_t)Sacc[2 * ks + 1][k];
          }
        const h4 vt = *(const h4*)(VT + (16 * w + lr) * 16 + lq * 4);
        f4 rhs = (f4){0.f, 0.f, 0.f, 0.f};
#pragma unroll
        for (int ks = 0; ks < 2; ++ks) {
          const h4 g0 = *(const h4*)(G_ + lr * 72 + (2 * ks) * 16 + lq * 4);
          const h4 g1 = *(const h4*)(G_ + lr * 72 + (2 * ks + 1) * 16 + lq * 4);
          h8 gf;
          gf[0] = g0[0]; gf[1] = g0[1]; gf[2] = g0[2]; gf[3] = g0[3];
          gf[4] = g1[0]; gf[5] = g1[1]; gf[6] = g1[2]; gf[7] = g1[3];
          rhs = __builtin_amdgcn_mfma_f32_16x16x32_f16(gf, bS[ks], rhs, 0, 0, 0);
        }
        {
          f4 r16 = (f4){0.f, 0.f, 0.f, 0.f};
          r16 = __builtin_amdgcn_mfma_f32_16x16x16f16(*(const h4*)(Bm + lr * 16 + lq * 4), vt, r16, 0, 0, 0);
          rhs = rhs + r16;
        }
        h4 rh;
#pragma unroll
        for (int k = 0; k < 4; ++k) rh[k] = (half_t)rhs[k];
        f4 av = (f4){0.f, 0.f, 0.f, 0.f};
        av = __builtin_amdgcn_mfma_f32_16x16x16f16(*(const h4*)(Mm + lr * 16 + lq * 4), rh, av, 0, 0, 0);
        h4 na;
#pragma unroll
        for (int k = 0; k < 4; ++k) na[k] = (half_t)(-av[k]);
        if (c >= 16) {
          f4 y = (f4){0.f, 0.f, 0.f, 0.f};
#pragma unroll
          for (int ks = 0; ks < 2; ++ks) {
            const h4 g0 = *(const h4*)(R_ + lr * 72 + (2 * ks) * 16 + lq * 4);
            const h4 g1 = *(const h4*)(R_ + lr * 72 + (2 * ks + 1) * 16 + lq * 4);
            h8 gf;
            gf[0] = g0[0]; gf[1] = g0[1]; gf[2] = g0[2]; gf[3] = g0[3];
            gf[4] = g1[0]; gf[5] = g1[1]; gf[6] = g1[2]; gf[7] = g1[3];
            y = __builtin_amdgcn_mfma_f32_16x16x32_f16(gf, bS[ks], y, 0, 0, 0);
          }
          f4 y16 = (f4){0.f, 0.f, 0.f, 0.f};
          y16 = __builtin_amdgcn_mfma_f32_16x16x16f16(*(const h4*)(Cm + lr * 16 + lq * 4), na, y16, 0, 0, 0);
          y16 = __builtin_amdgcn_mfma_f32_16x16x16f16(*(const h4*)(Dm + lr * 16 + lq * 4), vt, y16, 0, 0, 0);
          y = y + y16;
#pragma unroll
          for (int k = 0; k < 4; ++k) {
            const int row = grow(c * 16 + lq * 4 + k);
            Yd[(size_t)row * 1024 + h * 64 + 16 * w + lr] = (half_t)y[k];
          }
        }
#pragma unroll
        for (int jt = 0; jt < 4; ++jt) {
          Sacc[jt] = __builtin_amdgcn_mfma_f32_16x16x16f16(*(const h4*)(AT + (jt * 16 + lr) * 16 + lq * 4), na, Sacc[jt], 0, 0, 0);
          Sacc[jt] = __builtin_amdgcn_mfma_f32_16x16x16f16(*(const h4*)(BT + (jt * 16 + lr) * 16 + lq * 4), vt, Sacc[jt], 0, 0, 0);
          Sacc[jt] = Sacc[jt] * *(const f4*)(Pend + jt * 16 + lq * 4);
        }
      }
    }
    __syncthreads();
  }
}

__device__ void phase_readout(const P& p) {
  const int lane = tidx() & 63;
  const int gw = bidx() * 8 + (tidx() >> 6), stride = gridDim.x * 8;
  char* ws = (p.ws + opaque_zero());
  const half_t* Y0 = (const half_t*)(ws + OFF_A0);
  const half_t* Y1 = (const half_t*)(ws + OFF_A1);
  const half_t* VVp = (const half_t*)(ws + OFF_VV);
  const half_t* Gp = (const half_t*)(ws + OFF_G);
  const float* BN0 = (const float*)(ws + OFF_BN);
  const float* BN1 = BN0 + (size_t)RL * 16;
  half_t* Z1 = (half_t*)(ws + OFF_Z1);
  const int c0 = lane * 16, head = lane >> 2;
  for (int row = gw; row < RL; row += stride) {
    const size_t o = (size_t)row * 1024 + c0;
    float y[16], vv[16], gg[16];
#pragma unroll
    for (int hh = 0; hh < 2; ++hh) {
      const h8 a = *(const h8*)(Y0 + o + hh * 8);
      const h8 bq = *(const h8*)(Y1 + o + hh * 8);
      const h8 v = *(const h8*)(VVp + o + hh * 8);
      const h8 g = *(const h8*)(Gp + o + hh * 8);
#pragma unroll
      for (int i = 0; i < 8; ++i) {
        y[hh * 8 + i] = (float)a[i] + (float)bq[i];
        vv[hh * 8 + i] = (float)v[i];
        gg[hh * 8 + i] = (float)g[i];
      }
    }
    float s = 0.f;
#pragma unroll
    for (int i = 0; i < 16; ++i) s += y[i];
    s = red4(s);
    const float mean = s * (1.f / 64.f);
    float q = 0.f;
#pragma unroll
    for (int i = 0; i < 16; ++i) { const float d = y[i] - mean; q += d * d; }
    q = red4(q);
    const float rstd = rsqrtf(q * (1.f / 64.f) + 64e-5f);
    const float bonus = BN0[(size_t)row * 16 + head] + BN1[(size_t)row * 16 + head];
    h8 o0, o1;
#pragma unroll
    for (int i = 0; i < 16; ++i) {
      const float lg = p.rw_lng[c0 + i], lb = p.rw_lnb[c0 + i];
      const float r = ((y[i] - mean) * rstd * lg + lb + bonus * vv[i]) * gg[i];
      if (i < 8) o0[i] = (half_t)r; else o1[i - 8] = (half_t)r;
    }
    *(h8*)(Z1 + o) = o0;
    *(h8*)(Z1 + o + 8) = o1;
  }
}

#define NPHASE 18
__global__ void __launch_bounds__(512) mega(P p_in, int ph_lo, int ph_hi) {
  __shared__ __attribute__((aligned(16))) char smem[SMEM_BYTES];
  cg::grid_group grid = cg::this_grid();
  const P& p = p_in;
  for (int ph = ph_lo; ph < ph_hi; ++ph) {
    char* ws = p_in.ws + opaque_zero();
    int kind = 2, arg = 0;
    size_t oA = 0, oB = 0, oC = 0;
    int lda = 1024, ldb = 1024, K = 1024, ldc = 1024, epi = 0, nMt = 136, nNt = 8, feat = 0;
    switch (ph) {
      case 0: kind = 0; break;
      case 1: kind = 1; arg = 0; break;
      case 2: oA = OFF_A0; oB = OFF_WIN; oC = OFF_U; ldc = 2048; nNt = 8; feat = 2; break;
      case 3: kind = 3; break;
      case 4: oA = OFF_Z; oB = OFF_WOUT; oC = OFF_A1; nNt = 4; feat = 3; break;
      case 5: kind = 1; arg = 1; break;
      case 6: oA = OFF_A0; oB = OFF_M1; oC = OFF_F; ldc = 4096; nNt = 16; epi = 1; feat = 3; break;
      case 7: oA = OFF_F; lda = 4096; oB = OFF_M2; ldb = 4096; K = 4096; oC = OFF_A1; nNt = 4; feat = 3; break;
      case 8: kind = 1; arg = 2; break;
      case 9: kind = 4; break;
      case 10: oA = OFF_A0; oB = OFF_WR; oC = OFF_RR; nNt = 27; feat = 1; break;
      case 11: kind = 5; break;
      case 12: oA = OFF_L + 512; lda = 384; oB = OFF_G2; ldb = 128; K = 128; oC = OFF_Z1; nMt = 128; epi = 5; break;
      case 13: oA = OFF_Z1; oB = OFF_WO; oC = OFF_A1; nMt = 128; nNt = 4; feat = 3; break;
      case 14: kind = 1; arg = 3; break;
      case 15: oA = OFF_A0; oB = OFF_M1 + 8 * MIB; oC = OFF_F; ldc = 4096; nNt = 16; epi = 1; nMt = 128; feat = 3; break;
      case 16: oA = OFF_F; lda = 4096; oB = OFF_M2 + 8 * MIB; ldb = 4096; K = 4096; oC = OFF_A1; nMt = 128; nNt = 4; feat = 3; break;
      default: kind = 1; arg = 4; break;
    }
    if (kind == 2) {
      gemm_phase(p, (const half_t*)(ws + oA), lda, (const half_t*)(ws + oB), ldb, K, (half_t*)(ws + oC), ldc, epi, nMt, nNt, feat, smem);
    } else if (kind == 1) {
      phase_rowwise(p, arg);
    } else if (kind == 0) {
      phase_prep(p, smem);
    } else if (kind == 3) {
      for (int it = bidx(); it < 2176 + 1088; it += gridDim.x) {
        if (it < 2176) attn_item(p, it, smem); else pool_item(p, it - 2176);
      }
    } else if (kind == 4) {
      phase_shift(p);
    } else if (kind == 5) {
      for (int it = bidx(); it < 256; it += gridDim.x) scan_item(p, it, smem);
    } else {
      phase_readout(p);
    }
    if (ph + 1 < ph_hi) grid.sync();
  }
}

extern "C" void kernel_launch(void* const* d_in, const int* in_sizes, int n_in, void* d_out, int out_size, void* d_ws,
                              size_t ws_size, hipStream_t stream) {
  P p{};
  const float** pp = (const float**)&p;
  for (int i = 0; i < 32; ++i) pp[i] = (const float*)d_in[i];
  p.out = (float*)d_out;
  p.ws = (char*)d_ws;
  static int grid_blocks = 0;
  if (!grid_blocks) {
    int dev = 0, cus = 0, per_cu = 0;
    (void)hipGetDevice(&dev);
    (void)hipDeviceGetAttribute(&cus, hipDeviceAttributeMultiprocessorCount, dev);
    (void)hipOccupancyMaxActiveBlocksPerMultiprocessor(&per_cu, mega, 512, 0);
    if (per_cu < 1) per_cu = 1;
    grid_blocks = cus * per_cu;
  }
  int lo = 0, hi = NPHASE;
  void* args[] = {&p, &lo, &hi};
  hipError_t e = hipLaunchCooperativeKernel((void*)mega, dim3(grid_blocks), dim3(512), args, 0, stream);
  if (e != hipSuccess) fprintf(stderr, "cooperative launch failed: %s (grid %d)\n", hipGetErrorString(e), grid_blocks);
}
```

```cpp
#include <hip/hip_runtime.h>
#include <hip/hip_cooperative_groups.h>
#include <cstdio>
namespace cg = cooperative_groups;

typedef _Float16 half_t;
typedef _Float16 h8 __attribute__((ext_vector_type(8)));
typedef _Float16 h4 __attribute__((ext_vector_type(4)));
typedef _Float16 h2 __attribute__((ext_vector_type(2)));
typedef float f4 __attribute__((ext_vector_type(4)));

#define RL 32768
#define RC 2048
#define RT 34816
#define MIB (1ull << 20)
#define OFF_WIN (0 * MIB)
#define OFF_WOUT (4 * MIB)
#define OFF_M1 (7 * MIB)
#define OFF_M2 (23 * MIB)
#define OFF_WR (39 * MIB)
#define OFF_WK (41 * MIB)
#define OFF_WV (43 * MIB)
#define OFF_WO (45 * MIB)
#define OFF_L1 (47 * MIB)
#define OFF_W2 (48 * MIB)
#define OFF_A2 (48 * MIB + 256 * 1024)
#define OFF_G2 (48 * MIB + 512 * 1024)
#define OFF_MOD (49 * MIB)
#define OFF_BN (50 * MIB)
#define OFF_XC (54 * MIB)
#define OFF_A0 (62 * MIB)
#define OFF_A1 (130 * MIB)
#define OFF_BIG (198 * MIB)
#define OFF_U OFF_BIG
#define OFF_Z (334 * MIB)
#define OFF_F OFF_BIG
#define OFF_RR OFF_BIG
#define OFF_KK (266 * MIB)
#define OFF_VV (334 * MIB)
#define OFF_L (402 * MIB)
#define OFF_G OFF_BIG
#define OFF_Z1 (266 * MIB)

#define SMEM_BYTES 151552

struct P {
  const float *x, *c, *ctx, *c_ctx, *ada_w, *ada_b, *norm_g, *mlp_w1, *mlp_w2, *ev_w_in, *ev_w_out, *ev_pool_w,
      *ev_pool_scale, *ev_rpb, *rw_mu, *rw_wr, *rw_wk, *rw_wv, *rw_wo, *rw_w0, *rw_w1, *rw_w2, *rw_a0, *rw_a1, *rw_a2,
      *rw_g1, *rw_g2, *rw_kk, *rw_ka, *rw_rk, *rw_lng, *rw_lnb;
  float* out;
  char* ws;
};

__device__ __forceinline__ int tidx() { int v = threadIdx.x; asm volatile("" : "+v"(v)); return v; }
__device__ __forceinline__ int bidx() { int v = blockIdx.x; asm volatile("" : "+s"(v)); return v; }
__device__ __forceinline__ size_t opaque_zero() { size_t z = 0; asm volatile("" : "+s"(z)); return z; }
__device__ __forceinline__ float opaque_f(float v) { asm volatile("" : "+v"(v)); return v; }
__device__ __forceinline__ float sigm(float x) { return 1.f / (1.f + __expf(-x)); }
__device__ __forceinline__ float bperm(float v, int srclane) {
  return __builtin_bit_cast(float, __builtin_amdgcn_ds_bpermute(srclane << 2, __builtin_bit_cast(int, v)));
}
template <int CTRL>
__device__ __forceinline__ float dpp(float x) {
  return __builtin_bit_cast(float, __builtin_amdgcn_mov_dpp(__builtin_bit_cast(int, x), CTRL, 0xf, 0xf, true));
}
__device__ __forceinline__ float red4(float x) { x += dpp<0xB1>(x); x += dpp<0x4E>(x); return x; }
__device__ __forceinline__ float red8(float x) { x = red4(x); x += dpp<0x141>(x); return x; }
__device__ __forceinline__ float red16(float x) { x = red8(x); x += dpp<0x140>(x); return x; }
__device__ __forceinline__ float wave_sum(float v, int lane) {
  v = red16(v);
  v += bperm(v, lane ^ 16);
  v += bperm(v, lane ^ 32);
  return v;
}

struct GemmTile {
  const half_t* A; const half_t* A2; const float* mu; int lda;
  const half_t* Bt; int ldb; int K;
  half_t* C; int ldc; int epi;
  int row0, col0;
  const P* pp;
};

template <bool MIX>
__device__ __forceinline__ void gemm_tile(const GemmTile& g, char* smem) {
  half_t* As = (half_t*)smem;
  half_t* Bs = (half_t*)(smem + 73728);
  const int tid = tidx(), lane = tid & 63, w = tid >> 6;
  const int wm = w >> 1, wn = w & 1, lr = lane & 15, lq = lane >> 4;
  const int ldr = tid >> 3, ldk = (tid & 7) * 8;
  f4 acc[4][4];
#pragma unroll
  for (int i = 0; i < 4; ++i)
#pragma unroll
    for (int j = 0; j < 4; ++j) acc[i][j] = (f4){0.f, 0.f, 0.f, 0.f};
  uint4 ra0, ra1, ra2, ra3, rb0, rb1;
  uint4 rx0, rx1, rx2, rx3;
  float4 mu0, mu1;
  const int nk = g.K >> 6;
  const half_t* Ap = g.A + (size_t)ldr * g.lda + ldk;
  const half_t* A2p = MIX ? g.A2 + (size_t)ldr * g.lda + ldk : nullptr;
  const float* mup = MIX ? g.mu + ldk : nullptr;
  const half_t* Bp = g.Bt + (size_t)ldr * g.ldb + ldk;
  const size_t astep = (size_t)64 * g.lda, bstep = (size_t)64 * g.ldb;
  half_t* asw = As + ldr * 72 + ldk;
  half_t* bsw = Bs + ldr * 72 + ldk;
  const half_t* asr = As + (wm * 64 + lr) * 72 + lq * 8;
  const half_t* bsr = Bs + (wn * 64 + lr) * 72 + lq * 8;

#define GLOAD(kt)                                              \
  {                                                            \
    const int k0 = (kt) * 64;                                  \
    ra0 = *(const uint4*)(Ap + k0);                            \
    ra1 = *(const uint4*)(Ap + astep + k0);                    \
    ra2 = *(const uint4*)(Ap + 2 * astep + k0);                \
    ra3 = *(const uint4*)(Ap + 3 * astep + k0);                \
    rb0 = *(const uint4*)(Bp + k0);                            \
    rb1 = *(const uint4*)(Bp + bstep + k0);                    \
    if (MIX) {                                                 \
      rx0 = *(const uint4*)(A2p + k0);                         \
      rx1 = *(const uint4*)(A2p + astep + k0);                 \
      rx2 = *(const uint4*)(A2p + 2 * astep + k0);             \
      rx3 = *(const uint4*)(A2p + 3 * astep + k0);             \
      mu0 = *(const float4*)(mup + k0);                        \
      mu1 = *(const float4*)(mup + k0 + 4);                    \
    }                                                          \
  }
#define MIXV(r, x) __builtin_bit_cast(uint4, (h8)(__builtin_bit_cast(h8, r) + __builtin_bit_cast(h8, x) * m))
#define SSTORE(buf)                                            \
  {                                                            \
    half_t* as = asw + (buf) * (256 * 72);                     \
    half_t* bs = bsw + (buf) * (128 * 72);                     \
    if (MIX) {                                                 \
      h8 m;                                                    \
      m[0] = (half_t)mu0.x; m[1] = (half_t)mu0.y; m[2] = (half_t)mu0.z; m[3] = (half_t)mu0.w; \
      m[4] = (half_t)mu1.x; m[5] = (half_t)mu1.y; m[6] = (half_t)mu1.z; m[7] = (half_t)mu1.w; \
      ra0 = MIXV(ra0, rx0); ra1 = MIXV(ra1, rx1); ra2 = MIXV(ra2, rx2); ra3 = MIXV(ra3, rx3); \
    }                                                          \
    *(uint4*)(as) = ra0;                                       \
    *(uint4*)(as + 64 * 72) = ra1;                             \
    *(uint4*)(as + 128 * 72) = ra2;                            \
    *(uint4*)(as + 192 * 72) = ra3;                            \
    *(uint4*)(bs) = rb0;                                       \
    *(uint4*)(bs + 64 * 72) = rb1;                             \
  }

  GLOAD(0);
  SSTORE(0);
  __syncthreads();
  for (int kt = 0; kt < nk; ++kt) {
    const bool more = kt + 1 < nk;
    if (more) GLOAD(kt + 1);
    __builtin_amdgcn_sched_barrier(0);
    {
      const half_t* as = asr + (kt & 1) * (256 * 72);
      const half_t* bs = bsr + (kt & 1) * (128 * 72);
#pragma unroll
      for (int ks = 0; ks < 2; ++ks) {
        h8 a[4], b[4];
#pragma unroll
        for (int i = 0; i < 4; ++i) {
          a[i] = *(const h8*)(as + i * 16 * 72 + ks * 32);
          b[i] = *(const h8*)(bs + i * 16 * 72 + ks * 32);
        }
#pragma unroll
        for (int mt = 0; mt < 4; ++mt)
#pragma unroll
          for (int nt = 0; nt < 4; ++nt)
            acc[mt][nt] = __builtin_amdgcn_mfma_f32_16x16x32_f16(b[nt], a[mt], acc[mt][nt], 0, 0, 0);
      }
    }
    if (more) SSTORE((kt + 1) & 1);
    __syncthreads();
  }
#undef GLOAD
#undef SSTORE
#undef MIXV
#pragma unroll
  for (int mt = 0; mt < 4; ++mt) {
    half_t* cp = g.C + (size_t)(wm * 64 + mt * 16 + lr) * g.ldc + wn * 64 + lq * 4;
#pragma unroll
    for (int nt = 0; nt < 4; ++nt) {
      h4 o;
#pragma unroll
      for (int j = 0; j < 4; ++j) {
        float v = acc[mt][nt][j];
        if (g.epi == 1) { v = fmaxf(v, 0.f); v = v * v; }
        else if (g.epi == 2) v = 1.f - 2.f / (__expf(2.f * v) + 1.f);
        else if (g.epi == 3) v = sigm(v);
        o[j] = (half_t)v;
      }
      *(h4*)(cp + nt * 16) = o;
    }
  }
}

__device__ __forceinline__ void gemm_tile2(const GemmTile& g, char* smem) {
  half_t* As = (half_t*)smem;
  half_t* Bs = (half_t*)(smem + 73728);
  const int tid = tidx(), lane = tid & 63, w = tid >> 6;
  const int wm = w >> 1, wn = w & 1, lr = lane & 15, lq = lane >> 4;
  const int ldr = tid >> 3, ldk = (tid & 7) * 8;
  f4 acc[4][4];
#pragma unroll
  for (int i = 0; i < 4; ++i)
#pragma unroll
    for (int j = 0; j < 4; ++j) acc[i][j] = (f4){0.f, 0.f, 0.f, 0.f};
  uint4 xa0, xa1, xa2, xa3, xb0, xb1;
  uint4 ya0, ya1, ya2, ya3, yb0, yb1;
  const int nk = g.K >> 6;
  const half_t* Ap = g.A + (size_t)ldr * g.lda + ldk;
  const half_t* Bp = g.Bt + (size_t)ldr * g.ldb + ldk;
  const size_t astep = (size_t)64 * g.lda, bstep = (size_t)64 * g.ldb;
  half_t* asw = As + ldr * 72 + ldk;
  half_t* bsw = Bs + ldr * 72 + ldk;
  const half_t* asr = As + (wm * 64 + lr) * 72 + lq * 8;
  const half_t* bsr = Bs + (wn * 64 + lr) * 72 + lq * 8;
#define GLD(S, kt)                                   \
  {                                                  \
    const int k0 = (kt) * 64;                        \
    S##a0 = *(const uint4*)(Ap + k0);                \
    S##a1 = *(const uint4*)(Ap + astep + k0);        \
    S##a2 = *(const uint4*)(Ap + 2 * astep + k0);    \
    S##a3 = *(const uint4*)(Ap + 3 * astep + k0);    \
    S##b0 = *(const uint4*)(Bp + k0);                \
    S##b1 = *(const uint4*)(Bp + bstep + k0);        \
  }
#define SST(S, buf)                                  \
  {                                                  \
    half_t* as = asw + (buf) * (256 * 72);           \
    half_t* bs = bsw + (buf) * (128 * 72);           \
    *(uint4*)(as) = S##a0;                           \
    *(uint4*)(as + 64 * 72) = S##a1;                 \
    *(uint4*)(as + 128 * 72) = S##a2;                \
    *(uint4*)(as + 192 * 72) = S##a3;                \
    *(uint4*)(bs) = S##b0;                           \
    *(uint4*)(bs + 64 * 72) = S##b1;                 \
  }
#define CMP(buf)                                                                                     \
  {                                                                                                  \
    const half_t* as = asr + (buf) * (256 * 72);                                                     \
    const half_t* bs = bsr + (buf) * (128 * 72);                                                     \
    _Pragma("unroll") for (int ks = 0; ks < 2; ++ks) {                                               \
      h8 a[4], b[4];                                                                                 \
      _Pragma("unroll") for (int i = 0; i < 4; ++i) {                                                \
        a[i] = *(const h8*)(as + i * 16 * 72 + ks * 32);                                             \
        b[i] = *(const h8*)(bs + i * 16 * 72 + ks * 32);                                             \
      }                                                                                              \
      _Pragma("unroll") for (int mt = 0; mt < 4; ++mt)                                               \
        _Pragma("unroll") for (int nt = 0; nt < 4; ++nt)                                             \
          acc[mt][nt] = __builtin_amdgcn_mfma_f32_16x16x32_f16(b[nt], a[mt], acc[mt][nt], 0, 0, 0);  \
    }                                                                                                \
  }
  GLD(x, 0);
  SST(x, 0);
  if (nk > 1) GLD(x, 1);
  if (nk > 2) GLD(y, 2);
  __syncthreads();
  for (int kt = 0; kt < nk; kt += 2) {
    CMP(0);
    if (kt + 1 < nk) SST(x, 1);
    if (kt + 3 < nk) GLD(x, kt + 3);
    __syncthreads();
    CMP(1);
    if (kt + 2 < nk) SST(y, 0);
    if (kt + 4 < nk) GLD(y, kt + 4);
    __syncthreads();
  }
#undef GLD
#undef SST
#undef CMP
#pragma unroll
  for (int mt = 0; mt < 4; ++mt) {
    half_t* cp = g.C + (size_t)(wm * 64 + mt * 16 + lr) * g.ldc + wn * 64 + lq * 4;
#pragma unroll
    for (int nt = 0; nt < 4; ++nt) {
      h4 o;
#pragma unroll
      for (int j = 0; j < 4; ++j) {
        float v = acc[mt][nt][j];
        if (g.epi == 1) { v = fmaxf(v, 0.f); v = v * v; }
        o[j] = (half_t)v;
      }
      *(h4*)(cp + nt * 16) = o;
    }
  }
}

__device__ __forceinline__ void gemm_tile3(const GemmTile& g, char* smem) {
  const int tid = tidx(), lane = tid & 63, w = tid >> 6;
  const int wm = w >> 1, wn = w & 1, lr = lane & 15, lq = lane >> 4;
  f4 acc[4][4];
#pragma unroll
  for (int i = 0; i < 4; ++i)
#pragma unroll
    for (int j = 0; j < 4; ++j) acc[i][j] = (f4){0.f, 0.f, 0.f, 0.f};
  const int nk = g.K >> 6;
  const int lrow = lane >> 3, lslot = lane & 7;
  const half_t* Ag[4];
  const half_t* Bg[2];
#pragma unroll
  for (int i = 0; i < 4; ++i) {
    const int row = (w * 4 + i) * 8 + lrow;
    Ag[i] = g.A + (size_t)row * g.lda + ((lslot ^ ((row >> 1) & 7)) * 8);
  }
#pragma unroll
  for (int i = 0; i < 2; ++i) {
    const int row = (w * 2 + i) * 8 + lrow;
    Bg[i] = g.Bt + (size_t)row * g.ldb + ((lslot ^ ((row >> 1) & 7)) * 8);
  }
  char* aw = smem + (w * 4) * 1024 + lane * 16;
  char* bw = smem + 32768 + (w * 2) * 1024 + lane * 16;
  const int swz = (lr >> 1) & 7;
  const int ko0 = ((0 + lq) ^ swz) * 16, ko1 = ((4 + lq) ^ swz) * 16;
  const char* ar = smem + (wm * 64 + lr) * 128;
  const char* br = smem + 32768 + (wn * 64 + lr) * 128;
#define ISSUE(kt, st)                                                                                      \
  {                                                                                                        \
    _Pragma("unroll") for (int i = 0; i < 4; ++i)                                                          \
      __builtin_amdgcn_global_load_lds((const unsigned*)(Ag[i] + (kt) * 64), (unsigned*)(aw + (st) * 49152 + i * 1024), 16, 0, 0); \
    _Pragma("unroll") for (int i = 0; i < 2; ++i)                                                          \
      __builtin_amdgcn_global_load_lds((const unsigned*)(Bg[i] + (kt) * 64), (unsigned*)(bw + (st) * 49152 + i * 1024), 16, 0, 0); \
  }
  ISSUE(0, 0);
  if (nk > 1) {
    ISSUE(1, 1);
    asm volatile("s_waitcnt vmcnt(6)" ::: "memory");
  } else {
    asm volatile("s_waitcnt vmcnt(0)" ::: "memory");
  }
  __builtin_amdgcn_s_barrier();
  asm volatile("" ::: "memory");
  h8 a0[4], b0[4], a1[4], b1[4];
#define LDF(fa, fb, stg, ko)                                             \
  {                                                                      \
    const char* as = ar + (stg) * 49152 + (ko);                          \
    const char* bs = br + (stg) * 49152 + (ko);                          \
    _Pragma("unroll") for (int i = 0; i < 4; ++i) {                      \
      fa[i] = *(const h8*)(as + i * 2048);                               \
      fb[i] = *(const h8*)(bs + i * 2048);                               \
    }                                                                    \
  }
#define MMA(fa, fb)                                                      \
  {                                                                      \
    _Pragma("unroll") for (int mt = 0; mt < 4; ++mt)                     \
      _Pragma("unroll") for (int nt = 0; nt < 4; ++nt)                   \
        acc[mt][nt] = __builtin_amdgcn_mfma_f32_16x16x32_f16(fb[nt], fa[mt], acc[mt][nt], 0, 0, 0); \
  }
  LDF(a0, b0, 0, ko0);
  int st = 0;
  for (int kt = 0; kt < nk; ++kt) {
    const bool more = kt + 2 < nk;
    int st1 = st + 1; if (st1 >= 3) st1 -= 3;
    int st2 = st + 2; if (st2 >= 3) st2 -= 3;
    if (more) ISSUE(kt + 2, st2);
    LDF(a1, b1, st, ko1);
    __builtin_amdgcn_sched_barrier(0);
    MMA(a0, b0);
    __builtin_amdgcn_sched_barrier(0);
    if (more) asm volatile("s_waitcnt vmcnt(6) lgkmcnt(0)" ::: "memory");
    else asm volatile("s_waitcnt vmcnt(0) lgkmcnt(0)" ::: "memory");
    __builtin_amdgcn_s_barrier();
    asm volatile("" ::: "memory");
    if (kt + 1 < nk) LDF(a0, b0, st1, ko0);
    __builtin_amdgcn_sched_barrier(0);
    MMA(a1, b1);
    __builtin_amdgcn_sched_barrier(0);
    st = st1;
  }
#undef LDF
#undef MMA
#undef ISSUE
  if (g.epi == 5) {
    const P& p = *g.pp;
    char* ws = p.ws + opaque_zero();
    const half_t* Y0 = (const half_t*)(ws + OFF_A0);
    const half_t* Y1 = (const half_t*)(ws + OFF_A1);
    const half_t* VVp = (const half_t*)(ws + OFF_VV);
    const float* BN0 = (const float*)(ws + OFF_BN);
    const float* BN1 = BN0 + (size_t)RL * 16;
    half_t* Z1 = (half_t*)(ws + OFF_Z1);
    const int head = (g.col0 >> 6) + wn;
#pragma unroll 1
    for (int mt = 0; mt < 4; ++mt) {
      const int row = g.row0 + wm * 64 + mt * 16 + lr;
      const size_t base = (size_t)row * 1024 + head * 64 + lq * 4;
      float y[4][4], vv[4][4];
      float sm = 0.f;
#pragma unroll
      for (int nt = 0; nt < 4; ++nt) {
        const h4 ya = *(const h4*)(Y0 + base + nt * 16);
        const h4 yb = *(const h4*)(Y1 + base + nt * 16);
        const h4 vh = *(const h4*)(VVp + base + nt * 16);
#pragma unroll
        for (int j = 0; j < 4; ++j) { y[nt][j] = (float)ya[j] + (float)yb[j]; vv[nt][j] = (float)vh[j]; sm += y[nt][j]; }
      }
      sm += bperm(sm, lane ^ 16);
      sm += bperm(sm, lane ^ 32);
      const float mean = sm * (1.f / 64.f);
      float q = 0.f;
#pragma unroll
      for (int nt = 0; nt < 4; ++nt)
#pragma unroll
        for (int j = 0; j < 4; ++j) { const float d = y[nt][j] - mean; q += d * d; }
      q += bperm(q, lane ^ 16);
      q += bperm(q, lane ^ 32);
      const float rstd = rsqrtf(q * (1.f / 64.f) + 64e-5f);
      const float bonus = BN0[(size_t)row * 16 + head] + BN1[(size_t)row * 16 + head];
#pragma unroll
      for (int nt = 0; nt < 4; ++nt) {
        const int ch = head * 64 + nt * 16 + lq * 4;
        const float4 lg = *(const float4*)(p.rw_lng + ch);
        const float4 lb = *(const float4*)(p.rw_lnb + ch);
        const float lgv[4] = {lg.x, lg.y, lg.z, lg.w}, lbv[4] = {lb.x, lb.y, lb.z, lb.w};
        const f4 gv = mt == 0 ? acc[0][nt] : (mt == 1 ? acc[1][nt] : (mt == 2 ? acc[2][nt] : acc[3][nt]));
        h4 o;
#pragma unroll
        for (int j = 0; j < 4; ++j) o[j] = (half_t)(((y[nt][j] - mean) * rstd * lgv[j] + lbv[j] + bonus * vv[nt][j]) * gv[j]);
        *(h4*)(Z1 + base + nt * 16) = o;
      }
    }
    return;
  }
  if (g.epi == 4) {
    half_t* vp = g.C + (size_t)((wm * 8 + wn) * 64) * 64 + lr;
#pragma unroll
    for (int mt = 0; mt < 4; ++mt)
#pragma unroll
      for (int nt = 0; nt < 4; ++nt)
#pragma unroll
        for (int j = 0; j < 4; ++j) vp[(nt * 16 + lq * 4 + j) * 64 + mt * 16] = (half_t)acc[mt][nt][j];
    return;
  }
#pragma unroll
  for (int mt = 0; mt < 4; ++mt) {
    half_t* cp = g.C + (size_t)(wm * 64 + mt * 16 + lr) * g.ldc + wn * 64 + lq * 4;
#pragma unroll
    for (int nt = 0; nt < 4; ++nt) {
      h4 o;
#pragma unroll
      for (int j = 0; j < 4; ++j) {
        float v = acc[mt][nt][j];
        if (g.epi == 1) { v = fmaxf(v, 0.f); v = v * v; }
        o[j] = (half_t)v;
      }
      *(h4*)(cp + nt * 16) = o;
    }
  }
}

__device__ __forceinline__ void gemm_tile4(const GemmTile& g, char* smem) {
  const int tid = tidx(), lane = tid & 63, w = tid >> 6;
  const int wm = w >> 1, wn = w & 1, lr = lane & 15, lq = lane >> 4;
  f4 acc[4][8];
#pragma unroll
  for (int i = 0; i < 4; ++i)
#pragma unroll
    for (int j = 0; j < 8; ++j) acc[i][j] = (f4){0.f, 0.f, 0.f, 0.f};
  const int nk = g.K >> 6;
  const int lrow = lane >> 3, lslot = lane & 7;
  const half_t* Ag[4];
  const half_t* Bg[4];
#pragma unroll
  for (int i = 0; i < 4; ++i) {
    const int row = (w * 4 + i) * 8 + lrow;
    const int so = (lslot ^ ((row >> 1) & 7)) * 8;
    Ag[i] = g.A + (size_t)row * g.lda + so;
    Bg[i] = g.Bt + (size_t)row * g.ldb + so;
  }
  char* aw = smem + (w * 4) * 1024 + lane * 16;
  char* bw = smem + 32768 + (w * 4) * 1024 + lane * 16;
  const int swz = (lr >> 1) & 7;
  const int ko0 = ((0 + lq) ^ swz) * 16, ko1 = ((4 + lq) ^ swz) * 16;
  const char* ar = smem + (wm * 64 + lr) * 128;
  const char* br = smem + 32768 + (wn * 128 + lr) * 128;
#define ISSUE4(kt, st)                                                                                     \
  {                                                                                                        \
    _Pragma("unroll") for (int i = 0; i < 4; ++i)                                                          \
      __builtin_amdgcn_global_load_lds((const unsigned*)(Ag[i] + (kt) * 64), (unsigned*)(aw + (st) * 65536 + i * 1024), 16, 0, 0); \
    _Pragma("unroll") for (int i = 0; i < 4; ++i)                                                          \
      __builtin_amdgcn_global_load_lds((const unsigned*)(Bg[i] + (kt) * 64), (unsigned*)(bw + (st) * 65536 + i * 1024), 16, 0, 0); \
  }
  ISSUE4(0, 0);
  asm volatile("s_waitcnt vmcnt(0)" ::: "memory");
  __builtin_amdgcn_s_barrier();
  asm volatile("" ::: "memory");
  for (int kt = 0; kt < nk; ++kt) {
    const int st = kt & 1;
    if (kt + 1 < nk) ISSUE4(kt + 1, st ^ 1);
    const char* as = ar + st * 65536;
    const char* bs = br + st * 65536;
#pragma unroll
    for (int ks = 0; ks < 2; ++ks) {
      const int ko = ks ? ko1 : ko0;
      h8 a[4], b[8];
#pragma unroll
      for (int i = 0; i < 4; ++i) a[i] = *(const h8*)(as + i * 2048 + ko);
#pragma unroll
      for (int i = 0; i < 8; ++i) b[i] = *(const h8*)(bs + i * 2048 + ko);
#pragma unroll
      for (int mt = 0; mt < 4; ++mt)
#pragma unroll
        for (int nt = 0; nt < 8; ++nt)
          acc[mt][nt] = __builtin_amdgcn_mfma_f32_16x16x32_f16(b[nt], a[mt], acc[mt][nt], 0, 0, 0);
    }
    asm volatile("s_waitcnt vmcnt(0) lgkmcnt(0)" ::: "memory");
    __builtin_amdgcn_s_barrier();
    asm volatile("" ::: "memory");
  }
#undef ISSUE4
  if (g.epi == 4) {
#pragma unroll
    for (int mt = 0; mt < 4; ++mt)
#pragma unroll
      for (int nt = 0; nt < 8; ++nt) {
        half_t* vp = g.C + (size_t)((wm * 8 + wn * 2 + (nt >> 2)) * 64) * 64 + lr;
#pragma unroll
        for (int j = 0; j < 4; ++j) vp[((nt & 3) * 16 + lq * 4 + j) * 64 + mt * 16] = (half_t)acc[mt][nt][j];
      }
    return;
  }
#pragma unroll
  for (int mt = 0; mt < 4; ++mt) {
    half_t* cp = g.C + (size_t)(wm * 64 + mt * 16 + lr) * g.ldc + wn * 128 + lq * 4;
#pragma unroll
    for (int nt = 0; nt < 8; ++nt) {
      h4 o;
#pragma unroll
      for (int j = 0; j < 4; ++j) {
        float v = acc[mt][nt][j];
        if (g.epi == 1) { v = fmaxf(v, 0.f); v = v * v; }
        o[j] = (half_t)v;
      }
      *(h4*)(cp + nt * 16) = o;
    }
  }
}

__device__ __forceinline__ int p8_lds_byte(int r, int c) {
  const int st = (r >> 4) * 2 + (c >> 5), rr = r & 15, cc = c & 31, ob = rr * 64 + cc * 2;
  return st * 1024 + (ob ^ (((ob >> 9) & 1) << 5));
}
__device__ __forceinline__ void p8_stage_rc(int b, int& R, int& C) {
  const int st = b / 1024, sb = b % 1024, swz = sb ^ (((sb >> 9) & 1) << 5);
  R = (st >> 1) * 16 + swz / 64;
  C = (st & 1) * 32 + (swz % 64) / 2;
}
__device__ __forceinline__ void gemm_tile8(const GemmTile& g, char* smem) {
  constexpr int HT = 128 * 64;
  half_t* shm = (half_t*)smem;
  const int tid = tidx();
  const int wid = tid >> 6, lane = tid & 63, wr = wid >> 2, wc = wid & 3, fr = lane & 15, fq = lane >> 4;
  const half_t* A = g.A;
  const half_t* Bt = g.Bt;
  const int lda = g.lda, ldb = g.lda;
#define P8_SA(b, h) (shm + ((b) * 2 + (h)) * HT)
#define P8_SB(b, h) (shm + (4 + (b) * 2 + (h)) * HT)
  int sr0, sc0, sr1, sc1;
  p8_stage_rc(tid * 16, sr0, sc0);
  p8_stage_rc(tid * 16 + 8192, sr1, sc1);
  const int ao0 = sr0 * lda + sc0, ao1 = sr1 * lda + sc1;
#define bo0 ao0
#define bo1 ao1
#define P8_STAGE_A(Pp, br, kt)                                                                                   \
  {                                                                                                              \
    const half_t* gb_ = A + (size_t)(br) * lda + (size_t)(kt) * 64;                                              \
    __builtin_amdgcn_global_load_lds((const unsigned*)(gb_ + ao0), (unsigned*)((char*)(Pp) + tid * 16), 16, 0, 0);        \
    __builtin_amdgcn_global_load_lds((const unsigned*)(gb_ + ao1), (unsigned*)((char*)(Pp) + tid * 16 + 8192), 16, 0, 0); \
  }
#define P8_STAGE_B(Pp, br, kt)                                                                                   \
  {                                                                                                              \
    const half_t* gb_ = Bt + (size_t)(br) * ldb + (size_t)(kt) * 64;                                             \
    __builtin_amdgcn_global_load_lds((const unsigned*)(gb_ + bo0), (unsigned*)((char*)(Pp) + tid * 16), 16, 0, 0);        \
    __builtin_amdgcn_global_load_lds((const unsigned*)(gb_ + bo1), (unsigned*)((char*)(Pp) + tid * 16 + 8192), 16, 0, 0); \
  }
  const char* abase = smem + p8_lds_byte(wr * 64 + fr, fq * 8);
  const char* bbase = smem + 4 * HT * 2 + p8_lds_byte(wc * 32 + fr, fq * 8);
#define P8_LDA(dst, b, h)                                                                                        \
  _Pragma("unroll") for (int m = 0; m < 4; ++m) _Pragma("unroll") for (int k = 0; k < 2; ++k)                    \
      dst[m][k] = *(const h8*)(abase + ((b) * 2 + (h)) * (HT * 2) + (m * 2 + k) * 1024);
#define P8_LDB(dst, b, h)                                                                                        \
  _Pragma("unroll") for (int n = 0; n < 2; ++n) _Pragma("unroll") for (int k = 0; k < 2; ++k)                    \
      dst[n][k] = *(const h8*)(bbase + ((b) * 2 + (h)) * (HT * 2) + (n * 2 + k) * 1024);
#define P8_MMA(ai, bj, Af, Bf)                                                                                   \
  {                                                                                                              \
    __builtin_amdgcn_s_setprio(1);                                                                               \
    _Pragma("unroll") for (int m = 0; m < 4; ++m) _Pragma("unroll") for (int n = 0; n < 2; ++n)                  \
        _Pragma("unroll") for (int k = 0; k < 2; ++k)                                                            \
            acc[ai][bj][m][n] = __builtin_amdgcn_mfma_f32_16x16x32_f16(Bf[n][k], Af[m][k], acc[ai][bj][m][n], 0, 0, 0); \
    __builtin_amdgcn_s_setprio(0);                                                                               \
  }
#define P8_WAIT_V(n) asm volatile("s_waitcnt vmcnt(" #n ")" ::: "memory")
#define P8_WAIT_L(n) asm volatile("s_waitcnt lgkmcnt(" #n ")" ::: "memory")
#define P8_BAR __builtin_amdgcn_s_barrier()
#define P8_SCHED __builtin_amdgcn_sched_barrier(0)

  f4 acc[2][2][4][2];
#pragma unroll
  for (int i0 = 0; i0 < 2; ++i0)
#pragma unroll
    for (int i1 = 0; i1 < 2; ++i1)
#pragma unroll
      for (int i2 = 0; i2 < 4; ++i2)
#pragma unroll
        for (int i3 = 0; i3 < 2; ++i3) acc[i0][i1][i2][i3] = (f4){0.f, 0.f, 0.f, 0.f};
  h8 At[4][2], B0[2][2], B1[2][2];
  const int nt = g.K >> 6;
  P8_STAGE_B(P8_SB(0, 0), 0, 0); P8_STAGE_A(P8_SA(0, 0), 0, 0);
  P8_STAGE_B(P8_SB(0, 1), 128, 0); P8_STAGE_A(P8_SA(0, 1), 128, 0);
  if (wr == 1) P8_BAR;
  P8_WAIT_V(4); P8_BAR;
  P8_STAGE_B(P8_SB(1, 0), 0, 1); P8_STAGE_A(P8_SA(1, 0), 0, 1); P8_STAGE_B(P8_SB(1, 1), 128, 1);
  P8_WAIT_V(6); P8_BAR;
  for (int t = 0; t < nt - 2; t += 2) {
    P8_LDB(B0, 0, 0); P8_SCHED; P8_LDA(At, 0, 0); P8_STAGE_A(P8_SA(1, 1), 128, t + 1);
    P8_WAIT_L(8); P8_BAR; P8_WAIT_L(0); P8_MMA(0, 0, At, B0); P8_BAR; P8_SCHED;
    P8_LDB(B1, 0, 1); P8_STAGE_B(P8_SB(0, 0), 0, t + 2);
    P8_BAR; P8_WAIT_L(0); P8_MMA(0, 1, At, B1); P8_BAR;
    P8_LDA(At, 0, 1); P8_STAGE_A(P8_SA(0, 0), 0, t + 2);
    P8_BAR; P8_WAIT_L(0); P8_MMA(1, 0, At, B0); P8_BAR; P8_SCHED;
    P8_STAGE_B(P8_SB(0, 1), 128, t + 2);
    P8_WAIT_V(6); P8_BAR; P8_MMA(1, 1, At, B1); P8_BAR;
    P8_LDB(B0, 1, 0); P8_SCHED; P8_LDA(At, 1, 0); P8_STAGE_A(P8_SA(0, 1), 128, t + 2);
    P8_WAIT_L(8); P8_BAR; P8_WAIT_L(0); P8_MMA(0, 0, At, B0); P8_BAR; P8_SCHED;
    P8_LDB(B1, 1, 1); P8_STAGE_B(P8_SB(1, 0), 0, t + 3);
    P8_BAR; P8_WAIT_L(0); P8_MMA(0, 1, At, B1); P8_BAR;
    P8_LDA(At, 1, 1); P8_STAGE_A(P8_SA(1, 0), 0, t + 3);
    P8_BAR; P8_WAIT_L(0); P8_MMA(1, 0, At, B0); P8_BAR; P8_SCHED;
    P8_STAGE_B(P8_SB(1, 1), 128, t + 3);
    P8_WAIT_V(6); P8_BAR; P8_MMA(1, 1, At, B1); P8_BAR;
  }
  {
    P8_LDB(B0, 0, 0); P8_LDA(At, 0, 0); P8_STAGE_A(P8_SA(1, 1), 128, nt - 1);
    P8_BAR; P8_WAIT_L(0); P8_MMA(0, 0, At, B0); P8_BAR;
    P8_LDB(B1, 0, 1); P8_BAR; P8_WAIT_L(0); P8_MMA(0, 1, At, B1); P8_BAR;
    P8_LDA(At, 0, 1); P8_WAIT_V(4); P8_BAR; P8_WAIT_L(0); P8_MMA(1, 0, At, B0); P8_MMA(1, 1, At, B1); P8_BAR;
  }
  {
    P8_LDB(B0, 1, 0); P8_LDA(At, 1, 0); P8_WAIT_V(2); P8_BAR; P8_WAIT_L(0); P8_MMA(0, 0, At, B0); P8_BAR;
    P8_LDB(B1, 1, 1); P8_WAIT_V(0); P8_BAR; P8_WAIT_L(0); P8_MMA(0, 1, At, B1); P8_BAR;
    P8_LDA(At, 1, 1); P8_BAR; P8_WAIT_L(0); P8_MMA(1, 0, At, B0); P8_MMA(1, 1, At, B1); P8_BAR;
  }
  if (wr == 0) P8_BAR;
  asm volatile("" ::: "memory");
#pragma unroll
  for (int ai = 0; ai < 2; ++ai)
#pragma unroll
    for (int m = 0; m < 4; ++m) {
      const int row = ai * 128 + wr * 64 + m * 16 + fr;
#pragma unroll
      for (int bj = 0; bj < 2; ++bj)
#pragma unroll
        for (int n = 0; n < 2; ++n) {
          const int col = bj * 128 + wc * 32 + n * 16 + fq * 4;
          if (g.epi == 4) {
            half_t* vp = g.C + (size_t)(((row >> 6) * 8 + (col >> 6)) * 64 + (col & 63)) * 64 + (row & 63);
#pragma unroll
            for (int j = 0; j < 4; ++j) vp[j * 64] = (half_t)acc[ai][bj][m][n][j];
          } else {
            h4 o;
#pragma unroll
            for (int j = 0; j < 4; ++j) {
              float v = acc[ai][bj][m][n][j];
              if (g.epi == 1) { v = fmaxf(v, 0.f); v = v * v; }
              o[j] = (half_t)v;
            }
            *(h4*)(g.C + (size_t)row * g.ldc + col) = o;
          }
        }
    }
#undef bo0
#undef bo1
#undef P8_SA
#undef P8_SB
#undef P8_STAGE_A
#undef P8_STAGE_B
#undef P8_LDA
#undef P8_LDB
#undef P8_MMA
#undef P8_WAIT_V
#undef P8_WAIT_L
#undef P8_BAR
#undef P8_SCHED
}

__device__ __forceinline__ void gemm_phase(const P& p, const half_t* A, int lda, const half_t* Bt, int ldb, int K, half_t* C, int ldc,
                                           int epi, int nMt, int nNt, int feat, char* smem) {
  char* ws = (p.ws + opaque_zero());
  const bool split = (feat >= 2 && nMt == 136);
  if (split) nMt = 128;
  const int nbig = nMt * nNt;
  const int total = nbig + (split ? 16 * nNt : 0), G = gridDim.x, per_xcd = G >> 3;
  for (int t0 = bidx(); t0 < total + G; t0 += G) {
    const int rnd = t0 / G, bb = t0 - rnd * G;
    const int t = ((G & 7) == 0) ? rnd * G + (bb & 7) * per_xcd + (bb >> 3) : t0;
    if (t >= total) continue;
    const bool small = t >= nbig;
    const int gsz = 8 * nNt, first = (t / gsz) * 8, gm = min(nMt - first, 8);
    const int mt = small ? 128 + ((t - nbig) & 7) : first + (t % gsz) % gm;
    const int nt = small ? (t - nbig) >> 3 : (t % gsz) / gm;
    GemmTile g;
    g.A = A + (size_t)mt * 256 * lda; g.A2 = nullptr; g.mu = nullptr; g.lda = lda;
    const int tw = (feat >= 2 && !small) ? 256 : 128;
    g.Bt = Bt + (size_t)nt * tw * ldb; g.ldb = ldb; g.K = K;
    g.C = C + (size_t)mt * 256 * ldc + nt * tw; g.ldc = ldc; g.epi = epi;
    g.row0 = mt * 256; g.col0 = nt * tw; g.pp = &p;
    if (feat == 2 && !small && nt >= 6) {
      g.epi = 4;
      g.C = (half_t*)(ws + OFF_A1) + ((size_t)(mt * 4) * 8 + (nt - 6) * 4) * 4096;
    }
    if (feat == 2 && small && nt >= 12) {
      g.epi = 4;
      g.C = (half_t*)(ws + OFF_A1) + ((size_t)(mt * 4) * 8 + (nt - 12) * 2) * 4096;
    }
    if (feat == 1) {
      g.A2 = (const half_t*)(ws + OFF_A1) + (size_t)mt * 256 * 1024;
      const int grp = nt >> 3, sub = nt & 7;
      int mixi;
      if (grp < 3) {
        mixi = grp == 0 ? 0 : (grp == 1 ? 2 : 3);
        g.Bt = (const half_t*)(ws + (grp == 0 ? OFF_WR : (grp == 1 ? OFF_WK : OFF_WV))) + (size_t)sub * 128 * 1024;
        g.C = (half_t*)(ws + (grp == 0 ? OFF_RR : (grp == 1 ? OFF_KK : OFF_VV))) + (size_t)mt * 256 * 1024 + sub * 128;
      } else {
        mixi = sub == 0 ? 1 : (sub == 1 ? 4 : 5);
        g.Bt = (const half_t*)(ws + OFF_L1) + (size_t)sub * 128 * 1024;
        g.C = (half_t*)(ws + OFF_L) + (size_t)mt * 256 * 384 + sub * 128;
        g.ldc = 384;
        g.epi = sub == 0 ? 2 : (sub == 1 ? 0 : 3);
      }
      g.mu = p.rw_mu + mixi * 1024;
    }
    if (feat == 1) gemm_tile<true>(g, smem); else if (feat >= 2 && !small) gemm_tile8(g, smem); else gemm_tile3(g, smem);
  }
}

__device__ void xpose_seg(const float* src, int ldsrc, int K, int N, half_t* dst, int lddst, int koff, int& base,
                          char* smem) {
  float* ts = (float*)smem;
  const int tid = tidx(), G = gridDim.x;
  const int tkn = K >> 6, tnn = N >> 6, cnt = tkn * tnn;
  int t0 = ((int)bidx() - (base % G) + G) % G;
  for (int t = t0; t < cnt; t += G) {
    const int k0 = (t % tkn) * 64, n0 = (t / tkn) * 64;
#pragma unroll
    for (int i = 0; i < 2; ++i) {
      const int c = tid + 512 * i, r = c >> 4, c4 = (c & 15) * 4;
      const float4 v = *(const float4*)(src + (size_t)(k0 + r) * ldsrc + n0 + c4);
      float* d = ts + r * 65 + c4;
      d[0] = v.x; d[1] = v.y; d[2] = v.z; d[3] = v.w;
    }
    __syncthreads();
    {
      const int n = tid >> 3, kc = (tid & 7) * 8;
      h8 o;
#pragma unroll
      for (int i = 0; i < 8; ++i) o[i] = (half_t)ts[(kc + i) * 65 + n];
      *(h8*)(dst + (size_t)(n0 + n) * lddst + koff + k0 + kc) = o;
    }
    __syncthreads();
  }
  base += cnt;
}

__device__ void phase_prep(const P& p, char* smem) {
  const int tid = tidx();
  char* ws = (p.ws + opaque_zero());
  float* MOD = (float*)(ws + OFF_MOD);
  if (bidx() < 192 || gridDim.x < 256) {
    float* sl = (float*)smem;
    for (int i = tid; i < 9216; i += 512) {
      const int b = i >> 10, k = i & 1023;
      const float cv = b < 8 ? p.c[b * 1024 + k] : p.c_ctx[k];
      sl[i] = cv / (1.f + __expf(-cv));
    }
    __syncthreads();
    float* red = sl + 9216;
    for (int item = bidx(); item < 192; item += gridDim.x) {
      const int l = item / 96, n0 = (item % 96) * 64, cn = tid & 63, kq = tid >> 6;
      float acc[9];
#pragma unroll
      for (int b = 0; b < 9; ++b) acc[b] = 0.f;
      const float* wp = p.ada_w + (size_t)l * 1024 * 6144 + n0 + cn;
#pragma unroll 4
      for (int k = kq * 128; k < kq * 128 + 128; ++k) {
        const float wv = wp[(size_t)k * 6144];
#pragma unroll
        for (int b = 0; b < 9; ++b) acc[b] += sl[b * 1024 + k] * wv;
      }
#pragma unroll
      for (int b = 0; b < 9; ++b) red[(kq * 9 + b) * 64 + cn] = acc[b];
      __syncthreads();
      for (int i = tid; i < 576; i += 512) {
        const int b = i >> 6, c = i & 63;
        float s = 0.f;
#pragma unroll
        for (int q = 0; q < 8; ++q) s += red[(q * 9 + b) * 64 + c];
        MOD[(size_t)(l * 9 + b) * 6144 + n0 + c] = s + p.ada_b[l * 6144 + n0 + c];
      }
      __syncthreads();
    }
  }
  for (int it = bidx(); it < 256; it += gridDim.x) {
    if (it < 192) continue;
    const int fi = it - 192, gi = fi >> 4, n0 = (fi & 15) * 64, n = tid & 63, ig = tid >> 6;
    float acc[16];
#pragma unroll
    for (int i = 0; i < 16; ++i) acc[i] = 0.f;
    for (int j = 0; j < 128; ++j) {
      const float wv = p.ev_w_out[(size_t)(gi * 128 + j) * 1024 + n0 + n] * p.ev_pool_scale[gi * 128 + j];
      const float* pw = p.ev_pool_w + ((size_t)gi * 128 + ig * 16) * 128 + j;
#pragma unroll
      for (int i = 0; i < 16; ++i) acc[i] += pw[i * 128] * wv;
    }
    h8 o0, o1;
#pragma unroll
    for (int i = 0; i < 8; ++i) { o0[i] = (half_t)acc[i]; o1[i] = (half_t)acc[8 + i]; }
    half_t* d = (half_t*)(ws + OFF_WOUT) + (size_t)(n0 + n) * 1024 + gi * 128 + ig * 16;
    *(h8*)d = o0;
    *(h8*)(d + 8) = o1;
  }
  __syncthreads();
  int base = 0;
  xpose_seg(p.ev_w_in, 2048, 1024, 2048, (half_t*)(ws + OFF_WIN), 1024, 0, base, smem);
  xpose_seg(p.ev_w_out + 512 * 1024, 1024, 512, 1024, (half_t*)(ws + OFF_WOUT), 1024, 512, base, smem);
  for (int l = 0; l < 2; ++l) {
    xpose_seg(p.mlp_w1 + (size_t)l * 1024 * 4096, 4096, 1024, 4096, (half_t*)(ws + OFF_M1 + l * 8 * MIB), 1024, 0, base, smem);
    xpose_seg(p.mlp_w2 + (size_t)l * 1024 * 4096, 1024, 4096, 1024, (half_t*)(ws + OFF_M2 + l * 8 * MIB), 4096, 0, base, smem);
  }
  xpose_seg(p.rw_wr, 1024, 1024, 1024, (half_t*)(ws + OFF_WR), 1024, 0, base, smem);
  xpose_seg(p.rw_wk, 1024, 1024, 1024, (half_t*)(ws + OFF_WK), 1024, 0, base, smem);
  xpose_seg(p.rw_wv, 1024, 1024, 1024, (half_t*)(ws + OFF_WV), 1024, 0, base, smem);
  xpose_seg(p.rw_wo, 1024, 1024, 1024, (half_t*)(ws + OFF_WO), 1024, 0, base, smem);
  for (int d = 0; d < 2; ++d) {
    xpose_seg(p.rw_w1 + (size_t)d * 1024 * 64, 64, 1024, 64, (half_t*)(ws + OFF_L1) + (size_t)(d * 64) * 1024, 1024, 0, base, smem);
    xpose_seg(p.rw_a1 + (size_t)d * 1024 * 64, 64, 1024, 64, (half_t*)(ws + OFF_L1) + (size_t)(128 + d * 64) * 1024, 1024, 0, base, smem);
    xpose_seg(p.rw_w2 + (size_t)d * 64 * 1024, 1024, 64, 1024, (half_t*)(ws + OFF_W2) + (size_t)d * 1024 * 64, 64, 0, base, smem);
    xpose_seg(p.rw_a2 + (size_t)d * 64 * 1024, 1024, 64, 1024, (half_t*)(ws + OFF_A2) + (size_t)d * 1024 * 64, 64, 0, base, smem);
  }
  xpose_seg(p.rw_g1, 128, 1024, 128, (half_t*)(ws + OFF_L1) + (size_t)256 * 1024, 1024, 0, base, smem);
  xpose_seg(p.rw_g2, 1024, 128, 1024, (half_t*)(ws + OFF_G2), 128, 0, base, smem);
}

__device__ void phase_rowwise(const P& p, int mode) {
  const int lane = tidx() & 63;
  const int gw = bidx() * 8 + (tidx() >> 6), nw = gridDim.x * 8;
  char* ws = (p.ws + opaque_zero());
  const float* MOD = (const float*)(ws + OFF_MOD);
  float* XC = (float*)(ws + OFF_XC);
  half_t* H = (half_t*)(ws + OFF_A0);
  const half_t* Y = (const half_t*)(ws + OFF_A1);
  const int nrows = (mode >= 3) ? RL : RT;
  const int per = (nrows + nw - 1) / nw;
  const int r0 = gw * per, r1 = min(r0 + per, nrows);
  if (r0 >= r1) return;
  const bool hasY = mode != 0, hasH = mode != 4;
  const float EPS = opaque_f(1e-6f);
  const int lyr = (mode <= 1) ? 0 : ((mode == 2) ? 0 : 1);
  const int gyi = (mode == 1) ? 1 : (mode == 2 ? 3 : (mode == 3 ? 5 : 7));
  const int gti = (mode == 1) ? 2 : (mode == 2 ? 5 : (mode == 3 ? 2 : 5));
  const int hl = (mode <= 1) ? 0 : 1;
  const int ghi = (mode == 0) ? 0 : (mode == 1 ? 2 : (mode == 2 ? 4 : 6));
  const int shi = (mode == 0 || mode == 2) ? 0 : 3;
  auto xsrc = [&](int row) -> const float* {
    if (mode <= 1) return row < RL ? p.x + (size_t)row * 1024 : p.ctx + (size_t)(row - RL) * 1024;
    return row < RL ? p.out + (size_t)row * 1024 : XC + (size_t)(row - RL) * 1024;
  };
  auto xdst = [&](int row) -> float* { return row < RL ? p.out + (size_t)row * 1024 : XC + (size_t)(row - RL) * 1024; };
  float4 gy[4], gt[4], gh[4], s1[4], s2[4];
  int cur_mi = -1;
  float4 nx[4];
  h4 ny[4];
  {
    const float* xs = xsrc(r0);
#pragma unroll
    for (int i = 0; i < 4; ++i) nx[i] = *(const float4*)(xs + i * 256 + lane * 4);
    if (hasY) {
#pragma unroll
      for (int i = 0; i < 4; ++i) ny[i] = *(const h4*)(Y + (size_t)r0 * 1024 + i * 256 + lane * 4);
    }
  }
  for (int row = r0; row < r1; ++row) {
    float xv[4][4];
    h4 yh[4];
#pragma unroll
    for (int i = 0; i < 4; ++i) { xv[i][0] = nx[i].x; xv[i][1] = nx[i].y; xv[i][2] = nx[i].z; xv[i][3] = nx[i].w; yh[i] = ny[i]; }
    if (row + 1 < r1) {
      const float* xs = xsrc(row + 1);
#pragma unroll
      for (int i = 0; i < 4; ++i) nx[i] = *(const float4*)(xs + i * 256 + lane * 4);
      if (hasY) {
#pragma unroll
        for (int i = 0; i < 4; ++i) ny[i] = *(const h4*)(Y + (size_t)(row + 1) * 1024 + i * 256 + lane * 4);
      }
    }
    const int mi = row < RL ? (row >> 12) : 8;
    if (mi != cur_mi) {
      cur_mi = mi;
      const float* mg = MOD + (size_t)(lyr * 9 + mi) * 6144;
      const float* mh = MOD + (size_t)(hl * 9 + mi) * 6144;
#pragma unroll
      for (int i = 0; i < 4; ++i) {
        const int o = i * 256 + lane * 4;
        if (hasY) { gy[i] = *(const float4*)(p.norm_g + gyi * 1024 + o); gt[i] = *(const float4*)(mg + gti * 1024 + o); }
        if (hasH) {
          gh[i] = *(const float4*)(p.norm_g + ghi * 1024 + o);
          s1[i] = *(const float4*)(mh + shi * 1024 + o);
          s2[i] = *(const float4*)(mh + (shi + 1) * 1024 + o);
        }
      }
    }
    if (hasY) {
      float yv[4][4];
      float ss = 0.f;
#pragma unroll
      for (int i = 0; i < 4; ++i)
#pragma unroll
        for (int k = 0; k < 4; ++k) { yv[i][k] = (float)yh[i][k]; ss += yv[i][k] * yv[i][k]; }
      ss = wave_sum(ss, lane);
      const float rs = rsqrtf(ss * (1.f / 1024.f) + EPS);
      float* xo = xdst(row);
#pragma unroll
      for (int i = 0; i < 4; ++i) {
        xv[i][0] += gt[i].x * (yv[i][0] * rs * gy[i].x);
        xv[i][1] += gt[i].y * (yv[i][1] * rs * gy[i].y);
        xv[i][2] += gt[i].z * (yv[i][2] * rs * gy[i].z);
        xv[i][3] += gt[i].w * (yv[i][3] * rs * gy[i].w);
        *(float4*)(xo + i * 256 + lane * 4) = make_float4(xv[i][0], xv[i][1], xv[i][2], xv[i][3]);
      }
    }
    if (hasH) {
      float ss = 0.f;
#pragma unroll
      for (int i = 0; i < 4; ++i)
#pragma unroll
        for (int k = 0; k < 4; ++k) ss += xv[i][k] * xv[i][k];
      ss = wave_sum(ss, lane);
      const float rs = rsqrtf(ss * (1.f / 1024.f) + EPS);
      half_t* ho = H + (size_t)row * 1024;
#pragma unroll
      for (int i = 0; i < 4; ++i) {
        h4 o;
        o[0] = (half_t)(xv[i][0] * rs * gh[i].x * (1.f + s2[i].x) + s1[i].x);
        o[1] = (half_t)(xv[i][1] * rs * gh[i].y * (1.f + s2[i].y) + s1[i].y);
        o[2] = (half_t)(xv[i][2] * rs * gh[i].z * (1.f + s2[i].z) + s1[i].z);
        o[3] = (half_t)(xv[i][3] * rs * gh[i].w * (1.f + s2[i].w) + s1[i].w);
        *(h4*)(ho + i * 256 + lane * 4) = o;
      }
    }
  }
}

__device__ __forceinline__ int clampi(int v, int lo, int hi) { return v < lo ? lo : (v > hi ? hi : v); }

__device__ void attn_item(const P& p, int item, char* smem) {
  half_t* Ks = (half_t*)smem;
  half_t* Vt = Ks + 2 * 64 * 72;
  float* rpbs = (float*)(smem + 36864);
  const int tid = tidx(), lane = tid & 63, w = tid >> 6, lr = lane & 15, lq = lane >> 4;
  const half_t* U = (const half_t*)((p.ws + opaque_zero()) + OFF_U);
  half_t* Z = (half_t*)((p.ws + opaque_zero()) + OFF_Z);
  const bool isctx = item >= 2048;
  int b, h, qrow, nlat = 0, start0 = 0, my_r = 0, my_start = 0, cw = 0, cs = 0, qcol = 0;
  if (!isctx) {
    b = item >> 8; h = (item >> 5) & 7;
    const int r0 = (item & 31) * 2;
    my_r = r0 + (w >> 2);
    const int cgp = w & 3;
    qcol = cgp * 16 + lr;
    qrow = b * 4096 + my_r * 64 + qcol;
    start0 = clampi(r0 - 4, 0, 56);
    const int start1 = clampi(r0 + 1 - 4, 0, 56);
    nlat = start1 + 8 - start0;
    my_start = clampi(my_r - 4, 0, 56);
    cw = clampi(cgp * 16 - 8, 0, 32);
    cs = clampi(qcol - 8, 0, 48);
  } else {
    const int it = item - 2048;
    b = it >> 4; h = (it >> 1) & 7;
    qrow = RL + b * 256 + (it & 1) * 128 + w * 16 + lr;
  }
  const int ntiles = nlat + 4;
  h8 qf[2];
#pragma unroll
  for (int ks = 0; ks < 2; ++ks) {
    h8 t = *(const h8*)(U + (size_t)qrow * 2048 + 512 + h * 64 + ks * 32 + lq * 8);
#pragma unroll
    for (int i = 0; i < 8; ++i) t[i] = t[i] * (half_t)0.125f;
    qf[ks] = t;
  }
  if (!isctx)
    for (int i = tid; i < 465; i += 512) rpbs[i] = p.ev_rpb[h * 465 + i];

  const int skey = tid >> 3, sd = (tid & 7) * 8;
  uint4 kA, vA, kB, vB;
  auto tile_row0 = [&](int i) -> int { return i < nlat ? b * 4096 + (start0 + i) * 64 : RL + b * 256 + (i - nlat) * 64; };
  const half_t* VTg = (const half_t*)((p.ws + opaque_zero()) + OFF_A1);
#define AT_GLOAD(kr, vr, i)                                                                            \
  {                                                                                                    \
    const int r0t = tile_row0(i);                                                                      \
    kr = *(const uint4*)(U + (size_t)(r0t + skey) * 2048 + 1024 + h * 64 + sd);                        \
    vr = *(const uint4*)(VTg + ((size_t)(r0t >> 6) * 8 + h) * 4096 + skey * 64 + sd);                  \
  }
#define AT_SSTORE(kr, vr, buf)                                                                         \
  {                                                                                                    \
    *(uint4*)(Ks + (buf) * 4608 + skey * 72 + sd) = kr;                                                \
    *(uint4*)(Vt + (buf) * 4608 + skey * 72 + sd) = vr;                                                \
  }
  f4 o[4];
#pragma unroll
  for (int i = 0; i < 4; ++i) o[i] = (f4){0.f, 0.f, 0.f, 0.f};
  const float NEG = opaque_f(-1e30f);
  float m = NEG, l = 0.f;

  AT_GLOAD(kA, vA, 0);
  AT_SSTORE(kA, vA, 0);
  AT_GLOAD(kA, vA, 1);
  AT_GLOAD(kB, vB, 2);
  __syncthreads();
  for (int i = 0; i < ntiles; ++i) {
    const int buf = i & 1;
    const bool lt = i < nlat;
    const int kr_abs = start0 + i;
    const bool active = !lt || (kr_abs >= my_start && kr_abs < my_start + 8);
    if (active) {
      const int npairs = lt ? 1 : 2;
      for (int pi = 0; pi < npairs; ++pi) {
        const int kb = lt ? cw : pi * 32;
        f4 s[2];
#pragma unroll
        for (int st = 0; st < 2; ++st) {
          f4 z = (f4){0.f, 0.f, 0.f, 0.f};
#pragma unroll
          for (int ks = 0; ks < 2; ++ks) {
            const h8 kf = *(const h8*)(Ks + buf * 4608 + (kb + st * 16 + lr) * 72 + ks * 32 + lq * 8);
            z = __builtin_amdgcn_mfma_f32_16x16x32_f16(kf, qf[ks], z, 0, 0, 0);
          }
          s[st] = z;
        }
        float tmax = NEG;
        if (lt) {
          const int dr = clampi(kr_abs - my_r + 7, 0, 14);
          float bias[2][4];
#pragma unroll
          for (int st = 0; st < 2; ++st)
#pragma unroll
            for (int j = 0; j < 4; ++j) {
              const int kc = kb + st * 16 + lq * 4 + j;
              bias[st][j] = rpbs[dr * 31 + clampi(kc - qcol + 15, 0, 30)];
            }
#pragma unroll
          for (int st = 0; st < 2; ++st)
#pragma unroll
            for (int j = 0; j < 4; ++j) {
              const int kc = kb + st * 16 + lq * 4 + j;
              const bool ok = (kc >= cs) && (kc < cs + 16);
              const float v = s[st][j] + bias[st][j];
              s[st][j] = ok ? v : NEG;
            }
        }
#pragma unroll
        for (int st = 0; st < 2; ++st)
#pragma unroll
          for (int j = 0; j < 4; ++j) tmax = fmaxf(tmax, s[st][j]);
        tmax = fmaxf(tmax, bperm(tmax, lane ^ 16));
        tmax = fmaxf(tmax, bperm(tmax, lane ^ 32));
        const float mn = fmaxf(m, tmax);
        const float alpha = __expf(m - mn);
        m = mn;
        h8 pb;
        float ps = 0.f;
#pragma unroll
        for (int st = 0; st < 2; ++st)
#pragma unroll
          for (int j = 0; j < 4; ++j) {
            const float e = __expf(s[st][j] - mn);
            ps += e;
            pb[st * 4 + j] = (half_t)e;
          }
        l = l * alpha + ps;
#pragma unroll
        for (int dt = 0; dt < 4; ++dt) {
          o[dt] = o[dt] * alpha;
          const half_t* vp = Vt + buf * 4608 + (dt * 16 + lr) * 72 + kb + lq * 4;
          const h4 v0 = *(const h4*)vp;
          const h4 v1 = *(const h4*)(vp + 16);
          h8 vf;
          vf[0] = v0[0]; vf[1] = v0[1]; vf[2] = v0[2]; vf[3] = v0[3];
          vf[4] = v1[0]; vf[5] = v1[1]; vf[6] = v1[2]; vf[7] = v1[3];
          o[dt] = __builtin_amdgcn_mfma_f32_16x16x32_f16(vf, pb, o[dt], 0, 0, 0);
        }
      }
    }
    if (i + 1 < ntiles) {
      if ((i + 1) & 1) {
        AT_SSTORE(kA, vA, 1);
        if (i + 3 < ntiles) AT_GLOAD(kA, vA, i + 3);
      } else {
        AT_SSTORE(kB, vB, 0);
        if (i + 3 < ntiles) AT_GLOAD(kB, vB, i + 3);
      }
    }
    __syncthreads();
  }
#undef AT_GLOAD
#undef AT_SSTORE
  l += bperm(l, lane ^ 16);
  l += bperm(l, lane ^ 32);
  const float inv = 1.f / l;
#pragma unroll
  for (int dt = 0; dt < 4; ++dt) {
    h4 ov;
#pragma unroll
    for (int j = 0; j < 4; ++j) ov[j] = (half_t)(o[dt][j] * inv);
    *(h4*)(Z + (size_t)qrow * 1024 + 512 + h * 64 + dt * 16 + lq * 4) = ov;
  }
}

template <int HW>
__device__ __forceinline__ void pool_rows(const float (&pre)[4][25], int tl0, int L, half_t* zp) {
#pragma unroll
  for (int r = 0; r < 8; ++r) {
    const int tl = tl0 + r;
    const int lo = max(tl - HW, 0), hi = min(tl + HW, L);
    const float inv = 1.f / (float)(hi - lo);
    h4 o;
#pragma unroll
    for (int c = 0; c < 4; ++c) {
      const float sum = pre[c][8 + r + HW] - pre[c][8 + r - HW];
      const float cur = pre[c][8 + r + 1] - pre[c][8 + r];
      o[c] = (half_t)(sum * inv - cur);
    }
    *(h4*)(zp + (size_t)r * 1024) = o;
  }
}

__device__ void pool_item(const P& p, int item) {
  const half_t* U = (const half_t*)((p.ws + opaque_zero()) + OFF_U);
  half_t* Z = (half_t*)((p.ws + opaque_zero()) + OFF_Z);
  const int tid = tidx();
  const int c4 = (tid & 127) * 4, gi = c4 >> 7;
  const int row0 = item * 32 + (tid >> 7) * 8;
  int s0, L;
  if (row0 < RL) { s0 = row0 & ~4095; L = 4096; } else { s0 = RL + ((row0 - RL) & ~255); L = 256; }
  const int tl0 = row0 - s0;
  float pre[4][25];
#pragma unroll
  for (int c = 0; c < 4; ++c) pre[c][0] = 0.f;
#pragma unroll
  for (int i = 0; i < 24; ++i) {
    const int tl = tl0 - 8 + i;
    h4 v;
    v[0] = (half_t)0.f; v[1] = (half_t)0.f; v[2] = (half_t)0.f; v[3] = (half_t)0.f;
    if (tl >= 0 && tl < L) v = *(const h4*)(U + (size_t)(s0 + tl) * 2048 + c4);
#pragma unroll
    for (int c = 0; c < 4; ++c) pre[c][i + 1] = (float)v[c];
  }
#pragma unroll
  for (int i = 0; i < 24; ++i)
#pragma unroll
    for (int c = 0; c < 4; ++c) pre[c][i + 1] += pre[c][i];
  half_t* zp = Z + (size_t)row0 * 1024 + c4;
  if (gi == 0) pool_rows<1>(pre, tl0, L, zp);
  else if (gi == 1) pool_rows<2>(pre, tl0, L, zp);
  else if (gi == 2) pool_rows<4>(pre, tl0, L, zp);
  else pool_rows<8>(pre, tl0, L, zp);
}

__device__ void phase_shift(const P& p) {
  const half_t* H = (const half_t*)((p.ws + opaque_zero()) + OFF_A0);
  half_t* XX = (half_t*)((p.ws + opaque_zero()) + OFF_A1);
  const size_t total = (size_t)RT * 128;
  for (size_t idx = (size_t)bidx() * 512 + tidx(); idx < total; idx += (size_t)gridDim.x * 512) {
    const int row = (int)(idx >> 7), c = (int)(idx & 127) * 8;
    bool st, en;
    if (row < RL) { st = (row & 4095) == 0; en = (row & 4095) == 4095; }
    else { st = ((row - RL) & 255) == 0; en = ((row - RL) & 255) == 255; }
    const h8 cur = *(const h8*)(H + (size_t)row * 1024 + c);
    h8 pv, nx;
#pragma unroll
    for (int i = 0; i < 8; ++i) { pv[i] = (half_t)0.f; nx[i] = (half_t)0.f; }
    if (!st) pv = *(const h8*)(H + (size_t)(row - 1) * 1024 + c);
    if (!en) nx = *(const h8*)(H + (size_t)(row + 1) * 1024 + c);
    h8 o;
#pragma unroll
    for (int i = 0; i < 8; ++i) o[i] = (half_t)(0.5f * ((float)pv[i] + (float)nx[i]) - (float)cur[i]);
    *(h8*)(XX + (size_t)row * 1024 + c) = o;
  }
}

#define CS_BYTES 13312
#define CS_G 0
#define CS_R 2304
#define CS_AT 4608
#define CS_BT 6656
#define CS_VT 8704
#define CS_M 10752
#define CS_BM 11264
#define CS_CM 11776
#define CS_DM 12288
#define CS_PREF 12800
#define CS_PEND 13056
#define SCR_BASE 106496
#define SCR_BYTES 5632

__device__ void scan_item(const P& p, int item, char* smem) {
  const int tid = tidx(), lane = tid & 63, w = tid >> 6, lr = lane & 15, lq = lane >> 4;
  const int b = item >> 5, h = (item >> 1) & 15, dir = item & 1;
  char* ws = (p.ws + opaque_zero());
  const half_t* RRp = (const half_t*)(ws + OFF_RR);
  const half_t* KKp = (const half_t*)(ws + OFF_KK);
  const half_t* VVp = (const half_t*)(ws + OFF_VV);
  const half_t* Lp = (const half_t*)(ws + OFF_L);
  half_t* Yd = (half_t*)(ws + (dir ? OFF_A1 : OFF_A0));
  float* BN = (float*)(ws + OFF_BN) + (size_t)dir * RL * 16;

  auto grow = [&](int pp) -> int {
    if (pp < 256) return RL + b * 256 + (dir ? 255 - pp : pp);
    const int t = pp - 256;
    return b * 4096 + (dir ? 4095 - t : t);
  };

  auto prep = [&](int c) {
    char* cs = smem + w * CS_BYTES;
    half_t* G_ = (half_t*)(cs + CS_G);
    half_t* R_ = (half_t*)(cs + CS_R);
    half_t* AT = (half_t*)(cs + CS_AT);
    half_t* BT = (half_t*)(cs + CS_BT);
    half_t* VT = (half_t*)(cs + CS_VT);
    half_t* Mm = (half_t*)(cs + CS_M);
    half_t* Bm = (half_t*)(cs + CS_BM);
    half_t* Cm = (half_t*)(cs + CS_CM);
    half_t* Dm = (half_t*)(cs + CS_DM);
    float* Pref = (float*)(cs + CS_PREF);
    float* Pend = (float*)(cs + CS_PEND);
    char* scr = smem + SCR_BASE + w * SCR_BYTES;
    half_t* A_ = (half_t*)scr;
    half_t* B_ = (half_t*)(scr + 2304);
    float* Am = (float*)(scr + 4608);
    const bool lat = c >= 16;
    const int p0 = c * 16;
    const int rowA = grow(p0 + lr);
    const half_t* lp = Lp + (size_t)rowA * 384 + dir * 64 + lq * 8;
    const h8 aw0 = *(const h8*)(lp), aw1 = *(const h8*)(lp + 32);
    const h8 aa0 = *(const h8*)(lp + 128), aa1 = *(const h8*)(lp + 160);
    float ss[4], bp[4];
    int rows[4];
#pragma unroll
    for (int j = 0; j < 4; ++j) { ss[j] = 0.f; bp[j] = 0.f; rows[j] = grow(p0 + lq * 4 + j); }
#pragma unroll 1
    for (int nt = 0; nt < 4; ++nt) {
      const int ch = h * 64 + nt * 16 + lr;
      const float kkc = p.rw_kk[ch];
#pragma unroll
      for (int j = 0; j < 4; ++j) {
        const float k = (float)KKp[(size_t)rows[j] * 1024 + ch];
        ss[j] += (k * kkc) * (k * kkc);
      }
    }
    float inv[4];
#pragma unroll
    for (int j = 0; j < 4; ++j) inv[j] = rsqrtf(fmaxf(red16(ss[j]), 1e-24f));
#pragma unroll 1
    for (int nt = 0; nt < 4; ++nt) {
      const int ch = h * 64 + nt * 16 + lr;
      const half_t* w2p = (const half_t*)(ws + OFF_W2) + (size_t)dir * 65536 + (size_t)ch * 64 + lq * 8;
      const half_t* a2p = (const half_t*)(ws + OFF_A2) + (size_t)dir * 65536 + (size_t)ch * 64 + lq * 8;
      const h8 bw0 = *(const h8*)(w2p), bw1 = *(const h8*)(w2p + 32);
      const h8 ba0 = *(const h8*)(a2p), ba1 = *(const h8*)(a2p + 32);
      const float w0c = p.rw_w0[dir * 1024 + ch], a0c = p.rw_a0[dir * 1024 + ch];
      const float kkc = p.rw_kk[ch], kac = p.rw_ka[ch], rkc = p.rw_rk[ch];
      f4 cwv = (f4){0.f, 0.f, 0.f, 0.f}, cav = (f4){0.f, 0.f, 0.f, 0.f};
      cwv = __builtin_amdgcn_mfma_f32_16x16x32_f16(aw0, bw0, cwv, 0, 0, 0);
      cwv = __builtin_amdgcn_mfma_f32_16x16x32_f16(aw1, bw1, cwv, 0, 0, 0);
      cav = __builtin_amdgcn_mfma_f32_16x16x32_f16(aa0, ba0, cav, 0, 0, 0);
      cav = __builtin_amdgcn_mfma_f32_16x16x32_f16(aa1, ba1, cav, 0, 0, 0);
      h4 vq;
      float ev[4], avv[4], rv[4], kv[4];
#pragma unroll
      for (int j = 0; j < 4; ++j) {
        const size_t gi = (size_t)rows[j] * 1024 + ch;
        kv[j] = (float)KKp[gi];
        vq[j] = VVp[gi];
        rv[j] = lat ? (float)RRp[gi] : 0.f;
        ev[j] = 0.60653066f * sigm(cwv[j] + w0c);
        avv[j] = sigm(cav[j] + a0c);
        bp[j] += rv[j] * kv[j] * rkc * (dir == 0 ? (2.f - 2.f * kac + kac * avv[j]) : kac * avv[j]);
      }
      *(h4*)(VT + (nt * 16 + lr) * 16 + lq * 4) = vq;
      float cum[4];
      cum[0] = ev[0];
      cum[1] = cum[0] + ev[1];
      cum[2] = cum[1] + ev[2];
      cum[3] = cum[2] + ev[3];
      const float t1 = bperm(cum[3], (lane - 16) & 63), t2 = bperm(cum[3], (lane - 32) & 63), t3 = bperm(cum[3], (lane - 48) & 63);
      const float off = (lq >= 1 ? t1 : 0.f) + (lq >= 2 ? t2 : 0.f) + (lq >= 3 ? t3 : 0.f);
#pragma unroll
      for (int j = 0; j < 4; ++j) cum[j] += off;
      const float ref = bperm(cum[3], 16 + lr);
      const float end = bperm(cum[3], 48 + lr);
      if (lq == 0) {
        Pref[nt * 16 + lr] = __expf(-ref);
        Pend[nt * 16 + lr] = __expf(-(end - ref));
      }
      h4 aq, bq;
#pragma unroll
      for (int j = 0; j < 4; ++j) {
        const float d = cum[j] - ref;
        const float E1 = __expf(d), E2 = __expf(-d), E3 = __expf(ev[j] - d);
        const float k = kv[j];
        const float kk = k * kkc * inv[j];
        const float kd = k * (1.f + (avv[j] - 1.f) * kac);
        const half_t ga = (half_t)(kk * E3);
        const half_t ro = (half_t)(rv[j] * E2);
        const half_t al = (half_t)(kk * avv[j] * E1);
        const half_t be = (half_t)(kd * E1);
        const int o = (lq * 4 + j) * 72 + nt * 16 + lr;
        G_[o] = ga; R_[o] = ro; A_[o] = al; B_[o] = be;
        aq[j] = al; bq[j] = be;
      }
      *(h4*)(AT + (nt * 16 + lr) * 16 + lq * 4) = aq;
      *(h4*)(BT + (nt * 16 + lr) * 16 + lq * 4) = bq;
    }
#pragma unroll
    for (int j = 0; j < 4; ++j) {
      const float bpr = red16(bp[j]);
      if (lat && lr == 0) BN[(size_t)rows[j] * 16 + h] = bpr;
    }
    asm volatile("s_waitcnt lgkmcnt(0)" ::: "memory");
    f4 am = (f4){0.f, 0.f, 0.f, 0.f}, bm = am, cm = am, dm = am;
#pragma unroll
    for (int ks = 0; ks < 2; ++ks) {
      const h8 fa = *(const h8*)(A_ + lr * 72 + ks * 32 + lq * 8);
      const h8 fb = *(const h8*)(B_ + lr * 72 + ks * 32 + lq * 8);
      const h8 fg = *(const h8*)(G_ + lr * 72 + ks * 32 + lq * 8);
      const h8 fr = *(const h8*)(R_ + lr * 72 + ks * 32 + lq * 8);
      am = __builtin_amdgcn_mfma_f32_16x16x32_f16(fa, fg, am, 0, 0, 0);
      bm = __builtin_amdgcn_mfma_f32_16x16x32_f16(fb, fg, bm, 0, 0, 0);
      cm = __builtin_amdgcn_mfma_f32_16x16x32_f16(fa, fr, cm, 0, 0, 0);
      dm = __builtin_amdgcn_mfma_f32_16x16x32_f16(fb, fr, dm, 0, 0, 0);
    }
    h4 bmh, cmh, dmh;
#pragma unroll
    for (int j = 0; j < 4; ++j) {
      const int u = lq * 4 + j;
      am[j] = u < lr ? am[j] : 0.f;
      bmh[j] = (half_t)(u < lr ? bm[j] : 0.f);
      cmh[j] = (half_t)(u <= lr ? cm[j] : 0.f);
      dmh[j] = (half_t)(u <= lr ? dm[j] : 0.f);
    }
    *(h4*)(Bm + lr * 16 + lq * 4) = bmh;
    *(h4*)(Cm + lr * 16 + lq * 4) = cmh;
    *(h4*)(Dm + lr * 16 + lq * 4) = dmh;
    *(f4*)(Am + lr * 16 + lq * 4) = am;
    asm volatile("s_waitcnt lgkmcnt(0)" ::: "memory");
    float m[16];
#pragma unroll
    for (int t = 0; t < 16; ++t) {
      float acc = (t == lr) ? 1.f : 0.f;
#pragma unroll
      for (int u4 = 0; u4 < 4; ++u4) {
        if (u4 * 4 < t) {
          const f4 rw = *(const f4*)(Am + t * 16 + u4 * 4);
#pragma unroll
          for (int k = 0; k < 4; ++k)
            if (u4 * 4 + k < t) acc -= rw[k] * m[u4 * 4 + k];
        }
      }
      m[t] = acc;
    }
    if (lq == 0) {
#pragma unroll
      for (int t = 0; t < 16; ++t) Mm[t * 16 + lr] = (half_t)m[t];
    }
  };

  f4 Sacc[4];
#pragma unroll
  for (int jt = 0; jt < 4; ++jt) Sacc[jt] = (f4){0.f, 0.f, 0.f, 0.f};

  for (int sc = 0; sc < 34; ++sc) {
    prep(sc * 8 + w);
    __syncthreads();
    if (w < 4) {
      for (int cc = 0; cc < 8; ++cc) {
        const int c = sc * 8 + cc;
        const char* cs = smem + cc * CS_BYTES;
        const half_t* G_ = (const half_t*)(cs + CS_G);
        const half_t* R_ = (const half_t*)(cs + CS_R);
        const half_t* AT = (const half_t*)(cs + CS_AT);
        const half_t* BT = (const half_t*)(cs + CS_BT);
        const half_t* VT = (const half_t*)(cs + CS_VT);
        const half_t* Mm = (const half_t*)(cs + CS_M);
        const half_t* Bm = (const half_t*)(cs + CS_BM);
        const half_t* Cm = (const half_t*)(cs + CS_CM);
        const half_t* Dm = (const half_t*)(cs + CS_DM);
        const float* Pref = (const float*)(cs + CS_PREF);
        const float* Pend = (const float*)(cs + CS_PEND);
#pragma unroll
        for (int jt = 0; jt < 4; ++jt) Sacc[jt] = Sacc[jt] * *(const f4*)(Pref + jt * 16 + lq * 4);
        h8 bS[2];
#pragma unroll
        for (int ks = 0; ks < 2; ++ks)
#pragma unroll
          for (int k = 0; k < 4; ++k) {
            bS[ks][k] = (half_t)Sacc[2 * ks][k];
            bS[ks][4 + k] = (half_t)Sacc[2 * ks + 1][k];
          }
        const h4 vt = *(const h4*)(VT + (16 * w + lr) * 16 + lq * 4);
        f4 rhs = (f4){0.f, 0.f, 0.f, 0.f};
#pragma unroll
        for (int ks = 0; ks < 2; ++ks) {
          const h4 g0 = *(const h4*)(G_ + lr * 72 + (2 * ks) * 16 + lq * 4);
          const h4 g1 = *(const h4*)(G_ + lr * 72 + (2 * ks + 1) * 16 + lq * 4);
          h8 gf;
          gf[0] = g0[0]; gf[1] = g0[1]; gf[2] = g0[2]; gf[3] = g0[3];
          gf[4] = g1[0]; gf[5] = g1[1]; gf[6] = g1[2]; gf[7] = g1[3];
          rhs = __builtin_amdgcn_mfma_f32_16x16x32_f16(gf, bS[ks], rhs, 0, 0, 0);
        }
        {
          f4 r16 = (f4){0.f, 0.f, 0.f, 0.f};
          r16 = __builtin_amdgcn_mfma_f32_16x16x16f16(*(const h4*)(Bm + lr * 16 + lq * 4), vt, r16, 0, 0, 0);
          rhs = rhs + r16;
        }
        h4 rh;
#pragma unroll
        for (int k = 0; k < 4; ++k) rh[k] = (half_t)rhs[k];
        f4 av = (f4){0.f, 0.f, 0.f, 0.f};
        av = __builtin_amdgcn_mfma_f32_16x16x16f16(*(const h4*)(Mm + lr * 16 + lq * 4), rh, av, 0, 0, 0);
        h4 na;
#pragma unroll
        for (int k = 0; k < 4; ++k) na[k] = (half_t)(-av[k]);
        if (c >= 16) {
          f4 y = (f4){0.f, 0.f, 0.f, 0.f};
#pragma unroll
          for (int ks = 0; ks < 2; ++ks) {
            const h4 g0 = *(const h4*)(R_ + lr * 72 + (2 * ks) * 16 + lq * 4);
            const h4 g1 = *(const h4*)(R_ + lr * 72 + (2 * ks + 1) * 16 + lq * 4);
            h8 gf;
            gf[0] = g0[0]; gf[1] = g0[1]; gf[2] = g0[2]; gf[3] = g0[3];
            gf[4] = g1[0]; gf[5] = g1[1]; gf[6] = g1[2]; gf[7] = g1[3];
            y = __builtin_amdgcn_mfma_f32_16x16x32_f16(gf, bS[ks], y, 0, 0, 0);
          }
          f4 y16 = (f4){0.f, 0.f, 0.f, 0.f};
          y16 = __builtin_amdgcn_mfma_f32_16x16x16f16(*(const h4*)(Cm + lr * 16 + lq * 4), na, y16, 0, 0, 0);
          y16 = __builtin_amdgcn_mfma_f32_16x16x16f16(*(const h4*)(Dm + lr * 16 + lq * 4), vt, y16, 0, 0, 0);
          y = y + y16;
#pragma unroll
          for (int k = 0; k < 4; ++k) {
            const int row = grow(c * 16 + lq * 4 + k);
            Yd[(size_t)row * 1024 + h * 64 + 16 * w + lr] = (half_t)y[k];
          }
        }
#pragma unroll
        for (int jt = 0; jt < 4; ++jt) {
          Sacc[jt] = __builtin_amdgcn_mfma_f32_16x16x16f16(*(const h4*)(AT + (jt * 16 + lr) * 16 + lq * 4), na, Sacc[jt], 0, 0, 0);
          Sacc[jt] = __builtin_amdgcn_mfma_f32_16x16x16f16(*(const h4*)(BT + (jt * 16 + lr) * 16 + lq * 4), vt, Sacc[jt], 0, 0, 0);
          Sacc[jt] = Sacc[jt] * *(const f4*)(Pend + jt * 16 + lq * 4);
        }
      }
    }
    __syncthreads();
  }
}

__device__ void phase_readout(const P& p) {
  const int lane = tidx() & 63;
  const int gw = bidx() * 8 + (tidx() >> 6), stride = gridDim.x * 8;
  char* ws = (p.ws + opaque_zero());
  const half_t* Y0 = (const half_t*)(ws + OFF_A0);
  const half_t* Y1 = (const half_t*)(ws + OFF_A1);
  const half_t* VVp = (const half_t*)(ws + OFF_VV);
  const half_t* Gp = (const half_t*)(ws + OFF_G);
  const float* BN0 = (const float*)(ws + OFF_BN);
  const float* BN1 = BN0 + (size_t)RL * 16;
  half_t* Z1 = (half_t*)(ws + OFF_Z1);
  const int c0 = lane * 16, head = lane >> 2;
  for (int row = gw; row < RL; row += stride) {
    const size_t o = (size_t)row * 1024 + c0;
    float y[16], vv[16], gg[16];
#pragma unroll
    for (int hh = 0; hh < 2; ++hh) {
      const h8 a = *(const h8*)(Y0 + o + hh * 8);
      const h8 bq = *(const h8*)(Y1 + o + hh * 8);
      const h8 v = *(const h8*)(VVp + o + hh * 8);
      const h8 g = *(const h8*)(Gp + o + hh * 8);
#pragma unroll
      for (int i = 0; i < 8; ++i) {
        y[hh * 8 + i] = (float)a[i] + (float)bq[i];
        vv[hh * 8 + i] = (float)v[i];
        gg[hh * 8 + i] = (float)g[i];
      }
    }
    float s = 0.f;
#pragma unroll
    for (int i = 0; i < 16; ++i) s += y[i];
    s = red4(s);
    const float mean = s * (1.f / 64.f);
    float q = 0.f;
#pragma unroll
    for (int i = 0; i < 16; ++i) { const float d = y[i] - mean; q += d * d; }
    q = red4(q);
    const float rstd = rsqrtf(q * (1.f / 64.f) + 64e-5f);
    const float bonus = BN0[(size_t)row * 16 + head] + BN1[(size_t)row * 16 + head];
    h8 o0, o1;
#pragma unroll
    for (int i = 0; i < 16; ++i) {
      const float lg = p.rw_lng[c0 + i], lb = p.rw_lnb[c0 + i];
      const float r = ((y[i] - mean) * rstd * lg + lb + bonus * vv[i]) * gg[i];
      if (i < 8) o0[i] = (half_t)r; else o1[i - 8] = (half_t)r;
    }
    *(h8*)(Z1 + o) = o0;
    *(h8*)(Z1 + o + 8) = o1;
  }
}

#define NPHASE 18
__global__ void __launch_bounds__(512) mega(P p_in, int ph_lo, int ph_hi) {
  __shared__ __attribute__((aligned(16))) char smem[SMEM_BYTES];
  cg::grid_group grid = cg::this_grid();
  const P& p = p_in;
  for (int ph = ph_lo; ph < ph_hi; ++ph) {
    char* ws = p_in.ws + opaque_zero();
    int kind = 2, arg = 0;
    size_t oA = 0, oB = 0, oC = 0;
    int lda = 1024, ldb = 1024, K = 1024, ldc = 1024, epi = 0, nMt = 136, nNt = 8, feat = 0;
    switch (ph) {
      case 0: kind = 0; break;
      case 1: kind = 1; arg = 0; break;
      case 2: oA = OFF_A0; oB = OFF_WIN; oC = OFF_U; ldc = 2048; nNt = 8; feat = 2; break;
      case 3: kind = 3; break;
      case 4: oA = OFF_Z; oB = OFF_WOUT; oC = OFF_A1; nNt = 4; feat = 3; break;
      case 5: kind = 1; arg = 1; break;
      case 6: oA = OFF_A0; oB = OFF_M1; oC = OFF_F; ldc = 4096; nNt = 16; epi = 1; feat = 3; break;
      case 7: oA = OFF_F; lda = 4096; oB = OFF_M2; ldb = 4096; K = 4096; oC = OFF_A1; nNt = 4; feat = 3; break;
      case 8: kind = 1; arg = 2; break;
      case 9: kind = 4; break;
      case 10: oA = OFF_A0; oB = OFF_WR; oC = OFF_RR; nNt = 27; feat = 1; break;
      case 11: kind = 5; break;
      case 12: oA = OFF_L + 512; lda = 384; oB = OFF_G2; ldb = 128; K = 128; oC = OFF_Z1; nMt = 128; epi = 5; break;
      case 13: oA = OFF_Z1; oB = OFF_WO; oC = OFF_A1; nMt = 128; nNt = 4; feat = 3; break;
      case 14: kind = 1; arg = 3; break;
      case 15: oA = OFF_A0; oB = OFF_M1 + 8 * MIB; oC = OFF_F; ldc = 4096; nNt = 16; epi = 1; nMt = 128; feat = 3; break;
      case 16: oA = OFF_F; lda = 4096; oB = OFF_M2 + 8 * MIB; ldb = 4096; K = 4096; oC = OFF_A1; nMt = 128; nNt = 4; feat = 3; break;
      default: kind = 1; arg = 4; break;
    }
    if (kind == 2) {
      gemm_phase(p, (const half_t*)(ws + oA), lda, (const half_t*)(ws + oB), ldb, K, (half_t*)(ws + oC), ldc, epi, nMt, nNt, feat, smem);
    } else if (kind == 1) {
      phase_rowwise(p, arg);
    } else if (kind == 0) {
      phase_prep(p, smem);
    } else if (kind == 3) {
      for (int it = bidx(); it < 2176 + 1088; it += gridDim.x) {
        if (it < 2176) attn_item(p, it, smem); else pool_item(p, it - 2176);
      }
    } else if (kind == 4) {
      phase_shift(p);
    } else if (kind == 5) {
      for (int it = bidx(); it < 256; it += gridDim.x) scan_item(p, it, smem);
    } else {
      phase_readout(p);
    }
    if (ph + 1 < ph_hi) grid.sync();
  }
}

extern "C" void kernel_launch(void* const* d_in, const int* in_sizes, int n_in, void* d_out, int out_size, void* d_ws,
                              size_t ws_size, hipStream_t stream) {
  P p{};
  const float** pp = (const float**)&p;
  for (int i = 0; i < 32; ++i) pp[i] = (const float*)d_in[i];
  p.out = (float*)d_out;
  p.ws = (char*)d_ws;
  static int grid_blocks = 0;
  if (!grid_blocks) {
    int dev = 0, cus = 0, per_cu = 0;
    (void)hipGetDevice(&dev);
    (void)hipDeviceGetAttribute(&cus, hipDeviceAttributeMultiprocessorCount, dev);
    (void)hipOccupancyMaxActiveBlocksPerMultiprocessor(&per_cu, mega, 512, 0);
    if (per_cu < 1) per_cu = 1;
    grid_blocks = cus * per_cu;
  }
  int lo = 0, hi = NPHASE;
  void* args[] = {&p, &lo, &hi};
  hipError_t e = hipLaunchCooperativeKernel((void*)mega, dim3(grid_blocks), dim3(512), args, 0, stream);
  if (e != hipSuccess) fprintf(stderr, "cooperative launch failed: %s (grid %d)\n", hipGetErrorString(e), grid_blocks);
}
```

```cpp
#include <hip/hip_runtime.h>
#include <hip/hip_cooperative_groups.h>
#include <cstdio>
namespace cg = cooperative_groups;

typedef _Float16 half_t;
typedef _Float16 h8 __attribute__((ext_vector_type(8)));
typedef _Float16 h4 __attribute__((ext_vector_type(4)));
typedef _Float16 h2 __attribute__((ext_vector_type(2)));
typedef float f4 __attribute__((ext_vector_type(4)));

#define RL 32768
#define RC 2048
#define RT 34816
#define MIB (1ull << 20)
#define OFF_WIN (0 * MIB)
#define OFF_WOUT (4 * MIB)
#define OFF_M1 (7 * MIB)
#define OFF_M2 (23 * MIB)
#define OFF_WR (39 * MIB)
#define OFF_WK (41 * MIB)
#define OFF_WV (43 * MIB)
#define OFF_WO (45 * MIB)
#define OFF_L1 (47 * MIB)
#define OFF_W2 (48 * MIB)
#define OFF_A2 (48 * MIB + 256 * 1024)
#define OFF_G2 (48 * MIB + 512 * 1024)
#define OFF_MOD (49 * MIB)
#define OFF_BN (50 * MIB)
#define OFF_XC (54 * MIB)
#define OFF_A0 (62 * MIB)
#define OFF_A1 (130 * MIB)
#define OFF_BIG (198 * MIB)
#define OFF_U OFF_BIG
#define OFF_Z (334 * MIB)
#define OFF_F OFF_BIG
#define OFF_RR OFF_BIG
#define OFF_KK (266 * MIB)
#define OFF_VV (334 * MIB)
#define OFF_L (402 * MIB)
#define OFF_G OFF_BIG
#define OFF_Z1 (266 * MIB)

#define SMEM_BYTES 151552

struct P {
  const float *x, *c, *ctx, *c_ctx, *ada_w, *ada_b, *norm_g, *mlp_w1, *mlp_w2, *ev_w_in, *ev_w_out, *ev_pool_w,
      *ev_pool_scale, *ev_rpb, *rw_mu, *rw_wr, *rw_wk, *rw_wv, *rw_wo, *rw_w0, *rw_w1, *rw_w2, *rw_a0, *rw_a1, *rw_a2,
      *rw_g1, *rw_g2, *rw_kk, *rw_ka, *rw_rk, *rw_lng, *rw_lnb;
  float* out;
  char* ws;
};

__device__ __forceinline__ int tidx() { int v = threadIdx.x; asm volatile("" : "+v"(v)); return v; }
__device__ __forceinline__ int bidx() { int v = blockIdx.x; asm volatile("" : "+s"(v)); return v; }
__device__ __forceinline__ size_t opaque_zero() { size_t z = 0; asm volatile("" : "+s"(z)); return z; }
__device__ __forceinline__ float opaque_f(float v) { asm volatile("" : "+v"(v)); return v; }
__device__ __forceinline__ float sigm(float x) { return 1.f / (1.f + __expf(-x)); }
__device__ __forceinline__ float bperm(float v, int srclane) {
  return __builtin_bit_cast(float, __builtin_amdgcn_ds_bpermute(srclane << 2, __builtin_bit_cast(int, v)));
}
template <int CTRL>
__device__ __forceinline__ float dpp(float x) {
  return __builtin_bit_cast(float, __builtin_amdgcn_mov_dpp(__builtin_bit_cast(int, x), CTRL, 0xf, 0xf, true));
}
__device__ __forceinline__ float red4(float x) { x += dpp<0xB1>(x); x += dpp<0x4E>(x); return x; }
__device__ __forceinline__ float red8(float x) { x = red4(x); x += dpp<0x141>(x); return x; }
__device__ __forceinline__ float red16(float x) { x = red8(x); x += dpp<0x140>(x); return x; }
__device__ __forceinline__ float wave_sum(float v, int lane) {
  v = red16(v);
  v += bperm(v, lane ^ 16);
  v += bperm(v, lane ^ 32);
  return v;
}

struct GemmTile {
  const half_t* A; const half_t* A2; const float* mu; int lda;
  const half_t* Bt; int ldb; int K;
  half_t* C; int ldc; int epi;
  int row0, col0;
  const P* pp;
};

template <bool MIX>
__device__ __forceinline__ void gemm_tile(const GemmTile& g, char* smem) {
  half_t* As = (half_t*)smem;
  half_t* Bs = (half_t*)(smem + 73728);
  const int tid = tidx(), lane = tid & 63, w = tid >> 6;
  const int wm = w >> 1, wn = w & 1, lr = lane & 15, lq = lane >> 4;
  const int ldr = tid >> 3, ldk = (tid & 7) * 8;
  f4 acc[4][4];
#pragma unroll
  for (int i = 0; i < 4; ++i)
#pragma unroll
    for (int j = 0; j < 4; ++j) acc[i][j] = (f4){0.f, 0.f, 0.f, 0.f};
  uint4 ra0, ra1, ra2, ra3, rb0, rb1;
  uint4 rx0, rx1, rx2, rx3;
  float4 mu0, mu1;
  const int nk = g.K >> 6;
  const half_t* Ap = g.A + (size_t)ldr * g.lda + ldk;
  const half_t* A2p = MIX ? g.A2 + (size_t)ldr * g.lda + ldk : nullptr;
  const float* mup = MIX ? g.mu + ldk : nullptr;
  const half_t* Bp = g.Bt + (size_t)ldr * g.ldb + ldk;
  const size_t astep = (size_t)64 * g.lda, bstep = (size_t)64 * g.ldb;
  half_t* asw = As + ldr * 72 + ldk;
  half_t* bsw = Bs + ldr * 72 + ldk;
  const half_t* asr = As + (wm * 64 + lr) * 72 + lq * 8;
  const half_t* bsr = Bs + (wn * 64 + lr) * 72 + lq * 8;

#define GLOAD(kt)                                              \
  {                                                            \
    const int k0 = (kt) * 64;                                  \
    ra0 = *(const uint4*)(Ap + k0);                            \
    ra1 = *(const uint4*)(Ap + astep + k0);                    \
    ra2 = *(const uint4*)(Ap + 2 * astep + k0);                \
    ra3 = *(const uint4*)(Ap + 3 * astep + k0);                \
    rb0 = *(const uint4*)(Bp + k0);                            \
    rb1 = *(const uint4*)(Bp + bstep + k0);                    \
    if (MIX) {                                                 \
      rx0 = *(const uint4*)(A2p + k0);                         \
      rx1 = *(const uint4*)(A2p + astep + k0);                 \
      rx2 = *(const uint4*)(A2p + 2 * astep + k0);             \
      rx3 = *(const uint4*)(A2p + 3 * astep + k0);             \
      mu0 = *(const float4*)(mup + k0);                        \
      mu1 = *(const float4*)(mup + k0 + 4);                    \
    }                                                          \
  }
#define MIXV(r, x) __builtin_bit_cast(uint4, (h8)(__builtin_bit_cast(h8, r) + __builtin_bit_cast(h8, x) * m))
#define SSTORE(buf)                                            \
  {                                                            \
    half_t* as = asw + (buf) * (256 * 72);                     \
    half_t* bs = bsw + (buf) * (128 * 72);                     \
    if (MIX) {                                                 \
      h8 m;                                                    \
      m[0] = (half_t)mu0.x; m[1] = (half_t)mu0.y; m[2] = (half_t)mu0.z; m[3] = (half_t)mu0.w; \
      m[4] = (half_t)mu1.x; m[5] = (half_t)mu1.y; m[6] = (half_t)mu1.z; m[7] = (half_t)mu1.w; \
      ra0 = MIXV(ra0, rx0); ra1 = MIXV(ra1, rx1); ra2 = MIXV(ra2, rx2); ra3 = MIXV(ra3, rx3); \
    }                                                          \
    *(uint4*)(as) = ra0;                                       \
    *(uint4*)(as + 64 * 72) = ra1;                             \
    *(uint4*)(as + 128 * 72) = ra2;                            \
    *(uint4*)(as + 192 * 72) = ra3;                            \
    *(uint4*)(bs) = rb0;                                       \
    *(uint4*)(bs + 64 * 72) = rb1;                             \
  }

  GLOAD(0);
  SSTORE(0);
  __syncthreads();
  for (int kt = 0; kt < nk; ++kt) {
    const bool more = kt + 1 < nk;
    if (more) GLOAD(kt + 1);
    __builtin_amdgcn_sched_barrier(0);
    {
      const half_t* as = asr + (kt & 1) * (256 * 72);
      const half_t* bs = bsr + (kt & 1) * (128 * 72);
#pragma unroll
      for (int ks = 0; ks < 2; ++ks) {
        h8 a[4], b[4];
#pragma unroll
        for (int i = 0; i < 4; ++i) {
          a[i] = *(const h8*)(as + i * 16 * 72 + ks * 32);
          b[i] = *(const h8*)(bs + i * 16 * 72 + ks * 32);
        }
#pragma unroll
        for (int mt = 0; mt < 4; ++mt)
#pragma unroll
          for (int nt = 0; nt < 4; ++nt)
            acc[mt][nt] = __builtin_amdgcn_mfma_f32_16x16x32_f16(b[nt], a[mt], acc[mt][nt], 0, 0, 0);
      }
    }
    if (more) SSTORE((kt + 1) & 1);
    __syncthreads();
  }
#undef GLOAD
#undef SSTORE
#undef MIXV
#pragma unroll
  for (int mt = 0; mt < 4; ++mt) {
    half_t* cp = g.C + (size_t)(wm * 64 + mt * 16 + lr) * g.ldc + wn * 64 + lq * 4;
#pragma unroll
    for (int nt = 0; nt < 4; ++nt) {
      h4 o;
#pragma unroll
      for (int j = 0; j < 4; ++j) {
        float v = acc[mt][nt][j];
        if (g.epi == 1) { v = fmaxf(v, 0.f); v = v * v; }
        else if (g.epi == 2) v = 1.f - 2.f / (__expf(2.f * v) + 1.f);
        else if (g.epi == 3) v = sigm(v);
        o[j] = (half_t)v;
      }
      *(h4*)(cp + nt * 16) = o;
    }
  }
}

__device__ __forceinline__ void gemm_tile2(const GemmTile& g, char* smem) {
  half_t* As = (half_t*)smem;
  half_t* Bs = (half_t*)(smem + 73728);
  const int tid = tidx(), lane = tid & 63, w = tid >> 6;
  const int wm = w >> 1, wn = w & 1, lr = lane & 15, lq = lane >> 4;
  const int ldr = tid >> 3, ldk = (tid & 7) * 8;
  f4 acc[4][4];
#pragma unroll
  for (int i = 0; i < 4; ++i)
#pragma unroll
    for (int j = 0; j < 4; ++j) acc[i][j] = (f4){0.f, 0.f, 0.f, 0.f};
  uint4 xa0, xa1, xa2, xa3, xb0, xb1;
  uint4 ya0, ya1, ya2, ya3, yb0, yb1;
  const int nk = g.K >> 6;
  const half_t* Ap = g.A + (size_t)ldr * g.lda + ldk;
  const half_t* Bp = g.Bt + (size_t)ldr * g.ldb + ldk;
  const size_t astep = (size_t)64 * g.lda, bstep = (size_t)64 * g.ldb;
  half_t* asw = As + ldr * 72 + ldk;
  half_t* bsw = Bs + ldr * 72 + ldk;
  const half_t* asr = As + (wm * 64 + lr) * 72 + lq * 8;
  const half_t* bsr = Bs + (wn * 64 + lr) * 72 + lq * 8;
#define GLD(S, kt)                                   \
  {                                                  \
    const int k0 = (kt) * 64;                        \
    S##a0 = *(const uint4*)(Ap + k0);                \
    S##a1 = *(const uint4*)(Ap + astep + k0);        \
    S##a2 = *(const uint4*)(Ap + 2 * astep + k0);    \
    S##a3 = *(const uint4*)(Ap + 3 * astep + k0);    \
    S##b0 = *(const uint4*)(Bp + k0);                \
    S##b1 = *(const uint4*)(Bp + bstep + k0);        \
  }
#define SST(S, buf)                                  \
  {                                                  \
    half_t* as = asw + (buf) * (256 * 72);           \
    half_t* bs = bsw + (buf) * (128 * 72);           \
    *(uint4*)(as) = S##a0;                           \
    *(uint4*)(as + 64 * 72) = S##a1;                 \
    *(uint4*)(as + 128 * 72) = S##a2;                \
    *(uint4*)(as + 192 * 72) = S##a3;                \
    *(uint4*)(bs) = S##b0;                           \
    *(uint4*)(bs + 64 * 72) = S##b1;                 \
  }
#define CMP(buf)                                                                                     \
  {                                                                                                  \
    const half_t* as = asr + (buf) * (256 * 72);                                                     \
    const half_t* bs = bsr + (buf) * (128 * 72);                                                     \
    _Pragma("unroll") for (int ks = 0; ks < 2; ++ks) {                                               \
      h8 a[4], b[4];                                                                                 \
      _Pragma("unroll") for (int i = 0; i < 4; ++i) {                                                \
        a[i] = *(const h8*)(as + i * 16 * 72 + ks * 32);                                             \
        b[i] = *(const h8*)(bs + i * 16 * 72 + ks * 32);                                             \
      }                                                                                              \
      _Pragma("unroll") for (int mt = 0; mt < 4; ++mt)                                               \
        _Pragma("unroll") for (int nt = 0; nt < 4; ++nt)                                             \
          acc[mt][nt] = __builtin_amdgcn_mfma_f32_16x16x32_f16(b[nt], a[mt], acc[mt][nt], 0, 0, 0);  \
    }                                                                                                \
  }
  GLD(x, 0);
  SST(x, 0);
  if (nk > 1) GLD(x, 1);
  if (nk > 2) GLD(y, 2);
  __syncthreads();
  for (int kt = 0; kt < nk; kt += 2) {
    CMP(0);
    if (kt + 1 < nk) SST(x, 1);
    if (kt + 3 < nk) GLD(x, kt + 3);
    __syncthreads();
    CMP(1);
    if (kt + 2 < nk) SST(y, 0);
    if (kt + 4 < nk) GLD(y, kt + 4);
    __syncthreads();
  }
#undef GLD
#undef SST
#undef CMP
#pragma unroll
  for (int mt = 0; mt < 4; ++mt) {
    half_t* cp = g.C + (size_t)(wm * 64 + mt * 16 + lr) * g.ldc + wn * 64 + lq * 4;
#pragma unroll
    for (int nt = 0; nt < 4; ++nt) {
      h4 o;
#pragma unroll
      for (int j = 0; j < 4; ++j) {
        float v = acc[mt][nt][j];
        if (g.epi == 1) { v = fmaxf(v, 0.f); v = v * v; }
        o[j] = (half_t)v;
      }
      *(h4*)(cp + nt * 16) = o;
    }
  }
}

__device__ __forceinline__ void gemm_tile3(const GemmTile& g, char* smem) {
  const int tid = tidx(), lane = tid & 63, w = tid >> 6;
  const int wm = w >> 1, wn = w & 1, lr = lane & 15, lq = lane >> 4;
  f4 acc[4][4];
#pragma unroll
  for (int i = 0; i < 4; ++i)
#pragma unroll
    for (int j = 0; j < 4; ++j) acc[i][j] = (f4){0.f, 0.f, 0.f, 0.f};
  const int nk = g.K >> 6;
  const int lrow = lane >> 3, lslot = lane & 7;
  const half_t* Ag[4];
  const half_t* Bg[2];
#pragma unroll
  for (int i = 0; i < 4; ++i) {
    const int row = (w * 4 + i) * 8 + lrow;
    Ag[i] = g.A + (size_t)row * g.lda + ((lslot ^ ((row >> 1) & 7)) * 8);
  }
#pragma unroll
  for (int i = 0; i < 2; ++i) {
    const int row = (w * 2 + i) * 8 + lrow;
    Bg[i] = g.Bt + (size_t)row * g.ldb + ((lslot ^ ((row >> 1) & 7)) * 8);
  }
  char* aw = smem + (w * 4) * 1024 + lane * 16;
  char* bw = smem + 32768 + (w * 2) * 1024 + lane * 16;
  const int swz = (lr >> 1) & 7;
  const int ko0 = ((0 + lq) ^ swz) * 16, ko1 = ((4 + lq) ^ swz) * 16;
  const char* ar = smem + (wm * 64 + lr) * 128;
  const char* br = smem + 32768 + (wn * 64 + lr) * 128;
#define ISSUE(kt, st)                                                                                      \
  {                                                                                                        \
    _Pragma("unroll") for (int i = 0; i < 4; ++i)                                                          \
      __builtin_amdgcn_global_load_lds((const unsigned*)(Ag[i] + (kt) * 64), (unsigned*)(aw + (st) * 49152 + i * 1024), 16, 0, 0); \
    _Pragma("unroll") for (int i = 0; i < 2; ++i)                                                          \
      __builtin_amdgcn_global_load_lds((const unsigned*)(Bg[i] + (kt) * 64), (unsigned*)(bw + (st) * 49152 + i * 1024), 16, 0, 0); \
  }
  ISSUE(0, 0);
  if (nk > 1) {
    ISSUE(1, 1);
    asm volatile("s_waitcnt vmcnt(6)" ::: "memory");
  } else {
    asm volatile("s_waitcnt vmcnt(0)" ::: "memory");
  }
  __builtin_amdgcn_s_barrier();
  asm volatile("" ::: "memory");
  h8 a0[4], b0[4], a1[4], b1[4];
#define LDF(fa, fb, stg, ko)                                             \
  {                                                                      \
    const char* as = ar + (stg) * 49152 + (ko);                          \
    const char* bs = br + (stg) * 49152 + (ko);                          \
    _Pragma("unroll") for (int i = 0; i < 4; ++i) {                      \
      fa[i] = *(const h8*)(as + i * 2048);                               \
      fb[i] = *(const h8*)(bs + i * 2048);                               \
    }                                                                    \
  }
#define MMA(fa, fb)                                                      \
  {                                                                      \
    _Pragma("unroll") for (int mt = 0; mt < 4; ++mt)                     \
      _Pragma("unroll") for (int nt = 0; nt < 4; ++nt)                   \
        acc[mt][nt] = __builtin_amdgcn_mfma_f32_16x16x32_f16(fb[nt], fa[mt], acc[mt][nt], 0, 0, 0); \
  }
  LDF(a0, b0, 0, ko0);
  int st = 0;
  for (int kt = 0; kt < nk; ++kt) {
    const bool more = kt + 2 < nk;
    int st1 = st + 1; if (st1 >= 3) st1 -= 3;
    int st2 = st + 2; if (st2 >= 3) st2 -= 3;
    if (more) ISSUE(kt + 2, st2);
    LDF(a1, b1, st, ko1);
    __builtin_amdgcn_sched_barrier(0);
    MMA(a0, b0);
    __builtin_amdgcn_sched_barrier(0);
    if (more) asm volatile("s_waitcnt vmcnt(6) lgkmcnt(0)" ::: "memory");
    else asm volatile("s_waitcnt vmcnt(0) lgkmcnt(0)" ::: "memory");
    __builtin_amdgcn_s_barrier();
    asm volatile("" ::: "memory");
    if (kt + 1 < nk) LDF(a0, b0, st1, ko0);
    __builtin_amdgcn_sched_barrier(0);
    MMA(a1, b1);
    __builtin_amdgcn_sched_barrier(0);
    st = st1;
  }
#undef LDF
#undef MMA
#undef ISSUE
  if (g.epi == 5) {
    const P& p = *g.pp;
    char* ws = p.ws + opaque_zero();
    const half_t* Y0 = (const half_t*)(ws + OFF_A0);
    const half_t* Y1 = (const half_t*)(ws + OFF_A1);
    const half_t* VVp = (const half_t*)(ws + OFF_VV);
    const float* BN0 = (const float*)(ws + OFF_BN);
    const float* BN1 = BN0 + (size_t)RL * 16;
    half_t* Z1 = (half_t*)(ws + OFF_Z1);
    const int head = (g.col0 >> 6) + wn;
#pragma unroll 1
    for (int mt = 0; mt < 4; ++mt) {
      const int row = g.row0 + wm * 64 + mt * 16 + lr;
      const size_t base = (size_t)row * 1024 + head * 64 + lq * 4;
      float y[4][4], vv[4][4];
      float sm = 0.f;
#pragma unroll
      for (int nt = 0; nt < 4; ++nt) {
        const h4 ya = *(const h4*)(Y0 + base + nt * 16);
        const h4 yb = *(const h4*)(Y1 + base + nt * 16);
        const h4 vh = *(const h4*)(VVp + base + nt * 16);
#pragma unroll
        for (int j = 0; j < 4; ++j) { y[nt][j] = (float)ya[j] + (float)yb[j]; vv[nt][j] = (float)vh[j]; sm += y[nt][j]; }
      }
      sm += bperm(sm, lane ^ 16);
      sm += bperm(sm, lane ^ 32);
      const float mean = sm * (1.f / 64.f);
      float q = 0.f;
#pragma unroll
      for (int nt = 0; nt < 4; ++nt)
#pragma unroll
        for (int j = 0; j < 4; ++j) { const float d = y[nt][j] - mean; q += d * d; }
      q += bperm(q, lane ^ 16);
      q += bperm(q, lane ^ 32);
      const float rstd = rsqrtf(q * (1.f / 64.f) + 64e-5f);
      const float bonus = BN0[(size_t)row * 16 + head] + BN1[(size_t)row * 16 + head];
#pragma unroll
      for (int nt = 0; nt < 4; ++nt) {
        const int ch = head * 64 + nt * 16 + lq * 4;
        const float4 lg = *(const float4*)(p.rw_lng + ch);
        const float4 lb = *(const float4*)(p.rw_lnb + ch);
        const float lgv[4] = {lg.x, lg.y, lg.z, lg.w}, lbv[4] = {lb.x, lb.y, lb.z, lb.w};
        const f4 gv = mt == 0 ? acc[0][nt] : (mt == 1 ? acc[1][nt] : (mt == 2 ? acc[2][nt] : acc[3][nt]));
        h4 o;
#pragma unroll
        for (int j = 0; j < 4; ++j) o[j] = (half_t)(((y[nt][j] - mean) * rstd * lgv[j] + lbv[j] + bonus * vv[nt][j]) * gv[j]);
        *(h4*)(Z1 + base + nt * 16) = o;
      }
    }
    return;
  }
  if (g.epi == 4) {
    half_t* vp = g.C + (size_t)((wm * 8 + wn) * 64) * 64 + lr;
#pragma unroll
    for (int mt = 0; mt < 4; ++mt)
#pragma unroll
      for (int nt = 0; nt < 4; ++nt)
#pragma unroll
        for (int j = 0; j < 4; ++j) vp[(nt * 16 + lq * 4 + j) * 64 + mt * 16] = (half_t)acc[mt][nt][j];
    return;
  }
#pragma unroll
  for (int mt = 0; mt < 4; ++mt) {
    half_t* cp = g.C + (size_t)(wm * 64 + mt * 16 + lr) * g.ldc + wn * 64 + lq * 4;
#pragma unroll
    for (int nt = 0; nt < 4; ++nt) {
      h4 o;
#pragma unroll
      for (int j = 0; j < 4; ++j) {
        float v = acc[mt][nt][j];
        if (g.epi == 1) { v = fmaxf(v, 0.f); v = v * v; }
        o[j] = (half_t)v;
      }
      *(h4*)(cp + nt * 16) = o;
    }
  }
}

__device__ __forceinline__ void gemm_tile4(const GemmTile& g, char* smem) {
  const int tid = tidx(), lane = tid & 63, w = tid >> 6;
  const int wm = w >> 1, wn = w & 1, lr = lane & 15, lq = lane >> 4;
  f4 acc[4][8];
#pragma unroll
  for (int i = 0; i < 4; ++i)
#pragma unroll
    for (int j = 0; j < 8; ++j) acc[i][j] = (f4){0.f, 0.f, 0.f, 0.f};
  const int nk = g.K >> 6;
  const int lrow = lane >> 3, lslot = lane & 7;
  const half_t* Ag[4];
  const half_t* Bg[4];
#pragma unroll
  for (int i = 0; i < 4; ++i) {
    const int row = (w * 4 + i) * 8 + lrow;
    const int so = (lslot ^ ((row >> 1) & 7)) * 8;
    Ag[i] = g.A + (size_t)row * g.lda + so;
    Bg[i] = g.Bt + (size_t)row * g.ldb + so;
  }
  char* aw = smem + (w * 4) * 1024 + lane * 16;
  char* bw = smem + 32768 + (w * 4) * 1024 + lane * 16;
  const int swz = (lr >> 1) & 7;
  const int ko0 = ((0 + lq) ^ swz) * 16, ko1 = ((4 + lq) ^ swz) * 16;
  const char* ar = smem + (wm * 64 + lr) * 128;
  const char* br = smem + 32768 + (wn * 128 + lr) * 128;
#define ISSUE4(kt, st)                                                                                     \
  {                                                                                                        \
    _Pragma("unroll") for (int i = 0; i < 4; ++i)                                                          \
      __builtin_amdgcn_global_load_lds((const unsigned*)(Ag[i] + (kt) * 64), (unsigned*)(aw + (st) * 65536 + i * 1024), 16, 0, 0); \
    _Pragma("unroll") for (int i = 0; i < 4; ++i)                                                          \
      __builtin_amdgcn_global_load_lds((const unsigned*)(Bg[i] + (kt) * 64), (unsigned*)(bw + (st) * 65536 + i * 1024), 16, 0, 0); \
  }
  ISSUE4(0, 0);
  asm volatile("s_waitcnt vmcnt(0)" ::: "memory");
  __builtin_amdgcn_s_barrier();
  asm volatile("" ::: "memory");
  for (int kt = 0; kt < nk; ++kt) {
    const int st = kt & 1;
    if (kt + 1 < nk) ISSUE4(kt + 1, st ^ 1);
    const char* as = ar + st * 65536;
    const char* bs = br + st * 65536;
#pragma unroll
    for (int ks = 0; ks < 2; ++ks) {
      const int ko = ks ? ko1 : ko0;
      h8 a[4], b[8];
#pragma unroll
      for (int i = 0; i < 4; ++i) a[i] = *(const h8*)(as + i * 2048 + ko);
#pragma unroll
      for (int i = 0; i < 8; ++i) b[i] = *(const h8*)(bs + i * 2048 + ko);
#pragma unroll
      for (int mt = 0; mt < 4; ++mt)
#pragma unroll
        for (int nt = 0; nt < 8; ++nt)
          acc[mt][nt] = __builtin_amdgcn_mfma_f32_16x16x32_f16(b[nt], a[mt], acc[mt][nt], 0, 0, 0);
    }
    asm volatile("s_waitcnt vmcnt(0) lgkmcnt(0)" ::: "memory");
    __builtin_amdgcn_s_barrier();
    asm volatile("" ::: "memory");
  }
#undef ISSUE4
  if (g.epi == 4) {
#pragma unroll
    for (int mt = 0; mt < 4; ++mt)
#pragma unroll
      for (int nt = 0; nt < 8; ++nt) {
        half_t* vp = g.C + (size_t)((wm * 8 + wn * 2 + (nt >> 2)) * 64) * 64 + lr;
#pragma unroll
        for (int j = 0; j < 4; ++j) vp[((nt & 3) * 16 + lq * 4 + j) * 64 + mt * 16] = (half_t)acc[mt][nt][j];
      }
    return;
  }
#pragma unroll
  for (int mt = 0; mt < 4; ++mt) {
    half_t* cp = g.C + (size_t)(wm * 64 + mt * 16 + lr) * g.ldc + wn * 128 + lq * 4;
#pragma unroll
    for (int nt = 0; nt < 8; ++nt) {
      h4 o;
#pragma unroll
      for (int j = 0; j < 4; ++j) {
        float v = acc[mt][nt][j];
        if (g.epi == 1) { v = fmaxf(v, 0.f); v = v * v; }
        o[j] = (half_t)v;
      }
      *(h4*)(cp + nt * 16) = o;
    }
  }
}

__device__ __forceinline__ int p8_lds_byte(int r, int c) {
  const int st = (r >> 4) * 2 + (c >> 5), rr = r & 15, cc = c & 31, ob = rr * 64 + cc * 2;
  return st * 1024 + (ob ^ (((ob >> 9) & 1) << 5));
}
__device__ __forceinline__ void p8_stage_rc(int b, int& R, int& C) {
  const int st = b / 1024, sb = b % 1024, swz = sb ^ (((sb >> 9) & 1) << 5);
  R = (st >> 1) * 16 + swz / 64;
  C = (st & 1) * 32 + (swz % 64) / 2;
}
__device__ __forceinline__ void gemm_tile8(const GemmTile& g, char* smem) {
  constexpr int HT = 128 * 64;
  half_t* shm = (half_t*)smem;
  const int tid = tidx();
  const int wid = tid >> 6, lane = tid & 63, wr = wid >> 2, wc = wid & 3, fr = lane & 15, fq = lane >> 4;
  const half_t* A = g.A;
  const half_t* Bt = g.Bt;
  const int lda = g.lda, ldb = g.lda;
#define P8_SA(b, h) (shm + ((b) * 2 + (h)) * HT)
#define P8_SB(b, h) (shm + (4 + (b) * 2 + (h)) * HT)
  int sr0, sc0, sr1, sc1;
  p8_stage_rc(tid * 16, sr0, sc0);
  p8_stage_rc(tid * 16 + 8192, sr1, sc1);
  const int ao0 = sr0 * lda + sc0, ao1 = sr1 * lda + sc1;
#define bo0 ao0
#define bo1 ao1
#define P8_STAGE_A(Pp, br, kt)                                                                                   \
  {                                                                                                              \
    const half_t* gb_ = A + (size_t)(br) * lda + (size_t)(kt) * 64;                                              \
    __builtin_amdgcn_global_load_lds((const unsigned*)(gb_ + ao0), (unsigned*)((char*)(Pp) + tid * 16), 16, 0, 0);        \
    __builtin_amdgcn_global_load_lds((const unsigned*)(gb_ + ao1), (unsigned*)((char*)(Pp) + tid * 16 + 8192), 16, 0, 0); \
  }
#define P8_STAGE_B(Pp, br, kt)                                                                                   \
  {                                                                                                              \
    const half_t* gb_ = Bt + (size_t)(br) * ldb + (size_t)(kt) * 64;                                             \
    __builtin_amdgcn_global_load_lds((const unsigned*)(gb_ + bo0), (unsigned*)((char*)(Pp) + tid * 16), 16, 0, 0);        \
    __builtin_amdgcn_global_load_lds((const unsigned*)(gb_ + bo1), (unsigned*)((char*)(Pp) + tid * 16 + 8192), 16, 0, 0); \
  }
  const char* abase = smem + p8_lds_byte(wr * 64 + fr, fq * 8);
  const char* bbase = smem + 4 * HT * 2 + p8_lds_byte(wc * 32 + fr, fq * 8);
#define P8_LDA(dst, b, h)                                                                                        \
  _Pragma("unroll") for (int m = 0; m < 4; ++m) _Pragma("unroll") for (int k = 0; k < 2; ++k)                    \
      dst[m][k] = *(const h8*)(abase + ((b) * 2 + (h)) * (HT * 2) + (m * 2 + k) * 1024);
#define P8_LDB(dst, b, h)                                                                                        \
  _Pragma("unroll") for (int n = 0; n < 2; ++n) _Pragma("unroll") for (int k = 0; k < 2; ++k)                    \
      dst[n][k] = *(const h8*)(bbase + ((b) * 2 + (h)) * (HT * 2) + (n * 2 + k) * 1024);
#define P8_MMA(ai, bj, Af, Bf)                                                                                   \
  {                                                                                                              \
    __builtin_amdgcn_s_setprio(1);                                                                               \
    _Pragma("unroll") for (int m = 0; m < 4; ++m) _Pragma("unroll") for (int n = 0; n < 2; ++n)                  \
        _Pragma("unroll") for (int k = 0; k < 2; ++k)                                                            \
            acc[ai][bj][m][n] = __builtin_amdgcn_mfma_f32_16x16x32_f16(Bf[n][k], Af[m][k], acc[ai][bj][m][n], 0, 0, 0); \
    __builtin_amdgcn_s_setprio(0);                                                                               \
  }
#define P8_WAIT_V(n) asm volatile("s_waitcnt vmcnt(" #n ")" ::: "memory")
#define P8_WAIT_L(n) asm volatile("s_waitcnt lgkmcnt(" #n ")" ::: "memory")
#define P8_BAR __builtin_amdgcn_s_barrier()
#define P8_SCHED __builtin_amdgcn_sched_barrier(0)

  f4 acc[2][2][4][2];
#pragma unroll
  for (int i0 = 0; i0 < 2; ++i0)
#pragma unroll
    for (int i1 = 0; i1 < 2; ++i1)
#pragma unroll
      for (int i2 = 0; i2 < 4; ++i2)
#pragma unroll
        for (int i3 = 0; i3 < 2; ++i3) acc[i0][i1][i2][i3] = (f4){0.f, 0.f, 0.f, 0.f};
  h8 At[4][2], B0[2][2], B1[2][2];
  const int nt = g.K >> 6;
  P8_STAGE_B(P8_SB(0, 0), 0, 0); P8_STAGE_A(P8_SA(0, 0), 0, 0);
  P8_STAGE_B(P8_SB(0, 1), 128, 0); P8_STAGE_A(P8_SA(0, 1), 128, 0);
  if (wr == 1) P8_BAR;
  P8_WAIT_V(4); P8_BAR;
  P8_STAGE_B(P8_SB(1, 0), 0, 1); P8_STAGE_A(P8_SA(1, 0), 0, 1); P8_STAGE_B(P8_SB(1, 1), 128, 1);
  P8_WAIT_V(6); P8_BAR;
  for (int t = 0; t < nt - 2; t += 2) {
    P8_LDB(B0, 0, 0); P8_SCHED; P8_LDA(At, 0, 0); P8_STAGE_A(P8_SA(1, 1), 128, t + 1);
    P8_WAIT_L(8); P8_BAR; P8_WAIT_L(0); P8_MMA(0, 0, At, B0); P8_BAR; P8_SCHED;
    P8_LDB(B1, 0, 1); P8_STAGE_B(P8_SB(0, 0), 0, t + 2);
    P8_BAR; P8_WAIT_L(0); P8_MMA(0, 1, At, B1); P8_BAR;
    P8_LDA(At, 0, 1); P8_STAGE_A(P8_SA(0, 0), 0, t + 2);
    P8_BAR; P8_WAIT_L(0); P8_MMA(1, 0, At, B0); P8_BAR; P8_SCHED;
    P8_STAGE_B(P8_SB(0, 1), 128, t + 2);
    P8_WAIT_V(6); P8_BAR; P8_MMA(1, 1, At, B1); P8_BAR;
    P8_LDB(B0, 1, 0); P8_SCHED; P8_LDA(At, 1, 0); P8_STAGE_A(P8_SA(0, 1), 128, t + 2);
    P8_WAIT_L(8); P8_BAR; P8_WAIT_L(0); P8_MMA(0, 0, At, B0); P8_BAR; P8_SCHED;
    P8_LDB(B1, 1, 1); P8_STAGE_B(P8_SB(1, 0), 0, t + 3);
    P8_BAR; P8_WAIT_L(0); P8_MMA(0, 1, At, B1); P8_BAR;
    P8_LDA(At, 1, 1); P8_STAGE_A(P8_SA(1, 0), 0, t + 3);
    P8_BAR; P8_WAIT_L(0); P8_MMA(1, 0, At, B0); P8_BAR; P8_SCHED;
    P8_STAGE_B(P8_SB(1, 1), 128, t + 3);
    P8_WAIT_V(6); P8_BAR; P8_MMA(1, 1, At, B1); P8_BAR;
  }
  {
    P8_LDB(B0, 0, 0); P8_LDA(At, 0, 0); P8_STAGE_A(P8_SA(1, 1), 128, nt - 1);
    P8_BAR; P8_WAIT_L(0); P8_MMA(0, 0, At, B0); P8_BAR;
    P8_LDB(B1, 0, 1); P8_BAR; P8_WAIT_L(0); P8_MMA(0, 1, At, B1); P8_BAR;
    P8_LDA(At, 0, 1); P8_WAIT_V(4); P8_BAR; P8_WAIT_L(0); P8_MMA(1, 0, At, B0); P8_MMA(1, 1, At, B1); P8_BAR;
  }
  {
    P8_LDB(B0, 1, 0); P8_LDA(At, 1, 0); P8_WAIT_V(2); P8_BAR; P8_WAIT_L(0); P8_MMA(0, 0, At, B0); P8_BAR;
    P8_LDB(B1, 1, 1); P8_WAIT_V(0); P8_BAR; P8_WAIT_L(0); P8_MMA(0, 1, At, B1); P8_BAR;
    P8_LDA(At, 1, 1); P8_BAR; P8_WAIT_L(0); P8_MMA(1, 0, At, B0); P8_MMA(1, 1, At, B1); P8_BAR;
  }
  if (wr == 0) P8_BAR;
  asm volatile("" ::: "memory");
#pragma unroll
  for (int ai = 0; ai < 2; ++ai)
#pragma unroll
    for (int m = 0; m < 4; ++m) {
      const int row = ai * 128 + wr * 64 + m * 16 + fr;
#pragma unroll
      for (int bj = 0; bj < 2; ++bj)
#pragma unroll
        for (int n = 0; n < 2; ++n) {
          const int col = bj * 128 + wc * 32 + n * 16 + fq * 4;
          if (g.epi == 4) {
            half_t* vp = g.C + (size_t)(((row >> 6) * 8 + (col >> 6)) * 64 + (col & 63)) * 64 + (row & 63);
#pragma unroll
            for (int j = 0; j < 4; ++j) vp[j * 64] = (half_t)acc[ai][bj][m][n][j];
          } else {
            h4 o;
#pragma unroll
            for (int j = 0; j < 4; ++j) {
              float v = acc[ai][bj][m][n][j];
              if (g.epi == 1) { v = fmaxf(v, 0.f); v = v * v; }
              o[j] = (half_t)v;
            }
            *(h4*)(g.C + (size_t)row * g.ldc + col) = o;
          }
        }
    }
#undef bo0
#undef bo1
#undef P8_SA
#undef P8_SB
#undef P8_STAGE_A
#undef P8_STAGE_B
#undef P8_LDA
#undef P8_LDB
#undef P8_MMA
#undef P8_WAIT_V
#undef P8_WAIT_L
#undef P8_BAR
#undef P8_SCHED
}

__device__ __forceinline__ void gemm_phase(const P& p, const half_t* A, int lda, const half_t* Bt, int ldb, int K, half_t* C, int ldc,
                                           int epi, int nMt, int nNt, int feat, char* smem) {
  char* ws = (p.ws + opaque_zero());
  const bool split = (feat >= 2 && nMt == 136);
  if (split) nMt = 128;
  const int nbig = nMt * nNt;
  const int total = nbig + (split ? 16 * nNt : 0), G = gridDim.x, per_xcd = G >> 3;
  for (int t0 = bidx(); t0 < total + G; t0 += G) {
    const int rnd = t0 / G, bb = t0 - rnd * G;
    const int t = ((G & 7) == 0) ? rnd * G + (bb & 7) * per_xcd + (bb >> 3) : t0;
    if (t >= total) continue;
    const bool small = t >= nbig;
    const int gsz = 8 * nNt, first = (t / gsz) * 8, gm = min(nMt - first, 8);
    const int mt = small ? 128 + ((t - nbig) & 7) : first + (t % gsz) % gm;
    const int nt = small ? (t - nbig) >> 3 : (t % gsz) / gm;
    GemmTile g;
    g.A = A + (size_t)mt * 256 * lda; g.A2 = nullptr; g.mu = nullptr; g.lda = lda;
    const int tw = (feat >= 2 && !small) ? 256 : 128;
    g.Bt = Bt + (size_t)nt * tw * ldb; g.ldb = ldb; g.K = K;
    g.C = C + (size_t)mt * 256 * ldc + nt * tw; g.ldc = ldc; g.epi = epi;
    g.row0 = mt * 256; g.col0 = nt * tw; g.pp = &p;
    if (feat == 2 && !small && nt >= 6) {
      g.epi = 4;
      g.C = (half_t*)(ws + OFF_A1) + ((size_t)(mt * 4) * 8 + (nt - 6) * 4) * 4096;
    }
    if (feat == 2 && small && nt >= 12) {
      g.epi = 4;
      g.C = (half_t*)(ws + OFF_A1) + ((size_t)(mt * 4) * 8 + (nt - 12) * 2) * 4096;
    }
    if (feat == 1) {
      g.A2 = (const half_t*)(ws + OFF_A1) + (size_t)mt * 256 * 1024;
      const int grp = nt >> 3, sub = nt & 7;
      int mixi;
      if (grp < 3) {
        mixi = grp == 0 ? 0 : (grp == 1 ? 2 : 3);
        g.Bt = (const half_t*)(ws + (grp == 0 ? OFF_WR : (grp == 1 ? OFF_WK : OFF_WV))) + (size_t)sub * 128 * 1024;
        g.C = (half_t*)(ws + (grp == 0 ? OFF_RR : (grp == 1 ? OFF_KK : OFF_VV))) + (size_t)mt * 256 * 1024 + sub * 128;
      } else {
        mixi = sub == 0 ? 1 : (sub == 1 ? 4 : 5);
        g.Bt = (const half_t*)(ws + OFF_L1) + (size_t)sub * 128 * 1024;
        g.C = (half_t*)(ws + OFF_L) + (size_t)mt * 256 * 384 + sub * 128;
        g.ldc = 384;
        g.epi = sub == 0 ? 2 : (sub == 1 ? 0 : 3);
      }
      g.mu = p.rw_mu + mixi * 1024;
    }
    if (feat == 1) gemm_tile<true>(g, smem); else if (feat >= 2 && !small) gemm_tile8(g, smem); else gemm_tile3(g, smem);
  }
}

__device__ void xpose_seg(const float* src, int ldsrc, int K, int N, half_t* dst, int lddst, int koff, int& base,
                          char* smem) {
  float* ts = (float*)smem;
  const int tid = tidx(), G = gridDim.x;
  const int tkn = K >> 6, tnn = N >> 6, cnt = tkn * tnn;
  int t0 = ((int)bidx() - (base % G) + G) % G;
  for (int t = t0; t < cnt; t += G) {
    const int k0 = (t % tkn) * 64, n0 = (t / tkn) * 64;
#pragma unroll
    for (int i = 0; i < 2; ++i) {
      const int c = tid + 512 * i, r = c >> 4, c4 = (c & 15) * 4;
      const float4 v = *(const float4*)(src + (size_t)(k0 + r) * ldsrc + n0 + c4);
      float* d = ts + r * 65 + c4;
      d[0] = v.x; d[1] = v.y; d[2] = v.z; d[3] = v.w;
    }
    __syncthreads();
    {
      const int n = tid >> 3, kc = (tid & 7) * 8;
      h8 o;
#pragma unroll
      for (int i = 0; i < 8; ++i) o[i] = (half_t)ts[(kc + i) * 65 + n];
      *(h8*)(dst + (size_t)(n0 + n) * lddst + koff + k0 + kc) = o;
    }
    __syncthreads();
  }
  base += cnt;
}

__device__ void phase_prep(const P& p, char* smem) {
  const int tid = tidx();
  char* ws = (p.ws + opaque_zero());
  float* MOD = (float*)(ws + OFF_MOD);
  if (bidx() < 192 || gridDim.x < 256) {
    float* sl = (float*)smem;
    for (int i = tid; i < 9216; i += 512) {
      const int b = i >> 10, k = i & 1023;
      const float cv = b < 8 ? p.c[b * 1024 + k] : p.c_ctx[k];
      sl[i] = cv / (1.f + __expf(-cv));
    }
    __syncthreads();
    float* red = sl + 9216;
    for (int item = bidx(); item < 192; item += gridDim.x) {
      const int l = item / 96, n0 = (item % 96) * 64, cn = tid & 63, kq = tid >> 6;
      float acc[9];
#pragma unroll
      for (int b = 0; b < 9; ++b) acc[b] = 0.f;
      const float* wp = p.ada_w + (size_t)l * 1024 * 6144 + n0 + cn;
#pragma unroll 4
      for (int k = kq * 128; k < kq * 128 + 128; ++k) {
        const float wv = wp[(size_t)k * 6144];
#pragma unroll
        for (int b = 0; b < 9; ++b) acc[b] += sl[b * 1024 + k] * wv;
      }
#pragma unroll
      for (int b = 0; b < 9; ++b) red[(kq * 9 + b) * 64 + cn] = acc[b];
      __syncthreads();
      for (int i = tid; i < 576; i += 512) {
        const int b = i >> 6, c = i & 63;
        float s = 0.f;
#pragma unroll
        for (int q = 0; q < 8; ++q) s += red[(q * 9 + b) * 64 + c];
        MOD[(size_t)(l * 9 + b) * 6144 + n0 + c] = s + p.ada_b[l * 6144 + n0 + c];
      }
      __syncthreads();
    }
  }
  for (int it = bidx(); it < 256; it += gridDim.x) {
    if (it < 192) continue;
    const int fi = it - 192, gi = fi >> 4, n0 = (fi & 15) * 64, n = tid & 63, ig = tid >> 6;
    float acc[16];
#pragma unroll
    for (int i = 0; i < 16; ++i) acc[i] = 0.f;
    for (int j = 0; j < 128; ++j) {
      const float wv = p.ev_w_out[(size_t)(gi * 128 + j) * 1024 + n0 + n] * p.ev_pool_scale[gi * 128 + j];
      const float* pw = p.ev_pool_w + ((size_t)gi * 128 + ig * 16) * 128 + j;
#pragma unroll
      for (int i = 0; i < 16; ++i) acc[i] += pw[i * 128] * wv;
    }
    h8 o0, o1;
#pragma unroll
    for (int i = 0; i < 8; ++i) { o0[i] = (half_t)acc[i]; o1[i] = (half_t)acc[8 + i]; }
    half_t* d = (half_t*)(ws + OFF_WOUT) + (size_t)(n0 + n) * 1024 + gi * 128 + ig * 16;
    *(h8*)d = o0;
    *(h8*)(d + 8) = o1;
  }
  __syncthreads();
  int base = 0;
  xpose_seg(p.ev_w_in, 2048, 1024, 2048, (half_t*)(ws + OFF_WIN), 1024, 0, base, smem);
  xpose_seg(p.ev_w_out + 512 * 1024, 1024, 512, 1024, (half_t*)(ws + OFF_WOUT), 1024, 512, base, smem);
  for (int l = 0; l < 2; ++l) {
    xpose_seg(p.mlp_w1 + (size_t)l * 1024 * 4096, 4096, 1024, 4096, (half_t*)(ws + OFF_M1 + l * 8 * MIB), 1024, 0, base, smem);
    xpose_seg(p.mlp_w2 + (size_t)l * 1024 * 4096, 1024, 4096, 1024, (half_t*)(ws + OFF_M2 + l * 8 * MIB), 4096, 0, base, smem);
  }
  xpose_seg(p.rw_wr, 1024, 1024, 1024, (half_t*)(ws + OFF_WR), 1024, 0, base, smem);
  xpose_seg(p.rw_wk, 1024, 1024, 1024, (half_t*)(ws + OFF_WK), 1024, 0, base, smem);
  xpose_seg(p.rw_wv, 1024, 1024, 1024, (half_t*)(ws + OFF_WV), 1024, 0, base, smem);
  xpose_seg(p.rw_wo, 1024, 1024, 1024, (half_t*)(ws + OFF_WO), 1024, 0, base, smem);
  for (int d = 0; d < 2; ++d) {
    xpose_seg(p.rw_w1 + (size_t)d * 1024 * 64, 64, 1024, 64, (half_t*)(ws + OFF_L1) + (size_t)(d * 64) * 1024, 1024, 0, base, smem);
    xpose_seg(p.rw_a1 + (size_t)d * 1024 * 64, 64, 1024, 64, (half_t*)(ws + OFF_L1) + (size_t)(128 + d * 64) * 1024, 1024, 0, base, smem);
    xpose_seg(p.rw_w2 + (size_t)d * 64 * 1024, 1024, 64, 1024, (half_t*)(ws + OFF_W2) + (size_t)d * 1024 * 64, 64, 0, base, smem);
    xpose_seg(p.rw_a2 + (size_t)d * 64 * 1024, 1024, 64, 1024, (half_t*)(ws + OFF_A2) + (size_t)d * 1024 * 64, 64, 0, base, smem);
  }
  xpose_seg(p.rw_g1, 128, 1024, 128, (half_t*)(ws + OFF_L1) + (size_t)256 * 1024, 1024, 0, base, smem);
  xpose_seg(p.rw_g2, 1024, 128, 1024, (half_t*)(ws + OFF_G2), 128, 0, base, smem);
}

__device__ void phase_rowwise(const P& p, int mode) {
  const int lane = tidx() & 63;
  const int gw = bidx() * 8 + (tidx() >> 6), nw = gridDim.x * 8;
  char* ws = (p.ws + opaque_zero());
  const float* MOD = (const float*)(ws + OFF_MOD);
  float* XC = (float*)(ws + OFF_XC);
  half_t* H = (half_t*)(ws + OFF_A0);
  const half_t* Y = (const half_t*)(ws + OFF_A1);
  const int nrows = (mode >= 3) ? RL : RT;
  const int per = (nrows + nw - 1) / nw;
  const int r0 = gw * per, r1 = min(r0 + per, nrows);
  if (r0 >= r1) return;
  const bool hasY = mode != 0, hasH = mode != 4;
  const float EPS = opaque_f(1e-6f);
  const int lyr = (mode <= 1) ? 0 : ((mode == 2) ? 0 : 1);
  const int gyi = (mode == 1) ? 1 : (mode == 2 ? 3 : (mode == 3 ? 5 : 7));
  const int gti = (mode == 1) ? 2 : (mode == 2 ? 5 : (mode == 3 ? 2 : 5));
  const int hl = (mode <= 1) ? 0 : 1;
  const int ghi = (mode == 0) ? 0 : (mode == 1 ? 2 : (mode == 2 ? 4 : 6));
  const int shi = (mode == 0 || mode == 2) ? 0 : 3;
  auto xsrc = [&](int row) -> const float* {
    if (mode <= 1) return row < RL ? p.x + (size_t)row * 1024 : p.ctx + (size_t)(row - RL) * 1024;
    return row < RL ? p.out + (size_t)row * 1024 : XC + (size_t)(row - RL) * 1024;
  };
  auto xdst = [&](int row) -> float* { return row < RL ? p.out + (size_t)row * 1024 : XC + (size_t)(row - RL) * 1024; };
  float4 gy[4], gt[4], gh[4], s1[4], s2[4];
  int cur_mi = -1;
  float4 nx[4];
  h4 ny[4];
  {
    const float* xs = xsrc(r0);
#pragma unroll
    for (int i = 0; i < 4; ++i) nx[i] = *(const float4*)(xs + i * 256 + lane * 4);
    if (hasY) {
#pragma unroll
      for (int i = 0; i < 4; ++i) ny[i] = *(const h4*)(Y + (size_t)r0 * 1024 + i * 256 + lane * 4);
    }
  }
  for (int row = r0; row < r1; ++row) {
    float xv[4][4];
    h4 yh[4];
#pragma unroll
    for (int i = 0; i < 4; ++i) { xv[i][0] = nx[i].x; xv[i][1] = nx[i].y; xv[i][2] = nx[i].z; xv[i][3] = nx[i].w; yh[i] = ny[i]; }
    if (row + 1 < r1) {
      const float* xs = xsrc(row + 1);
#pragma unroll
      for (int i = 0; i < 4; ++i) nx[i] = *(const float4*)(xs + i * 256 + lane * 4);
      if (hasY) {
#pragma unroll
        for (int i = 0; i < 4; ++i) ny[i] = *(const h4*)(Y + (size_t)(row + 1) * 1024 + i * 256 + lane * 4);
      }
    }
    const int mi = row < RL ? (row >> 12) : 8;
    if (mi != cur_mi) {
      cur_mi = mi;
      const float* mg = MOD + (size_t)(lyr * 9 + mi) * 6144;
      const float* mh = MOD + (size_t)(hl * 9 + mi) * 6144;
#pragma unroll
      for (int i = 0; i < 4; ++i) {
        const int o = i * 256 + lane * 4;
        if (hasY) { gy[i] = *(const float4*)(p.norm_g + gyi * 1024 + o); gt[i] = *(const float4*)(mg + gti * 1024 + o); }
        if (hasH) {
          gh[i] = *(const float4*)(p.norm_g + ghi * 1024 + o);
          s1[i] = *(const float4*)(mh + shi * 1024 + o);
          s2[i] = *(const float4*)(mh + (shi + 1) * 1024 + o);
        }
      }
    }
    if (hasY) {
      float yv[4][4];
      float ss = 0.f;
#pragma unroll
      for (int i = 0; i < 4; ++i)
#pragma unroll
        for (int k = 0; k < 4; ++k) { yv[i][k] = (float)yh[i][k]; ss += yv[i][k] * yv[i][k]; }
      ss = wave_sum(ss, lane);
      const float rs = rsqrtf(ss * (1.f / 1024.f) + EPS);
      float* xo = xdst(row);
#pragma unroll
      for (int i = 0; i < 4; ++i) {
        xv[i][0] += gt[i].x * (yv[i][0] * rs * gy[i].x);
        xv[i][1] += gt[i].y * (yv[i][1] * rs * gy[i].y);
        xv[i][2] += gt[i].z * (yv[i][2] * rs * gy[i].z);
        xv[i][3] += gt[i].w * (yv[i][3] * rs * gy[i].w);
        *(float4*)(xo + i * 256 + lane * 4) = make_float4(xv[i][0], xv[i][1], xv[i][2], xv[i][3]);
      }
    }
    if (hasH) {
      float ss = 0.f;
#pragma unroll
      for (int i = 0; i < 4; ++i)
#pragma unroll
        for (int k = 0; k < 4; ++k) ss += xv[i][k] * xv[i][k];
      ss = wave_sum(ss, lane);
      const float rs = rsqrtf(ss * (1.f / 1024.f) + EPS);
      half_t* ho = H + (size_t)row * 1024;
#pragma unroll
      for (int i = 0; i < 4; ++i) {
        h4 o;
        o[0] = (half_t)(xv[i][0] * rs * gh[i].x * (1.f + s2[i].x) + s1[i].x);
        o[1] = (half_t)(xv[i][1] * rs * gh[i].y * (1.f + s2[i].y) + s1[i].y);
        o[2] = (half_t)(xv[i][2] * rs * gh[i].z * (1.f + s2[i].z) + s1[i].z);
        o[3] = (half_t)(xv[i][3] * rs * gh[i].w * (1.f + s2[i].w) + s1[i].w);
        *(h4*)(ho + i * 256 + lane * 4) = o;
      }
    }
  }
}

__device__ __forceinline__ int clampi(int v, int lo, int hi) { return v < lo ? lo : (v > hi ? hi : v); }

__device__ void attn_item(const P& p, int item, char* smem) {
  half_t* Ks = (half_t*)smem;
  half_t* Vt = Ks + 2 * 64 * 72;
  float* rpbs = (float*)(smem + 36864);
  const int tid = tidx(), lane = tid & 63, w = tid >> 6, lr = lane & 15, lq = lane >> 4;
  const half_t* U = (const half_t*)((p.ws + opaque_zero()) + OFF_U);
  half_t* Z = (half_t*)((p.ws + opaque_zero()) + OFF_Z);
  const bool isctx = item >= 2048;
  int b, h, qrow, nlat = 0, start0 = 0, my_r = 0, my_start = 0, cw = 0, cs = 0, qcol = 0;
  if (!isctx) {
    b = item >> 8; h = (item >> 5) & 7;
    const int r0 = (item & 31) * 2;
    my_r = r0 + (w >> 2);
    const int cgp = w & 3;
    qcol = cgp * 16 + lr;
    qrow = b * 4096 + my_r * 64 + qcol;
    start0 = clampi(r0 - 4, 0, 56);
    const int start1 = clampi(r0 + 1 - 4, 0, 56);
    nlat = start1 + 8 - start0;
    my_start = clampi(my_r - 4, 0, 56);
    cw = clampi(cgp * 16 - 8, 0, 32);
    cs = clampi(qcol - 8, 0, 48);
  } else {
    const int it = item - 2048;
    b = it >> 4; h = (it >> 1) & 7;
    qrow = RL + b * 256 + (it & 1) * 128 + w * 16 + lr;
  }
  const int ntiles = nlat + 4;
  h8 qf[2];
#pragma unroll
  for (int ks = 0; ks < 2; ++ks) {
    h8 t = *(const h8*)(U + (size_t)qrow * 2048 + 512 + h * 64 + ks * 32 + lq * 8);
#pragma unroll
    for (int i = 0; i < 8; ++i) t[i] = t[i] * (half_t)0.125f;
    qf[ks] = t;
  }
  if (!isctx)
    for (int i = tid; i < 465; i += 512) rpbs[i] = p.ev_rpb[h * 465 + i];

  const int skey = tid >> 3, sd = (tid & 7) * 8;
  uint4 kA, vA, kB, vB;
  auto tile_row0 = [&](int i) -> int { return i < nlat ? b * 4096 + (start0 + i) * 64 : RL + b * 256 + (i - nlat) * 64; };
  const half_t* VTg = (const half_t*)((p.ws + opaque_zero()) + OFF_A1);
#define AT_GLOAD(kr, vr, i)                                                                            \
  {                                                                                                    \
    const int r0t = tile_row0(i);                                                                      \
    kr = *(const uint4*)(U + (size_t)(r0t + skey) * 2048 + 1024 + h * 64 + sd);                        \
    vr = *(const uint4*)(VTg + ((size_t)(r0t >> 6) * 8 + h) * 4096 + skey * 64 + sd);                  \
  }
#define AT_SSTORE(kr, vr, buf)                                                                         \
  {                                                                                                    \
    *(uint4*)(Ks + (buf) * 4608 + skey * 72 + sd) = kr;                                                \
    *(uint4*)(Vt + (buf) * 4608 + skey * 72 + sd) = vr;                                                \
  }
  f4 o[4];
#pragma unroll
  for (int i = 0; i < 4; ++i) o[i] = (f4){0.f, 0.f, 0.f, 0.f};
  const float NEG = opaque_f(-1e30f);
  float m = NEG, l = 0.f;

  AT_GLOAD(kA, vA, 0);
  AT_SSTORE(kA, vA, 0);
  AT_GLOAD(kA, vA, 1);
  AT_GLOAD(kB, vB, 2);
  __syncthreads();
  for (int i = 0; i < ntiles; ++i) {
    const int buf = i & 1;
    const bool lt = i < nlat;
    const int kr_abs = start0 + i;
    const bool active = !lt || (kr_abs >= my_start && kr_abs < my_start + 8);
    if (active) {
      const int npairs = lt ? 1 : 2;
      for (int pi = 0; pi < npairs; ++pi) {
        const int kb = lt ? cw : pi * 32;
        f4 s[2];
#pragma unroll
        for (int st = 0; st < 2; ++st) {
          f4 z = (f4){0.f, 0.f, 0.f, 0.f};
#pragma unroll
          for (int ks = 0; ks < 2; ++ks) {
            const h8 kf = *(const h8*)(Ks + buf * 4608 + (kb + st * 16 + lr) * 72 + ks * 32 + lq * 8);
            z = __builtin_amdgcn_mfma_f32_16x16x32_f16(kf, qf[ks], z, 0, 0, 0);
          }
          s[st] = z;
        }
        float tmax = NEG;
        if (lt) {
          const int dr = clampi(kr_abs - my_r + 7, 0, 14);
          float bias[2][4];
#pragma unroll
          for (int st = 0; st < 2; ++st)
#pragma unroll
            for (int j = 0; j < 4; ++j) {
              const int kc = kb + st * 16 + lq * 4 + j;
              bias[st][j] = rpbs[dr * 31 + clampi(kc - qcol + 15, 0, 30)];
            }
#pragma unroll
          for (int st = 0; st < 2; ++st)
#pragma unroll
            for (int j = 0; j < 4; ++j) {
              const int kc = kb + st * 16 + lq * 4 + j;
              const bool ok = (kc >= cs) && (kc < cs + 16);
              const float v = s[st][j] + bias[st][j];
              s[st][j] = ok ? v : NEG;
            }
        }
#pragma unroll
        for (int st = 0; st < 2; ++st)
#pragma unroll
          for (int j = 0; j < 4; ++j) tmax = fmaxf(tmax, s[st][j]);
        tmax = fmaxf(tmax, bperm(tmax, lane ^ 16));
        tmax = fmaxf(tmax, bperm(tmax, lane ^ 32));
        const float mn = fmaxf(m, tmax);
        const float alpha = __expf(m - mn);
        m = mn;
        h8 pb;
        float ps = 0.f;
#pragma unroll
        for (int st = 0; st < 2; ++st)
#pragma unroll
          for (int j = 0; j < 4; ++j) {
            const float e = __expf(s[st][j] - mn);
            ps += e;
            pb[st * 4 + j] = (half_t)e;
          }
        l = l * alpha + ps;
#pragma unroll
        for (int dt = 0; dt < 4; ++dt) {
          o[dt] = o[dt] * alpha;
          const half_t* vp = Vt + buf * 4608 + (dt * 16 + lr) * 72 + kb + lq * 4;
          const h4 v0 = *(const h4*)vp;
          const h4 v1 = *(const h4*)(vp + 16);
          h8 vf;
          vf[0] = v0[0]; vf[1] = v0[1]; vf[2] = v0[2]; vf[3] = v0[3];
          vf[4] = v1[0]; vf[5] = v1[1]; vf[6] = v1[2]; vf[7] = v1[3];
          o[dt] = __builtin_amdgcn_mfma_f32_16x16x32_f16(vf, pb, o[dt], 0, 0, 0);
        }
      }
    }
    if (i + 1 < ntiles) {
      if ((i + 1) & 1) {
        AT_SSTORE(kA, vA, 1);
        if (i + 3 < ntiles) AT_GLOAD(kA, vA, i + 3);
      } else {
        AT_SSTORE(kB, vB, 0);
        if (i + 3 < ntiles) AT_GLOAD(kB, vB, i + 3);
      }
    }
    __syncthreads();
  }
#undef AT_GLOAD
#undef AT_SSTORE
  l += bperm(l, lane ^ 16);
  l += bperm(l, lane ^ 32);
  const float inv = 1.f / l;
#pragma unroll
  for (int dt = 0; dt < 4; ++dt) {
    h4 ov;
#pragma unroll
    for (int j = 0; j < 4; ++j) ov[j] = (half_t)(o[dt][j] * inv);
    *(h4*)(Z + (size_t)qrow * 1024 + 512 + h * 64 + dt * 16 + lq * 4) = ov;
  }
}

template <int HW>
__device__ __forceinline__ void pool_rows(const float (&pre)[4][25], int tl0, int L, half_t* zp) {
#pragma unroll
  for (int r = 0; r < 8; ++r) {
    const int tl = tl0 + r;
    const int lo = max(tl - HW, 0), hi = min(tl + HW, L);
    const float inv = 1.f / (float)(hi - lo);
    h4 o;
#pragma unroll
    for (int c = 0; c < 4; ++c) {
      const float sum = pre[c][8 + r + HW] - pre[c][8 + r - HW];
      const float cur = pre[c][8 + r + 1] - pre[c][8 + r];
      o[c] = (half_t)(sum * inv - cur);
    }
    *(h4*)(zp + (size_t)r * 1024) = o;
  }
}

__device__ void pool_item(const P& p, int item) {
  const half_t* U = (const half_t*)((p.ws + opaque_zero()) + OFF_U);
  half_t* Z = (half_t*)((p.ws + opaque_zero()) + OFF_Z);
  const int tid = tidx();
  const int c4 = (tid & 127) * 4, gi = c4 >> 7;
  const int row0 = item * 32 + (tid >> 7) * 8;
  int s0, L;
  if (row0 < RL) { s0 = row0 & ~4095; L = 4096; } else { s0 = RL + ((row0 - RL) & ~255); L = 256; }
  const int tl0 = row0 - s0;
  float pre[4][25];
#pragma unroll
  for (int c = 0; c < 4; ++c) pre[c][0] = 0.f;
#pragma unroll
  for (int i = 0; i < 24; ++i) {
    const int tl = tl0 - 8 + i;
    h4 v;
    v[0] = (half_t)0.f; v[1] = (half_t)0.f; v[2] = (half_t)0.f; v[3] = (half_t)0.f;
    if (tl >= 0 && tl < L) v = *(const h4*)(U + (size_t)(s0 + tl) * 2048 + c4);
#pragma unroll
    for (int c = 0; c < 4; ++c) pre[c][i + 1] = (float)v[c];
  }
#pragma unroll
  for (int i = 0; i < 24; ++i)
#pragma unroll
    for (int c = 0; c < 4; ++c) pre[c][i + 1] += pre[c][i];
  half_t* zp = Z + (size_t)row0 * 1024 + c4;
  if (gi == 0) pool_rows<1>(pre, tl0, L, zp);
  else if (gi == 1) pool_rows<2>(pre, tl0, L, zp);
  else if (gi == 2) pool_rows<4>(pre, tl0, L, zp);
  else pool_rows<8>(pre, tl0, L, zp);
}

__device__ void phase_shift(const P& p) {
  const half_t* H = (const half_t*)((p.ws + opaque_zero()) + OFF_A0);
  half_t* XX = (half_t*)((p.ws + opaque_zero()) + OFF_A1);
  const size_t total = (size_t)RT * 128;
  for (size_t idx = (size_t)bidx() * 512 + tidx(); idx < total; idx += (size_t)gridDim.x * 512) {
    const int row = (int)(idx >> 7), c = (int)(idx & 127) * 8;
    bool st, en;
    if (row < RL) { st = (row & 4095) == 0; en = (row & 4095) == 4095; }
    else { st = ((row - RL) & 255) == 0; en = ((row - RL) & 255) == 255; }
    const h8 cur = *(const h8*)(H + (size_t)row * 1024 + c);
    h8 pv, nx;
#pragma unroll
    for (int i = 0; i < 8; ++i) { pv[i] = (half_t)0.f; nx[i] = (half_t)0.f; }
    if (!st) pv = *(const h8*)(H + (size_t)(row - 1) * 1024 + c);
    if (!en) nx = *(const h8*)(H + (size_t)(row + 1) * 1024 + c);
    h8 o;
#pragma unroll
    for (int i = 0; i < 8; ++i) o[i] = (half_t)(0.5f * ((float)pv[i] + (float)nx[i]) - (float)cur[i]);
    *(h8*)(XX + (size_t)row * 1024 + c) = o;
  }
}

#define CS_BYTES 13312
#define CS_G 0
#define CS_R 2304
#define CS_AT 4608
#define CS_BT 6656
#define CS_VT 8704
#define CS_M 10752
#define CS_BM 11264
#define CS_CM 11776
#define CS_DM 12288
#define CS_PREF 12800
#define CS_PEND 13056
#define SCR_BASE 106496
#define SCR_BYTES 5632

__device__ void scan_item(const P& p, int item, char* smem) {
  const int tid = tidx(), lane = tid & 63, w = tid >> 6, lr = lane & 15, lq = lane >> 4;
  const int b = item >> 5, h = (item >> 1) & 15, dir = item & 1;
  char* ws = (p.ws + opaque_zero());
  const half_t* RRp = (const half_t*)(ws + OFF_RR);
  const half_t* KKp = (const half_t*)(ws + OFF_KK);
  const half_t* VVp = (const half_t*)(ws + OFF_VV);
  const half_t* Lp = (const half_t*)(ws + OFF_L);
  half_t* Yd = (half_t*)(ws + (dir ? OFF_A1 : OFF_A0));
  float* BN = (float*)(ws + OFF_BN) + (size_t)dir * RL * 16;

  auto grow = [&](int pp) -> int {
    if (pp < 256) return RL + b * 256 + (dir ? 255 - pp : pp);
    const int t = pp - 256;
    return b * 4096 + (dir ? 4095 - t : t);
  };

  auto prep = [&](int c) {
    char* cs = smem + w * CS_BYTES;
    half_t* G_ = (half_t*)(cs + CS_G);
    half_t* R_ = (half_t*)(cs + CS_R);
    half_t* AT = (half_t*)(cs + CS_AT);
    half_t* BT = (half_t*)(cs + CS_BT);
    half_t* VT = (half_t*)(cs + CS_VT);
    half_t* Mm = (half_t*)(cs + CS_M);
    half_t* Bm = (half_t*)(cs + CS_BM);
    half_t* Cm = (half_t*)(cs + CS_CM);
    half_t* Dm = (half_t*)(cs + CS_DM);
    float* Pref = (float*)(cs + CS_PREF);
    float* Pend = (float*)(cs + CS_PEND);
    char* scr = smem + SCR_BASE + w * SCR_BYTES;
    half_t* A_ = (half_t*)scr;
    half_t* B_ = (half_t*)(scr + 2304);
    float* Am = (float*)(scr + 4608);
    const bool lat = c >= 16;
    const int p0 = c * 16;
    const int rowA = grow(p0 + lr);
    const half_t* lp = Lp + (size_t)rowA * 384 + dir * 64 + lq * 8;
    const h8 aw0 = *(const h8*)(lp), aw1 = *(const h8*)(lp + 32);
    const h8 aa0 = *(const h8*)(lp + 128), aa1 = *(const h8*)(lp + 160);
    float ss[4], bp[4];
    int rows[4];
#pragma unroll
    for (int j = 0; j < 4; ++j) { ss[j] = 0.f; bp[j] = 0.f; rows[j] = grow(p0 + lq * 4 + j); }
#pragma unroll
    for (int nt = 0; nt < 4; ++nt) {
      const int ch = h * 64 + nt * 16 + lr;
      const float kkc = p.rw_kk[ch];
#pragma unroll
      for (int j = 0; j < 4; ++j) {
        const float k = (float)KKp[(size_t)rows[j] * 1024 + ch];
        ss[j] += (k * kkc) * (k * kkc);
      }
    }
    float inv[4];
#pragma unroll
    for (int j = 0; j < 4; ++j) inv[j] = rsqrtf(fmaxf(red16(ss[j]), 1e-24f));
#pragma unroll 1
    for (int nt = 0; nt < 4; ++nt) {
      const int ch = h * 64 + nt * 16 + lr;
      const half_t* w2p = (const half_t*)(ws + OFF_W2) + (size_t)dir * 65536 + (size_t)ch * 64 + lq * 8;
      const half_t* a2p = (const half_t*)(ws + OFF_A2) + (size_t)dir * 65536 + (size_t)ch * 64 + lq * 8;
      const h8 bw0 = *(const h8*)(w2p), bw1 = *(const h8*)(w2p + 32);
      const h8 ba0 = *(const h8*)(a2p), ba1 = *(const h8*)(a2p + 32);
      const float w0c = p.rw_w0[dir * 1024 + ch], a0c = p.rw_a0[dir * 1024 + ch];
      const float kkc = p.rw_kk[ch], kac = p.rw_ka[ch], rkc = p.rw_rk[ch];
      f4 cwv = (f4){0.f, 0.f, 0.f, 0.f}, cav = (f4){0.f, 0.f, 0.f, 0.f};
      cwv = __builtin_amdgcn_mfma_f32_16x16x32_f16(aw0, bw0, cwv, 0, 0, 0);
      cwv = __builtin_amdgcn_mfma_f32_16x16x32_f16(aw1, bw1, cwv, 0, 0, 0);
      cav = __builtin_amdgcn_mfma_f32_16x16x32_f16(aa0, ba0, cav, 0, 0, 0);
      cav = __builtin_amdgcn_mfma_f32_16x16x32_f16(aa1, ba1, cav, 0, 0, 0);
      h4 vq;
      float ev[4], avv[4], rv[4], kv[4];
#pragma unroll
      for (int j = 0; j < 4; ++j) {
        const size_t gi = (size_t)rows[j] * 1024 + ch;
        kv[j] = (float)KKp[gi];
        vq[j] = VVp[gi];
        rv[j] = lat ? (float)RRp[gi] : 0.f;
        ev[j] = 0.60653066f * sigm(cwv[j] + w0c);
        avv[j] = sigm(cav[j] + a0c);
        bp[j] += rv[j] * kv[j] * rkc * (dir == 0 ? (2.f - 2.f * kac + kac * avv[j]) : kac * avv[j]);
      }
      *(h4*)(VT + (nt * 16 + lr) * 16 + lq * 4) = vq;
      float cum[4];
      cum[0] = ev[0];
      cum[1] = cum[0] + ev[1];
      cum[2] = cum[1] + ev[2];
      cum[3] = cum[2] + ev[3];
      const float t1 = bperm(cum[3], (lane - 16) & 63), t2 = bperm(cum[3], (lane - 32) & 63), t3 = bperm(cum[3], (lane - 48) & 63);
      const float off = (lq >= 1 ? t1 : 0.f) + (lq >= 2 ? t2 : 0.f) + (lq >= 3 ? t3 : 0.f);
#pragma unroll
      for (int j = 0; j < 4; ++j) cum[j] += off;
      const float ref = bperm(cum[3], 16 + lr);
      const float end = bperm(cum[3], 48 + lr);
      if (lq == 0) {
        Pref[nt * 16 + lr] = __expf(-ref);
        Pend[nt * 16 + lr] = __expf(-(end - ref));
      }
      h4 aq, bq;
#pragma unroll
      for (int j = 0; j < 4; ++j) {
        const float d = cum[j] - ref;
        const float E1 = __expf(d), E2 = __expf(-d), E3 = __expf(ev[j] - d);
        const float k = kv[j];
        const float kk = k * kkc * inv[j];
        const float kd = k * (1.f + (avv[j] - 1.f) * kac);
        const half_t ga = (half_t)(kk * E3);
        const half_t ro = (half_t)(rv[j] * E2);
        const half_t al = (half_t)(kk * avv[j] * E1);
        const half_t be = (half_t)(kd * E1);
        const int o = (lq * 4 + j) * 72 + nt * 16 + lr;
        G_[o] = ga; R_[o] = ro; A_[o] = al; B_[o] = be;
        aq[j] = al; bq[j] = be;
      }
      *(h4*)(AT + (nt * 16 + lr) * 16 + lq * 4) = aq;
      *(h4*)(BT + (nt * 16 + lr) * 16 + lq * 4) = bq;
    }
#pragma unroll
    for (int j = 0; j < 4; ++j) {
      const float bpr = red16(bp[j]);
      if (lat && lr == 0) BN[(size_t)rows[j] * 16 + h] = bpr;
    }
    asm volatile("s_waitcnt lgkmcnt(0)" ::: "memory");
    f4 am = (f4){0.f, 0.f, 0.f, 0.f}, bm = am, cm = am, dm = am;
#pragma unroll
    for (int ks = 0; ks < 2; ++ks) {
      const h8 fa = *(const h8*)(A_ + lr * 72 + ks * 32 + lq * 8);
      const h8 fb = *(const h8*)(B_ + lr * 72 + ks * 32 + lq * 8);
      const h8 fg = *(const h8*)(G_ + lr * 72 + ks * 32 + lq * 8);
      const h8 fr = *(const h8*)(R_ + lr * 72 + ks * 32 + lq * 8);
      am = __builtin_amdgcn_mfma_f32_16x16x32_f16(fa, fg, am, 0, 0, 0);
      bm = __builtin_amdgcn_mfma_f32_16x16x32_f16(fb, fg, bm, 0, 0, 0);
      cm = __builtin_amdgcn_mfma_f32_16x16x32_f16(fa, fr, cm, 0, 0, 0);
      dm = __builtin_amdgcn_mfma_f32_16x16x32_f16(fb, fr, dm, 0, 0, 0);
    }
    h4 bmh, cmh, dmh;
#pragma unroll
    for (int j = 0; j < 4; ++j) {
      const int u = lq * 4 + j;
      am[j] = u < lr ? am[j] : 0.f;
      bmh[j] = (half_t)(u < lr ? bm[j] : 0.f);
      cmh[j] = (half_t)(u <= lr ? cm[j] : 0.f);
      dmh[j] = (half_t)(u <= lr ? dm[j] : 0.f);
    }
    *(h4*)(Bm + lr * 16 + lq * 4) = bmh;
    *(h4*)(Cm + lr * 16 + lq * 4) = cmh;
    *(h4*)(Dm + lr * 16 + lq * 4) = dmh;
    *(f4*)(Am + lr * 16 + lq * 4) = am;
    asm volatile("s_waitcnt lgkmcnt(0)" ::: "memory");
    float m[16];
#pragma unroll
    for (int t = 0; t < 16; ++t) {
      float acc = (t == lr) ? 1.f : 0.f;
#pragma unroll
      for (int u4 = 0; u4 < 4; ++u4) {
        if (u4 * 4 < t) {
          const f4 rw = *(const f4*)(Am + t * 16 + u4 * 4);
#pragma unroll
          for (int k = 0; k < 4; ++k)
            if (u4 * 4 + k < t) acc -= rw[k] * m[u4 * 4 + k];
        }
      }
      m[t] = acc;
    }
    if (lq == 0) {
#pragma unroll
      for (int t = 0; t < 16; ++t) Mm[t * 16 + lr] = (half_t)m[t];
    }
  };

  f4 Sacc[4];
#pragma unroll
  for (int jt = 0; jt < 4; ++jt) Sacc[jt] = (f4){0.f, 0.f, 0.f, 0.f};

  for (int sc = 0; sc < 34; ++sc) {
    prep(sc * 8 + w);
    __syncthreads();
    if (w < 4) {
      for (int cc = 0; cc < 8; ++cc) {
        const int c = sc * 8 + cc;
        const char* cs = smem + cc * CS_BYTES;
        const half_t* G_ = (const half_t*)(cs + CS_G);
        const half_t* R_ = (const half_t*)(cs + CS_R);
        const half_t* AT = (const half_t*)(cs + CS_AT);
        const half_t* BT = (const half_t*)(cs + CS_BT);
        const half_t* VT = (const half_t*)(cs + CS_VT);
        const half_t* Mm = (const half_t*)(cs + CS_M);
        const half_t* Bm = (const half_t*)(cs + CS_BM);
        const half_t* Cm = (const half_t*)(cs + CS_CM);
        const half_t* Dm = (const half_t*)(cs + CS_DM);
        const float* Pref = (const float*)(cs + CS_PREF);
        const float* Pend = (const float*)(cs + CS_PEND);
#pragma unroll
        for (int jt = 0; jt < 4; ++jt) Sacc[jt] = Sacc[jt] * *(const f4*)(Pref + jt * 16 + lq * 4);
        h8 bS[2];
#pragma unroll
        for (int ks = 0; ks < 2; ++ks)
#pragma unroll
          for (int k = 0; k < 4; ++k) {
            bS[ks][k] = (half_t)Sacc[2 * ks][k];
            bS[ks][4 + k] = (half_t)Sacc[2 * ks + 1][k];
          }
        const h4 vt = *(const h4*)(VT + (16 * w + lr) * 16 + lq * 4);
        f4 rhs = (f4){0.f, 0.f, 0.f, 0.f};
#pragma unroll
        for (int ks = 0; ks < 2; ++ks) {
          const h4 g0 = *(const h4*)(G_ + lr * 72 + (2 * ks) * 16 + lq * 4);
          const h4 g1 = *(const h4*)(G_ + lr * 72 + (2 * ks + 1) * 16 + lq * 4);
          h8 gf;
          gf[0] = g0[0]; gf[1] = g0[1]; gf[2] = g0[2]; gf[3] = g0[3];
          gf[4] = g1[0]; gf[5] = g1[1]; gf[6] = g1[2]; gf[7] = g1[3];
          rhs = __builtin_amdgcn_mfma_f32_16x16x32_f16(gf, bS[ks], rhs, 0, 0, 0);
        }
        {
          f4 r16 = (f4){0.f, 0.f, 0.f, 0.f};
          r16 = __builtin_amdgcn_mfma_f32_16x16x16f16(*(const h4*)(Bm + lr * 16 + lq * 4), vt, r16, 0, 0, 0);
          rhs = rhs + r16;
        }
        h4 rh;
#pragma unroll
        for (int k = 0; k < 4; ++k) rh[k] = (half_t)rhs[k];
        f4 av = (f4){0.f, 0.f, 0.f, 0.f};
        av = __builtin_amdgcn_mfma_f32_16x16x16f16(*(const h4*)(Mm + lr * 16 + lq * 4), rh, av, 0, 0, 0);
        h4 na;
#pragma unroll
        for (int k = 0; k < 4; ++k) na[k] = (half_t)(-av[k]);
        if (c >= 16) {
          f4 y = (f4){0.f, 0.f, 0.f, 0.f};
#pragma unroll
          for (int ks = 0; ks < 2; ++ks) {
            const h4 g0 = *(const h4*)(R_ + lr * 72 + (2 * ks) * 16 + lq * 4);
            const h4 g1 = *(const h4*)(R_ + lr * 72 + (2 * ks + 1) * 16 + lq * 4);
            h8 gf;
            gf[0] = g0[0]; gf[1] = g0[1]; gf[2] = g0[2]; gf[3] = g0[3];
            gf[4] = g1[0]; gf[5] = g1[1]; gf[6] = g1[2]; gf[7] = g1[3];
            y = __builtin_amdgcn_mfma_f32_16x16x32_f16(gf, bS[ks], y, 0, 0, 0);
          }
          f4 y16 = (f4){0.f, 0.f, 0.f, 0.f};
          y16 = __builtin_amdgcn_mfma_f32_16x16x16f16(*(const h4*)(Cm + lr * 16 + lq * 4), na, y16, 0, 0, 0);
          y16 = __builtin_amdgcn_mfma_f32_16x16x16f16(*(const h4*)(Dm + lr * 16 + lq * 4), vt, y16, 0, 0, 0);
          y = y + y16;
#pragma unroll
          for (int k = 0; k < 4; ++k) {
            const int row = grow(c * 16 + lq * 4 + k);
            Yd[(size_t)row * 1024 + h * 64 + 16 * w + lr] = (half_t)y[k];
          }
        }
#pragma unroll
        for (int jt = 0; jt < 4; ++jt) {
          Sacc[jt] = __builtin_amdgcn_mfma_f32_16x16x16f16(*(const h4*)(AT + (jt * 16 + lr) * 16 + lq * 4), na, Sacc[jt], 0, 0, 0);
          Sacc[jt] = __builtin_amdgcn_mfma_f32_16x16x16f16(*(const h4*)(BT + (jt * 16 + lr) * 16 + lq * 4), vt, Sacc[jt], 0, 0, 0);
          Sacc[jt] = Sacc[jt] * *(const f4*)(Pend + jt * 16 + lq * 4);
        }
      }
    }
    __syncthreads();
  }
}

__device__ void phase_readout(const P& p) {
  const int lane = tidx() & 63;
  const int gw = bidx() * 8 + (tidx() >> 6), stride = gridDim.x * 8;
  char* ws = (p.ws + opaque_zero());
  const half_t* Y0 = (const half_t*)(ws + OFF_A0);
  const half_t* Y1 = (const half_t*)(ws + OFF_A1);
  const half_t* VVp = (const half_t*)(ws + OFF_VV);
  const half_t* Gp = (const half_t*)(ws + OFF_G);
  const float* BN0 = (const float*)(ws + OFF_BN);
  const float* BN1 = BN0 + (size_t)RL * 16;
  half_t* Z1 = (half_t*)(ws + OFF_Z1);
  const int c0 = lane * 16, head = lane >> 2;
  for (int row = gw; row < RL; row += stride) {
    const size_t o = (size_t)row * 1024 + c0;
    float y[16], vv[16], gg[16];
#pragma unroll
    for (int hh = 0; hh < 2; ++hh) {
      const h8 a = *(const h8*)(Y0 + o + hh * 8);
      const h8 bq = *(const h8*)(Y1 + o + hh * 8);
      const h8 v = *(const h8*)(VVp + o + hh * 8);
      const h8 g = *(const h8*)(Gp + o + hh * 8);
#pragma unroll
      for (int i = 0; i < 8; ++i) {
        y[hh * 8 + i] = (float)a[i] + (float)bq[i];
        vv[hh * 8 + i] = (float)v[i];
        gg[hh * 8 + i] = (float)g[i];
      }
    }
    float s = 0.f;
#pragma unroll
    for (int i = 0; i < 16; ++i) s += y[i];
    s = red4(s);
    const float mean = s * (1.f / 64.f);
    float q = 0.f;
#pragma unroll
    for (int i = 0; i < 16; ++i) { const float d = y[i] - mean; q += d * d; }
    q = red4(q);
    const float rstd = rsqrtf(q * (1.f / 64.f) + 64e-5f);
    const float bonus = BN0[(size_t)row * 16 + head] + BN1[(size_t)row * 16 + head];
    h8 o0, o1;
#pragma unroll
    for (int i = 0; i < 16; ++i) {
      const float lg = p.rw_lng[c0 + i], lb = p.rw_lnb[c0 + i];
      const float r = ((y[i] - mean) * rstd * lg + lb + bonus * vv[i]) * gg[i];
      if (i < 8) o0[i] = (half_t)r; else o1[i - 8] = (half_t)r;
    }
    *(h8*)(Z1 + o) = o0;
    *(h8*)(Z1 + o + 8) = o1;
  }
}

#define NPHASE 18
__global__ void __launch_bounds__(512) mega(P p_in, int ph_lo, int ph_hi) {
  __shared__ __attribute__((aligned(16))) char smem[SMEM_BYTES];
  cg::grid_group grid = cg::this_grid();
  const P& p = p_in;
  for (int ph = ph_lo; ph < ph_hi; ++ph) {
    char* ws = p_in.ws + opaque_zero();
    int kind = 2, arg = 0;
    size_t oA = 0, oB = 0, oC = 0;
    int lda = 1024, ldb = 1024, K = 1024, ldc = 1024, epi = 0, nMt = 136, nNt = 8, feat = 0;
    switch (ph) {
      case 0: kind = 0; break;
      case 1: kind = 1; arg = 0; break;
      case 2: oA = OFF_A0; oB = OFF_WIN; oC = OFF_U; ldc = 2048; nNt = 8; feat = 2; break;
      case 3: kind = 3; break;
      case 4: oA = OFF_Z; oB = OFF_WOUT; oC = OFF_A1; nNt = 4; feat = 3; break;
      case 5: kind = 1; arg = 1; break;
      case 6: oA = OFF_A0; oB = OFF_M1; oC = OFF_F; ldc = 4096; nNt = 16; epi = 1; feat = 3; break;
      case 7: oA = OFF_F; lda = 4096; oB = OFF_M2; ldb = 4096; K = 4096; oC = OFF_A1; nNt = 4; feat = 3; break;
      case 8: kind = 1; arg = 2; break;
      case 9: kind = 4; break;
      case 10: oA = OFF_A0; oB = OFF_WR; oC = OFF_RR; nNt = 27; feat = 1; break;
      case 11: kind = 5; break;
      case 12: oA = OFF_L + 512; lda = 384; oB = OFF_G2; ldb = 128; K = 128; oC = OFF_Z1; nMt = 128; epi = 5; break;
      case 13: oA = OFF_Z1; oB = OFF_WO; oC = OFF_A1; nMt = 128; nNt = 4; feat = 3; break;
      case 14: kind = 1; arg = 3; break;
      case 15: oA = OFF_A0; oB = OFF_M1 + 8 * MIB; oC = OFF_F; ldc = 4096; nNt = 16; epi = 1; nMt = 128; feat = 3; break;
      case 16: oA = OFF_F; lda = 4096; oB = OFF_M2 + 8 * MIB; ldb = 4096; K = 4096; oC = OFF_A1; nMt = 128; nNt = 4; feat = 3; break;
      default: kind = 1; arg = 4; break;
    }
    if (kind == 2) {
      gemm_phase(p, (const half_t*)(ws + oA), lda, (const half_t*)(ws + oB), ldb, K, (half_t*)(ws + oC), ldc, epi, nMt, nNt, feat, smem);
    } else if (kind == 1) {
      phase_rowwise(p, arg);
    } else if (kind == 0) {
      phase_prep(p, smem);
    } else if (kind == 3) {
      for (int it = bidx(); it < 2176 + 1088; it += gridDim.x) {
        if (it < 2176) attn_item(p, it, smem); else pool_item(p, it - 2176);
      }
    } else if (kind == 4) {
      phase_shift(p);
    } else if (kind == 5) {
      for (int it = bidx(); it < 256; it += gridDim.x) scan_item(p, it, smem);
    } else {
      phase_readout(p);
    }
    if (ph + 1 < ph_hi) grid.sync();
  }
}

extern "C" void kernel_launch(void* const* d_in, const int* in_sizes, int n_in, void* d_out, int out_size, void* d_ws,
                              size_t ws_size, hipStream_t stream) {
  P p{};
  const float** pp = (const float**)&p;
  for (int i = 0; i < 32; ++i) pp[i] = (const float*)d_in[i];
  p.out = (float*)d_out;
  p.ws = (char*)d_ws;
  static int grid_blocks = 0;
  if (!grid_blocks) {
    int dev = 0, cus = 0, per_cu = 0;
    (void)hipGetDevice(&dev);
    (void)hipDeviceGetAttribute(&cus, hipDeviceAttributeMultiprocessorCount, dev);
    (void)hipOccupancyMaxActiveBlocksPerMultiprocessor(&per_cu, mega, 512, 0);
    if (per_cu < 1) per_cu = 1;
    grid_blocks = cus * per_cu;
  }
  int lo = 0, hi = NPHASE;
  void* args[] = {&p, &lo, &hi};
  hipError_t e = hipLaunchCooperativeKernel((void*)mega, dim3(grid_blocks), dim3(512), args, 0, stream);
  if (e != hipSuccess) fprintf(stderr, "cooperative launch failed: %s (grid %d)\n", hipGetErrorString(e), grid_blocks);
}
```

```cpp
#include <hip/hip_runtime.h>
#include <hip/hip_cooperative_groups.h>
#include <cstdio>
namespace cg = cooperative_groups;

typedef _Float16 half_t;
typedef _Float16 h8 __attribute__((ext_vector_type(8)));
typedef _Float16 h4 __attribute__((ext_vector_type(4)));
typedef _Float16 h2 __attribute__((ext_vector_type(2)));
typedef float f4 __attribute__((ext_vector_type(4)));

#define RL 32768
#define RC 2048
#define RT 34816
#define MIB (1ull << 20)
#define OFF_WIN (0 * MIB)
#define OFF_WOUT (4 * MIB)
#define OFF_M1 (7 * MIB)
#define OFF_M2 (23 * MIB)
#define OFF_WR (39 * MIB)
#define OFF_WK (41 * MIB)
#define OFF_WV (43 * MIB)
#define OFF_WO (45 * MIB)
#define OFF_L1 (47 * MIB)
#define OFF_W2 (48 * MIB)
#define OFF_A2 (48 * MIB + 256 * 1024)
#define OFF_G2 (48 * MIB + 512 * 1024)
#define OFF_MOD (49 * MIB)
#define OFF_BN (50 * MIB)
#define OFF_XC (54 * MIB)
#define OFF_A0 (62 * MIB)
#define OFF_A1 (130 * MIB)
#define OFF_BIG (198 * MIB)
#define OFF_U OFF_BIG
#define OFF_Z (334 * MIB)
#define OFF_F OFF_BIG
#define OFF_RR OFF_BIG
#define OFF_KK (266 * MIB)
#define OFF_VV (334 * MIB)
#define OFF_L (402 * MIB)
#define OFF_G OFF_BIG
#define OFF_Z1 (266 * MIB)

#define SMEM_BYTES 151552

struct P {
  const float *x, *c, *ctx, *c_ctx, *ada_w, *ada_b, *norm_g, *mlp_w1, *mlp_w2, *ev_w_in, *ev_w_out, *ev_pool_w,
      *ev_pool_scale, *ev_rpb, *rw_mu, *rw_wr, *rw_wk, *rw_wv, *rw_wo, *rw_w0, *rw_w1, *rw_w2, *rw_a0, *rw_a1, *rw_a2,
      *rw_g1, *rw_g2, *rw_kk, *rw_ka, *rw_rk, *rw_lng, *rw_lnb;
  float* out;
  char* ws;
};

__device__ __forceinline__ int tidx() { int v = threadIdx.x; asm volatile("" : "+v"(v)); return v; }
__device__ __forceinline__ int bidx() { int v = blockIdx.x; asm volatile("" : "+s"(v)); return v; }
__device__ __forceinline__ size_t opaque_zero() { size_t z = 0; asm volatile("" : "+s"(z)); return z; }
__device__ __forceinline__ float opaque_f(float v) { asm volatile("" : "+v"(v)); return v; }
__device__ __forceinline__ float sigm(float x) { return 1.f / (1.f + __expf(-x)); }
__device__ __forceinline__ float bperm(float v, int srclane) {
  return __builtin_bit_cast(float, __builtin_amdgcn_ds_bpermute(srclane << 2, __builtin_bit_cast(int, v)));
}
template <int CTRL>
__device__ __forceinline__ float dpp(float x) {
  return __builtin_bit_cast(float, __builtin_amdgcn_mov_dpp(__builtin_bit_cast(int, x), CTRL, 0xf, 0xf, true));
}
__device__ __forceinline__ float red4(float x) { x += dpp<0xB1>(x); x += dpp<0x4E>(x); return x; }
__device__ __forceinline__ float red8(float x) { x = red4(x); x += dpp<0x141>(x); return x; }
__device__ __forceinline__ float red16(float x) { x = red8(x); x += dpp<0x140>(x); return x; }
__device__ __forceinline__ float wave_sum(float v, int lane) {
  v = red16(v);
  v += bperm(v, lane ^ 16);
  v += bperm(v, lane ^ 32);
  return v;
}

struct GemmTile {
  const half_t* A; const half_t* A2; const float* mu; int lda;
  const half_t* Bt; int ldb; int K;
  half_t* C; int ldc; int epi;
  int row0, col0;
  const P* pp;
};

template <bool MIX>
__device__ __forceinline__ void gemm_tile(const GemmTile& g, char* smem) {
  half_t* As = (half_t*)smem;
  half_t* Bs = (half_t*)(smem + 73728);
  const int tid = tidx(), lane = tid & 63, w = tid >> 6;
  const int wm = w >> 1, wn = w & 1, lr = lane & 15, lq = lane >> 4;
  const int ldr = tid >> 3, ldk = (tid & 7) * 8;
  f4 acc[4][4];
#pragma unroll
  for (int i = 0; i < 4; ++i)
#pragma unroll
    for (int j = 0; j < 4; ++j) acc[i][j] = (f4){0.f, 0.f, 0.f, 0.f};
  uint4 ra0, ra1, ra2, ra3, rb0, rb1;
  uint4 rx0, rx1, rx2, rx3;
  float4 mu0, mu1;
  const int nk = g.K >> 6;
  const half_t* Ap = g.A + (size_t)ldr * g.lda + ldk;
  const half_t* A2p = MIX ? g.A2 + (size_t)ldr * g.lda + ldk : nullptr;
  const float* mup = MIX ? g.mu + ldk : nullptr;
  const half_t* Bp = g.Bt + (size_t)ldr * g.ldb + ldk;
  const size_t astep = (size_t)64 * g.lda, bstep = (size_t)64 * g.ldb;
  half_t* asw = As + ldr * 72 + ldk;
  half_t* bsw = Bs + ldr * 72 + ldk;
  const half_t* asr = As + (wm * 64 + lr) * 72 + lq * 8;
  const half_t* bsr = Bs + (wn * 64 + lr) * 72 + lq * 8;

#define GLOAD(kt)                                              \
  {                                                            \
    const int k0 = (kt) * 64;                                  \
    ra0 = *(const uint4*)(Ap + k0);                            \
    ra1 = *(const uint4*)(Ap + astep + k0);                    \
    ra2 = *(const uint4*)(Ap + 2 * astep + k0);                \
    ra3 = *(const uint4*)(Ap + 3 * astep + k0);                \
    rb0 = *(const uint4*)(Bp + k0);                            \
    rb1 = *(const uint4*)(Bp + bstep + k0);                    \
    if (MIX) {                                                 \
      rx0 = *(const uint4*)(A2p + k0);                         \
      rx1 = *(const uint4*)(A2p + astep + k0);                 \
      rx2 = *(const uint4*)(A2p + 2 * astep + k0);             \
      rx3 = *(const uint4*)(A2p + 3 * astep + k0);             \
      mu0 = *(const float4*)(mup + k0);                        \
      mu1 = *(const float4*)(mup + k0 + 4);                    \
    }                                                          \
  }
#define MIXV(r, x) __builtin_bit_cast(uint4, (h8)(__builtin_bit_cast(h8, r) + __builtin_bit_cast(h8, x) * m))
#define SSTORE(buf)                                            \
  {                                                            \
    half_t* as = asw + (buf) * (256 * 72);                     \
    half_t* bs = bsw + (buf) * (128 * 72);                     \
    if (MIX) {                                                 \
      h8 m;                                                    \
      m[0] = (half_t)mu0.x; m[1] = (half_t)mu0.y; m[2] = (half_t)mu0.z; m[3] = (half_t)mu0.w; \
      m[4] = (half_t)mu1.x; m[5] = (half_t)mu1.y; m[6] = (half_t)mu1.z; m[7] = (half_t)mu1.w; \
      ra0 = MIXV(ra0, rx0); ra1 = MIXV(ra1, rx1); ra2 = MIXV(ra2, rx2); ra3 = MIXV(ra3, rx3); \
    }                                                          \
    *(uint4*)(as) = ra0;                                       \
    *(uint4*)(as + 64 * 72) = ra1;                             \
    *(uint4*)(as + 128 * 72) = ra2;                            \
    *(uint4*)(as + 192 * 72) = ra3;                            \
    *(uint4*)(bs) = rb0;                                       \
    *(uint4*)(bs + 64 * 72) = rb1;                             \
  }

  GLOAD(0);
  SSTORE(0);
  __syncthreads();
  for (int kt = 0; kt < nk; ++kt) {
    const bool more = kt + 1 < nk;
    if (more) GLOAD(kt + 1);
    __builtin_amdgcn_sched_barrier(0);
    {
      const half_t* as = asr + (kt & 1) * (256 * 72);
      const half_t* bs = bsr + (kt & 1) * (128 * 72);
#pragma unroll
      for (int ks = 0; ks < 2; ++ks) {
        h8 a[4], b[4];
#pragma unroll
        for (int i = 0; i < 4; ++i) {
          a[i] = *(const h8*)(as + i * 16 * 72 + ks * 32);
          b[i] = *(const h8*)(bs + i * 16 * 72 + ks * 32);
        }
#pragma unroll
        for (int mt = 0; mt < 4; ++mt)
#pragma unroll
          for (int nt = 0; nt < 4; ++nt)
            acc[mt][nt] = __builtin_amdgcn_mfma_f32_16x16x32_f16(b[nt], a[mt], acc[mt][nt], 0, 0, 0);
      }
    }
    if (more) SSTORE((kt + 1) & 1);
    __syncthreads();
  }
#undef GLOAD
#undef SSTORE
#undef MIXV
#pragma unroll
  for (int mt = 0; mt < 4; ++mt) {
    half_t* cp = g.C + (size_t)(wm * 64 + mt * 16 + lr) * g.ldc + wn * 64 + lq * 4;
#pragma unroll
    for (int nt = 0; nt < 4; ++nt) {
      h4 o;
#pragma unroll
      for (int j = 0; j < 4; ++j) {
        float v = acc[mt][nt][j];
        if (g.epi == 1) { v = fmaxf(v, 0.f); v = v * v; }
        else if (g.epi == 2) v = 1.f - 2.f / (__expf(2.f * v) + 1.f);
        else if (g.epi == 3) v = sigm(v);
        o[j] = (half_t)v;
      }
      *(h4*)(cp + nt * 16) = o;
    }
  }
}

__device__ __forceinline__ void gemm_tile2(const GemmTile& g, char* smem) {
  half_t* As = (half_t*)smem;
  half_t* Bs = (half_t*)(smem + 73728);
  const int tid = tidx(), lane = tid & 63, w = tid >> 6;
  const int wm = w >> 1, wn = w & 1, lr = lane & 15, lq = lane >> 4;
  const int ldr = tid >> 3, ldk = (tid & 7) * 8;
  f4 acc[4][4];
#pragma unroll
  for (int i = 0; i < 4; ++i)
#pragma unroll
    for (int j = 0; j < 4; ++j) acc[i][j] = (f4){0.f, 0.f, 0.f, 0.f};
  uint4 xa0, xa1, xa2, xa3, xb0, xb1;
  uint4 ya0, ya1, ya2, ya3, yb0, yb1;
  const int nk = g.K >> 6;
  const half_t* Ap = g.A + (size_t)ldr * g.lda + ldk;
  const half_t* Bp = g.Bt + (size_t)ldr * g.ldb + ldk;
  const size_t astep = (size_t)64 * g.lda, bstep = (size_t)64 * g.ldb;
  half_t* asw = As + ldr * 72 + ldk;
  half_t* bsw = Bs + ldr * 72 + ldk;
  const half_t* asr = As + (wm * 64 + lr) * 72 + lq * 8;
  const half_t* bsr = Bs + (wn * 64 + lr) * 72 + lq * 8;
#define GLD(S, kt)                                   \
  {                                                  \
    const int k0 = (kt) * 64;                        \
    S##a0 = *(const uint4*)(Ap + k0);                \
    S##a1 = *(const uint4*)(Ap + astep + k0);        \
    S##a2 = *(const uint4*)(Ap + 2 * astep + k0);    \
    S##a3 = *(const uint4*)(Ap + 3 * astep + k0);    \
    S##b0 = *(const uint4*)(Bp + k0);                \
    S##b1 = *(const uint4*)(Bp + bstep + k0);        \
  }
#define SST(S, buf)                                  \
  {                                                  \
    half_t* as = asw + (buf) * (256 * 72);           \
    half_t* bs = bsw + (buf) * (128 * 72);           \
    *(uint4*)(as) = S##a0;                           \
    *(uint4*)(as + 64 * 72) = S##a1;                 \
    *(uint4*)(as + 128 * 72) = S##a2;                \
    *(uint4*)(as + 192 * 72) = S##a3;                \
    *(uint4*)(bs) = S##b0;                           \
    *(uint4*)(bs + 64 * 72) = S##b1;                 \
  }
#define CMP(buf)                                                                                     \
  {                                                                                                  \
    const half_t* as = asr + (buf) * (256 * 72);                                                     \
    const half_t* bs = bsr + (buf) * (128 * 72);                                                     \
    _Pragma("unroll") for (int ks = 0; ks < 2; ++ks) {                                               \
      h8 a[4], b[4];                                                                                 \
      _Pragma("unroll") for (int i = 0; i < 4; ++i) {                                                \
        a[i] = *(const h8*)(as + i * 16 * 72 + ks * 32);                                             \
        b[i] = *(const h8*)(bs + i * 16 * 72 + ks * 32);                                             \
      }                                                                                              \
      _Pragma("unroll") for (int mt = 0; mt < 4; ++mt)                                               \
        _Pragma("unroll") for (int nt = 0; nt < 4; ++nt)                                             \
          acc[mt][nt] = __builtin_amdgcn_mfma_f32_16x16x32_f16(b[nt], a[mt], acc[mt][nt], 0, 0, 0);  \
    }                                                                                                \
  }
  GLD(x, 0);
  SST(x, 0);
  if (nk > 1) GLD(x, 1);
  if (nk > 2) GLD(y, 2);
  __syncthreads();
  for (int kt = 0; kt < nk; kt += 2) {
    CMP(0);
    if (kt + 1 < nk) SST(x, 1);
    if (kt + 3 < nk) GLD(x, kt + 3);
    __syncthreads();
    CMP(1);
    if (kt + 2 < nk) SST(y, 0);
    if (kt + 4 < nk) GLD(y, kt + 4);
    __syncthreads();
  }
#undef GLD
#undef SST
#undef CMP
#pragma unroll
  for (int mt = 0; mt < 4; ++mt) {
    half_t* cp = g.C + (size_t)(wm * 64 + mt * 16 + lr) * g.ldc + wn * 64 + lq * 4;
#pragma unroll
    for (int nt = 0; nt < 4; ++nt) {
      h4 o;
#pragma unroll
      for (int j = 0; j < 4; ++j) {
        float v = acc[mt][nt][j];
        if (g.epi == 1) { v = fmaxf(v, 0.f); v = v * v; }
        o[j] = (half_t)v;
      }
      *(h4*)(cp + nt * 16) = o;
    }
  }
}

__device__ __forceinline__ void gemm_tile3(const GemmTile& g, char* smem) {
  const int tid = tidx(), lane = tid & 63, w = tid >> 6;
  const int wm = w >> 1, wn = w & 1, lr = lane & 15, lq = lane >> 4;
  f4 acc[4][4];
#pragma unroll
  for (int i = 0; i < 4; ++i)
#pragma unroll
    for (int j = 0; j < 4; ++j) acc[i][j] = (f4){0.f, 0.f, 0.f, 0.f};
  const int nk = g.K >> 6;
  const int lrow = lane >> 3, lslot = lane & 7;
  const half_t* Ag[4];
  const half_t* Bg[2];
#pragma unroll
  for (int i = 0; i < 4; ++i) {
    const int row = (w * 4 + i) * 8 + lrow;
    Ag[i] = g.A + (size_t)row * g.lda + ((lslot ^ ((row >> 1) & 7)) * 8);
  }
#pragma unroll
  for (int i = 0; i < 2; ++i) {
    const int row = (w * 2 + i) * 8 + lrow;
    Bg[i] = g.Bt + (size_t)row * g.ldb + ((lslot ^ ((row >> 1) & 7)) * 8);
  }
  char* aw = smem + (w * 4) * 1024 + lane * 16;
  char* bw = smem + 32768 + (w * 2) * 1024 + lane * 16;
  const int swz = (lr >> 1) & 7;
  const int ko0 = ((0 + lq) ^ swz) * 16, ko1 = ((4 + lq) ^ swz) * 16;
  const char* ar = smem + (wm * 64 + lr) * 128;
  const char* br = smem + 32768 + (wn * 64 + lr) * 128;
#define ISSUE(kt, st)                                                                                      \
  {                                                                                                        \
    _Pragma("unroll") for (int i = 0; i < 4; ++i)                                                          \
      __builtin_amdgcn_global_load_lds((const unsigned*)(Ag[i] + (kt) * 64), (unsigned*)(aw + (st) * 49152 + i * 1024), 16, 0, 0); \
    _Pragma("unroll") for (int i = 0; i < 2; ++i)                                                          \
      __builtin_amdgcn_global_load_lds((const unsigned*)(Bg[i] + (kt) * 64), (unsigned*)(bw + (st) * 49152 + i * 1024), 16, 0, 0); \
  }
  ISSUE(0, 0);
  if (nk > 1) {
    ISSUE(1, 1);
    asm volatile("s_waitcnt vmcnt(6)" ::: "memory");
  } else {
    asm volatile("s_waitcnt vmcnt(0)" ::: "memory");
  }
  __builtin_amdgcn_s_barrier();
  asm volatile("" ::: "memory");
  h8 a0[4], b0[4], a1[4], b1[4];
#define LDF(fa, fb, stg, ko)                                             \
  {                                                                      \
    const char* as = ar + (stg) * 49152 + (ko);                          \
    const char* bs = br + (stg) * 49152 + (ko);                          \
    _Pragma("unroll") for (int i = 0; i < 4; ++i) {                      \
      fa[i] = *(const h8*)(as + i * 2048);                               \
      fb[i] = *(const h8*)(bs + i * 2048);                               \
    }                                                                    \
  }
#define MMA(fa, fb)                                                      \
  {                                                                      \
    _Pragma("unroll") for (int mt = 0; mt < 4; ++mt)                     \
      _Pragma("unroll") for (int nt = 0; nt < 4; ++nt)                   \
        acc[mt][nt] = __builtin_amdgcn_mfma_f32_16x16x32_f16(fb[nt], fa[mt], acc[mt][nt], 0, 0, 0); \
  }
  LDF(a0, b0, 0, ko0);
  int st = 0;
  for (int kt = 0; kt < nk; ++kt) {
    const bool more = kt + 2 < nk;
    int st1 = st + 1; if (st1 >= 3) st1 -= 3;
    int st2 = st + 2; if (st2 >= 3) st2 -= 3;
    if (more) ISSUE(kt + 2, st2);
    LDF(a1, b1, st, ko1);
    __builtin_amdgcn_sched_barrier(0);
    MMA(a0, b0);
    __builtin_amdgcn_sched_barrier(0);
    if (more) asm volatile("s_waitcnt vmcnt(6) lgkmcnt(0)" ::: "memory");
    else asm volatile("s_waitcnt vmcnt(0) lgkmcnt(0)" ::: "memory");
    __builtin_amdgcn_s_barrier();
    asm volatile("" ::: "memory");
    if (kt + 1 < nk) LDF(a0, b0, st1, ko0);
    __builtin_amdgcn_sched_barrier(0);
    MMA(a1, b1);
    __builtin_amdgcn_sched_barrier(0);
    st = st1;
  }
#undef LDF
#undef MMA
#undef ISSUE
  if (g.epi == 5) {
    const P& p = *g.pp;
    char* ws = p.ws + opaque_zero();
    const half_t* Y0 = (const half_t*)(ws + OFF_A0);
    const half_t* Y1 = (const half_t*)(ws + OFF_A1);
    const half_t* VVp = (const half_t*)(ws + OFF_VV);
    const float* BN0 = (const float*)(ws + OFF_BN);
    const float* BN1 = BN0 + (size_t)RL * 16;
    half_t* Z1 = (half_t*)(ws + OFF_Z1);
    const int head = (g.col0 >> 6) + wn;
#pragma unroll 1
    for (int mt = 0; mt < 4; ++mt) {
      const int row = g.row0 + wm * 64 + mt * 16 + lr;
      const size_t base = (size_t)row * 1024 + head * 64 + lq * 4;
      float y[4][4], vv[4][4];
      float sm = 0.f;
#pragma unroll
      for (int nt = 0; nt < 4; ++nt) {
        const h4 ya = *(const h4*)(Y0 + base + nt * 16);
        const h4 yb = *(const h4*)(Y1 + base + nt * 16);
        const h4 vh = *(const h4*)(VVp + base + nt * 16);
#pragma unroll
        for (int j = 0; j < 4; ++j) { y[nt][j] = (float)ya[j] + (float)yb[j]; vv[nt][j] = (float)vh[j]; sm += y[nt][j]; }
      }
      sm += bperm(sm, lane ^ 16);
      sm += bperm(sm, lane ^ 32);
      const float mean = sm * (1.f / 64.f);
      float q = 0.f;
#pragma unroll
      for (int nt = 0; nt < 4; ++nt)
#pragma unroll
        for (int j = 0; j < 4; ++j) { const float d = y[nt][j] - mean; q += d * d; }
      q += bperm(q, lane ^ 16);
      q += bperm(q, lane ^ 32);
      const float rstd = rsqrtf(q * (1.f / 64.f) + 64e-5f);
      const float bonus = BN0[(size_t)row * 16 + head] + BN1[(size_t)row * 16 + head];
#pragma unroll
      for (int nt = 0; nt < 4; ++nt) {
        const int ch = head * 64 + nt * 16 + lq * 4;
        const float4 lg = *(const float4*)(p.rw_lng + ch);
        const float4 lb = *(const float4*)(p.rw_lnb + ch);
        const float lgv[4] = {lg.x, lg.y, lg.z, lg.w}, lbv[4] = {lb.x, lb.y, lb.z, lb.w};
        const f4 gv = mt == 0 ? acc[0][nt] : (mt == 1 ? acc[1][nt] : (mt == 2 ? acc[2][nt] : acc[3][nt]));
        h4 o;
#pragma unroll
        for (int j = 0; j < 4; ++j) o[j] = (half_t)(((y[nt][j] - mean) * rstd * lgv[j] + lbv[j] + bonus * vv[nt][j]) * gv[j]);
        *(h4*)(Z1 + base + nt * 16) = o;
      }
    }
    return;
  }
  if (g.epi == 4) {
    half_t* vp = g.C + (size_t)((wm * 8 + wn) * 64) * 64 + lr;
#pragma unroll
    for (int mt = 0; mt < 4; ++mt)
#pragma unroll
      for (int nt = 0; nt < 4; ++nt)
#pragma unroll
        for (int j = 0; j < 4; ++j) vp[(nt * 16 + lq * 4 + j) * 64 + mt * 16] = (half_t)acc[mt][nt][j];
    return;
  }
#pragma unroll
  for (int mt = 0; mt < 4; ++mt) {
    half_t* cp = g.C + (size_t)(wm * 64 + mt * 16 + lr) * g.ldc + wn * 64 + lq * 4;
#pragma unroll
    for (int nt = 0; nt < 4; ++nt) {
      h4 o;
#pragma unroll
      for (int j = 0; j < 4; ++j) {
        float v = acc[mt][nt][j];
        if (g.epi == 1) { v = fmaxf(v, 0.f); v = v * v; }
        o[j] = (half_t)v;
      }
      *(h4*)(cp + nt * 16) = o;
    }
  }
}

__device__ __forceinline__ void gemm_tile4(const GemmTile& g, char* smem) {
  const int tid = tidx(), lane = tid & 63, w = tid >> 6;
  const int wm = w >> 1, wn = w & 1, lr = lane & 15, lq = lane >> 4;
  f4 acc[4][8];
#pragma unroll
  for (int i = 0; i < 4; ++i)
#pragma unroll
    for (int j = 0; j < 8; ++j) acc[i][j] = (f4){0.f, 0.f, 0.f, 0.f};
  const int nk = g.K >> 6;
  const int lrow = lane >> 3, lslot = lane & 7;
  const half_t* Ag[4];
  const half_t* Bg[4];
#pragma unroll
  for (int i = 0; i < 4; ++i) {
    const int row = (w * 4 + i) * 8 + lrow;
    const int so = (lslot ^ ((row >> 1) & 7)) * 8;
    Ag[i] = g.A + (size_t)row * g.lda + so;
    Bg[i] = g.Bt + (size_t)row * g.ldb + so;
  }
  char* aw = smem + (w * 4) * 1024 + lane * 16;
  char* bw = smem + 32768 + (w * 4) * 1024 + lane * 16;
  const int swz = (lr >> 1) & 7;
  const int ko0 = ((0 + lq) ^ swz) * 16, ko1 = ((4 + lq) ^ swz) * 16;
  const char* ar = smem + (wm * 64 + lr) * 128;
  const char* br = smem + 32768 + (wn * 128 + lr) * 128;
#define ISSUE4(kt, st)                                                                                     \
  {                                                                                                        \
    _Pragma("unroll") for (int i = 0; i < 4; ++i)                                                          \
      __builtin_amdgcn_global_load_lds((const unsigned*)(Ag[i] + (kt) * 64), (unsigned*)(aw + (st) * 65536 + i * 1024), 16, 0, 0); \
    _Pragma("unroll") for (int i = 0; i < 4; ++i)                                                          \
      __builtin_amdgcn_global_load_lds((const unsigned*)(Bg[i] + (kt) * 64), (unsigned*)(bw + (st) * 65536 + i * 1024), 16, 0, 0); \
  }
  ISSUE4(0, 0);
  asm volatile("s_waitcnt vmcnt(0)" ::: "memory");
  __builtin_amdgcn_s_barrier();
  asm volatile("" ::: "memory");
  for (int kt = 0; kt < nk; ++kt) {
    const int st = kt & 1;
    if (kt + 1 < nk) ISSUE4(kt + 1, st ^ 1);
    const char* as = ar + st * 65536;
    const char* bs = br + st * 65536;
#pragma unroll
    for (int ks = 0; ks < 2; ++ks) {
      const int ko = ks ? ko1 : ko0;
      h8 a[4], b[8];
#pragma unroll
      for (int i = 0; i < 4; ++i) a[i] = *(const h8*)(as + i * 2048 + ko);
#pragma unroll
      for (int i = 0; i < 8; ++i) b[i] = *(const h8*)(bs + i * 2048 + ko);
#pragma unroll
      for (int mt = 0; mt < 4; ++mt)
#pragma unroll
        for (int nt = 0; nt < 8; ++nt)
          acc[mt][nt] = __builtin_amdgcn_mfma_f32_16x16x32_f16(b[nt], a[mt], acc[mt][nt], 0, 0, 0);
    }
    asm volatile("s_waitcnt vmcnt(0) lgkmcnt(0)" ::: "memory");
    __builtin_amdgcn_s_barrier();
    asm volatile("" ::: "memory");
  }
#undef ISSUE4
  if (g.epi == 4) {
#pragma unroll
    for (int mt = 0; mt < 4; ++mt)
#pragma unroll
      for (int nt = 0; nt < 8; ++nt) {
        half_t* vp = g.C + (size_t)((wm * 8 + wn * 2 + (nt >> 2)) * 64) * 64 + lr;
#pragma unroll
        for (int j = 0; j < 4; ++j) vp[((nt & 3) * 16 + lq * 4 + j) * 64 + mt * 16] = (half_t)acc[mt][nt][j];
      }
    return;
  }
#pragma unroll
  for (int mt = 0; mt < 4; ++mt) {
    half_t* cp = g.C + (size_t)(wm * 64 + mt * 16 + lr) * g.ldc + wn * 128 + lq * 4;
#pragma unroll
    for (int nt = 0; nt < 8; ++nt) {
      h4 o;
#pragma unroll
      for (int j = 0; j < 4; ++j) {
        float v = acc[mt][nt][j];
        if (g.epi == 1) { v = fmaxf(v, 0.f); v = v * v; }
        o[j] = (half_t)v;
      }
      *(h4*)(cp + nt * 16) = o;
    }
  }
}

__device__ __forceinline__ int p8_lds_byte(int r, int c) {
  const int st = (r >> 4) * 2 + (c >> 5), rr = r & 15, cc = c & 31, ob = rr * 64 + cc * 2;
  return st * 1024 + (ob ^ (((ob >> 9) & 1) << 5));
}
__device__ __forceinline__ void p8_stage_rc(int b, int& R, int& C) {
  const int st = b / 1024, sb = b % 1024, swz = sb ^ (((sb >> 9) & 1) << 5);
  R = (st >> 1) * 16 + swz / 64;
  C = (st & 1) * 32 + (swz % 64) / 2;
}
__device__ __forceinline__ void gemm_tile8(const GemmTile& g, char* smem) {
  constexpr int HT = 128 * 64;
  half_t* shm = (half_t*)smem;
  const int tid = tidx();
  const int wid = tid >> 6, lane = tid & 63, wr = wid >> 2, wc = wid & 3, fr = lane & 15, fq = lane >> 4;
  const half_t* A = g.A;
  const half_t* Bt = g.Bt;
  const int lda = g.lda, ldb = g.lda;
#define P8_SA(b, h) (shm + ((b) * 2 + (h)) * HT)
#define P8_SB(b, h) (shm + (4 + (b) * 2 + (h)) * HT)
  int sr0, sc0, sr1, sc1;
  p8_stage_rc(tid * 16, sr0, sc0);
  p8_stage_rc(tid * 16 + 8192, sr1, sc1);
  const int ao0 = sr0 * lda + sc0, ao1 = sr1 * lda + sc1;
#define bo0 ao0
#define bo1 ao1
#define P8_STAGE_A(Pp, br, kt)                                                                                   \
  {                                                                                                              \
    const half_t* gb_ = A + (size_t)(br) * lda + (size_t)(kt) * 64;                                              \
    __builtin_amdgcn_global_load_lds((const unsigned*)(gb_ + ao0), (unsigned*)((char*)(Pp) + tid * 16), 16, 0, 0);        \
    __builtin_amdgcn_global_load_lds((const unsigned*)(gb_ + ao1), (unsigned*)((char*)(Pp) + tid * 16 + 8192), 16, 0, 0); \
  }
#define P8_STAGE_B(Pp, br, kt)                                                                                   \
  {                                                                                                              \
    const half_t* gb_ = Bt + (size_t)(br) * ldb + (size_t)(kt) * 64;                                             \
    __builtin_amdgcn_global_load_lds((const unsigned*)(gb_ + bo0), (unsigned*)((char*)(Pp) + tid * 16), 16, 0, 0);        \
    __builtin_amdgcn_global_load_lds((const unsigned*)(gb_ + bo1), (unsigned*)((char*)(Pp) + tid * 16 + 8192), 16, 0, 0); \
  }
  const char* abase = smem + p8_lds_byte(wr * 64 + fr, fq * 8);
  const char* bbase = smem + 4 * HT * 2 + p8_lds_byte(wc * 32 + fr, fq * 8);
#define P8_LDA(dst, b, h)                                                                                        \
  _Pragma("unroll") for (int m = 0; m < 4; ++m) _Pragma("unroll") for (int k = 0; k < 2; ++k)                    \
      dst[m][k] = *(const h8*)(abase + ((b) * 2 + (h)) * (HT * 2) + (m * 2 + k) * 1024);
#define P8_LDB(dst, b, h)                                                                                        \
  _Pragma("unroll") for (int n = 0; n < 2; ++n) _Pragma("unroll") for (int k = 0; k < 2; ++k)                    \
      dst[n][k] = *(const h8*)(bbase + ((b) * 2 + (h)) * (HT * 2) + (n * 2 + k) * 1024);
#define P8_MMA(ai, bj, Af, Bf)                                                                                   \
  {                                                                                                              \
    __builtin_amdgcn_s_setprio(1);                                                                               \
    _Pragma("unroll") for (int m = 0; m < 4; ++m) _Pragma("unroll") for (int n = 0; n < 2; ++n)                  \
        _Pragma("unroll") for (int k = 0; k < 2; ++k)                                                            \
            acc[ai][bj][m][n] = __builtin_amdgcn_mfma_f32_16x16x32_f16(Bf[n][k], Af[m][k], acc[ai][bj][m][n], 0, 0, 0); \
    __builtin_amdgcn_s_setprio(0);                                                                               \
  }
#define P8_WAIT_V(n) asm volatile("s_waitcnt vmcnt(" #n ")" ::: "memory")
#define P8_WAIT_L(n) asm volatile("s_waitcnt lgkmcnt(" #n ")" ::: "memory")
#define P8_BAR __builtin_amdgcn_s_barrier()
#define P8_SCHED __builtin_amdgcn_sched_barrier(0)

  f4 acc[2][2][4][2];
#pragma unroll
  for (int i0 = 0; i0 < 2; ++i0)
#pragma unroll
    for (int i1 = 0; i1 < 2; ++i1)
#pragma unroll
      for (int i2 = 0; i2 < 4; ++i2)
#pragma unroll
        for (int i3 = 0; i3 < 2; ++i3) acc[i0][i1][i2][i3] = (f4){0.f, 0.f, 0.f, 0.f};
  h8 At[4][2], B0[2][2], B1[2][2];
  const int nt = g.K >> 6;
  P8_STAGE_B(P8_SB(0, 0), 0, 0); P8_STAGE_A(P8_SA(0, 0), 0, 0);
  P8_STAGE_B(P8_SB(0, 1), 128, 0); P8_STAGE_A(P8_SA(0, 1), 128, 0);
  if (wr == 1) P8_BAR;
  P8_WAIT_V(4); P8_BAR;
  P8_STAGE_B(P8_SB(1, 0), 0, 1); P8_STAGE_A(P8_SA(1, 0), 0, 1); P8_STAGE_B(P8_SB(1, 1), 128, 1);
  P8_WAIT_V(6); P8_BAR;
  for (int t = 0; t < nt - 2; t += 2) {
    P8_LDB(B0, 0, 0); P8_SCHED; P8_LDA(At, 0, 0); P8_STAGE_A(P8_SA(1, 1), 128, t + 1);
    P8_WAIT_L(8); P8_BAR; P8_WAIT_L(0); P8_MMA(0, 0, At, B0); P8_BAR; P8_SCHED;
    P8_LDB(B1, 0, 1); P8_STAGE_B(P8_SB(0, 0), 0, t + 2);
    P8_BAR; P8_WAIT_L(0); P8_MMA(0, 1, At, B1); P8_BAR;
    P8_LDA(At, 0, 1); P8_STAGE_A(P8_SA(0, 0), 0, t + 2);
    P8_BAR; P8_WAIT_L(0); P8_MMA(1, 0, At, B0); P8_BAR; P8_SCHED;
    P8_STAGE_B(P8_SB(0, 1), 128, t + 2);
    P8_WAIT_V(6); P8_BAR; P8_MMA(1, 1, At, B1); P8_BAR;
    P8_LDB(B0, 1, 0); P8_SCHED; P8_LDA(At, 1, 0); P8_STAGE_A(P8_SA(0, 1), 128, t + 2);
    P8_WAIT_L(8); P8_BAR; P8_WAIT_L(0); P8_MMA(0, 0, At, B0); P8_BAR; P8_SCHED;
    P8_LDB(B1, 1, 1); P8_STAGE_B(P8_SB(1, 0), 0, t + 3);
    P8_BAR; P8_WAIT_L(0); P8_MMA(0, 1, At, B1); P8_BAR;
    P8_LDA(At, 1, 1); P8_STAGE_A(P8_SA(1, 0), 0, t + 3);
    P8_BAR; P8_WAIT_L(0); P8_MMA(1, 0, At, B0); P8_BAR; P8_SCHED;
    P8_STAGE_B(P8_SB(1, 1), 128, t + 3);
    P8_WAIT_V(6); P8_BAR; P8_MMA(1, 1, At, B1); P8_BAR;
  }
  {
    P8_LDB(B0, 0, 0); P8_LDA(At, 0, 0); P8_STAGE_A(P8_SA(1, 1), 128, nt - 1);
    P8_BAR; P8_WAIT_L(0); P8_MMA(0, 0, At, B0); P8_BAR;
    P8_LDB(B1, 0, 1); P8_BAR; P8_WAIT_L(0); P8_MMA(0, 1, At, B1); P8_BAR;
    P8_LDA(At, 0, 1); P8_WAIT_V(4); P8_BAR; P8_WAIT_L(0); P8_MMA(1, 0, At, B0); P8_MMA(1, 1, At, B1); P8_BAR;
  }
  {
    P8_LDB(B0, 1, 0); P8_LDA(At, 1, 0); P8_WAIT_V(2); P8_BAR; P8_WAIT_L(0); P8_MMA(0, 0, At, B0); P8_BAR;
    P8_LDB(B1, 1, 1); P8_WAIT_V(0); P8_BAR; P8_WAIT_L(0); P8_MMA(0, 1, At, B1); P8_BAR;
    P8_LDA(At, 1, 1); P8_BAR; P8_WAIT_L(0); P8_MMA(1, 0, At, B0); P8_MMA(1, 1, At, B1); P8_BAR;
  }
  if (wr == 0) P8_BAR;
  asm volatile("" ::: "memory");
#pragma unroll
  for (int ai = 0; ai < 2; ++ai)
#pragma unroll
    for (int m = 0; m < 4; ++m) {
      const int row = ai * 128 + wr * 64 + m * 16 + fr;
#pragma unroll
      for (int bj = 0; bj < 2; ++bj)
#pragma unroll
        for (int n = 0; n < 2; ++n) {
          const int col = bj * 128 + wc * 32 + n * 16 + fq * 4;
          if (g.epi == 4) {
            half_t* vp = g.C + (size_t)(((row >> 6) * 8 + (col >> 6)) * 64 + (col & 63)) * 64 + (row & 63);
#pragma unroll
            for (int j = 0; j < 4; ++j) vp[j * 64] = (half_t)acc[ai][bj][m][n][j];
          } else {
            h4 o;
#pragma unroll
            for (int j = 0; j < 4; ++j) {
              float v = acc[ai][bj][m][n][j];
              if (g.epi == 1) { v = fmaxf(v, 0.f); v = v * v; }
              o[j] = (half_t)v;
            }
            *(h4*)(g.C + (size_t)row * g.ldc + col) = o;
          }
        }
    }
#undef bo0
#undef bo1
#undef P8_SA
#undef P8_SB
#undef P8_STAGE_A
#undef P8_STAGE_B
#undef P8_LDA
#undef P8_LDB
#undef P8_MMA
#undef P8_WAIT_V
#undef P8_WAIT_L
#undef P8_BAR
#undef P8_SCHED
}

__device__ __forceinline__ void gemm_phase(const P& p, const half_t* A, int lda, const half_t* Bt, int ldb, int K, half_t* C, int ldc,
                                           int epi, int nMt, int nNt, int feat, char* smem) {
  char* ws = (p.ws + opaque_zero());
  const bool split = (feat >= 2 && nMt == 136);
  if (split) nMt = 128;
  const int nbig = nMt * nNt;
  const int total = nbig + (split ? 16 * nNt : 0), G = gridDim.x, per_xcd = G >> 3;
  for (int t0 = bidx(); t0 < total + G; t0 += G) {
    const int rnd = t0 / G, bb = t0 - rnd * G;
    const int t = ((G & 7) == 0) ? rnd * G + (bb & 7) * per_xcd + (bb >> 3) : t0;
    if (t >= total) continue;
    const bool small = t >= nbig;
    const int gsz = 8 * nNt, first = (t / gsz) * 8, gm = min(nMt - first, 8);
    const int mt = small ? 128 + ((t - nbig) & 7) : first + (t % gsz) % gm;
    const int nt = small ? (t - nbig) >> 3 : (t % gsz) / gm;
    GemmTile g;
    g.A = A + (size_t)mt * 256 * lda; g.A2 = nullptr; g.mu = nullptr; g.lda = lda;
    const int tw = (feat >= 2 && !small) ? 256 : 128;
    g.Bt = Bt + (size_t)nt * tw * ldb; g.ldb = ldb; g.K = K;
    g.C = C + (size_t)mt * 256 * ldc + nt * tw; g.ldc = ldc; g.epi = epi;
    g.row0 = mt * 256; g.col0 = nt * tw; g.pp = &p;
    if (feat == 2 && !small && nt >= 6) {
      g.epi = 4;
      g.C = (half_t*)(ws + OFF_A1) + ((size_t)(mt * 4) * 8 + (nt - 6) * 4) * 4096;
    }
    if (feat == 2 && small && nt >= 12) {
      g.epi = 4;
      g.C = (half_t*)(ws + OFF_A1) + ((size_t)(mt * 4) * 8 + (nt - 12) * 2) * 4096;
    }
    if (feat == 1) {
      g.A2 = (const half_t*)(ws + OFF_A1) + (size_t)mt * 256 * 1024;
      const int grp = nt >> 3, sub = nt & 7;
      int mixi;
      if (grp < 3) {
        mixi = grp == 0 ? 0 : (grp == 1 ? 2 : 3);
        g.Bt = (const half_t*)(ws + (grp == 0 ? OFF_WR : (grp == 1 ? OFF_WK : OFF_WV))) + (size_t)sub * 128 * 1024;
        g.C = (half_t*)(ws + (grp == 0 ? OFF_RR : (grp == 1 ? OFF_KK : OFF_VV))) + (size_t)mt * 256 * 1024 + sub * 128;
      } else {
        mixi = sub == 0 ? 1 : (sub == 1 ? 4 : 5);
        g.Bt = (const half_t*)(ws + OFF_L1) + (size_t)sub * 128 * 1024;
        g.C = (half_t*)(ws + OFF_L) + (size_t)mt * 256 * 384 + sub * 128;
        g.ldc = 384;
        g.epi = sub == 0 ? 2 : (sub == 1 ? 0 : 3);
      }
      g.mu = p.rw_mu + mixi * 1024;
    }
    if (feat == 1) gemm_tile<true>(g, smem); else if (feat >= 2 && !small) gemm_tile8(g, smem); else gemm_tile3(g, smem);
  }
}

__device__ void xpose_seg(const float* src, int ldsrc, int K, int N, half_t* dst, int lddst, int koff, int& base,
                          char* smem) {
  float* ts = (float*)smem;
  const int tid = tidx(), G = gridDim.x;
  const int tkn = K >> 6, tnn = N >> 6, cnt = tkn * tnn;
  int t0 = ((int)bidx() - (base % G) + G) % G;
  for (int t = t0; t < cnt; t += G) {
    const int k0 = (t % tkn) * 64, n0 = (t / tkn) * 64;
#pragma unroll
    for (int i = 0; i < 2; ++i) {
      const int c = tid + 512 * i, r = c >> 4, c4 = (c & 15) * 4;
      const float4 v = *(const float4*)(src + (size_t)(k0 + r) * ldsrc + n0 + c4);
      float* d = ts + r * 65 + c4;
      d[0] = v.x; d[1] = v.y; d[2] = v.z; d[3] = v.w;
    }
    __syncthreads();
    {
      const int n = tid >> 3, kc = (tid & 7) * 8;
      h8 o;
#pragma unroll
      for (int i = 0; i < 8; ++i) o[i] = (half_t)ts[(kc + i) * 65 + n];
      *(h8*)(dst + (size_t)(n0 + n) * lddst + koff + k0 + kc) = o;
    }
    __syncthreads();
  }
  base += cnt;
}

__device__ void phase_prep(const P& p, char* smem) {
  const int tid = tidx();
  char* ws = (p.ws + opaque_zero());
  float* MOD = (float*)(ws + OFF_MOD);
  if (bidx() < 192 || gridDim.x < 256) {
    float* sl = (float*)smem;
    for (int i = tid; i < 9216; i += 512) {
      const int b = i >> 10, k = i & 1023;
      const float cv = b < 8 ? p.c[b * 1024 + k] : p.c_ctx[k];
      sl[i] = cv / (1.f + __expf(-cv));
    }
    __syncthreads();
    float* red = sl + 9216;
    for (int item = bidx(); item < 192; item += gridDim.x) {
      const int l = item / 96, n0 = (item % 96) * 64, cn = tid & 63, kq = tid >> 6;
      float acc[9];
#pragma unroll
      for (int b = 0; b < 9; ++b) acc[b] = 0.f;
      const float* wp = p.ada_w + (size_t)l * 1024 * 6144 + n0 + cn;
#pragma unroll 4
      for (int k = kq * 128; k < kq * 128 + 128; ++k) {
        const float wv = wp[(size_t)k * 6144];
#pragma unroll
        for (int b = 0; b < 9; ++b) acc[b] += sl[b * 1024 + k] * wv;
      }
#pragma unroll
      for (int b = 0; b < 9; ++b) red[(kq * 9 + b) * 64 + cn] = acc[b];
      __syncthreads();
      for (int i = tid; i < 576; i += 512) {
        const int b = i >> 6, c = i & 63;
        float s = 0.f;
#pragma unroll
        for (int q = 0; q < 8; ++q) s += red[(q * 9 + b) * 64 + c];
        MOD[(size_t)(l * 9 + b) * 6144 + n0 + c] = s + p.ada_b[l * 6144 + n0 + c];
      }
      __syncthreads();
    }
  }
  for (int it = bidx(); it < 256; it += gridDim.x) {
    if (it < 192) continue;
    const int fi = it - 192, gi = fi >> 4, n0 = (fi & 15) * 64, n = tid & 63, ig = tid >> 6;
    float acc[16];
#pragma unroll
    for (int i = 0; i < 16; ++i) acc[i] = 0.f;
    for (int j = 0; j < 128; ++j) {
      const float wv = p.ev_w_out[(size_t)(gi * 128 + j) * 1024 + n0 + n] * p.ev_pool_scale[gi * 128 + j];
      const float* pw = p.ev_pool_w + ((size_t)gi * 128 + ig * 16) * 128 + j;
#pragma unroll
      for (int i = 0; i < 16; ++i) acc[i] += pw[i * 128] * wv;
    }
    h8 o0, o1;
#pragma unroll
    for (int i = 0; i < 8; ++i) { o0[i] = (half_t)acc[i]; o1[i] = (half_t)acc[8 + i]; }
    half_t* d = (half_t*)(ws + OFF_WOUT) + (size_t)(n0 + n) * 1024 + gi * 128 + ig * 16;
    *(h8*)d = o0;
    *(h8*)(d + 8) = o1;
  }
  __syncthreads();
  int base = 0;
  xpose_seg(p.ev_w_in, 2048, 1024, 2048, (half_t*)(ws + OFF_WIN), 1024, 0, base, smem);
  xpose_seg(p.ev_w_out + 512 * 1024, 1024, 512, 1024, (half_t*)(ws + OFF_WOUT), 1024, 512, base, smem);
  for (int l = 0; l < 2; ++l) {
    xpose_seg(p.mlp_w1 + (size_t)l * 1024 * 4096, 4096, 1024, 4096, (half_t*)(ws + OFF_M1 + l * 8 * MIB), 1024, 0, base, smem);
    xpose_seg(p.mlp_w2 + (size_t)l * 1024 * 4096, 1024, 4096, 1024, (half_t*)(ws + OFF_M2 + l * 8 * MIB), 4096, 0, base, smem);
  }
  xpose_seg(p.rw_wr, 1024, 1024, 1024, (half_t*)(ws + OFF_WR), 1024, 0, base, smem);
  xpose_seg(p.rw_wk, 1024, 1024, 1024, (half_t*)(ws + OFF_WK), 1024, 0, base, smem);
  xpose_seg(p.rw_wv, 1024, 1024, 1024, (half_t*)(ws + OFF_WV), 1024, 0, base, smem);
  xpose_seg(p.rw_wo, 1024, 1024, 1024, (half_t*)(ws + OFF_WO), 1024, 0, base, smem);
  for (int d = 0; d < 2; ++d) {
    xpose_seg(p.rw_w1 + (size_t)d * 1024 * 64, 64, 1024, 64, (half_t*)(ws + OFF_L1) + (size_t)(d * 64) * 1024, 1024, 0, base, smem);
    xpose_seg(p.rw_a1 + (size_t)d * 1024 * 64, 64, 1024, 64, (half_t*)(ws + OFF_L1) + (size_t)(128 + d * 64) * 1024, 1024, 0, base, smem);
    xpose_seg(p.rw_w2 + (size_t)d * 64 * 1024, 1024, 64, 1024, (half_t*)(ws + OFF_W2) + (size_t)d * 1024 * 64, 64, 0, base, smem);
    xpose_seg(p.rw_a2 + (size_t)d * 64 * 1024, 1024, 64, 1024, (half_t*)(ws + OFF_A2) + (size_t)d * 1024 * 64, 64, 0, base, smem);
  }
  xpose_seg(p.rw_g1, 128, 1024, 128, (half_t*)(ws + OFF_L1) + (size_t)256 * 1024, 1024, 0, base, smem);
  xpose_seg(p.rw_g2, 1024, 128, 1024, (half_t*)(ws + OFF_G2), 128, 0, base, smem);
}

__device__ void phase_rowwise(const P& p, int mode) {
  const int lane = tidx() & 63;
  const int gw = bidx() * 8 + (tidx() >> 6), nw = gridDim.x * 8;
  char* ws = (p.ws + opaque_zero());
  const float* MOD = (const float*)(ws + OFF_MOD);
  float* XC = (float*)(ws + OFF_XC);
  half_t* H = (half_t*)(ws + OFF_A0);
  const half_t* Y = (const half_t*)(ws + OFF_A1);
  const int nrows = (mode >= 3) ? RL : RT;
  const int per = (nrows + nw - 1) / nw;
  const int r0 = gw * per, r1 = min(r0 + per, nrows);
  if (r0 >= r1) return;
  const bool hasY = mode != 0, hasH = mode != 4;
  const float EPS = opaque_f(1e-6f);
  const int lyr = (mode <= 1) ? 0 : ((mode == 2) ? 0 : 1);
  const int gyi = (mode == 1) ? 1 : (mode == 2 ? 3 : (mode == 3 ? 5 : 7));
  const int gti = (mode == 1) ? 2 : (mode == 2 ? 5 : (mode == 3 ? 2 : 5));
  const int hl = (mode <= 1) ? 0 : 1;
  const int ghi = (mode == 0) ? 0 : (mode == 1 ? 2 : (mode == 2 ? 4 : 6));
  const int shi = (mode == 0 || mode == 2) ? 0 : 3;
  auto xsrc = [&](int row) -> const float* {
    if (mode <= 1) return row < RL ? p.x + (size_t)row * 1024 : p.ctx + (size_t)(row - RL) * 1024;
    return row < RL ? p.out + (size_t)row * 1024 : XC + (size_t)(row - RL) * 1024;
  };
  auto xdst = [&](int row) -> float* { return row < RL ? p.out + (size_t)row * 1024 : XC + (size_t)(row - RL) * 1024; };
  float4 gy[4], gt[4], gh[4], s1[4], s2[4];
  int cur_mi = -1;
  float4 nx[4];
  h4 ny[4];
  {
    const float* xs = xsrc(r0);
#pragma unroll
    for (int i = 0; i < 4; ++i) nx[i] = *(const float4*)(xs + i * 256 + lane * 4);
    if (hasY) {
#pragma unroll
      for (int i = 0; i < 4; ++i) ny[i] = *(const h4*)(Y + (size_t)r0 * 1024 + i * 256 + lane * 4);
    }
  }
  for (int row = r0; row < r1; ++row) {
    float xv[4][4];
    h4 yh[4];
#pragma unroll
    for (int i = 0; i < 4; ++i) { xv[i][0] = nx[i].x; xv[i][1] = nx[i].y; xv[i][2] = nx[i].z; xv[i][3] = nx[i].w; yh[i] = ny[i]; }
    if (row + 1 < r1) {
      const float* xs = xsrc(row + 1);
#pragma unroll
      for (int i = 0; i < 4; ++i) nx[i] = *(const float4*)(xs + i * 256 + lane * 4);
      if (hasY) {
#pragma unroll
        for (int i = 0; i < 4; ++i) ny[i] = *(const h4*)(Y + (size_t)(row + 1) * 1024 + i * 256 + lane * 4);
      }
    }
    const int mi = row < RL ? (row >> 12) : 8;
    if (mi != cur_mi) {
      cur_mi = mi;
      const float* mg = MOD + (size_t)(lyr * 9 + mi) * 6144;
      const float* mh = MOD + (size_t)(hl * 9 + mi) * 6144;
#pragma unroll
      for (int i = 0; i < 4; ++i) {
        const int o = i * 256 + lane * 4;
        if (hasY) { gy[i] = *(const float4*)(p.norm_g + gyi * 1024 + o); gt[i] = *(const float4*)(mg + gti * 1024 + o); }
        if (hasH) {
          gh[i] = *(const float4*)(p.norm_g + ghi * 1024 + o);
          s1[i] = *(const float4*)(mh + shi * 1024 + o);
          s2[i] = *(const float4*)(mh + (shi + 1) * 1024 + o);
        }
      }
    }
    if (hasY) {
      float yv[4][4];
      float ss = 0.f;
#pragma unroll
      for (int i = 0; i < 4; ++i)
#pragma unroll
        for (int k = 0; k < 4; ++k) { yv[i][k] = (float)yh[i][k]; ss += yv[i][k] * yv[i][k]; }
      ss = wave_sum(ss, lane);
      const float rs = rsqrtf(ss * (1.f / 1024.f) + EPS);
      float* xo = xdst(row);
#pragma unroll
      for (int i = 0; i < 4; ++i) {
        xv[i][0] += gt[i].x * (yv[i][0] * rs * gy[i].x);
        xv[i][1] += gt[i].y * (yv[i][1] * rs * gy[i].y);
        xv[i][2] += gt[i].z * (yv[i][2] * rs * gy[i].z);
        xv[i][3] += gt[i].w * (yv[i][3] * rs * gy[i].w);
        *(float4*)(xo + i * 256 + lane * 4) = make_float4(xv[i][0], xv[i][1], xv[i][2], xv[i][3]);
      }
    }
    if (hasH) {
      float ss = 0.f;
#pragma unroll
      for (int i = 0; i < 4; ++i)
#pragma unroll
        for (int k = 0; k < 4; ++k) ss += xv[i][k] * xv[i][k];
      ss = wave_sum(ss, lane);
      const float rs = rsqrtf(ss * (1.f / 1024.f) + EPS);
      half_t* ho = H + (size_t)row * 1024;
#pragma unroll
      for (int i = 0; i < 4; ++i) {
        h4 o;
        o[0] = (half_t)(xv[i][0] * rs * gh[i].x * (1.f + s2[i].x) + s1[i].x);
        o[1] = (half_t)(xv[i][1] * rs * gh[i].y * (1.f + s2[i].y) + s1[i].y);
        o[2] = (half_t)(xv[i][2] * rs * gh[i].z * (1.f + s2[i].z) + s1[i].z);
        o[3] = (half_t)(xv[i][3] * rs * gh[i].w * (1.f + s2[i].w) + s1[i].w);
        *(h4*)(ho + i * 256 + lane * 4) = o;
      }
    }
  }
}

__device__ __forceinline__ int clampi(int v, int lo, int hi) { return v < lo ? lo : (v > hi ? hi : v); }

__device__ void attn_item(const P& p, int item, char* smem) {
  half_t* Ks = (half_t*)smem;
  half_t* Vt = Ks + 2 * 64 * 72;
  float* rpbs = (float*)(smem + 36864);
  const int tid = tidx(), lane = tid & 63, w = tid >> 6, lr = lane & 15, lq = lane >> 4;
  const half_t* U = (const half_t*)((p.ws + opaque_zero()) + OFF_U);
  half_t* Z = (half_t*)((p.ws + opaque_zero()) + OFF_Z);
  const bool isctx = item >= 2048;
  int b, h, qrow, nlat = 0, start0 = 0, my_r = 0, my_start = 0, cw = 0, cs = 0, qcol = 0;
  if (!isctx) {
    b = item >> 8; h = (item >> 5) & 7;
    const int r0 = (item & 31) * 2;
    my_r = r0 + (w >> 2);
    const int cgp = w & 3;
    qcol = cgp * 16 + lr;
    qrow = b * 4096 + my_r * 64 + qcol;
    start0 = clampi(r0 - 4, 0, 56);
    const int start1 = clampi(r0 + 1 - 4, 0, 56);
    nlat = start1 + 8 - start0;
    my_start = clampi(my_r - 4, 0, 56);
    cw = clampi(cgp * 16 - 8, 0, 32);
    cs = clampi(qcol - 8, 0, 48);
  } else {
    const int it = item - 2048;
    b = it >> 4; h = (it >> 1) & 7;
    qrow = RL + b * 256 + (it & 1) * 128 + w * 16 + lr;
  }
  const int ntiles = nlat + 4;
  h8 qf[2];
#pragma unroll
  for (int ks = 0; ks < 2; ++ks) {
    h8 t = *(const h8*)(U + (size_t)qrow * 2048 + 512 + h * 64 + ks * 32 + lq * 8);
#pragma unroll
    for (int i = 0; i < 8; ++i) t[i] = t[i] * (half_t)0.125f;
    qf[ks] = t;
  }
  if (!isctx)
    for (int i = tid; i < 465; i += 512) rpbs[i] = p.ev_rpb[h * 465 + i];

  const int skey = tid >> 3, sd = (tid & 7) * 8;
  uint4 kA, vA, kB, vB;
  auto tile_row0 = [&](int i) -> int { return i < nlat ? b * 4096 + (start0 + i) * 64 : RL + b * 256 + (i - nlat) * 64; };
  const half_t* VTg = (const half_t*)((p.ws + opaque_zero()) + OFF_A1);
#define AT_GLOAD(kr, vr, i)                                                                            \
  {                                                                                                    \
    const int r0t = tile_row0(i);                                                                      \
    kr = *(const uint4*)(U + (size_t)(r0t + skey) * 2048 + 1024 + h * 64 + sd);                        \
    vr = *(const uint4*)(VTg + ((size_t)(r0t >> 6) * 8 + h) * 4096 + skey * 64 + sd);                  \
  }
#define AT_SSTORE(kr, vr, buf)                                                                         \
  {                                                                                                    \
    *(uint4*)(Ks + (buf) * 4608 + skey * 72 + sd) = kr;                                                \
    *(uint4*)(Vt + (buf) * 4608 + skey * 72 + sd) = vr;                                                \
  }
  f4 o[4];
#pragma unroll
  for (int i = 0; i < 4; ++i) o[i] = (f4){0.f, 0.f, 0.f, 0.f};
  const float NEG = opaque_f(-1e30f);
  float m = NEG, l = 0.f;

  AT_GLOAD(kA, vA, 0);
  AT_SSTORE(kA, vA, 0);
  AT_GLOAD(kA, vA, 1);
  AT_GLOAD(kB, vB, 2);
  __syncthreads();
  auto compute_tile = [&](int i, int buf) {
    const bool lt = i < nlat;
    const int kr_abs = start0 + i;
    const bool active = !lt || (kr_abs >= my_start && kr_abs < my_start + 8);
    if (active) {
      const int npairs = lt ? 1 : 2;
      for (int pi = 0; pi < npairs; ++pi) {
        const int kb = lt ? cw : pi * 32;
        f4 s[2];
#pragma unroll
        for (int st = 0; st < 2; ++st) {
          f4 z = (f4){0.f, 0.f, 0.f, 0.f};
#pragma unroll
          for (int ks = 0; ks < 2; ++ks) {
            const h8 kf = *(const h8*)(Ks + buf * 4608 + (kb + st * 16 + lr) * 72 + ks * 32 + lq * 8);
            z = __builtin_amdgcn_mfma_f32_16x16x32_f16(kf, qf[ks], z, 0, 0, 0);
          }
          s[st] = z;
        }
        float tmax = NEG;
        if (lt) {
          const int dr = clampi(kr_abs - my_r + 7, 0, 14);
          float bias[2][4];
#pragma unroll
          for (int st = 0; st < 2; ++st)
#pragma unroll
            for (int j = 0; j < 4; ++j) {
              const int kc = kb + st * 16 + lq * 4 + j;
              bias[st][j] = rpbs[dr * 31 + clampi(kc - qcol + 15, 0, 30)];
            }
#pragma unroll
          for (int st = 0; st < 2; ++st)
#pragma unroll
            for (int j = 0; j < 4; ++j) {
              const int kc = kb + st * 16 + lq * 4 + j;
              const bool ok = (kc >= cs) && (kc < cs + 16);
              const float v = s[st][j] + bias[st][j];
              s[st][j] = ok ? v : NEG;
            }
        }
#pragma unroll
        for (int st = 0; st < 2; ++st)
#pragma unroll
          for (int j = 0; j < 4; ++j) tmax = fmaxf(tmax, s[st][j]);
        tmax = fmaxf(tmax, bperm(tmax, lane ^ 16));
        tmax = fmaxf(tmax, bperm(tmax, lane ^ 32));
        const float mn = fmaxf(m, tmax);
        const float alpha = __expf(m - mn);
        m = mn;
        h8 pb;
        float ps = 0.f;
#pragma unroll
        for (int st = 0; st < 2; ++st)
#pragma unroll
          for (int j = 0; j < 4; ++j) {
            const float e = __expf(s[st][j] - mn);
            ps += e;
            pb[st * 4 + j] = (half_t)e;
          }
        l = l * alpha + ps;
#pragma unroll
        for (int dt = 0; dt < 4; ++dt) {
          o[dt] = o[dt] * alpha;
          const half_t* vp = Vt + buf * 4608 + (dt * 16 + lr) * 72 + kb + lq * 4;
          const h4 v0 = *(const h4*)vp;
          const h4 v1 = *(const h4*)(vp + 16);
          h8 vf;
          vf[0] = v0[0]; vf[1] = v0[1]; vf[2] = v0[2]; vf[3] = v0[3];
          vf[4] = v1[0]; vf[5] = v1[1]; vf[6] = v1[2]; vf[7] = v1[3];
          o[dt] = __builtin_amdgcn_mfma_f32_16x16x32_f16(vf, pb, o[dt], 0, 0, 0);
        }
      }
    }
  };
#define AT_BARRIER()                                         \
  {                                                          \
    asm volatile("s_waitcnt lgkmcnt(0)" ::: "memory");       \
    __builtin_amdgcn_s_barrier();                            \
    asm volatile("" ::: "memory");                           \
  }
  for (int i = 0; i < ntiles; i += 2) {
    compute_tile(i, 0);
    if (i + 1 < ntiles) {
      AT_SSTORE(kA, vA, 1);
      if (i + 3 < ntiles) AT_GLOAD(kA, vA, i + 3);
    }
    AT_BARRIER();
    if (i + 1 >= ntiles) break;
    compute_tile(i + 1, 1);
    if (i + 2 < ntiles) {
      AT_SSTORE(kB, vB, 0);
      if (i + 4 < ntiles) AT_GLOAD(kB, vB, i + 4);
    }
    AT_BARRIER();
  }
#undef AT_BARRIER
#undef AT_GLOAD
#undef AT_SSTORE
  l += bperm(l, lane ^ 16);
  l += bperm(l, lane ^ 32);
  const float inv = 1.f / l;
#pragma unroll
  for (int dt = 0; dt < 4; ++dt) {
    h4 ov;
#pragma unroll
    for (int j = 0; j < 4; ++j) ov[j] = (half_t)(o[dt][j] * inv);
    *(h4*)(Z + (size_t)qrow * 1024 + 512 + h * 64 + dt * 16 + lq * 4) = ov;
  }
}

template <int HW>
__device__ __forceinline__ void pool_rows(const float (&pre)[4][25], int tl0, int L, half_t* zp) {
#pragma unroll
  for (int r = 0; r < 8; ++r) {
    const int tl = tl0 + r;
    const int lo = max(tl - HW, 0), hi = min(tl + HW, L);
    const float inv = 1.f / (float)(hi - lo);
    h4 o;
#pragma unroll
    for (int c = 0; c < 4; ++c) {
      const float sum = pre[c][8 + r + HW] - pre[c][8 + r - HW];
      const float cur = pre[c][8 + r + 1] - pre[c][8 + r];
      o[c] = (half_t)(sum * inv - cur);
    }
    *(h4*)(zp + (size_t)r * 1024) = o;
  }
}

__device__ void pool_item(const P& p, int item) {
  const half_t* U = (const half_t*)((p.ws + opaque_zero()) + OFF_U);
  half_t* Z = (half_t*)((p.ws + opaque_zero()) + OFF_Z);
  const int tid = tidx();
  const int c4 = (tid & 127) * 4, gi = c4 >> 7;
  const int row0 = item * 32 + (tid >> 7) * 8;
  int s0, L;
  if (row0 < RL) { s0 = row0 & ~4095; L = 4096; } else { s0 = RL + ((row0 - RL) & ~255); L = 256; }
  const int tl0 = row0 - s0;
  float pre[4][25];
#pragma unroll
  for (int c = 0; c < 4; ++c) pre[c][0] = 0.f;
#pragma unroll
  for (int i = 0; i < 24; ++i) {
    const int tl = tl0 - 8 + i;
    h4 v;
    v[0] = (half_t)0.f; v[1] = (half_t)0.f; v[2] = (half_t)0.f; v[3] = (half_t)0.f;
    if (tl >= 0 && tl < L) v = *(const h4*)(U + (size_t)(s0 + tl) * 2048 + c4);
#pragma unroll
    for (int c = 0; c < 4; ++c) pre[c][i + 1] = (float)v[c];
  }
#pragma unroll
  for (int i = 0; i < 24; ++i)
#pragma unroll
    for (int c = 0; c < 4; ++c) pre[c][i + 1] += pre[c][i];
  half_t* zp = Z + (size_t)row0 * 1024 + c4;
  if (gi == 0) pool_rows<1>(pre, tl0, L, zp);
  else if (gi == 1) pool_rows<2>(pre, tl0, L, zp);
  else if (gi == 2) pool_rows<4>(pre, tl0, L, zp);
  else pool_rows<8>(pre, tl0, L, zp);
}

__device__ void phase_shift(const P& p) {
  const half_t* H = (const half_t*)((p.ws + opaque_zero()) + OFF_A0);
  half_t* XX = (half_t*)((p.ws + opaque_zero()) + OFF_A1);
  const size_t total = (size_t)RT * 128;
  for (size_t idx = (size_t)bidx() * 512 + tidx(); idx < total; idx += (size_t)gridDim.x * 512) {
    const int row = (int)(idx >> 7), c = (int)(idx & 127) * 8;
    bool st, en;
    if (row < RL) { st = (row & 4095) == 0; en = (row & 4095) == 4095; }
    else { st = ((row - RL) & 255) == 0; en = ((row - RL) & 255) == 255; }
    const h8 cur = *(const h8*)(H + (size_t)row * 1024 + c);
    h8 pv, nx;
#pragma unroll
    for (int i = 0; i < 8; ++i) { pv[i] = (half_t)0.f; nx[i] = (half_t)0.f; }
    if (!st) pv = *(const h8*)(H + (size_t)(row - 1) * 1024 + c);
    if (!en) nx = *(const h8*)(H + (size_t)(row + 1) * 1024 + c);
    h8 o;
#pragma unroll
    for (int i = 0; i < 8; ++i) o[i] = (half_t)(0.5f * ((float)pv[i] + (float)nx[i]) - (float)cur[i]);
    *(h8*)(XX + (size_t)row * 1024 + c) = o;
  }
}

#define CS_BYTES 13312
#define CS_G 0
#define CS_R 2304
#define CS_AT 4608
#define CS_BT 6656
#define CS_VT 8704
#define CS_M 10752
#define CS_BM 11264
#define CS_CM 11776
#define CS_DM 12288
#define CS_PREF 12800
#define CS_PEND 13056
#define SCR_BASE 106496
#define SCR_BYTES 5632

__device__ void scan_item(const P& p, int item, char* smem) {
  const int tid = tidx(), lane = tid & 63, w = tid >> 6, lr = lane & 15, lq = lane >> 4;
  const int b = item >> 5, h = (item >> 1) & 15, dir = item & 1;
  char* ws = (p.ws + opaque_zero());
  const half_t* RRp = (const half_t*)(ws + OFF_RR);
  const half_t* KKp = (const half_t*)(ws + OFF_KK);
  const half_t* VVp = (const half_t*)(ws + OFF_VV);
  const half_t* Lp = (const half_t*)(ws + OFF_L);
  half_t* Yd = (half_t*)(ws + (dir ? OFF_A1 : OFF_A0));
  float* BN = (float*)(ws + OFF_BN) + (size_t)dir * RL * 16;

  auto grow = [&](int pp) -> int {
    if (pp < 256) return RL + b * 256 + (dir ? 255 - pp : pp);
    const int t = pp - 256;
    return b * 4096 + (dir ? 4095 - t : t);
  };

  auto prep = [&](int c) {
    char* cs = smem + w * CS_BYTES;
    half_t* G_ = (half_t*)(cs + CS_G);
    half_t* R_ = (half_t*)(cs + CS_R);
    half_t* AT = (half_t*)(cs + CS_AT);
    half_t* BT = (half_t*)(cs + CS_BT);
    half_t* VT = (half_t*)(cs + CS_VT);
    half_t* Mm = (half_t*)(cs + CS_M);
    half_t* Bm = (half_t*)(cs + CS_BM);
    half_t* Cm = (half_t*)(cs + CS_CM);
    half_t* Dm = (half_t*)(cs + CS_DM);
    float* Pref = (float*)(cs + CS_PREF);
    float* Pend = (float*)(cs + CS_PEND);
    char* scr = smem + SCR_BASE + w * SCR_BYTES;
    half_t* A_ = (half_t*)scr;
    half_t* B_ = (half_t*)(scr + 2304);
    float* Am = (float*)(scr + 4608);
    const bool lat = c >= 16;
    const int p0 = c * 16;
    const int rowA = grow(p0 + lr);
    const half_t* lp = Lp + (size_t)rowA * 384 + dir * 64 + lq * 8;
    const h8 aw0 = *(const h8*)(lp), aw1 = *(const h8*)(lp + 32);
    const h8 aa0 = *(const h8*)(lp + 128), aa1 = *(const h8*)(lp + 160);
    float ss[4], bp[4];
    int rows[4];
#pragma unroll
    for (int j = 0; j < 4; ++j) { ss[j] = 0.f; bp[j] = 0.f; rows[j] = grow(p0 + lq * 4 + j); }
#pragma unroll
    for (int nt = 0; nt < 4; ++nt) {
      const int ch = h * 64 + nt * 16 + lr;
      const float kkc = p.rw_kk[ch];
#pragma unroll
      for (int j = 0; j < 4; ++j) {
        const float k = (float)KKp[(size_t)rows[j] * 1024 + ch];
        ss[j] += (k * kkc) * (k * kkc);
      }
    }
    float inv[4];
#pragma unroll
    for (int j = 0; j < 4; ++j) inv[j] = rsqrtf(fmaxf(red16(ss[j]), 1e-24f));
#pragma unroll 1
    for (int nt = 0; nt < 4; ++nt) {
      const int ch = h * 64 + nt * 16 + lr;
      const half_t* w2p = (const half_t*)(ws + OFF_W2) + (size_t)dir * 65536 + (size_t)ch * 64 + lq * 8;
      const half_t* a2p = (const half_t*)(ws + OFF_A2) + (size_t)dir * 65536 + (size_t)ch * 64 + lq * 8;
      const h8 bw0 = *(const h8*)(w2p), bw1 = *(const h8*)(w2p + 32);
      const h8 ba0 = *(const h8*)(a2p), ba1 = *(const h8*)(a2p + 32);
      const float w0c = p.rw_w0[dir * 1024 + ch], a0c = p.rw_a0[dir * 1024 + ch];
      const float kkc = p.rw_kk[ch], kac = p.rw_ka[ch], rkc = p.rw_rk[ch];
      f4 cwv = (f4){0.f, 0.f, 0.f, 0.f}, cav = (f4){0.f, 0.f, 0.f, 0.f};
      cwv = __builtin_amdgcn_mfma_f32_16x16x32_f16(aw0, bw0, cwv, 0, 0, 0);
      cwv = __builtin_amdgcn_mfma_f32_16x16x32_f16(aw1, bw1, cwv, 0, 0, 0);
      cav = __builtin_amdgcn_mfma_f32_16x16x32_f16(aa0, ba0, cav, 0, 0, 0);
      cav = __builtin_amdgcn_mfma_f32_16x16x32_f16(aa1, ba1, cav, 0, 0, 0);
      h4 vq;
      float ev[4], avv[4], rv[4], kv[4];
#pragma unroll
      for (int j = 0; j < 4; ++j) {
        const size_t gi = (size_t)rows[j] * 1024 + ch;
        kv[j] = (float)KKp[gi];
        vq[j] = VVp[gi];
        rv[j] = lat ? (float)RRp[gi] : 0.f;
        ev[j] = 0.60653066f * sigm(cwv[j] + w0c);
        avv[j] = sigm(cav[j] + a0c);
        bp[j] += rv[j] * kv[j] * rkc * (dir == 0 ? (2.f - 2.f * kac + kac * avv[j]) : kac * avv[j]);
      }
      *(h4*)(VT + (nt * 16 + lr) * 16 + lq * 4) = vq;
      float cum[4];
      cum[0] = ev[0];
      cum[1] = cum[0] + ev[1];
      cum[2] = cum[1] + ev[2];
      cum[3] = cum[2] + ev[3];
      const float t1 = bperm(cum[3], (lane - 16) & 63), t2 = bperm(cum[3], (lane - 32) & 63), t3 = bperm(cum[3], (lane - 48) & 63);
      const float off = (lq >= 1 ? t1 : 0.f) + (lq >= 2 ? t2 : 0.f) + (lq >= 3 ? t3 : 0.f);
#pragma unroll
      for (int j = 0; j < 4; ++j) cum[j] += off;
      const float ref = bperm(cum[3], 16 + lr);
      const float end = bperm(cum[3], 48 + lr);
      if (lq == 0) {
        Pref[nt * 16 + lr] = __expf(-ref);
        Pend[nt * 16 + lr] = __expf(-(end - ref));
      }
      h4 aq, bq;
#pragma unroll
      for (int j = 0; j < 4; ++j) {
        const float d = cum[j] - ref;
        const float E1 = __expf(d), E2 = __expf(-d), E3 = __expf(ev[j] - d);
        const float k = kv[j];
        const float kk = k * kkc * inv[j];
        const float kd = k * (1.f + (avv[j] - 1.f) * kac);
        const half_t ga = (half_t)(kk * E3);
        const half_t ro = (half_t)(rv[j] * E2);
        const half_t al = (half_t)(kk * avv[j] * E1);
        const half_t be = (half_t)(kd * E1);
        const int o = (lq * 4 + j) * 72 + nt * 16 + lr;
        G_[o] = ga; R_[o] = ro; A_[o] = al; B_[o] = be;
        aq[j] = al; bq[j] = be;
      }
      *(h4*)(AT + (nt * 16 + lr) * 16 + lq * 4) = aq;
      *(h4*)(BT + (nt * 16 + lr) * 16 + lq * 4) = bq;
    }
#pragma unroll
    for (int j = 0; j < 4; ++j) {
      const float bpr = red16(bp[j]);
      if (lat && lr == 0) BN[(size_t)rows[j] * 16 + h] = bpr;
    }
    asm volatile("s_waitcnt lgkmcnt(0)" ::: "memory");
    f4 am = (f4){0.f, 0.f, 0.f, 0.f}, bm = am, cm = am, dm = am;
#pragma unroll
    for (int ks = 0; ks < 2; ++ks) {
      const h8 fa = *(const h8*)(A_ + lr * 72 + ks * 32 + lq * 8);
      const h8 fb = *(const h8*)(B_ + lr * 72 + ks * 32 + lq * 8);
      const h8 fg = *(const h8*)(G_ + lr * 72 + ks * 32 + lq * 8);
      const h8 fr = *(const h8*)(R_ + lr * 72 + ks * 32 + lq * 8);
      am = __builtin_amdgcn_mfma_f32_16x16x32_f16(fa, fg, am, 0, 0, 0);
      bm = __builtin_amdgcn_mfma_f32_16x16x32_f16(fb, fg, bm, 0, 0, 0);
      cm = __builtin_amdgcn_mfma_f32_16x16x32_f16(fa, fr, cm, 0, 0, 0);
      dm = __builtin_amdgcn_mfma_f32_16x16x32_f16(fb, fr, dm, 0, 0, 0);
    }
    h4 bmh, cmh, dmh;
#pragma unroll
    for (int j = 0; j < 4; ++j) {
      const int u = lq * 4 + j;
      am[j] = u < lr ? am[j] : 0.f;
      bmh[j] = (half_t)(u < lr ? bm[j] : 0.f);
      cmh[j] = (half_t)(u <= lr ? cm[j] : 0.f);
      dmh[j] = (half_t)(u <= lr ? dm[j] : 0.f);
    }
    *(h4*)(Bm + lr * 16 + lq * 4) = bmh;
    *(h4*)(Cm + lr * 16 + lq * 4) = cmh;
    *(h4*)(Dm + lr * 16 + lq * 4) = dmh;
    *(f4*)(Am + lr * 16 + lq * 4) = am;
    asm volatile("s_waitcnt lgkmcnt(0)" ::: "memory");
    float m[16];
#pragma unroll
    for (int t = 0; t < 16; ++t) {
      float acc = (t == lr) ? 1.f : 0.f;
#pragma unroll
      for (int u4 = 0; u4 < 4; ++u4) {
        if (u4 * 4 < t) {
          const f4 rw = *(const f4*)(Am + t * 16 + u4 * 4);
#pragma unroll
          for (int k = 0; k < 4; ++k)
            if (u4 * 4 + k < t) acc -= rw[k] * m[u4 * 4 + k];
        }
      }
      m[t] = acc;
    }
    if (lq == 0) {
#pragma unroll
      for (int t = 0; t < 16; ++t) Mm[t * 16 + lr] = (half_t)m[t];
    }
  };

  f4 Sacc[4];
#pragma unroll
  for (int jt = 0; jt < 4; ++jt) Sacc[jt] = (f4){0.f, 0.f, 0.f, 0.f};

  for (int sc = 0; sc < 34; ++sc) {
    prep(sc * 8 + w);
    __syncthreads();
    if (w < 4) {
      for (int cc = 0; cc < 8; ++cc) {
        const int c = sc * 8 + cc;
        const char* cs = smem + cc * CS_BYTES;
        const half_t* G_ = (const half_t*)(cs + CS_G);
        const half_t* R_ = (const half_t*)(cs + CS_R);
        const half_t* AT = (const half_t*)(cs + CS_AT);
        const half_t* BT = (const half_t*)(cs + CS_BT);
        const half_t* VT = (const half_t*)(cs + CS_VT);
        const half_t* Mm = (const half_t*)(cs + CS_M);
        const half_t* Bm = (const half_t*)(cs + CS_BM);
        const half_t* Cm = (const half_t*)(cs + CS_CM);
        const half_t* Dm = (const half_t*)(cs + CS_DM);
        const float* Pref = (const float*)(cs + CS_PREF);
        const float* Pend = (const float*)(cs + CS_PEND);
#pragma unroll
        for (int jt = 0; jt < 4; ++jt) Sacc[jt] = Sacc[jt] * *(const f4*)(Pref + jt * 16 + lq * 4);
        h8 bS[2];
#pragma unroll
        for (int ks = 0; ks < 2; ++ks)
#pragma unroll
          for (int k = 0; k < 4; ++k) {
            bS[ks][k] = (half_t)Sacc[2 * ks][k];
            bS[ks][4 + k] = (half_t)Sacc[2 * ks + 1][k];
          }
        const h4 vt = *(const h4*)(VT + (16 * w + lr) * 16 + lq * 4);
        f4 rhs = (f4){0.f, 0.f, 0.f, 0.f};
#pragma unroll
        for (int ks = 0; ks < 2; ++ks) {
          const h4 g0 = *(const h4*)(G_ + lr * 72 + (2 * ks) * 16 + lq * 4);
          const h4 g1 = *(const h4*)(G_ + lr * 72 + (2 * ks + 1) * 16 + lq * 4);
          h8 gf;
          gf[0] = g0[0]; gf[1] = g0[1]; gf[2] = g0[2]; gf[3] = g0[3];
          gf[4] = g1[0]; gf[5] = g1[1]; gf[6] = g1[2]; gf[7] = g1[3];
          rhs = __builtin_amdgcn_mfma_f32_16x16x32_f16(gf, bS[ks], rhs, 0, 0, 0);
        }
        {
          f4 r16 = (f4){0.f, 0.f, 0.f, 0.f};
          r16 = __builtin_amdgcn_mfma_f32_16x16x16f16(*(const h4*)(Bm + lr * 16 + lq * 4), vt, r16, 0, 0, 0);
          rhs = rhs + r16;
        }
        h4 rh;
#pragma unroll
        for (int k = 0; k < 4; ++k) rh[k] = (half_t)rhs[k];
        f4 av = (f4){0.f, 0.f, 0.f, 0.f};
        av = __builtin_amdgcn_mfma_f32_16x16x16f16(*(const h4*)(Mm + lr * 16 + lq * 4), rh, av, 0, 0, 0);
        h4 na;
#pragma unroll
        for (int k = 0; k < 4; ++k) na[k] = (half_t)(-av[k]);
        if (c >= 16) {
          f4 y = (f4){0.f, 0.f, 0.f, 0.f};
#pragma unroll
          for (int ks = 0; ks < 2; ++ks) {
            const h4 g0 = *(const h4*)(R_ + lr * 72 + (2 * ks) * 16 + lq * 4);
            const h4 g1 = *(const h4*)(R_ + lr * 72 + (2 * ks + 1) * 16 + lq * 4);
            h8 gf;
            gf[0] = g0[0]; gf[1] = g0[1]; gf[2] = g0[2]; gf[3] = g0[3];
            gf[4] = g1[0]; gf[5] = g1[1]; gf[6] = g1[2]; gf[7] = g1[3];
            y = __builtin_amdgcn_mfma_f32_16x16x32_f16(gf, bS[ks], y, 0, 0, 0);
          }
          f4 y16 = (f4){0.f, 0.f, 0.f, 0.f};
          y16 = __builtin_amdgcn_mfma_f32_16x16x16f16(*(const h4*)(Cm + lr * 16 + lq * 4), na, y16, 0, 0, 0);
          y16 = __builtin_amdgcn_mfma_f32_16x16x16f16(*(const h4*)(Dm + lr * 16 + lq * 4), vt, y16, 0, 0, 0);
          y = y + y16;
#pragma unroll
          for (int k = 0; k < 4; ++k) {
            const int row = grow(c * 16 + lq * 4 + k);
            Yd[(size_t)row * 1024 + h * 64 + 16 * w + lr] = (half_t)y[k];
          }
        }
#pragma unroll
        for (int jt = 0; jt < 4; ++jt) {
          Sacc[jt] = __builtin_amdgcn_mfma_f32_16x16x16f16(*(const h4*)(AT + (jt * 16 + lr) * 16 + lq * 4), na, Sacc[jt], 0, 0, 0);
          Sacc[jt] = __builtin_amdgcn_mfma_f32_16x16x16f16(*(const h4*)(BT + (jt * 16 + lr) * 16 + lq * 4), vt, Sacc[jt], 0, 0, 0);
          Sacc[jt] = Sacc[jt] * *(const f4*)(Pend + jt * 16 + lq * 4);
        }
      }
    }
    __syncthreads();
  }
}

__device__ void phase_readout(const P& p) {
  const int lane = tidx() & 63;
  const int gw = bidx() * 8 + (tidx() >> 6), stride = gridDim.x * 8;
  char* ws = (p.ws + opaque_zero());
  const half_t* Y0 = (const half_t*)(ws + OFF_A0);
  const half_t* Y1 = (const half_t*)(ws + OFF_A1);
  const half_t* VVp = (const half_t*)(ws + OFF_VV);
  const half_t* Gp = (const half_t*)(ws + OFF_G);
  const float* BN0 = (const float*)(ws + OFF_BN);
  const float* BN1 = BN0 + (size_t)RL * 16;
  half_t* Z1 = (half_t*)(ws + OFF_Z1);
  const int c0 = lane * 16, head = lane >> 2;
  for (int row = gw; row < RL; row += stride) {
    const size_t o = (size_t)row * 1024 + c0;
    float y[16], vv[16], gg[16];
#pragma unroll
    for (int hh = 0; hh < 2; ++hh) {
      const h8 a = *(const h8*)(Y0 + o + hh * 8);
      const h8 bq = *(const h8*)(Y1 + o + hh * 8);
      const h8 v = *(const h8*)(VVp + o + hh * 8);
      const h8 g = *(const h8*)(Gp + o + hh * 8);
#pragma unroll
      for (int i = 0; i < 8; ++i) {
        y[hh * 8 + i] = (float)a[i] + (float)bq[i];
        vv[hh * 8 + i] = (float)v[i];
        gg[hh * 8 + i] = (float)g[i];
      }
    }
    float s = 0.f;
#pragma unroll
    for (int i = 0; i < 16; ++i) s += y[i];
    s = red4(s);
    const float mean = s * (1.f / 64.f);
    float q = 0.f;
#pragma unroll
    for (int i = 0; i < 16; ++i) { const float d = y[i] - mean; q += d * d; }
    q = red4(q);
    const float rstd = rsqrtf(q * (1.f / 64.f) + 64e-5f);
    const float bonus = BN0[(size_t)row * 16 + head] + BN1[(size_t)row * 16 + head];
    h8 o0, o1;
#pragma unroll
    for (int i = 0; i < 16; ++i) {
      const float lg = p.rw_lng[c0 + i], lb = p.rw_lnb[c0 + i];
      const float r = ((y[i] - mean) * rstd * lg + lb + bonus * vv[i]) * gg[i];
      if (i < 8) o0[i] = (half_t)r; else o1[i - 8] = (half_t)r;
    }
    *(h8*)(Z1 + o) = o0;
    *(h8*)(Z1 + o + 8) = o1;
  }
}

#define NPHASE 18
__global__ void __launch_bounds__(512) mega(P p_in, int ph_lo, int ph_hi) {
  __shared__ __attribute__((aligned(16))) char smem[SMEM_BYTES];
  cg::grid_group grid = cg::this_grid();
  const P& p = p_in;
  for (int ph = ph_lo; ph < ph_hi; ++ph) {
    char* ws = p_in.ws + opaque_zero();
    int kind = 2, arg = 0;
    size_t oA = 0, oB = 0, oC = 0;
    int lda = 1024, ldb = 1024, K = 1024, ldc = 1024, epi = 0, nMt = 136, nNt = 8, feat = 0;
    switch (ph) {
      case 0: kind = 0; break;
      case 1: kind = 1; arg = 0; break;
      case 2: oA = OFF_A0; oB = OFF_WIN; oC = OFF_U; ldc = 2048; nNt = 8; feat = 2; break;
      case 3: kind = 3; break;
      case 4: oA = OFF_Z; oB = OFF_WOUT; oC = OFF_A1; nNt = 4; feat = 3; break;
      case 5: kind = 1; arg = 1; break;
      case 6: oA = OFF_A0; oB = OFF_M1; oC = OFF_F; ldc = 4096; nNt = 16; epi = 1; feat = 3; break;
      case 7: oA = OFF_F; lda = 4096; oB = OFF_M2; ldb = 4096; K = 4096; oC = OFF_A1; nNt = 4; feat = 3; break;
      case 8: kind = 1; arg = 2; break;
      case 9: kind = 4; break;
      case 10: oA = OFF_A0; oB = OFF_WR; oC = OFF_RR; nNt = 27; feat = 1; break;
      case 11: kind = 5; break;
      case 12: oA = OFF_L + 512; lda = 384; oB = OFF_G2; ldb = 128; K = 128; oC = OFF_Z1; nMt = 128; epi = 5; break;
      case 13: oA = OFF_Z1; oB = OFF_WO; oC = OFF_A1; nMt = 128; nNt = 4; feat = 3; break;
      case 14: kind = 1; arg = 3; break;
      case 15: oA = OFF_A0; oB = OFF_M1 + 8 * MIB; oC = OFF_F; ldc = 4096; nNt = 16; epi = 1; nMt = 128; feat = 3; break;
      case 16: oA = OFF_F; lda = 4096; oB = OFF_M2 + 8 * MIB; ldb = 4096; K = 4096; oC = OFF_A1; nMt = 128; nNt = 4; feat = 3; break;
      default: kind = 1; arg = 4; break;
    }
    if (kind == 2) {
      gemm_phase(p, (const half_t*)(ws + oA), lda, (const half_t*)(ws + oB), ldb, K, (half_t*)(ws + oC), ldc, epi, nMt, nNt, feat, smem);
    } else if (kind == 1) {
      phase_rowwise(p, arg);
    } else if (kind == 0) {
      phase_prep(p, smem);
    } else if (kind == 3) {
      for (int it = bidx(); it < 2176 + 1088; it += gridDim.x) {
        if (it < 2176) attn_item(p, it, smem); else pool_item(p, it - 2176);
      }
    } else if (kind == 4) {
      phase_shift(p);
    } else if (kind == 5) {
      for (int it = bidx(); it < 256; it += gridDim.x) scan_item(p, it, smem);
    } else {
      phase_readout(p);
    }
    if (ph + 1 < ph_hi) grid.sync();
  }
}

extern "C" void kernel_launch(void* const* d_in, const int* in_sizes, int n_in, void* d_out, int out_size, void* d_ws,
                              size_t ws_size, hipStream_t stream) {
  P p{};
  const float** pp = (const float**)&p;
  for (int i = 0; i < 32; ++i) pp[i] = (const float*)d_in[i];
  p.out = (float*)d_out;
  p.ws = (char*)d_ws;
  static int grid_blocks = 0;
  if (!grid_blocks) {
    int dev = 0, cus = 0, per_cu = 0;
    (void)hipGetDevice(&dev);
    (void)hipDeviceGetAttribute(&cus, hipDeviceAttributeMultiprocessorCount, dev);
    (void)hipOccupancyMaxActiveBlocksPerMultiprocessor(&per_cu, mega, 512, 0);
    if (per_cu < 1) per_cu = 1;
    grid_blocks = cus * per_cu;
  }
  int lo = 0, hi = NPHASE;
  void* args[] = {&p, &lo, &hi};
  hipError_t e = hipLaunchCooperativeKernel((void*)mega, dim3(grid_blocks), dim3(512), args, 0, stream);
  if (e != hipSuccess) fprintf(stderr, "cooperative launch failed: %s (grid %d)\n", hipGetErrorString(e), grid_blocks);
}
```

```cpp
#include <hip/hip_runtime.h>
#include <hip/hip_cooperative_groups.h>
#include <cstdio>
namespace cg = cooperative_groups;

typedef _Float16 half_t;
typedef _Float16 h8 __attribute__((ext_vector_type(8)));
typedef _Float16 h4 __attribute__((ext_vector_type(4)));
typedef _Float16 h2 __attribute__((ext_vector_type(2)));
typedef float f4 __attribute__((ext_vector_type(4)));

#define RL 32768
#define RC 2048
#define RT 34816
#define MIB (1ull << 20)
#define OFF_WIN (0 * MIB)
#define OFF_WOUT (4 * MIB)
#define OFF_M1 (7 * MIB)
#define OFF_M2 (23 * MIB)
#define OFF_WR (39 * MIB)
#define OFF_WK (41 * MIB)
#define OFF_WV (43 * MIB)
#define OFF_WO (45 * MIB)
#define OFF_L1 (47 * MIB)
#define OFF_W2 (48 * MIB)
#define OFF_A2 (48 * MIB + 256 * 1024)
#define OFF_G2 (48 * MIB + 512 * 1024)
#define OFF_MOD (49 * MIB)
#define OFF_XBAR (49 * MIB + 768 * 1024)
#define OFF_BN (50 * MIB)
#define OFF_XC (54 * MIB)
#define OFF_A0 (62 * MIB)
#define OFF_A1 (130 * MIB)
#define OFF_BIG (198 * MIB)
#define OFF_U OFF_BIG
#define OFF_Z (334 * MIB)
#define OFF_F OFF_BIG
#define OFF_RR OFF_BIG
#define OFF_KK (266 * MIB)
#define OFF_VV (334 * MIB)
#define OFF_L (402 * MIB)
#define OFF_G OFF_BIG
#define OFF_Z1 (266 * MIB)

#define SMEM_BYTES 151552

struct P {
  const float *x, *c, *ctx, *c_ctx, *ada_w, *ada_b, *norm_g, *mlp_w1, *mlp_w2, *ev_w_in, *ev_w_out, *ev_pool_w,
      *ev_pool_scale, *ev_rpb, *rw_mu, *rw_wr, *rw_wk, *rw_wv, *rw_wo, *rw_w0, *rw_w1, *rw_w2, *rw_a0, *rw_a1, *rw_a2,
      *rw_g1, *rw_g2, *rw_kk, *rw_ka, *rw_rk, *rw_lng, *rw_lnb;
  float* out;
  char* ws;
};

__device__ __forceinline__ int tidx() { int v = threadIdx.x; asm volatile("" : "+v"(v)); return v; }
__device__ __forceinline__ int bidx() { int v = blockIdx.x; asm volatile("" : "+s"(v)); return v; }
__device__ __forceinline__ size_t opaque_zero() { size_t z = 0; asm volatile("" : "+s"(z)); return z; }
__device__ __forceinline__ float opaque_f(float v) { asm volatile("" : "+v"(v)); return v; }
__device__ __forceinline__ float sigm(float x) { return 1.f / (1.f + __expf(-x)); }
__device__ __forceinline__ float bperm(float v, int srclane) {
  return __builtin_bit_cast(float, __builtin_amdgcn_ds_bpermute(srclane << 2, __builtin_bit_cast(int, v)));
}
template <int CTRL>
__device__ __forceinline__ float dpp(float x) {
  return __builtin_bit_cast(float, __builtin_amdgcn_mov_dpp(__builtin_bit_cast(int, x), CTRL, 0xf, 0xf, true));
}
__device__ __forceinline__ float red4(float x) { x += dpp<0xB1>(x); x += dpp<0x4E>(x); return x; }
__device__ __forceinline__ float red8(float x) { x = red4(x); x += dpp<0x141>(x); return x; }
__device__ __forceinline__ float red16(float x) { x = red8(x); x += dpp<0x140>(x); return x; }
__device__ __forceinline__ float wave_sum(float v, int lane) {
  v = red16(v);
  v += bperm(v, lane ^ 16);
  v += bperm(v, lane ^ 32);
  return v;
}

struct GemmTile {
  const half_t* A; const half_t* A2; const float* mu; int lda;
  const half_t* Bt; int ldb; int K;
  half_t* C; int ldc; int epi;
  int row0, col0;
  const P* pp;
};

template <bool MIX>
__device__ __forceinline__ void gemm_tile(const GemmTile& g, char* smem) {
  half_t* As = (half_t*)smem;
  half_t* Bs = (half_t*)(smem + 73728);
  const int tid = tidx(), lane = tid & 63, w = tid >> 6;
  const int wm = w >> 1, wn = w & 1, lr = lane & 15, lq = lane >> 4;
  const int ldr = tid >> 3, ldk = (tid & 7) * 8;
  f4 acc[4][4];
#pragma unroll
  for (int i = 0; i < 4; ++i)
#pragma unroll
    for (int j = 0; j < 4; ++j) acc[i][j] = (f4){0.f, 0.f, 0.f, 0.f};
  uint4 ra0, ra1, ra2, ra3, rb0, rb1;
  uint4 rx0, rx1, rx2, rx3;
  float4 mu0, mu1;
  const int nk = g.K >> 6;
  const half_t* Ap = g.A + (size_t)ldr * g.lda + ldk;
  const half_t* A2p = MIX ? g.A2 + (size_t)ldr * g.lda + ldk : nullptr;
  const float* mup = MIX ? g.mu + ldk : nullptr;
  const half_t* Bp = g.Bt + (size_t)ldr * g.ldb + ldk;
  const size_t astep = (size_t)64 * g.lda, bstep = (size_t)64 * g.ldb;
  half_t* asw = As + ldr * 72 + ldk;
  half_t* bsw = Bs + ldr * 72 + ldk;
  const half_t* asr = As + (wm * 64 + lr) * 72 + lq * 8;
  const half_t* bsr = Bs + (wn * 64 + lr) * 72 + lq * 8;

#define GLOAD(kt)                                              \
  {                                                            \
    const int k0 = (kt) * 64;                                  \
    ra0 = *(const uint4*)(Ap + k0);                            \
    ra1 = *(const uint4*)(Ap + astep + k0);                    \
    ra2 = *(const uint4*)(Ap + 2 * astep + k0);                \
    ra3 = *(const uint4*)(Ap + 3 * astep + k0);                \
    rb0 = *(const uint4*)(Bp + k0);                            \
    rb1 = *(const uint4*)(Bp + bstep + k0);                    \
    if (MIX) {                                                 \
      rx0 = *(const uint4*)(A2p + k0);                         \
      rx1 = *(const uint4*)(A2p + astep + k0);                 \
      rx2 = *(const uint4*)(A2p + 2 * astep + k0);             \
      rx3 = *(const uint4*)(A2p + 3 * astep + k0);             \
      mu0 = *(const float4*)(mup + k0);                        \
      mu1 = *(const float4*)(mup + k0 + 4);                    \
    }                                                          \
  }
#define MIXV(r, x) __builtin_bit_cast(uint4, (h8)(__builtin_bit_cast(h8, r) + __builtin_bit_cast(h8, x) * m))
#define SSTORE(buf)                                            \
  {                                                            \
    half_t* as = asw + (buf) * (256 * 72);                     \
    half_t* bs = bsw + (buf) * (128 * 72);                     \
    if (MIX) {                                                 \
      h8 m;                                                    \
      m[0] = (half_t)mu0.x; m[1] = (half_t)mu0.y; m[2] = (half_t)mu0.z; m[3] = (half_t)mu0.w; \
      m[4] = (half_t)mu1.x; m[5] = (half_t)mu1.y; m[6] = (half_t)mu1.z; m[7] = (half_t)mu1.w; \
      ra0 = MIXV(ra0, rx0); ra1 = MIXV(ra1, rx1); ra2 = MIXV(ra2, rx2); ra3 = MIXV(ra3, rx3); \
    }                                                          \
    *(uint4*)(as) = ra0;                                       \
    *(uint4*)(as + 64 * 72) = ra1;                             \
    *(uint4*)(as + 128 * 72) = ra2;                            \
    *(uint4*)(as + 192 * 72) = ra3;                            \
    *(uint4*)(bs) = rb0;                                       \
    *(uint4*)(bs + 64 * 72) = rb1;                             \
  }

  GLOAD(0);
  SSTORE(0);
  __syncthreads();
  for (int kt = 0; kt < nk; ++kt) {
    const bool more = kt + 1 < nk;
    if (more) GLOAD(kt + 1);
    __builtin_amdgcn_sched_barrier(0);
    {
      const half_t* as = asr + (kt & 1) * (256 * 72);
      const half_t* bs = bsr + (kt & 1) * (128 * 72);
#pragma unroll
      for (int ks = 0; ks < 2; ++ks) {
        h8 a[4], b[4];
#pragma unroll
        for (int i = 0; i < 4; ++i) {
          a[i] = *(const h8*)(as + i * 16 * 72 + ks * 32);
          b[i] = *(const h8*)(bs + i * 16 * 72 + ks * 32);
        }
#pragma unroll
        for (int mt = 0; mt < 4; ++mt)
#pragma unroll
          for (int nt = 0; nt < 4; ++nt)
            acc[mt][nt] = __builtin_amdgcn_mfma_f32_16x16x32_f16(b[nt], a[mt], acc[mt][nt], 0, 0, 0);
      }
    }
    if (more) SSTORE((kt + 1) & 1);
    __syncthreads();
  }
#undef GLOAD
#undef SSTORE
#undef MIXV
#pragma unroll
  for (int mt = 0; mt < 4; ++mt) {
    half_t* cp = g.C + (size_t)(wm * 64 + mt * 16 + lr) * g.ldc + wn * 64 + lq * 4;
#pragma unroll
    for (int nt = 0; nt < 4; ++nt) {
      h4 o;
#pragma unroll
      for (int j = 0; j < 4; ++j) {
        float v = acc[mt][nt][j];
        if (g.epi == 1) { v = fmaxf(v, 0.f); v = v * v; }
        else if (g.epi == 2) v = 1.f - 2.f / (__expf(2.f * v) + 1.f);
        else if (g.epi == 3) v = sigm(v);
        o[j] = (half_t)v;
      }
      *(h4*)(cp + nt * 16) = o;
    }
  }
}

__device__ __forceinline__ void gemm_tile2(const GemmTile& g, char* smem) {
  half_t* As = (half_t*)smem;
  half_t* Bs = (half_t*)(smem + 73728);
  const int tid = tidx(), lane = tid & 63, w = tid >> 6;
  const int wm = w >> 1, wn = w & 1, lr = lane & 15, lq = lane >> 4;
  const int ldr = tid >> 3, ldk = (tid & 7) * 8;
  f4 acc[4][4];
#pragma unroll
  for (int i = 0; i < 4; ++i)
#pragma unroll
    for (int j = 0; j < 4; ++j) acc[i][j] = (f4){0.f, 0.f, 0.f, 0.f};
  uint4 xa0, xa1, xa2, xa3, xb0, xb1;
  uint4 ya0, ya1, ya2, ya3, yb0, yb1;
  const int nk = g.K >> 6;
  const half_t* Ap = g.A + (size_t)ldr * g.lda + ldk;
  const half_t* Bp = g.Bt + (size_t)ldr * g.ldb + ldk;
  const size_t astep = (size_t)64 * g.lda, bstep = (size_t)64 * g.ldb;
  half_t* asw = As + ldr * 72 + ldk;
  half_t* bsw = Bs + ldr * 72 + ldk;
  const half_t* asr = As + (wm * 64 + lr) * 72 + lq * 8;
  const half_t* bsr = Bs + (wn * 64 + lr) * 72 + lq * 8;
#define GLD(S, kt)                                   \
  {                                                  \
    const int k0 = (kt) * 64;                        \
    S##a0 = *(const uint4*)(Ap + k0);                \
    S##a1 = *(const uint4*)(Ap + astep + k0);        \
    S##a2 = *(const uint4*)(Ap + 2 * astep + k0);    \
    S##a3 = *(const uint4*)(Ap + 3 * astep + k0);    \
    S##b0 = *(const uint4*)(Bp + k0);                \
    S##b1 = *(const uint4*)(Bp + bstep + k0);        \
  }
#define SST(S, buf)                                  \
  {                                                  \
    half_t* as = asw + (buf) * (256 * 72);           \
    half_t* bs = bsw + (buf) * (128 * 72);           \
    *(uint4*)(as) = S##a0;                           \
    *(uint4*)(as + 64 * 72) = S##a1;                 \
    *(uint4*)(as + 128 * 72) = S##a2;                \
    *(uint4*)(as + 192 * 72) = S##a3;                \
    *(uint4*)(bs) = S##b0;                           \
    *(uint4*)(bs + 64 * 72) = S##b1;                 \
  }
#define CMP(buf)                                                                                     \
  {                                                                                                  \
    const half_t* as = asr + (buf) * (256 * 72);                                                     \
    const half_t* bs = bsr + (buf) * (128 * 72);                                                     \
    _Pragma("unroll") for (int ks = 0; ks < 2; ++ks) {                                               \
      h8 a[4], b[4];                                                                                 \
      _Pragma("unroll") for (int i = 0; i < 4; ++i) {                                                \
        a[i] = *(const h8*)(as + i * 16 * 72 + ks * 32);                                             \
        b[i] = *(const h8*)(bs + i * 16 * 72 + ks * 32);                                             \
      }                                                                                              \
      _Pragma("unroll") for (int mt = 0; mt < 4; ++mt)                                               \
        _Pragma("unroll") for (int nt = 0; nt < 4; ++nt)                                             \
          acc[mt][nt] = __builtin_amdgcn_mfma_f32_16x16x32_f16(b[nt], a[mt], acc[mt][nt], 0, 0, 0);  \
    }                                                                                                \
  }
  GLD(x, 0);
  SST(x, 0);
  if (nk > 1) GLD(x, 1);
  if (nk > 2) GLD(y, 2);
  __syncthreads();
  for (int kt = 0; kt < nk; kt += 2) {
    CMP(0);
    if (kt + 1 < nk) SST(x, 1);
    if (kt + 3 < nk) GLD(x, kt + 3);
    __syncthreads();
    CMP(1);
    if (kt + 2 < nk) SST(y, 0);
    if (kt + 4 < nk) GLD(y, kt + 4);
    __syncthreads();
  }
#undef GLD
#undef SST
#undef CMP
#pragma unroll
  for (int mt = 0; mt < 4; ++mt) {
    half_t* cp = g.C + (size_t)(wm * 64 + mt * 16 + lr) * g.ldc + wn * 64 + lq * 4;
#pragma unroll
    for (int nt = 0; nt < 4; ++nt) {
      h4 o;
#pragma unroll
      for (int j = 0; j < 4; ++j) {
        float v = acc[mt][nt][j];
        if (g.epi == 1) { v = fmaxf(v, 0.f); v = v * v; }
        o[j] = (half_t)v;
      }
      *(h4*)(cp + nt * 16) = o;
    }
  }
}

__device__ __forceinline__ void gemm_tile3(const GemmTile& g, char* smem) {
  const int tid = tidx(), lane = tid & 63, w = tid >> 6;
  const int wm = w >> 1, wn = w & 1, lr = lane & 15, lq = lane >> 4;
  f4 acc[4][4];
#pragma unroll
  for (int i = 0; i < 4; ++i)
#pragma unroll
    for (int j = 0; j < 4; ++j) acc[i][j] = (f4){0.f, 0.f, 0.f, 0.f};
  const int nk = g.K >> 6;
  const int lrow = lane >> 3, lslot = lane & 7;
  const half_t* Ag[4];
  const half_t* Bg[2];
#pragma unroll
  for (int i = 0; i < 4; ++i) {
    const int row = (w * 4 + i) * 8 + lrow;
    Ag[i] = g.A + (size_t)row * g.lda + ((lslot ^ ((row >> 1) & 7)) * 8);
  }
#pragma unroll
  for (int i = 0; i < 2; ++i) {
    const int row = (w * 2 + i) * 8 + lrow;
    Bg[i] = g.Bt + (size_t)row * g.ldb + ((lslot ^ ((row >> 1) & 7)) * 8);
  }
  char* aw = smem + (w * 4) * 1024 + lane * 16;
  char* bw = smem + 32768 + (w * 2) * 1024 + lane * 16;
  const int swz = (lr >> 1) & 7;
  const int ko0 = ((0 + lq) ^ swz) * 16, ko1 = ((4 + lq) ^ swz) * 16;
  const char* ar = smem + (wm * 64 + lr) * 128;
  const char* br = smem + 32768 + (wn * 64 + lr) * 128;
#define ISSUE(kt, st)                                                                                      \
  {                                                                                                        \
    _Pragma("unroll") for (int i = 0; i < 4; ++i)                                                          \
      __builtin_amdgcn_global_load_lds((const unsigned*)(Ag[i] + (kt) * 64), (unsigned*)(aw + (st) * 49152 + i * 1024), 16, 0, 0); \
    _Pragma("unroll") for (int i = 0; i < 2; ++i)                                                          \
      __builtin_amdgcn_global_load_lds((const unsigned*)(Bg[i] + (kt) * 64), (unsigned*)(bw + (st) * 49152 + i * 1024), 16, 0, 0); \
  }
  ISSUE(0, 0);
  if (nk > 1) {
    ISSUE(1, 1);
    asm volatile("s_waitcnt vmcnt(6)" ::: "memory");
  } else {
    asm volatile("s_waitcnt vmcnt(0)" ::: "memory");
  }
  __builtin_amdgcn_s_barrier();
  asm volatile("" ::: "memory");
  h8 a0[4], b0[4], a1[4], b1[4];
#define LDF(fa, fb, stg, ko)                                             \
  {                                                                      \
    const char* as = ar + (stg) * 49152 + (ko);                          \
    const char* bs = br + (stg) * 49152 + (ko);                          \
    _Pragma("unroll") for (int i = 0; i < 4; ++i) {                      \
      fa[i] = *(const h8*)(as + i * 2048);                               \
      fb[i] = *(const h8*)(bs + i * 2048);                               \
    }                                                                    \
  }
#define MMA(fa, fb)                                                      \
  {                                                                      \
    _Pragma("unroll") for (int mt = 0; mt < 4; ++mt)                     \
      _Pragma("unroll") for (int nt = 0; nt < 4; ++nt)                   \
        acc[mt][nt] = __builtin_amdgcn_mfma_f32_16x16x32_f16(fb[nt], fa[mt], acc[mt][nt], 0, 0, 0); \
  }
  LDF(a0, b0, 0, ko0);
  int st = 0;
  for (int kt = 0; kt < nk; ++kt) {
    const bool more = kt + 2 < nk;
    int st1 = st + 1; if (st1 >= 3) st1 -= 3;
    int st2 = st + 2; if (st2 >= 3) st2 -= 3;
    if (more) ISSUE(kt + 2, st2);
    LDF(a1, b1, st, ko1);
    __builtin_amdgcn_sched_barrier(0);
    MMA(a0, b0);
    __builtin_amdgcn_sched_barrier(0);
    if (more) asm volatile("s_waitcnt vmcnt(6) lgkmcnt(0)" ::: "memory");
    else asm volatile("s_waitcnt vmcnt(0) lgkmcnt(0)" ::: "memory");
    __builtin_amdgcn_s_barrier();
    asm volatile("" ::: "memory");
    if (kt + 1 < nk) LDF(a0, b0, st1, ko0);
    __builtin_amdgcn_sched_barrier(0);
    MMA(a1, b1);
    __builtin_amdgcn_sched_barrier(0);
    st = st1;
  }
#undef LDF
#undef MMA
#undef ISSUE
  if (g.epi == 5) {
    const P& p = *g.pp;
    char* ws = p.ws + opaque_zero();
    const half_t* Y0 = (const half_t*)(ws + OFF_A0);
    const half_t* Y1 = (const half_t*)(ws + OFF_A1);
    const half_t* VVp = (const half_t*)(ws + OFF_VV);
    const float* BN0 = (const float*)(ws + OFF_BN);
    const float* BN1 = BN0 + (size_t)RL * 16;
    half_t* Z1 = (half_t*)(ws + OFF_Z1);
    const int head = (g.col0 >> 6) + wn;
#pragma unroll 1
    for (int mt = 0; mt < 4; ++mt) {
      const int row = g.row0 + wm * 64 + mt * 16 + lr;
      const size_t base = (size_t)row * 1024 + head * 64 + lq * 4;
      float y[4][4], vv[4][4];
      float sm = 0.f;
#pragma unroll
      for (int nt = 0; nt < 4; ++nt) {
        const h4 ya = *(const h4*)(Y0 + base + nt * 16);
        const h4 yb = *(const h4*)(Y1 + base + nt * 16);
        const h4 vh = *(const h4*)(VVp + base + nt * 16);
#pragma unroll
        for (int j = 0; j < 4; ++j) { y[nt][j] = (float)ya[j] + (float)yb[j]; vv[nt][j] = (float)vh[j]; sm += y[nt][j]; }
      }
      sm += bperm(sm, lane ^ 16);
      sm += bperm(sm, lane ^ 32);
      const float mean = sm * (1.f / 64.f);
      float q = 0.f;
#pragma unroll
      for (int nt = 0; nt < 4; ++nt)
#pragma unroll
        for (int j = 0; j < 4; ++j) { const float d = y[nt][j] - mean; q += d * d; }
      q += bperm(q, lane ^ 16);
      q += bperm(q, lane ^ 32);
      const float rstd = rsqrtf(q * (1.f / 64.f) + 64e-5f);
      const float bonus = BN0[(size_t)row * 16 + head] + BN1[(size_t)row * 16 + head];
#pragma unroll
      for (int nt = 0; nt < 4; ++nt) {
        const int ch = head * 64 + nt * 16 + lq * 4;
        const float4 lg = *(const float4*)(p.rw_lng + ch);
        const float4 lb = *(const float4*)(p.rw_lnb + ch);
        const float lgv[4] = {lg.x, lg.y, lg.z, lg.w}, lbv[4] = {lb.x, lb.y, lb.z, lb.w};
        const f4 gv = mt == 0 ? acc[0][nt] : (mt == 1 ? acc[1][nt] : (mt == 2 ? acc[2][nt] : acc[3][nt]));
        h4 o;
#pragma unroll
        for (int j = 0; j < 4; ++j) o[j] = (half_t)(((y[nt][j] - mean) * rstd * lgv[j] + lbv[j] + bonus * vv[nt][j]) * gv[j]);
        *(h4*)(Z1 + base + nt * 16) = o;
      }
    }
    return;
  }
  if (g.epi == 4) {
    half_t* vp = g.C + (size_t)((wm * 8 + wn) * 64) * 64 + lr;
#pragma unroll
    for (int mt = 0; mt < 4; ++mt)
#pragma unroll
      for (int nt = 0; nt < 4; ++nt)
#pragma unroll
        for (int j = 0; j < 4; ++j) vp[(nt * 16 + lq * 4 + j) * 64 + mt * 16] = (half_t)acc[mt][nt][j];
    return;
  }
#pragma unroll
  for (int mt = 0; mt < 4; ++mt) {
    half_t* cp = g.C + (size_t)(wm * 64 + mt * 16 + lr) * g.ldc + wn * 64 + lq * 4;
#pragma unroll
    for (int nt = 0; nt < 4; ++nt) {
      h4 o;
#pragma unroll
      for (int j = 0; j < 4; ++j) {
        float v = acc[mt][nt][j];
        if (g.epi == 1) { v = fmaxf(v, 0.f); v = v * v; }
        o[j] = (half_t)v;
      }
      *(h4*)(cp + nt * 16) = o;
    }
  }
}

__device__ __forceinline__ void gemm_tile4(const GemmTile& g, char* smem) {
  const int tid = tidx(), lane = tid & 63, w = tid >> 6;
  const int wm = w >> 1, wn = w & 1, lr = lane & 15, lq = lane >> 4;
  f4 acc[4][8];
#pragma unroll
  for (int i = 0; i < 4; ++i)
#pragma unroll
    for (int j = 0; j < 8; ++j) acc[i][j] = (f4){0.f, 0.f, 0.f, 0.f};
  const int nk = g.K >> 6;
  const int lrow = lane >> 3, lslot = lane & 7;
  const half_t* Ag[4];
  const half_t* Bg[4];
#pragma unroll
  for (int i = 0; i < 4; ++i) {
    const int row = (w * 4 + i) * 8 + lrow;
    const int so = (lslot ^ ((row >> 1) & 7)) * 8;
    Ag[i] = g.A + (size_t)row * g.lda + so;
    Bg[i] = g.Bt + (size_t)row * g.ldb + so;
  }
  char* aw = smem + (w * 4) * 1024 + lane * 16;
  char* bw = smem + 32768 + (w * 4) * 1024 + lane * 16;
  const int swz = (lr >> 1) & 7;
  const int ko0 = ((0 + lq) ^ swz) * 16, ko1 = ((4 + lq) ^ swz) * 16;
  const char* ar = smem + (wm * 64 + lr) * 128;
  const char* br = smem + 32768 + (wn * 128 + lr) * 128;
#define ISSUE4(kt, st)                                                                                     \
  {                                                                                                        \
    _Pragma("unroll") for (int i = 0; i < 4; ++i)                                                          \
      __builtin_amdgcn_global_load_lds((const unsigned*)(Ag[i] + (kt) * 64), (unsigned*)(aw + (st) * 65536 + i * 1024), 16, 0, 0); \
    _Pragma("unroll") for (int i = 0; i < 4; ++i)                                                          \
      __builtin_amdgcn_global_load_lds((const unsigned*)(Bg[i] + (kt) * 64), (unsigned*)(bw + (st) * 65536 + i * 1024), 16, 0, 0); \
  }
  ISSUE4(0, 0);
  asm volatile("s_waitcnt vmcnt(0)" ::: "memory");
  __builtin_amdgcn_s_barrier();
  asm volatile("" ::: "memory");
  for (int kt = 0; kt < nk; ++kt) {
    const int st = kt & 1;
    if (kt + 1 < nk) ISSUE4(kt + 1, st ^ 1);
    const char* as = ar + st * 65536;
    const char* bs = br + st * 65536;
#pragma unroll
    for (int ks = 0; ks < 2; ++ks) {
      const int ko = ks ? ko1 : ko0;
      h8 a[4], b[8];
#pragma unroll
      for (int i = 0; i < 4; ++i) a[i] = *(const h8*)(as + i * 2048 + ko);
#pragma unroll
      for (int i = 0; i < 8; ++i) b[i] = *(const h8*)(bs + i * 2048 + ko);
#pragma unroll
      for (int mt = 0; mt < 4; ++mt)
#pragma unroll
        for (int nt = 0; nt < 8; ++nt)
          acc[mt][nt] = __builtin_amdgcn_mfma_f32_16x16x32_f16(b[nt], a[mt], acc[mt][nt], 0, 0, 0);
    }
    asm volatile("s_waitcnt vmcnt(0) lgkmcnt(0)" ::: "memory");
    __builtin_amdgcn_s_barrier();
    asm volatile("" ::: "memory");
  }
#undef ISSUE4
  if (g.epi == 4) {
#pragma unroll
    for (int mt = 0; mt < 4; ++mt)
#pragma unroll
      for (int nt = 0; nt < 8; ++nt) {
        half_t* vp = g.C + (size_t)((wm * 8 + wn * 2 + (nt >> 2)) * 64) * 64 + lr;
#pragma unroll
        for (int j = 0; j < 4; ++j) vp[((nt & 3) * 16 + lq * 4 + j) * 64 + mt * 16] = (half_t)acc[mt][nt][j];
      }
    return;
  }
#pragma unroll
  for (int mt = 0; mt < 4; ++mt) {
    half_t* cp = g.C + (size_t)(wm * 64 + mt * 16 + lr) * g.ldc + wn * 128 + lq * 4;
#pragma unroll
    for (int nt = 0; nt < 8; ++nt) {
      h4 o;
#pragma unroll
      for (int j = 0; j < 4; ++j) {
        float v = acc[mt][nt][j];
        if (g.epi == 1) { v = fmaxf(v, 0.f); v = v * v; }
        o[j] = (half_t)v;
      }
      *(h4*)(cp + nt * 16) = o;
    }
  }
}

__device__ __forceinline__ int p8_lds_byte(int r, int c) {
  const int st = (r >> 4) * 2 + (c >> 5), rr = r & 15, cc = c & 31, ob = rr * 64 + cc * 2;
  return st * 1024 + (ob ^ (((ob >> 9) & 1) << 5));
}
__device__ __forceinline__ void p8_stage_rc(int b, int& R, int& C) {
  const int st = b / 1024, sb = b % 1024, swz = sb ^ (((sb >> 9) & 1) << 5);
  R = (st >> 1) * 16 + swz / 64;
  C = (st & 1) * 32 + (swz % 64) / 2;
}
__device__ __forceinline__ void gemm_tile8(const GemmTile& g, char* smem) {
  constexpr int HT = 128 * 64;
  half_t* shm = (half_t*)smem;
  const int tid = tidx();
  const int wid = tid >> 6, lane = tid & 63, wr = wid >> 2, wc = wid & 3, fr = lane & 15, fq = lane >> 4;
  const half_t* A = g.A;
  const half_t* Bt = g.Bt;
  const int lda = g.lda, ldb = g.lda;
#define P8_SA(b, h) (shm + ((b) * 2 + (h)) * HT)
#define P8_SB(b, h) (shm + (4 + (b) * 2 + (h)) * HT)
  int sr0, sc0, sr1, sc1;
  p8_stage_rc(tid * 16, sr0, sc0);
  p8_stage_rc(tid * 16 + 8192, sr1, sc1);
  const int ao0 = sr0 * lda + sc0, ao1 = sr1 * lda + sc1;
#define bo0 ao0
#define bo1 ao1
#define P8_STAGE_A(Pp, br, kt)                                                                                   \
  {                                                                                                              \
    const half_t* gb_ = A + (size_t)(br) * lda + (size_t)(kt) * 64;                                              \
    __builtin_amdgcn_global_load_lds((const unsigned*)(gb_ + ao0), (unsigned*)((char*)(Pp) + tid * 16), 16, 0, 0);        \
    __builtin_amdgcn_global_load_lds((const unsigned*)(gb_ + ao1), (unsigned*)((char*)(Pp) + tid * 16 + 8192), 16, 0, 0); \
  }
#define P8_STAGE_B(Pp, br, kt)                                                                                   \
  {                                                                                                              \
    const half_t* gb_ = Bt + (size_t)(br) * ldb + (size_t)(kt) * 64;                                             \
    __builtin_amdgcn_global_load_lds((const unsigned*)(gb_ + bo0), (unsigned*)((char*)(Pp) + tid * 16), 16, 0, 0);        \
    __builtin_amdgcn_global_load_lds((const unsigned*)(gb_ + bo1), (unsigned*)((char*)(Pp) + tid * 16 + 8192), 16, 0, 0); \
  }
  const char* abase = smem + p8_lds_byte(wr * 64 + fr, fq * 8);
  const char* bbase = smem + 4 * HT * 2 + p8_lds_byte(wc * 32 + fr, fq * 8);
#define P8_LDA(dst, b, h)                                                                                        \
  _Pragma("unroll") for (int m = 0; m < 4; ++m) _Pragma("unroll") for (int k = 0; k < 2; ++k)                    \
      dst[m][k] = *(const h8*)(abase + ((b) * 2 + (h)) * (HT * 2) + (m * 2 + k) * 1024);
#define P8_LDB(dst, b, h)                                                                                        \
  _Pragma("unroll") for (int n = 0; n < 2; ++n) _Pragma("unroll") for (int k = 0; k < 2; ++k)                    \
      dst[n][k] = *(const h8*)(bbase + ((b) * 2 + (h)) * (HT * 2) + (n * 2 + k) * 1024);
#define P8_MMA(ai, bj, Af, Bf)                                                                                   \
  {                                                                                                              \
    __builtin_amdgcn_s_setprio(1);                                                                               \
    _Pragma("unroll") for (int m = 0; m < 4; ++m) _Pragma("unroll") for (int n = 0; n < 2; ++n)                  \
        _Pragma("unroll") for (int k = 0; k < 2; ++k)                                                            \
            acc[ai][bj][m][n] = __builtin_amdgcn_mfma_f32_16x16x32_f16(Bf[n][k], Af[m][k], acc[ai][bj][m][n], 0, 0, 0); \
    __builtin_amdgcn_s_setprio(0);                                                                               \
  }
#define P8_WAIT_V(n) asm volatile("s_waitcnt vmcnt(" #n ")" ::: "memory")
#define P8_WAIT_L(n) asm volatile("s_waitcnt lgkmcnt(" #n ")" ::: "memory")
#define P8_BAR __builtin_amdgcn_s_barrier()
#define P8_SCHED __builtin_amdgcn_sched_barrier(0)

  f4 acc[2][2][4][2];
#pragma unroll
  for (int i0 = 0; i0 < 2; ++i0)
#pragma unroll
    for (int i1 = 0; i1 < 2; ++i1)
#pragma unroll
      for (int i2 = 0; i2 < 4; ++i2)
#pragma unroll
        for (int i3 = 0; i3 < 2; ++i3) acc[i0][i1][i2][i3] = (f4){0.f, 0.f, 0.f, 0.f};
  h8 At[4][2], B0[2][2], B1[2][2];
  const int nt = g.K >> 6;
  P8_STAGE_B(P8_SB(0, 0), 0, 0); P8_STAGE_A(P8_SA(0, 0), 0, 0);
  P8_STAGE_B(P8_SB(0, 1), 128, 0); P8_STAGE_A(P8_SA(0, 1), 128, 0);
  if (wr == 1) P8_BAR;
  P8_WAIT_V(4); P8_BAR;
  P8_STAGE_B(P8_SB(1, 0), 0, 1); P8_STAGE_A(P8_SA(1, 0), 0, 1); P8_STAGE_B(P8_SB(1, 1), 128, 1);
  P8_WAIT_V(6); P8_BAR;
  for (int t = 0; t < nt - 2; t += 2) {
    P8_LDB(B0, 0, 0); P8_SCHED; P8_LDA(At, 0, 0); P8_STAGE_A(P8_SA(1, 1), 128, t + 1);
    P8_WAIT_L(8); P8_BAR; P8_WAIT_L(0); P8_MMA(0, 0, At, B0); P8_BAR; P8_SCHED;
    P8_LDB(B1, 0, 1); P8_STAGE_B(P8_SB(0, 0), 0, t + 2);
    P8_BAR; P8_WAIT_L(0); P8_MMA(0, 1, At, B1); P8_BAR;
    P8_LDA(At, 0, 1); P8_STAGE_A(P8_SA(0, 0), 0, t + 2);
    P8_BAR; P8_WAIT_L(0); P8_MMA(1, 0, At, B0); P8_BAR; P8_SCHED;
    P8_STAGE_B(P8_SB(0, 1), 128, t + 2);
    P8_WAIT_V(6); P8_BAR; P8_MMA(1, 1, At, B1); P8_BAR;
    P8_LDB(B0, 1, 0); P8_SCHED; P8_LDA(At, 1, 0); P8_STAGE_A(P8_SA(0, 1), 128, t + 2);
    P8_WAIT_L(8); P8_BAR; P8_WAIT_L(0); P8_MMA(0, 0, At, B0); P8_BAR; P8_SCHED;
    P8_LDB(B1, 1, 1); P8_STAGE_B(P8_SB(1, 0), 0, t + 3);
    P8_BAR; P8_WAIT_L(0); P8_MMA(0, 1, At, B1); P8_BAR;
    P8_LDA(At, 1, 1); P8_STAGE_A(P8_SA(1, 0), 0, t + 3);
    P8_BAR; P8_WAIT_L(0); P8_MMA(1, 0, At, B0); P8_BAR; P8_SCHED;
    P8_STAGE_B(P8_SB(1, 1), 128, t + 3);
    P8_WAIT_V(6); P8_BAR; P8_MMA(1, 1, At, B1); P8_BAR;
  }
  {
    P8_LDB(B0, 0, 0); P8_LDA(At, 0, 0); P8_STAGE_A(P8_SA(1, 1), 128, nt - 1);
    P8_BAR; P8_WAIT_L(0); P8_MMA(0, 0, At, B0); P8_BAR;
    P8_LDB(B1, 0, 1); P8_BAR; P8_WAIT_L(0); P8_MMA(0, 1, At, B1); P8_BAR;
    P8_LDA(At, 0, 1); P8_WAIT_V(4); P8_BAR; P8_WAIT_L(0); P8_MMA(1, 0, At, B0); P8_MMA(1, 1, At, B1); P8_BAR;
  }
  {
    P8_LDB(B0, 1, 0); P8_LDA(At, 1, 0); P8_WAIT_V(2); P8_BAR; P8_WAIT_L(0); P8_MMA(0, 0, At, B0); P8_BAR;
    P8_LDB(B1, 1, 1); P8_WAIT_V(0); P8_BAR; P8_WAIT_L(0); P8_MMA(0, 1, At, B1); P8_BAR;
    P8_LDA(At, 1, 1); P8_BAR; P8_WAIT_L(0); P8_MMA(1, 0, At, B0); P8_MMA(1, 1, At, B1); P8_BAR;
  }
  if (wr == 0) P8_BAR;
  asm volatile("" ::: "memory");
#pragma unroll
  for (int ai = 0; ai < 2; ++ai)
#pragma unroll
    for (int m = 0; m < 4; ++m) {
      const int row = ai * 128 + wr * 64 + m * 16 + fr;
#pragma unroll
      for (int bj = 0; bj < 2; ++bj)
#pragma unroll
        for (int n = 0; n < 2; ++n) {
          const int col = bj * 128 + wc * 32 + n * 16 + fq * 4;
          if (g.epi == 4) {
            half_t* vp = g.C + (size_t)(((row >> 6) * 8 + (col >> 6)) * 64 + (col & 63)) * 64 + (row & 63);
#pragma unroll
            for (int j = 0; j < 4; ++j) vp[j * 64] = (half_t)acc[ai][bj][m][n][j];
          } else {
            h4 o;
#pragma unroll
            for (int j = 0; j < 4; ++j) {
              float v = acc[ai][bj][m][n][j];
              if (g.epi == 1) { v = fmaxf(v, 0.f); v = v * v; }
              o[j] = (half_t)v;
            }
            *(h4*)(g.C + (size_t)row * g.ldc + col) = o;
          }
        }
    }
#undef bo0
#undef bo1
#undef P8_SA
#undef P8_SB
#undef P8_STAGE_A
#undef P8_STAGE_B
#undef P8_LDA
#undef P8_LDB
#undef P8_MMA
#undef P8_WAIT_V
#undef P8_WAIT_L
#undef P8_BAR
#undef P8_SCHED
}

__device__ __forceinline__ void gemm_phase(const P& p, const half_t* A, int lda, const half_t* Bt, int ldb, int K, half_t* C, int ldc,
                                           int epi, int nMt, int nNt, int feat, char* smem) {
  char* ws = (p.ws + opaque_zero());
  const bool split = (feat >= 2 && nMt == 136);
  if (split) nMt = 128;
  const int nbig = nMt * nNt;
  const int total = nbig + (split ? 16 * nNt : 0), G = gridDim.x, per_xcd = G >> 3;
  for (int t0 = bidx(); t0 < total + G; t0 += G) {
    const int rnd = t0 / G, bb = t0 - rnd * G;
    const int t = ((G & 7) == 0) ? rnd * G + (bb & 7) * per_xcd + (bb >> 3) : t0;
    if (t >= total) continue;
    const bool small = t >= nbig;
    const int gsz = 8 * nNt, first = (t / gsz) * 8, gm = min(nMt - first, 8);
    const int mt = small ? 128 + ((t - nbig) & 7) : first + (t % gsz) % gm;
    const int nt = small ? (t - nbig) >> 3 : (t % gsz) / gm;
    GemmTile g;
    g.A = A + (size_t)mt * 256 * lda; g.A2 = nullptr; g.mu = nullptr; g.lda = lda;
    const int tw = (feat >= 2 && !small) ? 256 : 128;
    g.Bt = Bt + (size_t)nt * tw * ldb; g.ldb = ldb; g.K = K;
    g.C = C + (size_t)mt * 256 * ldc + nt * tw; g.ldc = ldc; g.epi = epi;
    g.row0 = mt * 256; g.col0 = nt * tw; g.pp = &p;
    if (feat == 2 && !small && nt >= 6) {
      g.epi = 4;
      g.C = (half_t*)(ws + OFF_A1) + ((size_t)(mt * 4) * 8 + (nt - 6) * 4) * 4096;
    }
    if (feat == 2 && small && nt >= 12) {
      g.epi = 4;
      g.C = (half_t*)(ws + OFF_A1) + ((size_t)(mt * 4) * 8 + (nt - 12) * 2) * 4096;
    }
    if (feat == 1) {
      g.A2 = (const half_t*)(ws + OFF_A1) + (size_t)mt * 256 * 1024;
      const int grp = nt >> 3, sub = nt & 7;
      int mixi;
      if (grp < 3) {
        mixi = grp == 0 ? 0 : (grp == 1 ? 2 : 3);
        g.Bt = (const half_t*)(ws + (grp == 0 ? OFF_WR : (grp == 1 ? OFF_WK : OFF_WV))) + (size_t)sub * 128 * 1024;
        g.C = (half_t*)(ws + (grp == 0 ? OFF_RR : (grp == 1 ? OFF_KK : OFF_VV))) + (size_t)mt * 256 * 1024 + sub * 128;
      } else {
        mixi = sub == 0 ? 1 : (sub == 1 ? 4 : 5);
        g.Bt = (const half_t*)(ws + OFF_L1) + (size_t)sub * 128 * 1024;
        g.C = (half_t*)(ws + OFF_L) + (size_t)mt * 256 * 384 + sub * 128;
        g.ldc = 384;
        g.epi = sub == 0 ? 2 : (sub == 1 ? 0 : 3);
      }
      g.mu = p.rw_mu + mixi * 1024;
    }
    if (feat == 1) gemm_tile<true>(g, smem); else if (feat >= 2 && !small) gemm_tile8(g, smem); else gemm_tile3(g, smem);
  }
}

__device__ void xpose_seg(const float* src, int ldsrc, int K, int N, half_t* dst, int lddst, int koff, int& base,
                          char* smem) {
  float* ts = (float*)smem;
  const int tid = tidx(), G = gridDim.x;
  const int tkn = K >> 6, tnn = N >> 6, cnt = tkn * tnn;
  int t0 = ((int)bidx() - (base % G) + G) % G;
  for (int t = t0; t < cnt; t += G) {
    const int k0 = (t % tkn) * 64, n0 = (t / tkn) * 64;
#pragma unroll
    for (int i = 0; i < 2; ++i) {
      const int c = tid + 512 * i, r = c >> 4, c4 = (c & 15) * 4;
      const float4 v = *(const float4*)(src + (size_t)(k0 + r) * ldsrc + n0 + c4);
      float* d = ts + r * 65 + c4;
      d[0] = v.x; d[1] = v.y; d[2] = v.z; d[3] = v.w;
    }
    __syncthreads();
    {
      const int n = tid >> 3, kc = (tid & 7) * 8;
      h8 o;
#pragma unroll
      for (int i = 0; i < 8; ++i) o[i] = (half_t)ts[(kc + i) * 65 + n];
      *(h8*)(dst + (size_t)(n0 + n) * lddst + koff + k0 + kc) = o;
    }
    __syncthreads();
  }
  base += cnt;
}

__device__ void phase_prep(const P& p, char* smem) {
  const int tid = tidx();
  char* ws = (p.ws + opaque_zero());
  float* MOD = (float*)(ws + OFF_MOD);
  if (bidx() < 192 || gridDim.x < 256) {
    float* sl = (float*)smem;
    for (int i = tid; i < 9216; i += 512) {
      const int b = i >> 10, k = i & 1023;
      const float cv = b < 8 ? p.c[b * 1024 + k] : p.c_ctx[k];
      sl[i] = cv / (1.f + __expf(-cv));
    }
    __syncthreads();
    float* red = sl + 9216;
    for (int item = bidx(); item < 192; item += gridDim.x) {
      const int l = item / 96, n0 = (item % 96) * 64, cn = tid & 63, kq = tid >> 6;
      float acc[9];
#pragma unroll
      for (int b = 0; b < 9; ++b) acc[b] = 0.f;
      const float* wp = p.ada_w + (size_t)l * 1024 * 6144 + n0 + cn;
#pragma unroll 4
      for (int k = kq * 128; k < kq * 128 + 128; ++k) {
        const float wv = wp[(size_t)k * 6144];
#pragma unroll
        for (int b = 0; b < 9; ++b) acc[b] += sl[b * 1024 + k] * wv;
      }
#pragma unroll
      for (int b = 0; b < 9; ++b) red[(kq * 9 + b) * 64 + cn] = acc[b];
      __syncthreads();
      for (int i = tid; i < 576; i += 512) {
        const int b = i >> 6, c = i & 63;
        float s = 0.f;
#pragma unroll
        for (int q = 0; q < 8; ++q) s += red[(q * 9 + b) * 64 + c];
        MOD[(size_t)(l * 9 + b) * 6144 + n0 + c] = s + p.ada_b[l * 6144 + n0 + c];
      }
      __syncthreads();
    }
  }
  for (int it = bidx(); it < 256; it += gridDim.x) {
    if (it < 192) continue;
    const int fi = it - 192, gi = fi >> 4, n0 = (fi & 15) * 64, n = tid & 63, ig = tid >> 6;
    float acc[16];
#pragma unroll
    for (int i = 0; i < 16; ++i) acc[i] = 0.f;
    for (int j = 0; j < 128; ++j) {
      const float wv = p.ev_w_out[(size_t)(gi * 128 + j) * 1024 + n0 + n] * p.ev_pool_scale[gi * 128 + j];
      const float* pw = p.ev_pool_w + ((size_t)gi * 128 + ig * 16) * 128 + j;
#pragma unroll
      for (int i = 0; i < 16; ++i) acc[i] += pw[i * 128] * wv;
    }
    h8 o0, o1;
#pragma unroll
    for (int i = 0; i < 8; ++i) { o0[i] = (half_t)acc[i]; o1[i] = (half_t)acc[8 + i]; }
    half_t* d = (half_t*)(ws + OFF_WOUT) + (size_t)(n0 + n) * 1024 + gi * 128 + ig * 16;
    *(h8*)d = o0;
    *(h8*)(d + 8) = o1;
  }
  __syncthreads();
  int base = 0;
  xpose_seg(p.ev_w_in, 2048, 1024, 2048, (half_t*)(ws + OFF_WIN), 1024, 0, base, smem);
  xpose_seg(p.ev_w_out + 512 * 1024, 1024, 512, 1024, (half_t*)(ws + OFF_WOUT), 1024, 512, base, smem);
  for (int l = 0; l < 2; ++l) {
    xpose_seg(p.mlp_w1 + (size_t)l * 1024 * 4096, 4096, 1024, 4096, (half_t*)(ws + OFF_M1 + l * 8 * MIB), 1024, 0, base, smem);
    xpose_seg(p.mlp_w2 + (size_t)l * 1024 * 4096, 1024, 4096, 1024, (half_t*)(ws + OFF_M2 + l * 8 * MIB), 4096, 0, base, smem);
  }
  xpose_seg(p.rw_wr, 1024, 1024, 1024, (half_t*)(ws + OFF_WR), 1024, 0, base, smem);
  xpose_seg(p.rw_wk, 1024, 1024, 1024, (half_t*)(ws + OFF_WK), 1024, 0, base, smem);
  xpose_seg(p.rw_wv, 1024, 1024, 1024, (half_t*)(ws + OFF_WV), 1024, 0, base, smem);
  xpose_seg(p.rw_wo, 1024, 1024, 1024, (half_t*)(ws + OFF_WO), 1024, 0, base, smem);
  for (int d = 0; d < 2; ++d) {
    xpose_seg(p.rw_w1 + (size_t)d * 1024 * 64, 64, 1024, 64, (half_t*)(ws + OFF_L1) + (size_t)(d * 64) * 1024, 1024, 0, base, smem);
    xpose_seg(p.rw_a1 + (size_t)d * 1024 * 64, 64, 1024, 64, (half_t*)(ws + OFF_L1) + (size_t)(128 + d * 64) * 1024, 1024, 0, base, smem);
    xpose_seg(p.rw_w2 + (size_t)d * 64 * 1024, 1024, 64, 1024, (half_t*)(ws + OFF_W2) + (size_t)d * 1024 * 64, 64, 0, base, smem);
    xpose_seg(p.rw_a2 + (size_t)d * 64 * 1024, 1024, 64, 1024, (half_t*)(ws + OFF_A2) + (size_t)d * 1024 * 64, 64, 0, base, smem);
  }
  xpose_seg(p.rw_g1, 128, 1024, 128, (half_t*)(ws + OFF_L1) + (size_t)256 * 1024, 1024, 0, base, smem);
  xpose_seg(p.rw_g2, 1024, 128, 1024, (half_t*)(ws + OFF_G2), 128, 0, base, smem);
}

__device__ void phase_rowwise(const P& p, int mode) {
  const int lane = tidx() & 63;
  const int gw = bidx() * 8 + (tidx() >> 6), nw = gridDim.x * 8;
  char* ws = (p.ws + opaque_zero());
  const float* MOD = (const float*)(ws + OFF_MOD);
  float* XC = (float*)(ws + OFF_XC);
  half_t* H = (half_t*)(ws + OFF_A0);
  const half_t* Y = (const half_t*)(ws + OFF_A1);
  const int nrows = (mode >= 3) ? RL : RT;
  const int per = (nrows + nw - 1) / nw;
  const int r0 = gw * per, r1 = min(r0 + per, nrows);
  if (r0 >= r1) return;
  const bool hasY = mode != 0, hasH = mode != 4;
  const float EPS = opaque_f(1e-6f);
  const int lyr = (mode <= 1) ? 0 : ((mode == 2) ? 0 : 1);
  const int gyi = (mode == 1) ? 1 : (mode == 2 ? 3 : (mode == 3 ? 5 : 7));
  const int gti = (mode == 1) ? 2 : (mode == 2 ? 5 : (mode == 3 ? 2 : 5));
  const int hl = (mode <= 1) ? 0 : 1;
  const int ghi = (mode == 0) ? 0 : (mode == 1 ? 2 : (mode == 2 ? 4 : 6));
  const int shi = (mode == 0 || mode == 2) ? 0 : 3;
  auto xsrc = [&](int row) -> const float* {
    if (mode <= 1) return row < RL ? p.x + (size_t)row * 1024 : p.ctx + (size_t)(row - RL) * 1024;
    return row < RL ? p.out + (size_t)row * 1024 : XC + (size_t)(row - RL) * 1024;
  };
  auto xdst = [&](int row) -> float* { return row < RL ? p.out + (size_t)row * 1024 : XC + (size_t)(row - RL) * 1024; };
  float4 gy[4], gt[4], gh[4], s1[4], s2[4];
  int cur_mi = -1;
  float4 nx[4];
  h4 ny[4];
  {
    const float* xs = xsrc(r0);
#pragma unroll
    for (int i = 0; i < 4; ++i) nx[i] = *(const float4*)(xs + i * 256 + lane * 4);
    if (hasY) {
#pragma unroll
      for (int i = 0; i < 4; ++i) ny[i] = *(const h4*)(Y + (size_t)r0 * 1024 + i * 256 + lane * 4);
    }
  }
  for (int row = r0; row < r1; ++row) {
    float xv[4][4];
    h4 yh[4];
#pragma unroll
    for (int i = 0; i < 4; ++i) { xv[i][0] = nx[i].x; xv[i][1] = nx[i].y; xv[i][2] = nx[i].z; xv[i][3] = nx[i].w; yh[i] = ny[i]; }
    if (row + 1 < r1) {
      const float* xs = xsrc(row + 1);
#pragma unroll
      for (int i = 0; i < 4; ++i) nx[i] = *(const float4*)(xs + i * 256 + lane * 4);
      if (hasY) {
#pragma unroll
        for (int i = 0; i < 4; ++i) ny[i] = *(const h4*)(Y + (size_t)(row + 1) * 1024 + i * 256 + lane * 4);
      }
    }
    const int mi = row < RL ? (row >> 12) : 8;
    if (mi != cur_mi) {
      cur_mi = mi;
      const float* mg = MOD + (size_t)(lyr * 9 + mi) * 6144;
      const float* mh = MOD + (size_t)(hl * 9 + mi) * 6144;
#pragma unroll
      for (int i = 0; i < 4; ++i) {
        const int o = i * 256 + lane * 4;
        if (hasY) { gy[i] = *(const float4*)(p.norm_g + gyi * 1024 + o); gt[i] = *(const float4*)(mg + gti * 1024 + o); }
        if (hasH) {
          gh[i] = *(const float4*)(p.norm_g + ghi * 1024 + o);
          s1[i] = *(const float4*)(mh + shi * 1024 + o);
          s2[i] = *(const float4*)(mh + (shi + 1) * 1024 + o);
        }
      }
    }
    if (hasY) {
      float yv[4][4];
      float ss = 0.f;
#pragma unroll
      for (int i = 0; i < 4; ++i)
#pragma unroll
        for (int k = 0; k < 4; ++k) { yv[i][k] = (float)yh[i][k]; ss += yv[i][k] * yv[i][k]; }
      ss = wave_sum(ss, lane);
      const float rs = rsqrtf(ss * (1.f / 1024.f) + EPS);
      float* xo = xdst(row);
#pragma unroll
      for (int i = 0; i < 4; ++i) {
        xv[i][0] += gt[i].x * (yv[i][0] * rs * gy[i].x);
        xv[i][1] += gt[i].y * (yv[i][1] * rs * gy[i].y);
        xv[i][2] += gt[i].z * (yv[i][2] * rs * gy[i].z);
        xv[i][3] += gt[i].w * (yv[i][3] * rs * gy[i].w);
        *(float4*)(xo + i * 256 + lane * 4) = make_float4(xv[i][0], xv[i][1], xv[i][2], xv[i][3]);
      }
    }
    if (hasH) {
      float ss = 0.f;
#pragma unroll
      for (int i = 0; i < 4; ++i)
#pragma unroll
        for (int k = 0; k < 4; ++k) ss += xv[i][k] * xv[i][k];
      ss = wave_sum(ss, lane);
      const float rs = rsqrtf(ss * (1.f / 1024.f) + EPS);
      half_t* ho = H + (size_t)row * 1024;
#pragma unroll
      for (int i = 0; i < 4; ++i) {
        h4 o;
        o[0] = (half_t)(xv[i][0] * rs * gh[i].x * (1.f + s2[i].x) + s1[i].x);
        o[1] = (half_t)(xv[i][1] * rs * gh[i].y * (1.f + s2[i].y) + s1[i].y);
        o[2] = (half_t)(xv[i][2] * rs * gh[i].z * (1.f + s2[i].z) + s1[i].z);
        o[3] = (half_t)(xv[i][3] * rs * gh[i].w * (1.f + s2[i].w) + s1[i].w);
        *(h4*)(ho + i * 256 + lane * 4) = o;
      }
    }
  }
}

__device__ __forceinline__ int clampi(int v, int lo, int hi) { return v < lo ? lo : (v > hi ? hi : v); }

__device__ void attn_item(const P& p, int item, char* smem) {
  half_t* Ks = (half_t*)smem;
  half_t* Vt = Ks + 2 * 64 * 72;
  float* rpbs = (float*)(smem + 36864);
  const int tid = tidx(), lane = tid & 63, w = tid >> 6, lr = lane & 15, lq = lane >> 4;
  const half_t* U = (const half_t*)((p.ws + opaque_zero()) + OFF_U);
  half_t* Z = (half_t*)((p.ws + opaque_zero()) + OFF_Z);
  const bool isctx = item >= 2048;
  int b, h, qrow, nlat = 0, start0 = 0, my_r = 0, my_start = 0, cw = 0, cs = 0, qcol = 0;
  if (!isctx) {
    b = item >> 8; h = (item >> 5) & 7;
    const int r0 = (item & 31) * 2;
    my_r = r0 + (w >> 2);
    const int cgp = w & 3;
    qcol = cgp * 16 + lr;
    qrow = b * 4096 + my_r * 64 + qcol;
    start0 = clampi(r0 - 4, 0, 56);
    const int start1 = clampi(r0 + 1 - 4, 0, 56);
    nlat = start1 + 8 - start0;
    my_start = clampi(my_r - 4, 0, 56);
    cw = clampi(cgp * 16 - 8, 0, 32);
    cs = clampi(qcol - 8, 0, 48);
  } else {
    const int it = item - 2048;
    b = it >> 4; h = (it >> 1) & 7;
    qrow = RL + b * 256 + (it & 1) * 128 + w * 16 + lr;
  }
  const int ntiles = nlat + 4;
  h8 qf[2];
#pragma unroll
  for (int ks = 0; ks < 2; ++ks) {
    h8 t = *(const h8*)(U + (size_t)qrow * 2048 + 512 + h * 64 + ks * 32 + lq * 8);
#pragma unroll
    for (int i = 0; i < 8; ++i) t[i] = t[i] * (half_t)0.125f;
    qf[ks] = t;
  }
  if (!isctx)
    for (int i = tid; i < 465; i += 512) rpbs[i] = p.ev_rpb[h * 465 + i];

  const int skey = tid >> 3, sd = (tid & 7) * 8;
  uint4 kA, vA, kB, vB;
  auto tile_row0 = [&](int i) -> int { return i < nlat ? b * 4096 + (start0 + i) * 64 : RL + b * 256 + (i - nlat) * 64; };
  const half_t* VTg = (const half_t*)((p.ws + opaque_zero()) + OFF_A1);
#define AT_GLOAD(kr, vr, i)                                                                            \
  {                                                                                                    \
    const int r0t = tile_row0(i);                                                                      \
    kr = *(const uint4*)(U + (size_t)(r0t + skey) * 2048 + 1024 + h * 64 + sd);                        \
    vr = *(const uint4*)(VTg + ((size_t)(r0t >> 6) * 8 + h) * 4096 + skey * 64 + sd);                  \
  }
#define AT_SSTORE(kr, vr, buf)                                                                         \
  {                                                                                                    \
    *(uint4*)(Ks + (buf) * 4608 + skey * 72 + sd) = kr;                                                \
    *(uint4*)(Vt + (buf) * 4608 + skey * 72 + sd) = vr;                                                \
  }
  f4 o[4];
#pragma unroll
  for (int i = 0; i < 4; ++i) o[i] = (f4){0.f, 0.f, 0.f, 0.f};
  const float NEG = opaque_f(-1e30f);
  float m = NEG, l = 0.f;

  AT_GLOAD(kA, vA, 0);
  AT_SSTORE(kA, vA, 0);
  AT_GLOAD(kA, vA, 1);
  AT_GLOAD(kB, vB, 2);
  __syncthreads();
  auto compute_tile = [&](int i, int buf) {
    const bool lt = i < nlat;
    const int kr_abs = start0 + i;
    const bool active = !lt || (kr_abs >= my_start && kr_abs < my_start + 8);
    if (active) {
      const int npairs = lt ? 1 : 2;
      for (int pi = 0; pi < npairs; ++pi) {
        const int kb = lt ? cw : pi * 32;
        f4 s[2];
#pragma unroll
        for (int st = 0; st < 2; ++st) {
          f4 z = (f4){0.f, 0.f, 0.f, 0.f};
#pragma unroll
          for (int ks = 0; ks < 2; ++ks) {
            const h8 kf = *(const h8*)(Ks + buf * 4608 + (kb + st * 16 + lr) * 72 + ks * 32 + lq * 8);
            z = __builtin_amdgcn_mfma_f32_16x16x32_f16(kf, qf[ks], z, 0, 0, 0);
          }
          s[st] = z;
        }
        float tmax = NEG;
        if (lt) {
          const int dr = clampi(kr_abs - my_r + 7, 0, 14);
          float bias[2][4];
#pragma unroll
          for (int st = 0; st < 2; ++st)
#pragma unroll
            for (int j = 0; j < 4; ++j) {
              const int kc = kb + st * 16 + lq * 4 + j;
              bias[st][j] = rpbs[dr * 31 + clampi(kc - qcol + 15, 0, 30)];
            }
#pragma unroll
          for (int st = 0; st < 2; ++st)
#pragma unroll
            for (int j = 0; j < 4; ++j) {
              const int kc = kb + st * 16 + lq * 4 + j;
              const bool ok = (kc >= cs) && (kc < cs + 16);
              const float v = s[st][j] + bias[st][j];
              s[st][j] = ok ? v : NEG;
            }
        }
#pragma unroll
        for (int st = 0; st < 2; ++st)
#pragma unroll
          for (int j = 0; j < 4; ++j) tmax = fmaxf(tmax, s[st][j]);
        tmax = fmaxf(tmax, bperm(tmax, lane ^ 16));
        tmax = fmaxf(tmax, bperm(tmax, lane ^ 32));
        const float mn = fmaxf(m, tmax);
        const float alpha = __expf(m - mn);
        m = mn;
        h8 pb;
        float ps = 0.f;
#pragma unroll
        for (int st = 0; st < 2; ++st)
#pragma unroll
          for (int j = 0; j < 4; ++j) {
            const float e = __expf(s[st][j] - mn);
            ps += e;
            pb[st * 4 + j] = (half_t)e;
          }
        l = l * alpha + ps;
#pragma unroll
        for (int dt = 0; dt < 4; ++dt) {
          o[dt] = o[dt] * alpha;
          const half_t* vp = Vt + buf * 4608 + (dt * 16 + lr) * 72 + kb + lq * 4;
          const h4 v0 = *(const h4*)vp;
          const h4 v1 = *(const h4*)(vp + 16);
          h8 vf;
          vf[0] = v0[0]; vf[1] = v0[1]; vf[2] = v0[2]; vf[3] = v0[3];
          vf[4] = v1[0]; vf[5] = v1[1]; vf[6] = v1[2]; vf[7] = v1[3];
          o[dt] = __builtin_amdgcn_mfma_f32_16x16x32_f16(vf, pb, o[dt], 0, 0, 0);
        }
      }
    }
  };
#define AT_BARRIER()                                         \
  {                                                          \
    asm volatile("s_waitcnt lgkmcnt(0)" ::: "memory");       \
    __builtin_amdgcn_s_barrier();                            \
    asm volatile("" ::: "memory");                           \
  }
  for (int i = 0; i < ntiles; i += 2) {
    compute_tile(i, 0);
    if (i + 1 < ntiles) {
      AT_SSTORE(kA, vA, 1);
      if (i + 3 < ntiles) AT_GLOAD(kA, vA, i + 3);
    }
    AT_BARRIER();
    if (i + 1 >= ntiles) break;
    compute_tile(i + 1, 1);
    if (i + 2 < ntiles) {
      AT_SSTORE(kB, vB, 0);
      if (i + 4 < ntiles) AT_GLOAD(kB, vB, i + 4);
    }
    AT_BARRIER();
  }
#undef AT_BARRIER
#undef AT_GLOAD
#undef AT_SSTORE
  l += bperm(l, lane ^ 16);
  l += bperm(l, lane ^ 32);
  const float inv = 1.f / l;
#pragma unroll
  for (int dt = 0; dt < 4; ++dt) {
    h4 ov;
#pragma unroll
    for (int j = 0; j < 4; ++j) ov[j] = (half_t)(o[dt][j] * inv);
    *(h4*)(Z + (size_t)qrow * 1024 + 512 + h * 64 + dt * 16 + lq * 4) = ov;
  }
}

template <int HW>
__device__ __forceinline__ void pool_rows(const float (&pre)[4][25], int tl0, int L, half_t* zp) {
#pragma unroll
  for (int r = 0; r < 8; ++r) {
    const int tl = tl0 + r;
    const int lo = max(tl - HW, 0), hi = min(tl + HW, L);
    const float inv = 1.f / (float)(hi - lo);
    h4 o;
#pragma unroll
    for (int c = 0; c < 4; ++c) {
      const float sum = pre[c][8 + r + HW] - pre[c][8 + r - HW];
      const float cur = pre[c][8 + r + 1] - pre[c][8 + r];
      o[c] = (half_t)(sum * inv - cur);
    }
    *(h4*)(zp + (size_t)r * 1024) = o;
  }
}

__device__ void pool_item(const P& p, int item) {
  const half_t* U = (const half_t*)((p.ws + opaque_zero()) + OFF_U);
  half_t* Z = (half_t*)((p.ws + opaque_zero()) + OFF_Z);
  const int tid = tidx();
  const int c4 = (tid & 127) * 4, gi = c4 >> 7;
  const int row0 = item * 32 + (tid >> 7) * 8;
  int s0, L;
  if (row0 < RL) { s0 = row0 & ~4095; L = 4096; } else { s0 = RL + ((row0 - RL) & ~255); L = 256; }
  const int tl0 = row0 - s0;
  float pre[4][25];
#pragma unroll
  for (int c = 0; c < 4; ++c) pre[c][0] = 0.f;
#pragma unroll
  for (int i = 0; i < 24; ++i) {
    const int tl = tl0 - 8 + i;
    h4 v;
    v[0] = (half_t)0.f; v[1] = (half_t)0.f; v[2] = (half_t)0.f; v[3] = (half_t)0.f;
    if (tl >= 0 && tl < L) v = *(const h4*)(U + (size_t)(s0 + tl) * 2048 + c4);
#pragma unroll
    for (int c = 0; c < 4; ++c) pre[c][i + 1] = (float)v[c];
  }
#pragma unroll
  for (int i = 0; i < 24; ++i)
#pragma unroll
    for (int c = 0; c < 4; ++c) pre[c][i + 1] += pre[c][i];
  half_t* zp = Z + (size_t)row0 * 1024 + c4;
  if (gi == 0) pool_rows<1>(pre, tl0, L, zp);
  else if (gi == 1) pool_rows<2>(pre, tl0, L, zp);
  else if (gi == 2) pool_rows<4>(pre, tl0, L, zp);
  else pool_rows<8>(pre, tl0, L, zp);
}

__device__ void phase_shift(const P& p) {
  const half_t* H = (const half_t*)((p.ws + opaque_zero()) + OFF_A0);
  half_t* XX = (half_t*)((p.ws + opaque_zero()) + OFF_A1);
  const size_t total = (size_t)RT * 128;
  for (size_t idx = (size_t)bidx() * 512 + tidx(); idx < total; idx += (size_t)gridDim.x * 512) {
    const int row = (int)(idx >> 7), c = (int)(idx & 127) * 8;
    bool st, en;
    if (row < RL) { st = (row & 4095) == 0; en = (row & 4095) == 4095; }
    else { st = ((row - RL) & 255) == 0; en = ((row - RL) & 255) == 255; }
    const h8 cur = *(const h8*)(H + (size_t)row * 1024 + c);
    h8 pv, nx;
#pragma unroll
    for (int i = 0; i < 8; ++i) { pv[i] = (half_t)0.f; nx[i] = (half_t)0.f; }
    if (!st) pv = *(const h8*)(H + (size_t)(row - 1) * 1024 + c);
    if (!en) nx = *(const h8*)(H + (size_t)(row + 1) * 1024 + c);
    h8 o;
#pragma unroll
    for (int i = 0; i < 8; ++i) o[i] = (half_t)(0.5f * ((float)pv[i] + (float)nx[i]) - (float)cur[i]);
    *(h8*)(XX + (size_t)row * 1024 + c) = o;
  }
}

#define CS_BYTES 13312
#define CS_G 0
#define CS_R 2304
#define CS_AT 4608
#define CS_BT 6656
#define CS_VT 8704
#define CS_M 10752
#define CS_BM 11264
#define CS_CM 11776
#define CS_DM 12288
#define CS_PREF 12800
#define CS_PEND 13056
#define SCR_BASE 106496
#define SCR_BYTES 5632

__device__ void scan_item(const P& p, int item, char* smem) {
  const int tid = tidx(), lane = tid & 63, w = tid >> 6, lr = lane & 15, lq = lane >> 4;
  const int b = item >> 5, h = (item >> 1) & 15, dir = item & 1;
  char* ws = (p.ws + opaque_zero());
  const half_t* RRp = (const half_t*)(ws + OFF_RR);
  const half_t* KKp = (const half_t*)(ws + OFF_KK);
  const half_t* VVp = (const half_t*)(ws + OFF_VV);
  const half_t* Lp = (const half_t*)(ws + OFF_L);
  half_t* Yd = (half_t*)(ws + (dir ? OFF_A1 : OFF_A0));
  float* BN = (float*)(ws + OFF_BN) + (size_t)dir * RL * 16;

  auto grow = [&](int pp) -> int {
    if (pp < 256) return RL + b * 256 + (dir ? 255 - pp : pp);
    const int t = pp - 256;
    return b * 4096 + (dir ? 4095 - t : t);
  };

  auto prep = [&](int c) {
    char* cs = smem + w * CS_BYTES;
    half_t* G_ = (half_t*)(cs + CS_G);
    half_t* R_ = (half_t*)(cs + CS_R);
    half_t* AT = (half_t*)(cs + CS_AT);
    half_t* BT = (half_t*)(cs + CS_BT);
    half_t* VT = (half_t*)(cs + CS_VT);
    half_t* Mm = (half_t*)(cs + CS_M);
    half_t* Bm = (half_t*)(cs + CS_BM);
    half_t* Cm = (half_t*)(cs + CS_CM);
    half_t* Dm = (half_t*)(cs + CS_DM);
    float* Pref = (float*)(cs + CS_PREF);
    float* Pend = (float*)(cs + CS_PEND);
    char* scr = smem + SCR_BASE + w * SCR_BYTES;
    half_t* A_ = (half_t*)scr;
    half_t* B_ = (half_t*)(scr + 2304);
    float* Am = (float*)(scr + 4608);
    const bool lat = c >= 16;
    const int p0 = c * 16;
    const int rowA = grow(p0 + lr);
    const half_t* lp = Lp + (size_t)rowA * 384 + dir * 64 + lq * 8;
    const h8 aw0 = *(const h8*)(lp), aw1 = *(const h8*)(lp + 32);
    const h8 aa0 = *(const h8*)(lp + 128), aa1 = *(const h8*)(lp + 160);
    float ss[4], bp[4];
    int rows[4];
#pragma unroll
    for (int j = 0; j < 4; ++j) { ss[j] = 0.f; bp[j] = 0.f; rows[j] = grow(p0 + lq * 4 + j); }
#pragma unroll
    for (int nt = 0; nt < 4; ++nt) {
      const int ch = h * 64 + nt * 16 + lr;
      const float kkc = p.rw_kk[ch];
#pragma unroll
      for (int j = 0; j < 4; ++j) {
        const float k = (float)KKp[(size_t)rows[j] * 1024 + ch];
        ss[j] += (k * kkc) * (k * kkc);
      }
    }
    float inv[4];
#pragma unroll
    for (int j = 0; j < 4; ++j) inv[j] = rsqrtf(fmaxf(red16(ss[j]), 1e-24f));
#pragma unroll 1
    for (int nt = 0; nt < 4; ++nt) {
      const int ch = h * 64 + nt * 16 + lr;
      const half_t* w2p = (const half_t*)(ws + OFF_W2) + (size_t)dir * 65536 + (size_t)ch * 64 + lq * 8;
      const half_t* a2p = (const half_t*)(ws + OFF_A2) + (size_t)dir * 65536 + (size_t)ch * 64 + lq * 8;
      const h8 bw0 = *(const h8*)(w2p), bw1 = *(const h8*)(w2p + 32);
      const h8 ba0 = *(const h8*)(a2p), ba1 = *(const h8*)(a2p + 32);
      const float w0c = p.rw_w0[dir * 1024 + ch], a0c = p.rw_a0[dir * 1024 + ch];
      const float kkc = p.rw_kk[ch], kac = p.rw_ka[ch], rkc = p.rw_rk[ch];
      f4 cwv = (f4){0.f, 0.f, 0.f, 0.f}, cav = (f4){0.f, 0.f, 0.f, 0.f};
      cwv = __builtin_amdgcn_mfma_f32_16x16x32_f16(aw0, bw0, cwv, 0, 0, 0);
      cwv = __builtin_amdgcn_mfma_f32_16x16x32_f16(aw1, bw1, cwv, 0, 0, 0);
      cav = __builtin_amdgcn_mfma_f32_16x16x32_f16(aa0, ba0, cav, 0, 0, 0);
      cav = __builtin_amdgcn_mfma_f32_16x16x32_f16(aa1, ba1, cav, 0, 0, 0);
      h4 vq;
      float ev[4], avv[4], rv[4], kv[4];
#pragma unroll
      for (int j = 0; j < 4; ++j) {
        const size_t gi = (size_t)rows[j] * 1024 + ch;
        kv[j] = (float)KKp[gi];
        vq[j] = VVp[gi];
        rv[j] = lat ? (float)RRp[gi] : 0.f;
        ev[j] = 0.60653066f * sigm(cwv[j] + w0c);
        avv[j] = sigm(cav[j] + a0c);
        bp[j] += rv[j] * kv[j] * rkc * (dir == 0 ? (2.f - 2.f * kac + kac * avv[j]) : kac * avv[j]);
      }
      *(h4*)(VT + (nt * 16 + lr) * 16 + lq * 4) = vq;
      float cum[4];
      cum[0] = ev[0];
      cum[1] = cum[0] + ev[1];
      cum[2] = cum[1] + ev[2];
      cum[3] = cum[2] + ev[3];
      const float t1 = bperm(cum[3], (lane - 16) & 63), t2 = bperm(cum[3], (lane - 32) & 63), t3 = bperm(cum[3], (lane - 48) & 63);
      const float off = (lq >= 1 ? t1 : 0.f) + (lq >= 2 ? t2 : 0.f) + (lq >= 3 ? t3 : 0.f);
#pragma unroll
      for (int j = 0; j < 4; ++j) cum[j] += off;
      const float ref = bperm(cum[3], 16 + lr);
      const float end = bperm(cum[3], 48 + lr);
      if (lq == 0) {
        Pref[nt * 16 + lr] = __expf(-ref);
        Pend[nt * 16 + lr] = __expf(-(end - ref));
      }
      h4 aq, bq;
#pragma unroll
      for (int j = 0; j < 4; ++j) {
        const float d = cum[j] - ref;
        const float E1 = __expf(d), E2 = __expf(-d), E3 = __expf(ev[j] - d);
        const float k = kv[j];
        const float kk = k * kkc * inv[j];
        const float kd = k * (1.f + (avv[j] - 1.f) * kac);
        const half_t ga = (half_t)(kk * E3);
        const half_t ro = (half_t)(rv[j] * E2);
        const half_t al = (half_t)(kk * avv[j] * E1);
        const half_t be = (half_t)(kd * E1);
        const int o = (lq * 4 + j) * 72 + nt * 16 + lr;
        G_[o] = ga; R_[o] = ro; A_[o] = al; B_[o] = be;
        aq[j] = al; bq[j] = be;
      }
      *(h4*)(AT + (nt * 16 + lr) * 16 + lq * 4) = aq;
      *(h4*)(BT + (nt * 16 + lr) * 16 + lq * 4) = bq;
    }
#pragma unroll
    for (int j = 0; j < 4; ++j) {
      const float bpr = red16(bp[j]);
      if (lat && lr == 0) BN[(size_t)rows[j] * 16 + h] = bpr;
    }
    asm volatile("s_waitcnt lgkmcnt(0)" ::: "memory");
    f4 am = (f4){0.f, 0.f, 0.f, 0.f}, bm = am, cm = am, dm = am;
#pragma unroll
    for (int ks = 0; ks < 2; ++ks) {
      const h8 fa = *(const h8*)(A_ + lr * 72 + ks * 32 + lq * 8);
      const h8 fb = *(const h8*)(B_ + lr * 72 + ks * 32 + lq * 8);
      const h8 fg = *(const h8*)(G_ + lr * 72 + ks * 32 + lq * 8);
      const h8 fr = *(const h8*)(R_ + lr * 72 + ks * 32 + lq * 8);
      am = __builtin_amdgcn_mfma_f32_16x16x32_f16(fa, fg, am, 0, 0, 0);
      bm = __builtin_amdgcn_mfma_f32_16x16x32_f16(fb, fg, bm, 0, 0, 0);
      cm = __builtin_amdgcn_mfma_f32_16x16x32_f16(fa, fr, cm, 0, 0, 0);
      dm = __builtin_amdgcn_mfma_f32_16x16x32_f16(fb, fr, dm, 0, 0, 0);
    }
    h4 bmh, cmh, dmh;
#pragma unroll
    for (int j = 0; j < 4; ++j) {
      const int u = lq * 4 + j;
      am[j] = u < lr ? am[j] : 0.f;
      bmh[j] = (half_t)(u < lr ? bm[j] : 0.f);
      cmh[j] = (half_t)(u <= lr ? cm[j] : 0.f);
      dmh[j] = (half_t)(u <= lr ? dm[j] : 0.f);
    }
    *(h4*)(Bm + lr * 16 + lq * 4) = bmh;
    *(h4*)(Cm + lr * 16 + lq * 4) = cmh;
    *(h4*)(Dm + lr * 16 + lq * 4) = dmh;
    *(f4*)(Am + lr * 16 + lq * 4) = am;
    asm volatile("s_waitcnt lgkmcnt(0)" ::: "memory");
    float m[16];
#pragma unroll
    for (int t = 0; t < 16; ++t) {
      float acc = (t == lr) ? 1.f : 0.f;
#pragma unroll
      for (int u4 = 0; u4 < 4; ++u4) {
        if (u4 * 4 < t) {
          const f4 rw = *(const f4*)(Am + t * 16 + u4 * 4);
#pragma unroll
          for (int k = 0; k < 4; ++k)
            if (u4 * 4 + k < t) acc -= rw[k] * m[u4 * 4 + k];
        }
      }
      m[t] = acc;
    }
    if (lq == 0) {
#pragma unroll
      for (int t = 0; t < 16; ++t) Mm[t * 16 + lr] = (half_t)m[t];
    }
  };

  f4 Sacc[4];
#pragma unroll
  for (int jt = 0; jt < 4; ++jt) Sacc[jt] = (f4){0.f, 0.f, 0.f, 0.f};

  for (int sc = 0; sc < 34; ++sc) {
    prep(sc * 8 + w);
    __syncthreads();
    if (w < 4) {
      for (int cc = 0; cc < 8; ++cc) {
        const int c = sc * 8 + cc;
        const char* cs = smem + cc * CS_BYTES;
        const half_t* G_ = (const half_t*)(cs + CS_G);
        const half_t* R_ = (const half_t*)(cs + CS_R);
        const half_t* AT = (const half_t*)(cs + CS_AT);
        const half_t* BT = (const half_t*)(cs + CS_BT);
        const half_t* VT = (const half_t*)(cs + CS_VT);
        const half_t* Mm = (const half_t*)(cs + CS_M);
        const half_t* Bm = (const half_t*)(cs + CS_BM);
        const half_t* Cm = (const half_t*)(cs + CS_CM);
        const half_t* Dm = (const half_t*)(cs + CS_DM);
        const float* Pref = (const float*)(cs + CS_PREF);
        const float* Pend = (const float*)(cs + CS_PEND);
#pragma unroll
        for (int jt = 0; jt < 4; ++jt) Sacc[jt] = Sacc[jt] * *(const f4*)(Pref + jt * 16 + lq * 4);
        h8 bS[2];
#pragma unroll
        for (int ks = 0; ks < 2; ++ks)
#pragma unroll
          for (int k = 0; k < 4; ++k) {
            bS[ks][k] = (half_t)Sacc[2 * ks][k];
            bS[ks][4 + k] = (half_t)Sacc[2 * ks + 1][k];
          }
        const h4 vt = *(const h4*)(VT + (16 * w + lr) * 16 + lq * 4);
        f4 rhs = (f4){0.f, 0.f, 0.f, 0.f};
#pragma unroll
        for (int ks = 0; ks < 2; ++ks) {
          const h4 g0 = *(const h4*)(G_ + lr * 72 + (2 * ks) * 16 + lq * 4);
          const h4 g1 = *(const h4*)(G_ + lr * 72 + (2 * ks + 1) * 16 + lq * 4);
          h8 gf;
          gf[0] = g0[0]; gf[1] = g0[1]; gf[2] = g0[2]; gf[3] = g0[3];
          gf[4] = g1[0]; gf[5] = g1[1]; gf[6] = g1[2]; gf[7] = g1[3];
          rhs = __builtin_amdgcn_mfma_f32_16x16x32_f16(gf, bS[ks], rhs, 0, 0, 0);
        }
        {
          f4 r16 = (f4){0.f, 0.f, 0.f, 0.f};
          r16 = __builtin_amdgcn_mfma_f32_16x16x16f16(*(const h4*)(Bm + lr * 16 + lq * 4), vt, r16, 0, 0, 0);
          rhs = rhs + r16;
        }
        h4 rh;
#pragma unroll
        for (int k = 0; k < 4; ++k) rh[k] = (half_t)rhs[k];
        f4 av = (f4){0.f, 0.f, 0.f, 0.f};
        av = __builtin_amdgcn_mfma_f32_16x16x16f16(*(const h4*)(Mm + lr * 16 + lq * 4), rh, av, 0, 0, 0);
        h4 na;
#pragma unroll
        for (int k = 0; k < 4; ++k) na[k] = (half_t)(-av[k]);
        if (c >= 16) {
          f4 y = (f4){0.f, 0.f, 0.f, 0.f};
#pragma unroll
          for (int ks = 0; ks < 2; ++ks) {
            const h4 g0 = *(const h4*)(R_ + lr * 72 + (2 * ks) * 16 + lq * 4);
            const h4 g1 = *(const h4*)(R_ + lr * 72 + (2 * ks + 1) * 16 + lq * 4);
            h8 gf;
            gf[0] = g0[0]; gf[1] = g0[1]; gf[2] = g0[2]; gf[3] = g0[3];
            gf[4] = g1[0]; gf[5] = g1[1]; gf[6] = g1[2]; gf[7] = g1[3];
            y = __builtin_amdgcn_mfma_f32_16x16x32_f16(gf, bS[ks], y, 0, 0, 0);
          }
          f4 y16 = (f4){0.f, 0.f, 0.f, 0.f};
          y16 = __builtin_amdgcn_mfma_f32_16x16x16f16(*(const h4*)(Cm + lr * 16 + lq * 4), na, y16, 0, 0, 0);
          y16 = __builtin_amdgcn_mfma_f32_16x16x16f16(*(const h4*)(Dm + lr * 16 + lq * 4), vt, y16, 0, 0, 0);
          y = y + y16;
#pragma unroll
          for (int k = 0; k < 4; ++k) {
            const int row = grow(c * 16 + lq * 4 + k);
            Yd[(size_t)row * 1024 + h * 64 + 16 * w + lr] = (half_t)y[k];
          }
        }
#pragma unroll
        for (int jt = 0; jt < 4; ++jt) {
          Sacc[jt] = __builtin_amdgcn_mfma_f32_16x16x16f16(*(const h4*)(AT + (jt * 16 + lr) * 16 + lq * 4), na, Sacc[jt], 0, 0, 0);
          Sacc[jt] = __builtin_amdgcn_mfma_f32_16x16x16f16(*(const h4*)(BT + (jt * 16 + lr) * 16 + lq * 4), vt, Sacc[jt], 0, 0, 0);
          Sacc[jt] = Sacc[jt] * *(const f4*)(Pend + jt * 16 + lq * 4);
        }
      }
    }
    __syncthreads();
  }
}

__device__ void phase_readout(const P& p) {
  const int lane = tidx() & 63;
  const int gw = bidx() * 8 + (tidx() >> 6), stride = gridDim.x * 8;
  char* ws = (p.ws + opaque_zero());
  const half_t* Y0 = (const half_t*)(ws + OFF_A0);
  const half_t* Y1 = (const half_t*)(ws + OFF_A1);
  const half_t* VVp = (const half_t*)(ws + OFF_VV);
  const half_t* Gp = (const half_t*)(ws + OFF_G);
  const float* BN0 = (const float*)(ws + OFF_BN);
  const float* BN1 = BN0 + (size_t)RL * 16;
  half_t* Z1 = (half_t*)(ws + OFF_Z1);
  const int c0 = lane * 16, head = lane >> 2;
  for (int row = gw; row < RL; row += stride) {
    const size_t o = (size_t)row * 1024 + c0;
    float y[16], vv[16], gg[16];
#pragma unroll
    for (int hh = 0; hh < 2; ++hh) {
      const h8 a = *(const h8*)(Y0 + o + hh * 8);
      const h8 bq = *(const h8*)(Y1 + o + hh * 8);
      const h8 v = *(const h8*)(VVp + o + hh * 8);
      const h8 g = *(const h8*)(Gp + o + hh * 8);
#pragma unroll
      for (int i = 0; i < 8; ++i) {
        y[hh * 8 + i] = (float)a[i] + (float)bq[i];
        vv[hh * 8 + i] = (float)v[i];
        gg[hh * 8 + i] = (float)g[i];
      }
    }
    float s = 0.f;
#pragma unroll
    for (int i = 0; i < 16; ++i) s += y[i];
    s = red4(s);
    const float mean = s * (1.f / 64.f);
    float q = 0.f;
#pragma unroll
    for (int i = 0; i < 16; ++i) { const float d = y[i] - mean; q += d * d; }
    q = red4(q);
    const float rstd = rsqrtf(q * (1.f / 64.f) + 64e-5f);
    const float bonus = BN0[(size_t)row * 16 + head] + BN1[(size_t)row * 16 + head];
    h8 o0, o1;
#pragma unroll
    for (int i = 0; i < 16; ++i) {
      const float lg = p.rw_lng[c0 + i], lb = p.rw_lnb[c0 + i];
      const float r = ((y[i] - mean) * rstd * lg + lb + bonus * vv[i]) * gg[i];
      if (i < 8) o0[i] = (half_t)r; else o1[i - 8] = (half_t)r;
    }
    *(h8*)(Z1 + o) = o0;
    *(h8*)(Z1 + o + 8) = o1;
  }
}

#define XB_TMO      128
#define XB_XCNT(j)  (256  + 64 * (j))
#define XB_XSUB(j)  (1280 + 64 * (j))
#define XB_XGEN(j)  (2304 + 64 * (j))
#define XB_TOP      3328
#define XB_TOPGEN   3392
#define XCD_BAR_WORDS 3456
#define XB_SPIN_CAP (1u << 18)
#define LAS __attribute__((address_space(3)))
__device__ __forceinline__ unsigned xb_ld(unsigned* q) { return __hip_atomic_load(q, __ATOMIC_RELAXED, __HIP_MEMORY_SCOPE_AGENT); }
__device__ __forceinline__ unsigned xb_add(unsigned* q, unsigned v) { return __hip_atomic_fetch_add(q, v, __ATOMIC_RELAXED, __HIP_MEMORY_SCOPE_AGENT); }
__device__ __forceinline__ unsigned xb_xcc_id() { return (unsigned)__builtin_amdgcn_s_getreg((3 << 11) | 20) & 0xFu; }
#define XB_SPIN(cond, bar) do { unsigned _sp = 0; while (cond) { __builtin_amdgcn_s_sleep(1); \
    if ((++_sp & 255u) == 0u) { if (xb_ld(&(bar)[XB_TMO])) break; if (_sp > XB_SPIN_CAP) { atomicAdd(&(bar)[XB_TMO], 1u); break; } } } } while (0)
__device__ __forceinline__ void xcd_barrier_complete(unsigned* bar, unsigned x, unsigned& nloc, unsigned& nx) {
  const unsigned G = gridDim.x;
  unsigned sum, cnt, mine, sp = 0u;
  for (;;) {
    sum = 0u; cnt = 0u; mine = 0u;
#pragma unroll
    for (unsigned j = 0; j < 16; ++j) { const unsigned c = xb_ld(&bar[XB_XCNT(j)]); sum += c; cnt += (c > 0u) ? 1u : 0u; mine = (j == x) ? c : mine; }
    if (sum == G) break;
    __builtin_amdgcn_s_sleep(1);
    if ((++sp & 255u) == 0u) { if (xb_ld(&bar[XB_TMO])) break; if (sp > XB_SPIN_CAP) { atomicAdd(&bar[XB_TMO], 1u); break; } }
  }
  nloc = mine > 0u ? mine : 1u; nx = cnt > 0u ? cnt : 1u;
}
__device__ __forceinline__ void xcd_barrier(unsigned* bar, volatile LAS unsigned* st) {
  asm volatile("s_waitcnt vmcnt(0)" ::: "memory");
  __syncthreads();
  if (tidx() == 0) {
    __builtin_amdgcn_s_waitcnt(0);
    const unsigned x = xb_xcc_id();
    unsigned nloc = st[0], nx = st[1];
    if (nloc == 0u) { xcd_barrier_complete(bar, x, nloc, nx); st[0] = nloc; st[1] = nx; }
    const unsigned old = xb_add(&bar[XB_XSUB(x)], 1u);
    const unsigned gen = old / nloc;
    if (old + 1u == (gen + 1u) * nloc) {
      __builtin_amdgcn_fence(__ATOMIC_RELEASE, "agent");
      asm volatile("s_waitcnt vmcnt(0)" ::: "memory");
      const unsigned og = xb_add(&bar[XB_TOP], 1u);
      const unsigned tg = og / nx;
      if (og + 1u == (tg + 1u) * nx) xb_add(&bar[XB_TOPGEN], 1u);
      else XB_SPIN(xb_ld(&bar[XB_TOPGEN]) == tg, bar);
      __builtin_amdgcn_fence(__ATOMIC_ACQUIRE, "agent");
      xb_add(&bar[XB_XGEN(x)], 1u);
      asm volatile("s_waitcnt vmcnt(0)" ::: "memory");
    } else {
      XB_SPIN(xb_ld(&bar[XB_XGEN(x)]) == gen, bar);
      __builtin_amdgcn_fence(__ATOMIC_ACQUIRE, "agent");
      asm volatile("s_waitcnt vmcnt(0)" ::: "memory");
    }
  }
  __syncthreads();
}

#define NPHASE 18
__global__ void __launch_bounds__(512) mega(P p_in, int ph_lo, int ph_hi) {
  __shared__ __attribute__((aligned(16))) char smem[SMEM_BYTES];
  cg::grid_group grid = cg::this_grid();
  __shared__ uint4 xb_words;
  if (tidx() == 0) {
    xb_words = make_uint4(0u, 0u, 0u, 0u);
    (void)xb_add(&((unsigned*)(p_in.ws + OFF_XBAR))[XB_XCNT(xb_xcc_id())], 1u);
  }
  __syncthreads();
  const P& p = p_in;
  for (int ph = ph_lo; ph < ph_hi; ++ph) {
    char* ws = p_in.ws + opaque_zero();
    int kind = 2, arg = 0;
    size_t oA = 0, oB = 0, oC = 0;
    int lda = 1024, ldb = 1024, K = 1024, ldc = 1024, epi = 0, nMt = 136, nNt = 8, feat = 0;
    switch (ph) {
      case 0: kind = 0; break;
      case 1: kind = 1; arg = 0; break;
      case 2: oA = OFF_A0; oB = OFF_WIN; oC = OFF_U; ldc = 2048; nNt = 8; feat = 2; break;
      case 3: kind = 3; break;
      case 4: oA = OFF_Z; oB = OFF_WOUT; oC = OFF_A1; nNt = 4; feat = 3; break;
      case 5: kind = 1; arg = 1; break;
      case 6: oA = OFF_A0; oB = OFF_M1; oC = OFF_F; ldc = 4096; nNt = 16; epi = 1; feat = 3; break;
      case 7: oA = OFF_F; lda = 4096; oB = OFF_M2; ldb = 4096; K = 4096; oC = OFF_A1; nNt = 4; feat = 3; break;
      case 8: kind = 1; arg = 2; break;
      case 9: kind = 4; break;
      case 10: oA = OFF_A0; oB = OFF_WR; oC = OFF_RR; nNt = 27; feat = 1; break;
      case 11: kind = 5; break;
      case 12: oA = OFF_L + 512; lda = 384; oB = OFF_G2; ldb = 128; K = 128; oC = OFF_Z1; nMt = 128; epi = 5; break;
      case 13: oA = OFF_Z1; oB = OFF_WO; oC = OFF_A1; nMt = 128; nNt = 4; feat = 3; break;
      case 14: kind = 1; arg = 3; break;
      case 15: oA = OFF_A0; oB = OFF_M1 + 8 * MIB; oC = OFF_F; ldc = 4096; nNt = 16; epi = 1; nMt = 128; feat = 3; break;
      case 16: oA = OFF_F; lda = 4096; oB = OFF_M2 + 8 * MIB; ldb = 4096; K = 4096; oC = OFF_A1; nMt = 128; nNt = 4; feat = 3; break;
      default: kind = 1; arg = 4; break;
    }
    if (kind == 2) {
      gemm_phase(p, (const half_t*)(ws + oA), lda, (const half_t*)(ws + oB), ldb, K, (half_t*)(ws + oC), ldc, epi, nMt, nNt, feat, smem);
    } else if (kind == 1) {
      phase_rowwise(p, arg);
    } else if (kind == 0) {
      phase_prep(p, smem);
    } else if (kind == 3) {
      for (int it = bidx(); it < 2176 + 1088; it += gridDim.x) {
        if (it < 2176) attn_item(p, it, smem); else pool_item(p, it - 2176);
      }
    } else if (kind == 4) {
      phase_shift(p);
    } else if (kind == 5) {
      for (int it = bidx(); it < 256; it += gridDim.x) scan_item(p, it, smem);
    } else {
      phase_readout(p);
    }
    if (ph + 1 < ph_hi) {
      if (ph == ph_lo) grid.sync();
      else xcd_barrier((unsigned*)(p.ws + opaque_zero() + OFF_XBAR), (volatile LAS unsigned*)&xb_words);
    }
  }
}

extern "C" void kernel_launch(void* const* d_in, const int* in_sizes, int n_in, void* d_out, int out_size, void* d_ws,
                              size_t ws_size, hipStream_t stream) {
  P p{};
  const float** pp = (const float**)&p;
  for (int i = 0; i < 32; ++i) pp[i] = (const float*)d_in[i];
  p.out = (float*)d_out;
  p.ws = (char*)d_ws;
  static int grid_blocks = 0;
  if (!grid_blocks) {
    int dev = 0, cus = 0, per_cu = 0;
    (void)hipGetDevice(&dev);
    (void)hipDeviceGetAttribute(&cus, hipDeviceAttributeMultiprocessorCount, dev);
    (void)hipOccupancyMaxActiveBlocksPerMultiprocessor(&per_cu, mega, 512, 0);
    if (per_cu < 1) per_cu = 1;
    grid_blocks = cus * per_cu;
  }
  (void)hipMemsetAsync((char*)d_ws + OFF_XBAR, 0, XCD_BAR_WORDS * sizeof(unsigned), stream);
  int lo = 0, hi = NPHASE;
  void* args[] = {&p, &lo, &hi};
  hipError_t e = hipLaunchCooperativeKernel((void*)mega, dim3(grid_blocks), dim3(512), args, 0, stream);
  if (e != hipSuccess) fprintf(stderr, "cooperative launch failed: %s (grid %d)\n", hipGetErrorString(e), grid_blocks);
}
```

```cpp
#include <hip/hip_runtime.h>
#include <hip/hip_cooperative_groups.h>
#include <cstdio>
namespace cg = cooperative_groups;

typedef _Float16 half_t;
typedef _Float16 h8 __attribute__((ext_vector_type(8)));
typedef _Float16 h4 __attribute__((ext_vector_type(4)));
typedef _Float16 h2 __attribute__((ext_vector_type(2)));
typedef float f4 __attribute__((ext_vector_type(4)));

#define RL 32768
#define RC 2048
#define RT 34816
#define MIB (1ull << 20)
#define OFF_WIN (0 * MIB)
#define OFF_WOUT (4 * MIB)
#define OFF_M1 (7 * MIB)
#define OFF_M2 (23 * MIB)
#define OFF_WR (39 * MIB)
#define OFF_WK (41 * MIB)
#define OFF_WV (43 * MIB)
#define OFF_WO (45 * MIB)
#define OFF_L1 (47 * MIB)
#define OFF_W2 (48 * MIB)
#define OFF_A2 (48 * MIB + 256 * 1024)
#define OFF_G2 (48 * MIB + 512 * 1024)
#define OFF_MOD (49 * MIB)
#define OFF_XBAR (49 * MIB + 768 * 1024)
#define OFF_BN (50 * MIB)
#define OFF_XC (54 * MIB)
#define OFF_A0 (62 * MIB)
#define OFF_A1 (130 * MIB)
#define OFF_BIG (198 * MIB)
#define OFF_U OFF_BIG
#define OFF_Z (334 * MIB)
#define OFF_F OFF_BIG
#define OFF_RR OFF_BIG
#define OFF_KK (266 * MIB)
#define OFF_VV (334 * MIB)
#define OFF_L (402 * MIB)
#define OFF_G OFF_BIG
#define OFF_Z1 (266 * MIB)

#define SMEM_BYTES 151552

struct P {
  const float *x, *c, *ctx, *c_ctx, *ada_w, *ada_b, *norm_g, *mlp_w1, *mlp_w2, *ev_w_in, *ev_w_out, *ev_pool_w,
      *ev_pool_scale, *ev_rpb, *rw_mu, *rw_wr, *rw_wk, *rw_wv, *rw_wo, *rw_w0, *rw_w1, *rw_w2, *rw_a0, *rw_a1, *rw_a2,
      *rw_g1, *rw_g2, *rw_kk, *rw_ka, *rw_rk, *rw_lng, *rw_lnb;
  float* out;
  char* ws;
};

__device__ __forceinline__ int tidx() { int v = threadIdx.x; asm volatile("" : "+v"(v)); return v; }
__device__ __forceinline__ int bidx() { int v = blockIdx.x; asm volatile("" : "+s"(v)); return v; }
__device__ __forceinline__ size_t opaque_zero() { size_t z = 0; asm volatile("" : "+s"(z)); return z; }
__device__ __forceinline__ float opaque_f(float v) { asm volatile("" : "+v"(v)); return v; }
__device__ __forceinline__ float sigm(float x) { return 1.f / (1.f + __expf(-x)); }
__device__ __forceinline__ float bperm(float v, int srclane) {
  return __builtin_bit_cast(float, __builtin_amdgcn_ds_bpermute(srclane << 2, __builtin_bit_cast(int, v)));
}
template <int CTRL>
__device__ __forceinline__ float dpp(float x) {
  return __builtin_bit_cast(float, __builtin_amdgcn_mov_dpp(__builtin_bit_cast(int, x), CTRL, 0xf, 0xf, true));
}
__device__ __forceinline__ float red4(float x) { x += dpp<0xB1>(x); x += dpp<0x4E>(x); return x; }
__device__ __forceinline__ float red8(float x) { x = red4(x); x += dpp<0x141>(x); return x; }
__device__ __forceinline__ float red16(float x) { x = red8(x); x += dpp<0x140>(x); return x; }
__device__ __forceinline__ float wave_sum(float v, int lane) {
  v = red16(v);
  v += bperm(v, lane ^ 16);
  v += bperm(v, lane ^ 32);
  return v;
}

struct GemmTile {
  const half_t* A; const half_t* A2; const float* mu; int lda;
  const half_t* Bt; int ldb; int K;
  half_t* C; int ldc; int epi;
  int row0, col0;
  const P* pp;
};

template <bool MIX>
__device__ __forceinline__ void gemm_tile(const GemmTile& g, char* smem) {
  half_t* As = (half_t*)smem;
  half_t* Bs = (half_t*)(smem + 73728);
  const int tid = tidx(), lane = tid & 63, w = tid >> 6;
  const int wm = w >> 1, wn = w & 1, lr = lane & 15, lq = lane >> 4;
  const int ldr = tid >> 3, ldk = (tid & 7) * 8;
  f4 acc[4][4];
#pragma unroll
  for (int i = 0; i < 4; ++i)
#pragma unroll
    for (int j = 0; j < 4; ++j) acc[i][j] = (f4){0.f, 0.f, 0.f, 0.f};
  uint4 ra0, ra1, ra2, ra3, rb0, rb1;
  uint4 rx0, rx1, rx2, rx3;
  float4 mu0, mu1;
  const int nk = g.K >> 6;
  const half_t* Ap = g.A + (size_t)ldr * g.lda + ldk;
  const half_t* A2p = MIX ? g.A2 + (size_t)ldr * g.lda + ldk : nullptr;
  const float* mup = MIX ? g.mu + ldk : nullptr;
  const half_t* Bp = g.Bt + (size_t)ldr * g.ldb + ldk;
  const size_t astep = (size_t)64 * g.lda, bstep = (size_t)64 * g.ldb;
  half_t* asw = As + ldr * 72 + ldk;
  half_t* bsw = Bs + ldr * 72 + ldk;
  const half_t* asr = As + (wm * 64 + lr) * 72 + lq * 8;
  const half_t* bsr = Bs + (wn * 64 + lr) * 72 + lq * 8;

#define GLOAD(kt)                                              \
  {                                                            \
    const int k0 = (kt) * 64;                                  \
    ra0 = *(const uint4*)(Ap + k0);                            \
    ra1 = *(const uint4*)(Ap + astep + k0);                    \
    ra2 = *(const uint4*)(Ap + 2 * astep + k0);                \
    ra3 = *(const uint4*)(Ap + 3 * astep + k0);                \
    rb0 = *(const uint4*)(Bp + k0);                            \
    rb1 = *(const uint4*)(Bp + bstep + k0);                    \
    if (MIX) {                                                 \
      rx0 = *(const uint4*)(A2p + k0);                         \
      rx1 = *(const uint4*)(A2p + astep + k0);                 \
      rx2 = *(const uint4*)(A2p + 2 * astep + k0);             \
      rx3 = *(const uint4*)(A2p + 3 * astep + k0);             \
      mu0 = *(const float4*)(mup + k0);                        \
      mu1 = *(const float4*)(mup + k0 + 4);                    \
    }                                                          \
  }
#define MIXV(r, x) __builtin_bit_cast(uint4, (h8)(__builtin_bit_cast(h8, r) + __builtin_bit_cast(h8, x) * m))
#define SSTORE(buf)                                            \
  {                                                            \
    half_t* as = asw + (buf) * (256 * 72);                     \
    half_t* bs = bsw + (buf) * (128 * 72);                     \
    if (MIX) {                                                 \
      h8 m;                                                    \
      m[0] = (half_t)mu0.x; m[1] = (half_t)mu0.y; m[2] = (half_t)mu0.z; m[3] = (half_t)mu0.w; \
      m[4] = (half_t)mu1.x; m[5] = (half_t)mu1.y; m[6] = (half_t)mu1.z; m[7] = (half_t)mu1.w; \
      ra0 = MIXV(ra0, rx0); ra1 = MIXV(ra1, rx1); ra2 = MIXV(ra2, rx2); ra3 = MIXV(ra3, rx3); \
    }                                                          \
    *(uint4*)(as) = ra0;                                       \
    *(uint4*)(as + 64 * 72) = ra1;                             \
    *(uint4*)(as + 128 * 72) = ra2;                            \
    *(uint4*)(as + 192 * 72) = ra3;                            \
    *(uint4*)(bs) = rb0;                                       \
    *(uint4*)(bs + 64 * 72) = rb1;                             \
  }

  GLOAD(0);
  SSTORE(0);
  __syncthreads();
  for (int kt = 0; kt < nk; ++kt) {
    const bool more = kt + 1 < nk;
    if (more) GLOAD(kt + 1);
    __builtin_amdgcn_sched_barrier(0);
    {
      const half_t* as = asr + (kt & 1) * (256 * 72);
      const half_t* bs = bsr + (kt & 1) * (128 * 72);
#pragma unroll
      for (int ks = 0; ks < 2; ++ks) {
        h8 a[4], b[4];
#pragma unroll
        for (int i = 0; i < 4; ++i) {
          a[i] = *(const h8*)(as + i * 16 * 72 + ks * 32);
          b[i] = *(const h8*)(bs + i * 16 * 72 + ks * 32);
        }
#pragma unroll
        for (int mt = 0; mt < 4; ++mt)
#pragma unroll
          for (int nt = 0; nt < 4; ++nt)
            acc[mt][nt] = __builtin_amdgcn_mfma_f32_16x16x32_f16(b[nt], a[mt], acc[mt][nt], 0, 0, 0);
      }
    }
    if (more) SSTORE((kt + 1) & 1);
    __syncthreads();
  }
#undef GLOAD
#undef SSTORE
#undef MIXV
#pragma unroll
  for (int mt = 0; mt < 4; ++mt) {
    half_t* cp = g.C + (size_t)(wm * 64 + mt * 16 + lr) * g.ldc + wn * 64 + lq * 4;
#pragma unroll
    for (int nt = 0; nt < 4; ++nt) {
      h4 o;
#pragma unroll
      for (int j = 0; j < 4; ++j) {
        float v = acc[mt][nt][j];
        if (g.epi == 1) { v = fmaxf(v, 0.f); v = v * v; }
        else if (g.epi == 2) v = 1.f - 2.f / (__expf(2.f * v) + 1.f);
        else if (g.epi == 3) v = sigm(v);
        o[j] = (half_t)v;
      }
      *(h4*)(cp + nt * 16) = o;
    }
  }
}

__device__ __forceinline__ void gemm_tile2(const GemmTile& g, char* smem) {
  half_t* As = (half_t*)smem;
  half_t* Bs = (half_t*)(smem + 73728);
  const int tid = tidx(), lane = tid & 63, w = tid >> 6;
  const int wm = w >> 1, wn = w & 1, lr = lane & 15, lq = lane >> 4;
  const int ldr = tid >> 3, ldk = (tid & 7) * 8;
  f4 acc[4][4];
#pragma unroll
  for (int i = 0; i < 4; ++i)
#pragma unroll
    for (int j = 0; j < 4; ++j) acc[i][j] = (f4){0.f, 0.f, 0.f, 0.f};
  uint4 xa0, xa1, xa2, xa3, xb0, xb1;
  uint4 ya0, ya1, ya2, ya3, yb0, yb1;
  const int nk = g.K >> 6;
  const half_t* Ap = g.A + (size_t)ldr * g.lda + ldk;
  const half_t* Bp = g.Bt + (size_t)ldr * g.ldb + ldk;
  const size_t astep = (size_t)64 * g.lda, bstep = (size_t)64 * g.ldb;
  half_t* asw = As + ldr * 72 + ldk;
  half_t* bsw = Bs + ldr * 72 + ldk;
  const half_t* asr = As + (wm * 64 + lr) * 72 + lq * 8;
  const half_t* bsr = Bs + (wn * 64 + lr) * 72 + lq * 8;
#define GLD(S, kt)                                   \
  {                                                  \
    const int k0 = (kt) * 64;                        \
    S##a0 = *(const uint4*)(Ap + k0);                \
    S##a1 = *(const uint4*)(Ap + astep + k0);        \
    S##a2 = *(const uint4*)(Ap + 2 * astep + k0);    \
    S##a3 = *(const uint4*)(Ap + 3 * astep + k0);    \
    S##b0 = *(const uint4*)(Bp + k0);                \
    S##b1 = *(const uint4*)(Bp + bstep + k0);        \
  }
#define SST(S, buf)                                  \
  {                                                  \
    half_t* as = asw + (buf) * (256 * 72);           \
    half_t* bs = bsw + (buf) * (128 * 72);           \
    *(uint4*)(as) = S##a0;                           \
    *(uint4*)(as + 64 * 72) = S##a1;                 \
    *(uint4*)(as + 128 * 72) = S##a2;                \
    *(uint4*)(as + 192 * 72) = S##a3;                \
    *(uint4*)(bs) = S##b0;                           \
    *(uint4*)(bs + 64 * 72) = S##b1;                 \
  }
#define CMP(buf)                                                                                     \
  {                                                                                                  \
    const half_t* as = asr + (buf) * (256 * 72);                                                     \
    const half_t* bs = bsr + (buf) * (128 * 72);                                                     \
    _Pragma("unroll") for (int ks = 0; ks < 2; ++ks) {                                               \
      h8 a[4], b[4];                                                                                 \
      _Pragma("unroll") for (int i = 0; i < 4; ++i) {                                                \
        a[i] = *(const h8*)(as + i * 16 * 72 + ks * 32);                                             \
        b[i] = *(const h8*)(bs + i * 16 * 72 + ks * 32);                                             \
      }                                                                                              \
      _Pragma("unroll") for (int mt = 0; mt < 4; ++mt)                                               \
        _Pragma("unroll") for (int nt = 0; nt < 4; ++nt)                                             \
          acc[mt][nt] = __builtin_amdgcn_mfma_f32_16x16x32_f16(b[nt], a[mt], acc[mt][nt], 0, 0, 0);  \
    }                                                                                                \
  }
  GLD(x, 0);
  SST(x, 0);
  if (nk > 1) GLD(x, 1);
  if (nk > 2) GLD(y, 2);
  __syncthreads();
  for (int kt = 0; kt < nk; kt += 2) {
    CMP(0);
    if (kt + 1 < nk) SST(x, 1);
    if (kt + 3 < nk) GLD(x, kt + 3);
    __syncthreads();
    CMP(1);
    if (kt + 2 < nk) SST(y, 0);
    if (kt + 4 < nk) GLD(y, kt + 4);
    __syncthreads();
  }
#undef GLD
#undef SST
#undef CMP
#pragma unroll
  for (int mt = 0; mt < 4; ++mt) {
    half_t* cp = g.C + (size_t)(wm * 64 + mt * 16 + lr) * g.ldc + wn * 64 + lq * 4;
#pragma unroll
    for (int nt = 0; nt < 4; ++nt) {
      h4 o;
#pragma unroll
      for (int j = 0; j < 4; ++j) {
        float v = acc[mt][nt][j];
        if (g.epi == 1) { v = fmaxf(v, 0.f); v = v * v; }
        o[j] = (half_t)v;
      }
      *(h4*)(cp + nt * 16) = o;
    }
  }
}

__device__ __forceinline__ void gemm_tile3(const GemmTile& g, char* smem) {
  const int tid = tidx(), lane = tid & 63, w = tid >> 6;
  const int wm = w >> 1, wn = w & 1, lr = lane & 15, lq = lane >> 4;
  f4 acc[4][4];
#pragma unroll
  for (int i = 0; i < 4; ++i)
#pragma unroll
    for (int j = 0; j < 4; ++j) acc[i][j] = (f4){0.f, 0.f, 0.f, 0.f};
  const int nk = g.K >> 6;
  const int lrow = lane >> 3, lslot = lane & 7;
  const half_t* Ag[4];
  const half_t* Bg[2];
#pragma unroll
  for (int i = 0; i < 4; ++i) {
    const int row = (w * 4 + i) * 8 + lrow;
    Ag[i] = g.A + (size_t)row * g.lda + ((lslot ^ ((row >> 1) & 7)) * 8);
  }
#pragma unroll
  for (int i = 0; i < 2; ++i) {
    const int row = (w * 2 + i) * 8 + lrow;
    Bg[i] = g.Bt + (size_t)row * g.ldb + ((lslot ^ ((row >> 1) & 7)) * 8);
  }
  char* aw = smem + (w * 4) * 1024 + lane * 16;
  char* bw = smem + 32768 + (w * 2) * 1024 + lane * 16;
  const int swz = (lr >> 1) & 7;
  const int ko0 = ((0 + lq) ^ swz) * 16, ko1 = ((4 + lq) ^ swz) * 16;
  const char* ar = smem + (wm * 64 + lr) * 128;
  const char* br = smem + 32768 + (wn * 64 + lr) * 128;
#define ISSUE(kt, st)                                                                                      \
  {                                                                                                        \
    _Pragma("unroll") for (int i = 0; i < 4; ++i)                                                          \
      __builtin_amdgcn_global_load_lds((const unsigned*)(Ag[i] + (kt) * 64), (unsigned*)(aw + (st) * 49152 + i * 1024), 16, 0, 0); \
    _Pragma("unroll") for (int i = 0; i < 2; ++i)                                                          \
      __builtin_amdgcn_global_load_lds((const unsigned*)(Bg[i] + (kt) * 64), (unsigned*)(bw + (st) * 49152 + i * 1024), 16, 0, 0); \
  }
  ISSUE(0, 0);
  if (nk > 1) {
    ISSUE(1, 1);
    asm volatile("s_waitcnt vmcnt(6)" ::: "memory");
  } else {
    asm volatile("s_waitcnt vmcnt(0)" ::: "memory");
  }
  __builtin_amdgcn_s_barrier();
  asm volatile("" ::: "memory");
  h8 a0[4], b0[4], a1[4], b1[4];
#define LDF(fa, fb, stg, ko)                                             \
  {                                                                      \
    const char* as = ar + (stg) * 49152 + (ko);                          \
    const char* bs = br + (stg) * 49152 + (ko);                          \
    _Pragma("unroll") for (int i = 0; i < 4; ++i) {                      \
      fa[i] = *(const h8*)(as + i * 2048);                               \
      fb[i] = *(const h8*)(bs + i * 2048);                               \
    }                                                                    \
  }
#define MMA(fa, fb)                                                      \
  {                                                                      \
    _Pragma("unroll") for (int mt = 0; mt < 4; ++mt)                     \
      _Pragma("unroll") for (int nt = 0; nt < 4; ++nt)                   \
        acc[mt][nt] = __builtin_amdgcn_mfma_f32_16x16x32_f16(fb[nt], fa[mt], acc[mt][nt], 0, 0, 0); \
  }
  LDF(a0, b0, 0, ko0);
  int st = 0;
  for (int kt = 0; kt < nk; ++kt) {
    const bool more = kt + 2 < nk;
    int st1 = st + 1; if (st1 >= 3) st1 -= 3;
    int st2 = st + 2; if (st2 >= 3) st2 -= 3;
    if (more) ISSUE(kt + 2, st2);
    LDF(a1, b1, st, ko1);
    __builtin_amdgcn_sched_barrier(0);
    MMA(a0, b0);
    __builtin_amdgcn_sched_barrier(0);
    if (more) asm volatile("s_waitcnt vmcnt(6) lgkmcnt(0)" ::: "memory");
    else asm volatile("s_waitcnt vmcnt(0) lgkmcnt(0)" ::: "memory");
    __builtin_amdgcn_s_barrier();
    asm volatile("" ::: "memory");
    if (kt + 1 < nk) LDF(a0, b0, st1, ko0);
    __builtin_amdgcn_sched_barrier(0);
    MMA(a1, b1);
    __builtin_amdgcn_sched_barrier(0);
    st = st1;
  }
#undef LDF
#undef MMA
#undef ISSUE
  if (g.epi == 5) {
    const P& p = *g.pp;
    char* ws = p.ws + opaque_zero();
    const half_t* Y0 = (const half_t*)(ws + OFF_A0);
    const half_t* Y1 = (const half_t*)(ws + OFF_A1);
    const half_t* VVp = (const half_t*)(ws + OFF_VV);
    const float* BN0 = (const float*)(ws + OFF_BN);
    const float* BN1 = BN0 + (size_t)RL * 16;
    half_t* Z1 = (half_t*)(ws + OFF_Z1);
    const int head = (g.col0 >> 6) + wn;
#pragma unroll 1
    for (int mt = 0; mt < 4; ++mt) {
      const int row = g.row0 + wm * 64 + mt * 16 + lr;
      const size_t base = (size_t)row * 1024 + head * 64 + lq * 4;
      float y[4][4], vv[4][4];
      float sm = 0.f;
#pragma unroll
      for (int nt = 0; nt < 4; ++nt) {
        const h4 ya = *(const h4*)(Y0 + base + nt * 16);
        const h4 yb = *(const h4*)(Y1 + base + nt * 16);
        const h4 vh = *(const h4*)(VVp + base + nt * 16);
#pragma unroll
        for (int j = 0; j < 4; ++j) { y[nt][j] = (float)ya[j] + (float)yb[j]; vv[nt][j] = (float)vh[j]; sm += y[nt][j]; }
      }
      sm += bperm(sm, lane ^ 16);
      sm += bperm(sm, lane ^ 32);
      const float mean = sm * (1.f / 64.f);
      float q = 0.f;
#pragma unroll
      for (int nt = 0; nt < 4; ++nt)
#pragma unroll
        for (int j = 0; j < 4; ++j) { const float d = y[nt][j] - mean; q += d * d; }
      q += bperm(q, lane ^ 16);
      q += bperm(q, lane ^ 32);
      const float rstd = rsqrtf(q * (1.f / 64.f) + 64e-5f);
      const float bonus = BN0[(size_t)row * 16 + head] + BN1[(size_t)row * 16 + head];
#pragma unroll
      for (int nt = 0; nt < 4; ++nt) {
        const int ch = head * 64 + nt * 16 + lq * 4;
        const float4 lg = *(const float4*)(p.rw_lng + ch);
        const float4 lb = *(const float4*)(p.rw_lnb + ch);
        const float lgv[4] = {lg.x, lg.y, lg.z, lg.w}, lbv[4] = {lb.x, lb.y, lb.z, lb.w};
        const f4 gv = mt == 0 ? acc[0][nt] : (mt == 1 ? acc[1][nt] : (mt == 2 ? acc[2][nt] : acc[3][nt]));
        h4 o;
#pragma unroll
        for (int j = 0; j < 4; ++j) o[j] = (half_t)(((y[nt][j] - mean) * rstd * lgv[j] + lbv[j] + bonus * vv[nt][j]) * gv[j]);
        *(h4*)(Z1 + base + nt * 16) = o;
      }
    }
    return;
  }
  if (g.epi == 4) {
    half_t* vp = g.C + (size_t)((wm * 8 + wn) * 64) * 64 + lr;
#pragma unroll
    for (int mt = 0; mt < 4; ++mt)
#pragma unroll
      for (int nt = 0; nt < 4; ++nt)
#pragma unroll
        for (int j = 0; j < 4; ++j) vp[(nt * 16 + lq * 4 + j) * 64 + mt * 16] = (half_t)acc[mt][nt][j];
    return;
  }
#pragma unroll
  for (int mt = 0; mt < 4; ++mt) {
    half_t* cp = g.C + (size_t)(wm * 64 + mt * 16 + lr) * g.ldc + wn * 64 + lq * 4;
#pragma unroll
    for (int nt = 0; nt < 4; ++nt) {
      h4 o;
#pragma unroll
      for (int j = 0; j < 4; ++j) {
        float v = acc[mt][nt][j];
        if (g.epi == 1) { v = fmaxf(v, 0.f); v = v * v; }
        o[j] = (half_t)v;
      }
      *(h4*)(cp + nt * 16) = o;
    }
  }
}

__device__ __forceinline__ void gemm_tile4(const GemmTile& g, char* smem) {
  const int tid = tidx(), lane = tid & 63, w = tid >> 6;
  const int wm = w >> 1, wn = w & 1, lr = lane & 15, lq = lane >> 4;
  f4 acc[4][8];
#pragma unroll
  for (int i = 0; i < 4; ++i)
#pragma unroll
    for (int j = 0; j < 8; ++j) acc[i][j] = (f4){0.f, 0.f, 0.f, 0.f};
  const int nk = g.K >> 6;
  const int lrow = lane >> 3, lslot = lane & 7;
  const half_t* Ag[4];
  const half_t* Bg[4];
#pragma unroll
  for (int i = 0; i < 4; ++i) {
    const int row = (w * 4 + i) * 8 + lrow;
    const int so = (lslot ^ ((row >> 1) & 7)) * 8;
    Ag[i] = g.A + (size_t)row * g.lda + so;
    Bg[i] = g.Bt + (size_t)row * g.ldb + so;
  }
  char* aw = smem + (w * 4) * 1024 + lane * 16;
  char* bw = smem + 32768 + (w * 4) * 1024 + lane * 16;
  const int swz = (lr >> 1) & 7;
  const int ko0 = ((0 + lq) ^ swz) * 16, ko1 = ((4 + lq) ^ swz) * 16;
  const char* ar = smem + (wm * 64 + lr) * 128;
  const char* br = smem + 32768 + (wn * 128 + lr) * 128;
#define ISSUE4(kt, st)                                                                                     \
  {                                                                                                        \
    _Pragma("unroll") for (int i = 0; i < 4; ++i)                                                          \
      __builtin_amdgcn_global_load_lds((const unsigned*)(Ag[i] + (kt) * 64), (unsigned*)(aw + (st) * 65536 + i * 1024), 16, 0, 0); \
    _Pragma("unroll") for (int i = 0; i < 4; ++i)                                                          \
      __builtin_amdgcn_global_load_lds((const unsigned*)(Bg[i] + (kt) * 64), (unsigned*)(bw + (st) * 65536 + i * 1024), 16, 0, 0); \
  }
  ISSUE4(0, 0);
  asm volatile("s_waitcnt vmcnt(0)" ::: "memory");
  __builtin_amdgcn_s_barrier();
  asm volatile("" ::: "memory");
  for (int kt = 0; kt < nk; ++kt) {
    const int st = kt & 1;
    if (kt + 1 < nk) ISSUE4(kt + 1, st ^ 1);
    const char* as = ar + st * 65536;
    const char* bs = br + st * 65536;
#pragma unroll
    for (int ks = 0; ks < 2; ++ks) {
      const int ko = ks ? ko1 : ko0;
      h8 a[4], b[8];
#pragma unroll
      for (int i = 0; i < 4; ++i) a[i] = *(const h8*)(as + i * 2048 + ko);
#pragma unroll
      for (int i = 0; i < 8; ++i) b[i] = *(const h8*)(bs + i * 2048 + ko);
#pragma unroll
      for (int mt = 0; mt < 4; ++mt)
#pragma unroll
        for (int nt = 0; nt < 8; ++nt)
          acc[mt][nt] = __builtin_amdgcn_mfma_f32_16x16x32_f16(b[nt], a[mt], acc[mt][nt], 0, 0, 0);
    }
    asm volatile("s_waitcnt vmcnt(0) lgkmcnt(0)" ::: "memory");
    __builtin_amdgcn_s_barrier();
    asm volatile("" ::: "memory");
  }
#undef ISSUE4
  if (g.epi == 4) {
#pragma unroll
    for (int mt = 0; mt < 4; ++mt)
#pragma unroll
      for (int nt = 0; nt < 8; ++nt) {
        half_t* vp = g.C + (size_t)((wm * 8 + wn * 2 + (nt >> 2)) * 64) * 64 + lr;
#pragma unroll
        for (int j = 0; j < 4; ++j) vp[((nt & 3) * 16 + lq * 4 + j) * 64 + mt * 16] = (half_t)acc[mt][nt][j];
      }
    return;
  }
#pragma unroll
  for (int mt = 0; mt < 4; ++mt) {
    half_t* cp = g.C + (size_t)(wm * 64 + mt * 16 + lr) * g.ldc + wn * 128 + lq * 4;
#pragma unroll
    for (int nt = 0; nt < 8; ++nt) {
      h4 o;
#pragma unroll
      for (int j = 0; j < 4; ++j) {
        float v = acc[mt][nt][j];
        if (g.epi == 1) { v = fmaxf(v, 0.f); v = v * v; }
        o[j] = (half_t)v;
      }
      *(h4*)(cp + nt * 16) = o;
    }
  }
}

__device__ __forceinline__ int p8_lds_byte(int r, int c) {
  const int st = (r >> 4) * 2 + (c >> 5), rr = r & 15, cc = c & 31, ob = rr * 64 + cc * 2;
  return st * 1024 + (ob ^ (((ob >> 9) & 1) << 5));
}
__device__ __forceinline__ void p8_stage_rc(int b, int& R, int& C) {
  const int st = b / 1024, sb = b % 1024, swz = sb ^ (((sb >> 9) & 1) << 5);
  R = (st >> 1) * 16 + swz / 64;
  C = (st & 1) * 32 + (swz % 64) / 2;
}
__device__ __forceinline__ void gemm_tile8(const GemmTile& g, char* smem) {
  constexpr int HT = 128 * 64;
  half_t* shm = (half_t*)smem;
  const int tid = tidx();
  const int wid = tid >> 6, lane = tid & 63, wr = wid >> 2, wc = wid & 3, fr = lane & 15, fq = lane >> 4;
  const half_t* A = g.A;
  const half_t* Bt = g.Bt;
  const int lda = g.lda, ldb = g.lda;
#define P8_SA(b, h) (shm + ((b) * 2 + (h)) * HT)
#define P8_SB(b, h) (shm + (4 + (b) * 2 + (h)) * HT)
  int sr0, sc0, sr1, sc1;
  p8_stage_rc(tid * 16, sr0, sc0);
  p8_stage_rc(tid * 16 + 8192, sr1, sc1);
  const int ao0 = sr0 * lda + sc0, ao1 = sr1 * lda + sc1;
#define bo0 ao0
#define bo1 ao1
#define P8_STAGE_A(Pp, br, kt)                                                                                   \
  {                                                                                                              \
    const half_t* gb_ = A + (size_t)(br) * lda + (size_t)(kt) * 64;                                              \
    __builtin_amdgcn_global_load_lds((const unsigned*)(gb_ + ao0), (unsigned*)((char*)(Pp) + tid * 16), 16, 0, 0);        \
    __builtin_amdgcn_global_load_lds((const unsigned*)(gb_ + ao1), (unsigned*)((char*)(Pp) + tid * 16 + 8192), 16, 0, 0); \
  }
#define P8_STAGE_B(Pp, br, kt)                                                                                   \
  {                                                                                                              \
    const half_t* gb_ = Bt + (size_t)(br) * ldb + (size_t)(kt) * 64;                                             \
    __builtin_amdgcn_global_load_lds((const unsigned*)(gb_ + bo0), (unsigned*)((char*)(Pp) + tid * 16), 16, 0, 0);        \
    __builtin_amdgcn_global_load_lds((const unsigned*)(gb_ + bo1), (unsigned*)((char*)(Pp) + tid * 16 + 8192), 16, 0, 0); \
  }
  const char* abase = smem + p8_lds_byte(wr * 64 + fr, fq * 8);
  const char* bbase = smem + 4 * HT * 2 + p8_lds_byte(wc * 32 + fr, fq * 8);
#define P8_LDA(dst, b, h)                                                                                        \
  _Pragma("unroll") for (int m = 0; m < 4; ++m) _Pragma("unroll") for (int k = 0; k < 2; ++k)                    \
      dst[m][k] = *(const h8*)(abase + ((b) * 2 + (h)) * (HT * 2) + (m * 2 + k) * 1024);
#define P8_LDB(dst, b, h)                                                                                        \
  _Pragma("unroll") for (int n = 0; n < 2; ++n) _Pragma("unroll") for (int k = 0; k < 2; ++k)                    \
      dst[n][k] = *(const h8*)(bbase + ((b) * 2 + (h)) * (HT * 2) + (n * 2 + k) * 1024);
#define P8_MMA(ai, bj, Af, Bf)                                                                                   \
  {                                                                                                              \
    __builtin_amdgcn_s_setprio(1);                                                                               \
    _Pragma("unroll") for (int m = 0; m < 4; ++m) _Pragma("unroll") for (int n = 0; n < 2; ++n)                  \
        _Pragma("unroll") for (int k = 0; k < 2; ++k)                                                            \
            acc[ai][bj][m][n] = __builtin_amdgcn_mfma_f32_16x16x32_f16(Bf[n][k], Af[m][k], acc[ai][bj][m][n], 0, 0, 0); \
    __builtin_amdgcn_s_setprio(0);                                                                               \
  }
#define P8_WAIT_V(n) asm volatile("s_waitcnt vmcnt(" #n ")" ::: "memory")
#define P8_WAIT_L(n) asm volatile("s_waitcnt lgkmcnt(" #n ")" ::: "memory")
#define P8_BAR __builtin_amdgcn_s_barrier()
#define P8_SCHED __builtin_amdgcn_sched_barrier(0)

  f4 acc[2][2][4][2];
#pragma unroll
  for (int i0 = 0; i0 < 2; ++i0)
#pragma unroll
    for (int i1 = 0; i1 < 2; ++i1)
#pragma unroll
      for (int i2 = 0; i2 < 4; ++i2)
#pragma unroll
        for (int i3 = 0; i3 < 2; ++i3) acc[i0][i1][i2][i3] = (f4){0.f, 0.f, 0.f, 0.f};
  h8 At[4][2], B0[2][2], B1[2][2];
  const int nt = g.K >> 6;
  P8_STAGE_B(P8_SB(0, 0), 0, 0); P8_STAGE_A(P8_SA(0, 0), 0, 0);
  P8_STAGE_B(P8_SB(0, 1), 128, 0); P8_STAGE_A(P8_SA(0, 1), 128, 0);
  if (wr == 1) P8_BAR;
  P8_WAIT_V(4); P8_BAR;
  P8_STAGE_B(P8_SB(1, 0), 0, 1); P8_STAGE_A(P8_SA(1, 0), 0, 1); P8_STAGE_B(P8_SB(1, 1), 128, 1);
  P8_WAIT_V(6); P8_BAR;
  for (int t = 0; t < nt - 2; t += 2) {
    P8_LDB(B0, 0, 0); P8_SCHED; P8_LDA(At, 0, 0); P8_STAGE_A(P8_SA(1, 1), 128, t + 1);
    P8_WAIT_L(8); P8_BAR; P8_WAIT_L(0); P8_MMA(0, 0, At, B0); P8_BAR; P8_SCHED;
    P8_LDB(B1, 0, 1); P8_STAGE_B(P8_SB(0, 0), 0, t + 2);
    P8_BAR; P8_WAIT_L(0); P8_MMA(0, 1, At, B1); P8_BAR;
    P8_LDA(At, 0, 1); P8_STAGE_A(P8_SA(0, 0), 0, t + 2);
    P8_BAR; P8_WAIT_L(0); P8_MMA(1, 0, At, B0); P8_BAR; P8_SCHED;
    P8_STAGE_B(P8_SB(0, 1), 128, t + 2);
    P8_WAIT_V(6); P8_BAR; P8_MMA(1, 1, At, B1); P8_BAR;
    P8_LDB(B0, 1, 0); P8_SCHED; P8_LDA(At, 1, 0); P8_STAGE_A(P8_SA(0, 1), 128, t + 2);
    P8_WAIT_L(8); P8_BAR; P8_WAIT_L(0); P8_MMA(0, 0, At, B0); P8_BAR; P8_SCHED;
    P8_LDB(B1, 1, 1); P8_STAGE_B(P8_SB(1, 0), 0, t + 3);
    P8_BAR; P8_WAIT_L(0); P8_MMA(0, 1, At, B1); P8_BAR;
    P8_LDA(At, 1, 1); P8_STAGE_A(P8_SA(1, 0), 0, t + 3);
    P8_BAR; P8_WAIT_L(0); P8_MMA(1, 0, At, B0); P8_BAR; P8_SCHED;
    P8_STAGE_B(P8_SB(1, 1), 128, t + 3);
    P8_WAIT_V(6); P8_BAR; P8_MMA(1, 1, At, B1); P8_BAR;
  }
  {
    P8_LDB(B0, 0, 0); P8_LDA(At, 0, 0); P8_STAGE_A(P8_SA(1, 1), 128, nt - 1);
    P8_BAR; P8_WAIT_L(0); P8_MMA(0, 0, At, B0); P8_BAR;
    P8_LDB(B1, 0, 1); P8_BAR; P8_WAIT_L(0); P8_MMA(0, 1, At, B1); P8_BAR;
    P8_LDA(At, 0, 1); P8_WAIT_V(4); P8_BAR; P8_WAIT_L(0); P8_MMA(1, 0, At, B0); P8_MMA(1, 1, At, B1); P8_BAR;
  }
  {
    P8_LDB(B0, 1, 0); P8_LDA(At, 1, 0); P8_WAIT_V(2); P8_BAR; P8_WAIT_L(0); P8_MMA(0, 0, At, B0); P8_BAR;
    P8_LDB(B1, 1, 1); P8_WAIT_V(0); P8_BAR; P8_WAIT_L(0); P8_MMA(0, 1, At, B1); P8_BAR;
    P8_LDA(At, 1, 1); P8_BAR; P8_WAIT_L(0); P8_MMA(1, 0, At, B0); P8_MMA(1, 1, At, B1); P8_BAR;
  }
  if (wr == 0) P8_BAR;
  asm volatile("" ::: "memory");
#pragma unroll
  for (int ai = 0; ai < 2; ++ai)
#pragma unroll
    for (int m = 0; m < 4; ++m) {
      const int row = ai * 128 + wr * 64 + m * 16 + fr;
#pragma unroll
      for (int bj = 0; bj < 2; ++bj)
#pragma unroll
        for (int n = 0; n < 2; ++n) {
          const int col = bj * 128 + wc * 32 + n * 16 + fq * 4;
          if (g.epi == 4) {
            half_t* vp = g.C + (size_t)(((row >> 6) * 8 + (col >> 6)) * 64 + (col & 63)) * 64 + (row & 63);
#pragma unroll
            for (int j = 0; j < 4; ++j) vp[j * 64] = (half_t)acc[ai][bj][m][n][j];
          } else {
            h4 o;
#pragma unroll
            for (int j = 0; j < 4; ++j) {
              float v = acc[ai][bj][m][n][j];
              if (g.epi == 1) { v = fmaxf(v, 0.f); v = v * v; }
              o[j] = (half_t)v;
            }
            *(h4*)(g.C + (size_t)row * g.ldc + col) = o;
          }
        }
    }
#undef bo0
#undef bo1
#undef P8_SA
#undef P8_SB
#undef P8_STAGE_A
#undef P8_STAGE_B
#undef P8_LDA
#undef P8_LDB
#undef P8_MMA
#undef P8_WAIT_V
#undef P8_WAIT_L
#undef P8_BAR
#undef P8_SCHED
}

__device__ __forceinline__ void gemm_phase(const P& p, const half_t* A, int lda, const half_t* Bt, int ldb, int K, half_t* C, int ldc,
                                           int epi, int nMt, int nNt, int feat, char* smem) {
  char* ws = (p.ws + opaque_zero());
  const bool split = (feat >= 2 && nMt == 136);
  if (split) nMt = 128;
  const int nbig = nMt * nNt;
  const int total = nbig + (split ? 16 * nNt : 0), G = gridDim.x, per_xcd = G >> 3;
  for (int t0 = bidx(); t0 < total + G; t0 += G) {
    const int rnd = t0 / G, bb = t0 - rnd * G;
    const int t = ((G & 7) == 0) ? rnd * G + (bb & 7) * per_xcd + (bb >> 3) : t0;
    if (t >= total) continue;
    const bool small = t >= nbig;
    const int gsz = 8 * nNt, first = (t / gsz) * 8, gm = min(nMt - first, 8);
    const int mt = small ? 128 + ((t - nbig) & 7) : first + (t % gsz) % gm;
    const int nt = small ? (t - nbig) >> 3 : (t % gsz) / gm;
    GemmTile g;
    g.A = A + (size_t)mt * 256 * lda; g.A2 = nullptr; g.mu = nullptr; g.lda = lda;
    const int tw = (feat >= 2 && !small) ? 256 : 128;
    g.Bt = Bt + (size_t)nt * tw * ldb; g.ldb = ldb; g.K = K;
    g.C = C + (size_t)mt * 256 * ldc + nt * tw; g.ldc = ldc; g.epi = epi;
    g.row0 = mt * 256; g.col0 = nt * tw; g.pp = &p;
    if (feat == 2 && !small && nt >= 6) {
      g.epi = 4;
      g.C = (half_t*)(ws + OFF_A1) + ((size_t)(mt * 4) * 8 + (nt - 6) * 4) * 4096;
    }
    if (feat == 2 && small && nt >= 12) {
      g.epi = 4;
      g.C = (half_t*)(ws + OFF_A1) + ((size_t)(mt * 4) * 8 + (nt - 12) * 2) * 4096;
    }
    if (feat == 1) {
      g.A2 = (const half_t*)(ws + OFF_A1) + (size_t)mt * 256 * 1024;
      const int grp = nt >> 3, sub = nt & 7;
      int mixi;
      if (grp < 3) {
        mixi = grp == 0 ? 0 : (grp == 1 ? 2 : 3);
        g.Bt = (const half_t*)(ws + (grp == 0 ? OFF_WR : (grp == 1 ? OFF_WK : OFF_WV))) + (size_t)sub * 128 * 1024;
        g.C = (half_t*)(ws + (grp == 0 ? OFF_RR : (grp == 1 ? OFF_KK : OFF_VV))) + (size_t)mt * 256 * 1024 + sub * 128;
      } else {
        mixi = sub == 0 ? 1 : (sub == 1 ? 4 : 5);
        g.Bt = (const half_t*)(ws + OFF_L1) + (size_t)sub * 128 * 1024;
        g.C = (half_t*)(ws + OFF_L) + (size_t)mt * 256 * 384 + sub * 128;
        g.ldc = 384;
        g.epi = sub == 0 ? 2 : (sub == 1 ? 0 : 3);
      }
      g.mu = p.rw_mu + mixi * 1024;
    }
    if (feat == 1) gemm_tile<true>(g, smem); else if (feat >= 2 && !small) gemm_tile8(g, smem); else gemm_tile3(g, smem);
  }
}

__device__ void xpose_seg(const float* src, int ldsrc, int K, int N, half_t* dst, int lddst, int koff, int& base,
                          char* smem) {
  float* ts = (float*)smem;
  const int tid = tidx(), G = gridDim.x;
  const int tkn = K >> 6, tnn = N >> 6, cnt = tkn * tnn;
  int t0 = ((int)bidx() - (base % G) + G) % G;
  for (int t = t0; t < cnt; t += G) {
    const int k0 = (t % tkn) * 64, n0 = (t / tkn) * 64;
#pragma unroll
    for (int i = 0; i < 2; ++i) {
      const int c = tid + 512 * i, r = c >> 4, c4 = (c & 15) * 4;
      const float4 v = *(const float4*)(src + (size_t)(k0 + r) * ldsrc + n0 + c4);
      float* d = ts + r * 65 + c4;
      d[0] = v.x; d[1] = v.y; d[2] = v.z; d[3] = v.w;
    }
    __syncthreads();
    {
      const int n = tid >> 3, kc = (tid & 7) * 8;
      h8 o;
#pragma unroll
      for (int i = 0; i < 8; ++i) o[i] = (half_t)ts[(kc + i) * 65 + n];
      *(h8*)(dst + (size_t)(n0 + n) * lddst + koff + k0 + kc) = o;
    }
    __syncthreads();
  }
  base += cnt;
}

__device__ void phase_prep(const P& p, char* smem) {
  const int tid = tidx();
  char* ws = (p.ws + opaque_zero());
  float* MOD = (float*)(ws + OFF_MOD);
  if (bidx() < 192 || gridDim.x < 256) {
    float* sl = (float*)smem;
    for (int i = tid; i < 9216; i += 512) {
      const int b = i >> 10, k = i & 1023;
      const float cv = b < 8 ? p.c[b * 1024 + k] : p.c_ctx[k];
      sl[i] = cv / (1.f + __expf(-cv));
    }
    __syncthreads();
    float* red = sl + 9216;
    for (int item = bidx(); item < 192; item += gridDim.x) {
      const int l = item / 96, n0 = (item % 96) * 64, cn = tid & 63, kq = tid >> 6;
      float acc[9];
#pragma unroll
      for (int b = 0; b < 9; ++b) acc[b] = 0.f;
      const float* wp = p.ada_w + (size_t)l * 1024 * 6144 + n0 + cn;
#pragma unroll 4
      for (int k = kq * 128; k < kq * 128 + 128; ++k) {
        const float wv = wp[(size_t)k * 6144];
#pragma unroll
        for (int b = 0; b < 9; ++b) acc[b] += sl[b * 1024 + k] * wv;
      }
#pragma unroll
      for (int b = 0; b < 9; ++b) red[(kq * 9 + b) * 64 + cn] = acc[b];
      __syncthreads();
      for (int i = tid; i < 576; i += 512) {
        const int b = i >> 6, c = i & 63;
        float s = 0.f;
#pragma unroll
        for (int q = 0; q < 8; ++q) s += red[(q * 9 + b) * 64 + c];
        MOD[(size_t)(l * 9 + b) * 6144 + n0 + c] = s + p.ada_b[l * 6144 + n0 + c];
      }
      __syncthreads();
    }
  }
  for (int it = bidx(); it < 256; it += gridDim.x) {
    if (it < 192) continue;
    const int fi = it - 192, gi = fi >> 4, n0 = (fi & 15) * 64, n = tid & 63, ig = tid >> 6;
    float acc[16];
#pragma unroll
    for (int i = 0; i < 16; ++i) acc[i] = 0.f;
    for (int j = 0; j < 128; ++j) {
      const float wv = p.ev_w_out[(size_t)(gi * 128 + j) * 1024 + n0 + n] * p.ev_pool_scale[gi * 128 + j];
      const float* pw = p.ev_pool_w + ((size_t)gi * 128 + ig * 16) * 128 + j;
#pragma unroll
      for (int i = 0; i < 16; ++i) acc[i] += pw[i * 128] * wv;
    }
    h8 o0, o1;
#pragma unroll
    for (int i = 0; i < 8; ++i) { o0[i] = (half_t)acc[i]; o1[i] = (half_t)acc[8 + i]; }
    half_t* d = (half_t*)(ws + OFF_WOUT) + (size_t)(n0 + n) * 1024 + gi * 128 + ig * 16;
    *(h8*)d = o0;
    *(h8*)(d + 8) = o1;
  }
  __syncthreads();
  int base = 0;
  xpose_seg(p.ev_w_in, 2048, 1024, 2048, (half_t*)(ws + OFF_WIN), 1024, 0, base, smem);
  xpose_seg(p.ev_w_out + 512 * 1024, 1024, 512, 1024, (half_t*)(ws + OFF_WOUT), 1024, 512, base, smem);
  for (int l = 0; l < 2; ++l) {
    xpose_seg(p.mlp_w1 + (size_t)l * 1024 * 4096, 4096, 1024, 4096, (half_t*)(ws + OFF_M1 + l * 8 * MIB), 1024, 0, base, smem);
    xpose_seg(p.mlp_w2 + (size_t)l * 1024 * 4096, 1024, 4096, 1024, (half_t*)(ws + OFF_M2 + l * 8 * MIB), 4096, 0, base, smem);
  }
  xpose_seg(p.rw_wr, 1024, 1024, 1024, (half_t*)(ws + OFF_WR), 1024, 0, base, smem);
  xpose_seg(p.rw_wk, 1024, 1024, 1024, (half_t*)(ws + OFF_WK), 1024, 0, base, smem);
  xpose_seg(p.rw_wv, 1024, 1024, 1024, (half_t*)(ws + OFF_WV), 1024, 0, base, smem);
  xpose_seg(p.rw_wo, 1024, 1024, 1024, (half_t*)(ws + OFF_WO), 1024, 0, base, smem);
  for (int d = 0; d < 2; ++d) {
    xpose_seg(p.rw_w1 + (size_t)d * 1024 * 64, 64, 1024, 64, (half_t*)(ws + OFF_L1) + (size_t)(d * 64) * 1024, 1024, 0, base, smem);
    xpose_seg(p.rw_a1 + (size_t)d * 1024 * 64, 64, 1024, 64, (half_t*)(ws + OFF_L1) + (size_t)(128 + d * 64) * 1024, 1024, 0, base, smem);
    xpose_seg(p.rw_w2 + (size_t)d * 64 * 1024, 1024, 64, 1024, (half_t*)(ws + OFF_W2) + (size_t)d * 1024 * 64, 64, 0, base, smem);
    xpose_seg(p.rw_a2 + (size_t)d * 64 * 1024, 1024, 64, 1024, (half_t*)(ws + OFF_A2) + (size_t)d * 1024 * 64, 64, 0, base, smem);
  }
  xpose_seg(p.rw_g1, 128, 1024, 128, (half_t*)(ws + OFF_L1) + (size_t)256 * 1024, 1024, 0, base, smem);
  xpose_seg(p.rw_g2, 1024, 128, 1024, (half_t*)(ws + OFF_G2), 128, 0, base, smem);
}

__device__ void phase_rowwise(const P& p, int mode) {
  const int lane = tidx() & 63;
  const int gw = bidx() * 8 + (tidx() >> 6), nw = gridDim.x * 8;
  char* ws = (p.ws + opaque_zero());
  const float* MOD = (const float*)(ws + OFF_MOD);
  float* XC = (float*)(ws + OFF_XC);
  half_t* H = (half_t*)(ws + OFF_A0);
  const half_t* Y = (const half_t*)(ws + OFF_A1);
  const int nrows = (mode >= 3) ? RL : RT;
  const int per = (nrows + nw - 1) / nw;
  const int r0 = gw * per, r1 = min(r0 + per, nrows);
  if (r0 >= r1) return;
  const bool hasY = mode != 0, hasH = mode != 4;
  const float EPS = opaque_f(1e-6f);
  const int lyr = (mode <= 1) ? 0 : ((mode == 2) ? 0 : 1);
  const int gyi = (mode == 1) ? 1 : (mode == 2 ? 3 : (mode == 3 ? 5 : 7));
  const int gti = (mode == 1) ? 2 : (mode == 2 ? 5 : (mode == 3 ? 2 : 5));
  const int hl = (mode <= 1) ? 0 : 1;
  const int ghi = (mode == 0) ? 0 : (mode == 1 ? 2 : (mode == 2 ? 4 : 6));
  const int shi = (mode == 0 || mode == 2) ? 0 : 3;
  auto xsrc = [&](int row) -> const float* {
    if (mode <= 1) return row < RL ? p.x + (size_t)row * 1024 : p.ctx + (size_t)(row - RL) * 1024;
    return row < RL ? p.out + (size_t)row * 1024 : XC + (size_t)(row - RL) * 1024;
  };
  auto xdst = [&](int row) -> float* { return row < RL ? p.out + (size_t)row * 1024 : XC + (size_t)(row - RL) * 1024; };
  float4 gy[4], gt[4], gh[4], s1[4], s2[4];
  int cur_mi = -1;
  float4 nx[4];
  h4 ny[4];
  {
    const float* xs = xsrc(r0);
#pragma unroll
    for (int i = 0; i < 4; ++i) nx[i] = __builtin_bit_cast(float4, __builtin_nontemporal_load((const f4*)(xs + i * 256 + lane * 4)));
    if (hasY) {
#pragma unroll
      for (int i = 0; i < 4; ++i) ny[i] = __builtin_nontemporal_load((const h4*)(Y + (size_t)r0 * 1024 + i * 256 + lane * 4));
    }
  }
  for (int row = r0; row < r1; ++row) {
    float xv[4][4];
    h4 yh[4];
#pragma unroll
    for (int i = 0; i < 4; ++i) { xv[i][0] = nx[i].x; xv[i][1] = nx[i].y; xv[i][2] = nx[i].z; xv[i][3] = nx[i].w; yh[i] = ny[i]; }
    if (row + 1 < r1) {
      const float* xs = xsrc(row + 1);
#pragma unroll
      for (int i = 0; i < 4; ++i) nx[i] = __builtin_bit_cast(float4, __builtin_nontemporal_load((const f4*)(xs + i * 256 + lane * 4)));
      if (hasY) {
#pragma unroll
        for (int i = 0; i < 4; ++i) ny[i] = __builtin_nontemporal_load((const h4*)(Y + (size_t)(row + 1) * 1024 + i * 256 + lane * 4));
      }
    }
    const int mi = row < RL ? (row >> 12) : 8;
    if (mi != cur_mi) {
      cur_mi = mi;
      const float* mg = MOD + (size_t)(lyr * 9 + mi) * 6144;
      const float* mh = MOD + (size_t)(hl * 9 + mi) * 6144;
#pragma unroll
      for (int i = 0; i < 4; ++i) {
        const int o = i * 256 + lane * 4;
        if (hasY) { gy[i] = *(const float4*)(p.norm_g + gyi * 1024 + o); gt[i] = *(const float4*)(mg + gti * 1024 + o); }
        if (hasH) {
          gh[i] = *(const float4*)(p.norm_g + ghi * 1024 + o);
          s1[i] = *(const float4*)(mh + shi * 1024 + o);
          s2[i] = *(const float4*)(mh + (shi + 1) * 1024 + o);
        }
      }
    }
    if (hasY) {
      float yv[4][4];
      float ss = 0.f;
#pragma unroll
      for (int i = 0; i < 4; ++i)
#pragma unroll
        for (int k = 0; k < 4; ++k) { yv[i][k] = (float)yh[i][k]; ss += yv[i][k] * yv[i][k]; }
      ss = wave_sum(ss, lane);
      const float rs = rsqrtf(ss * (1.f / 1024.f) + EPS);
      float* xo = xdst(row);
#pragma unroll
      for (int i = 0; i < 4; ++i) {
        xv[i][0] += gt[i].x * (yv[i][0] * rs * gy[i].x);
        xv[i][1] += gt[i].y * (yv[i][1] * rs * gy[i].y);
        xv[i][2] += gt[i].z * (yv[i][2] * rs * gy[i].z);
        xv[i][3] += gt[i].w * (yv[i][3] * rs * gy[i].w);
        __builtin_nontemporal_store((f4){xv[i][0], xv[i][1], xv[i][2], xv[i][3]}, (f4*)(xo + i * 256 + lane * 4));
      }
    }
    if (hasH) {
      float ss = 0.f;
#pragma unroll
      for (int i = 0; i < 4; ++i)
#pragma unroll
        for (int k = 0; k < 4; ++k) ss += xv[i][k] * xv[i][k];
      ss = wave_sum(ss, lane);
      const float rs = rsqrtf(ss * (1.f / 1024.f) + EPS);
      half_t* ho = H + (size_t)row * 1024;
#pragma unroll
      for (int i = 0; i < 4; ++i) {
        h4 o;
        o[0] = (half_t)(xv[i][0] * rs * gh[i].x * (1.f + s2[i].x) + s1[i].x);
        o[1] = (half_t)(xv[i][1] * rs * gh[i].y * (1.f + s2[i].y) + s1[i].y);
        o[2] = (half_t)(xv[i][2] * rs * gh[i].z * (1.f + s2[i].z) + s1[i].z);
        o[3] = (half_t)(xv[i][3] * rs * gh[i].w * (1.f + s2[i].w) + s1[i].w);
        *(h4*)(ho + i * 256 + lane * 4) = o;
      }
    }
  }
}

__device__ __forceinline__ int clampi(int v, int lo, int hi) { return v < lo ? lo : (v > hi ? hi : v); }

__device__ void attn_item(const P& p, int item, char* smem) {
  half_t* Ks = (half_t*)smem;
  half_t* Vt = Ks + 2 * 64 * 72;
  float* rpbs = (float*)(smem + 36864);
  const int tid = tidx(), lane = tid & 63, w = tid >> 6, lr = lane & 15, lq = lane >> 4;
  const half_t* U = (const half_t*)((p.ws + opaque_zero()) + OFF_U);
  half_t* Z = (half_t*)((p.ws + opaque_zero()) + OFF_Z);
  const bool isctx = item >= 2048;
  int b, h, qrow, nlat = 0, start0 = 0, my_r = 0, my_start = 0, cw = 0, cs = 0, qcol = 0;
  if (!isctx) {
    b = item >> 8; h = (item >> 5) & 7;
    const int r0 = (item & 31) * 2;
    my_r = r0 + (w >> 2);
    const int cgp = w & 3;
    qcol = cgp * 16 + lr;
    qrow = b * 4096 + my_r * 64 + qcol;
    start0 = clampi(r0 - 4, 0, 56);
    const int start1 = clampi(r0 + 1 - 4, 0, 56);
    nlat = start1 + 8 - start0;
    my_start = clampi(my_r - 4, 0, 56);
    cw = clampi(cgp * 16 - 8, 0, 32);
    cs = clampi(qcol - 8, 0, 48);
  } else {
    const int it = item - 2048;
    b = it >> 4; h = (it >> 1) & 7;
    qrow = RL + b * 256 + (it & 1) * 128 + w * 16 + lr;
  }
  const int ntiles = nlat + 4;
  h8 qf[2];
#pragma unroll
  for (int ks = 0; ks < 2; ++ks) {
    h8 t = *(const h8*)(U + (size_t)qrow * 2048 + 512 + h * 64 + ks * 32 + lq * 8);
#pragma unroll
    for (int i = 0; i < 8; ++i) t[i] = t[i] * (half_t)0.125f;
    qf[ks] = t;
  }
  if (!isctx)
    for (int i = tid; i < 465; i += 512) rpbs[i] = p.ev_rpb[h * 465 + i];

  const int skey = tid >> 3, sd = (tid & 7) * 8;
  uint4 kA, vA, kB, vB;
  auto tile_row0 = [&](int i) -> int { return i < nlat ? b * 4096 + (start0 + i) * 64 : RL + b * 256 + (i - nlat) * 64; };
  const half_t* VTg = (const half_t*)((p.ws + opaque_zero()) + OFF_A1);
#define AT_GLOAD(kr, vr, i)                                                                            \
  {                                                                                                    \
    const int r0t = tile_row0(i);                                                                      \
    kr = *(const uint4*)(U + (size_t)(r0t + skey) * 2048 + 1024 + h * 64 + sd);                        \
    vr = *(const uint4*)(VTg + ((size_t)(r0t >> 6) * 8 + h) * 4096 + skey * 64 + sd);                  \
  }
#define AT_SSTORE(kr, vr, buf)                                                                         \
  {                                                                                                    \
    *(uint4*)(Ks + (buf) * 4608 + skey * 72 + sd) = kr;                                                \
    *(uint4*)(Vt + (buf) * 4608 + skey * 72 + sd) = vr;                                                \
  }
  f4 o[4];
#pragma unroll
  for (int i = 0; i < 4; ++i) o[i] = (f4){0.f, 0.f, 0.f, 0.f};
  const float NEG = opaque_f(-1e30f);
  float m = NEG, l = 0.f;

  AT_GLOAD(kA, vA, 0);
  AT_SSTORE(kA, vA, 0);
  AT_GLOAD(kA, vA, 1);
  AT_GLOAD(kB, vB, 2);
  __syncthreads();
  auto compute_tile = [&](int i, int buf) {
    const bool lt = i < nlat;
    const int kr_abs = start0 + i;
    const bool active = !lt || (kr_abs >= my_start && kr_abs < my_start + 8);
    if (active) {
      const int npairs = lt ? 1 : 2;
      for (int pi = 0; pi < npairs; ++pi) {
        const int kb = lt ? cw : pi * 32;
        f4 s[2];
#pragma unroll
        for (int st = 0; st < 2; ++st) {
          f4 z = (f4){0.f, 0.f, 0.f, 0.f};
#pragma unroll
          for (int ks = 0; ks < 2; ++ks) {
            const h8 kf = *(const h8*)(Ks + buf * 4608 + (kb + st * 16 + lr) * 72 + ks * 32 + lq * 8);
            z = __builtin_amdgcn_mfma_f32_16x16x32_f16(kf, qf[ks], z, 0, 0, 0);
          }
          s[st] = z;
        }
        float tmax = NEG;
        if (lt) {
          const int dr = clampi(kr_abs - my_r + 7, 0, 14);
          float bias[2][4];
#pragma unroll
          for (int st = 0; st < 2; ++st)
#pragma unroll
            for (int j = 0; j < 4; ++j) {
              const int kc = kb + st * 16 + lq * 4 + j;
              bias[st][j] = rpbs[dr * 31 + clampi(kc - qcol + 15, 0, 30)];
            }
#pragma unroll
          for (int st = 0; st < 2; ++st)
#pragma unroll
            for (int j = 0; j < 4; ++j) {
              const int kc = kb + st * 16 + lq * 4 + j;
              const bool ok = (kc >= cs) && (kc < cs + 16);
              const float v = s[st][j] + bias[st][j];
              s[st][j] = ok ? v : NEG;
            }
        }
#pragma unroll
        for (int st = 0; st < 2; ++st)
#pragma unroll
          for (int j = 0; j < 4; ++j) tmax = fmaxf(tmax, s[st][j]);
        tmax = fmaxf(tmax, bperm(tmax, lane ^ 16));
        tmax = fmaxf(tmax, bperm(tmax, lane ^ 32));
        const float mn = fmaxf(m, tmax);
        const float alpha = __expf(m - mn);
        m = mn;
        h8 pb;
        float ps = 0.f;
#pragma unroll
        for (int st = 0; st < 2; ++st)
#pragma unroll
          for (int j = 0; j < 4; ++j) {
            const float e = __expf(s[st][j] - mn);
            ps += e;
            pb[st * 4 + j] = (half_t)e;
          }
        l = l * alpha + ps;
#pragma unroll
        for (int dt = 0; dt < 4; ++dt) {
          o[dt] = o[dt] * alpha;
          const half_t* vp = Vt + buf * 4608 + (dt * 16 + lr) * 72 + kb + lq * 4;
          const h4 v0 = *(const h4*)vp;
          const h4 v1 = *(const h4*)(vp + 16);
          h8 vf;
          vf[0] = v0[0]; vf[1] = v0[1]; vf[2] = v0[2]; vf[3] = v0[3];
          vf[4] = v1[0]; vf[5] = v1[1]; vf[6] = v1[2]; vf[7] = v1[3];
          o[dt] = __builtin_amdgcn_mfma_f32_16x16x32_f16(vf, pb, o[dt], 0, 0, 0);
        }
      }
    }
  };
#define AT_BARRIER()                                         \
  {                                                          \
    asm volatile("s_waitcnt lgkmcnt(0)" ::: "memory");       \
    __builtin_amdgcn_s_barrier();                            \
    asm volatile("" ::: "memory");                           \
  }
  for (int i = 0; i < ntiles; i += 2) {
    compute_tile(i, 0);
    if (i + 1 < ntiles) {
      AT_SSTORE(kA, vA, 1);
      if (i + 3 < ntiles) AT_GLOAD(kA, vA, i + 3);
    }
    AT_BARRIER();
    if (i + 1 >= ntiles) break;
    compute_tile(i + 1, 1);
    if (i + 2 < ntiles) {
      AT_SSTORE(kB, vB, 0);
      if (i + 4 < ntiles) AT_GLOAD(kB, vB, i + 4);
    }
    AT_BARRIER();
  }
#undef AT_BARRIER
#undef AT_GLOAD
#undef AT_SSTORE
  l += bperm(l, lane ^ 16);
  l += bperm(l, lane ^ 32);
  const float inv = 1.f / l;
#pragma unroll
  for (int dt = 0; dt < 4; ++dt) {
    h4 ov;
#pragma unroll
    for (int j = 0; j < 4; ++j) ov[j] = (half_t)(o[dt][j] * inv);
    *(h4*)(Z + (size_t)qrow * 1024 + 512 + h * 64 + dt * 16 + lq * 4) = ov;
  }
}

template <int HW>
__device__ __forceinline__ void pool_rows(const float (&pre)[4][25], int tl0, int L, half_t* zp) {
#pragma unroll
  for (int r = 0; r < 8; ++r) {
    const int tl = tl0 + r;
    const int lo = max(tl - HW, 0), hi = min(tl + HW, L);
    const float inv = 1.f / (float)(hi - lo);
    h4 o;
#pragma unroll
    for (int c = 0; c < 4; ++c) {
      const float sum = pre[c][8 + r + HW] - pre[c][8 + r - HW];
      const float cur = pre[c][8 + r + 1] - pre[c][8 + r];
      o[c] = (half_t)(sum * inv - cur);
    }
    *(h4*)(zp + (size_t)r * 1024) = o;
  }
}

__device__ void pool_item(const P& p, int item) {
  const half_t* U = (const half_t*)((p.ws + opaque_zero()) + OFF_U);
  half_t* Z = (half_t*)((p.ws + opaque_zero()) + OFF_Z);
  const int tid = tidx();
  const int c4 = (tid & 127) * 4, gi = c4 >> 7;
  const int row0 = item * 32 + (tid >> 7) * 8;
  int s0, L;
  if (row0 < RL) { s0 = row0 & ~4095; L = 4096; } else { s0 = RL + ((row0 - RL) & ~255); L = 256; }
  const int tl0 = row0 - s0;
  float pre[4][25];
#pragma unroll
  for (int c = 0; c < 4; ++c) pre[c][0] = 0.f;
#pragma unroll
  for (int i = 0; i < 24; ++i) {
    const int tl = tl0 - 8 + i;
    h4 v;
    v[0] = (half_t)0.f; v[1] = (half_t)0.f; v[2] = (half_t)0.f; v[3] = (half_t)0.f;
    if (tl >= 0 && tl < L) v = *(const h4*)(U + (size_t)(s0 + tl) * 2048 + c4);
#pragma unroll
    for (int c = 0; c < 4; ++c) pre[c][i + 1] = (float)v[c];
  }
#pragma unroll
  for (int i = 0; i < 24; ++i)
#pragma unroll
    for (int c = 0; c < 4; ++c) pre[c][i + 1] += pre[c][i];
  half_t* zp = Z + (size_t)row0 * 1024 + c4;
  if (gi == 0) pool_rows<1>(pre, tl0, L, zp);
  else if (gi == 1) pool_rows<2>(pre, tl0, L, zp);
  else if (gi == 2) pool_rows<4>(pre, tl0, L, zp);
  else pool_rows<8>(pre, tl0, L, zp);
}

__device__ void phase_shift(const P& p) {
  const half_t* H = (const half_t*)((p.ws + opaque_zero()) + OFF_A0);
  half_t* XX = (half_t*)((p.ws + opaque_zero()) + OFF_A1);
  const size_t total = (size_t)RT * 128;
  for (size_t idx = (size_t)bidx() * 512 + tidx(); idx < total; idx += (size_t)gridDim.x * 512) {
    const int row = (int)(idx >> 7), c = (int)(idx & 127) * 8;
    bool st, en;
    if (row < RL) { st = (row & 4095) == 0; en = (row & 4095) == 4095; }
    else { st = ((row - RL) & 255) == 0; en = ((row - RL) & 255) == 255; }
    const h8 cur = *(const h8*)(H + (size_t)row * 1024 + c);
    h8 pv, nx;
#pragma unroll
    for (int i = 0; i < 8; ++i) { pv[i] = (half_t)0.f; nx[i] = (half_t)0.f; }
    if (!st) pv = *(const h8*)(H + (size_t)(row - 1) * 1024 + c);
    if (!en) nx = *(const h8*)(H + (size_t)(row + 1) * 1024 + c);
    h8 o;
#pragma unroll
    for (int i = 0; i < 8; ++i) o[i] = (half_t)(0.5f * ((float)pv[i] + (float)nx[i]) - (float)cur[i]);
    *(h8*)(XX + (size_t)row * 1024 + c) = o;
  }
}

#define CS_BYTES 13312
#define CS_G 0
#define CS_R 2304
#define CS_AT 4608
#define CS_BT 6656
#define CS_VT 8704
#define CS_M 10752
#define CS_BM 11264
#define CS_CM 11776
#define CS_DM 12288
#define CS_PREF 12800
#define CS_PEND 13056
#define SCR_BASE 106496
#define SCR_BYTES 5632

__device__ void scan_item(const P& p, int item, char* smem) {
  const int tid = tidx(), lane = tid & 63, w = tid >> 6, lr = lane & 15, lq = lane >> 4;
  const int b = item >> 5, h = (item >> 1) & 15, dir = item & 1;
  char* ws = (p.ws + opaque_zero());
  const half_t* RRp = (const half_t*)(ws + OFF_RR);
  const half_t* KKp = (const half_t*)(ws + OFF_KK);
  const half_t* VVp = (const half_t*)(ws + OFF_VV);
  const half_t* Lp = (const half_t*)(ws + OFF_L);
  half_t* Yd = (half_t*)(ws + (dir ? OFF_A1 : OFF_A0));
  float* BN = (float*)(ws + OFF_BN) + (size_t)dir * RL * 16;

  auto grow = [&](int pp) -> int {
    if (pp < 256) return RL + b * 256 + (dir ? 255 - pp : pp);
    const int t = pp - 256;
    return b * 4096 + (dir ? 4095 - t : t);
  };

  auto prep = [&](int c) {
    char* cs = smem + w * CS_BYTES;
    half_t* G_ = (half_t*)(cs + CS_G);
    half_t* R_ = (half_t*)(cs + CS_R);
    half_t* AT = (half_t*)(cs + CS_AT);
    half_t* BT = (half_t*)(cs + CS_BT);
    half_t* VT = (half_t*)(cs + CS_VT);
    half_t* Mm = (half_t*)(cs + CS_M);
    half_t* Bm = (half_t*)(cs + CS_BM);
    half_t* Cm = (half_t*)(cs + CS_CM);
    half_t* Dm = (half_t*)(cs + CS_DM);
    float* Pref = (float*)(cs + CS_PREF);
    float* Pend = (float*)(cs + CS_PEND);
    char* scr = smem + SCR_BASE + w * SCR_BYTES;
    half_t* A_ = (half_t*)scr;
    half_t* B_ = (half_t*)(scr + 2304);
    float* Am = (float*)(scr + 4608);
    const bool lat = c >= 16;
    const int p0 = c * 16;
    const int rowA = grow(p0 + lr);
    const half_t* lp = Lp + (size_t)rowA * 384 + dir * 64 + lq * 8;
    const h8 aw0 = *(const h8*)(lp), aw1 = *(const h8*)(lp + 32);
    const h8 aa0 = *(const h8*)(lp + 128), aa1 = *(const h8*)(lp + 160);
    float ss[4], bp[4];
    int rows[4];
#pragma unroll
    for (int j = 0; j < 4; ++j) { ss[j] = 0.f; bp[j] = 0.f; rows[j] = grow(p0 + lq * 4 + j); }
#pragma unroll
    for (int nt = 0; nt < 4; ++nt) {
      const int ch = h * 64 + nt * 16 + lr;
      const float kkc = p.rw_kk[ch];
#pragma unroll
      for (int j = 0; j < 4; ++j) {
        const float k = (float)KKp[(size_t)rows[j] * 1024 + ch];
        ss[j] += (k * kkc) * (k * kkc);
      }
    }
    float inv[4];
#pragma unroll
    for (int j = 0; j < 4; ++j) inv[j] = rsqrtf(fmaxf(red16(ss[j]), 1e-24f));
#pragma unroll 1
    for (int nt = 0; nt < 4; ++nt) {
      const int ch = h * 64 + nt * 16 + lr;
      const half_t* w2p = (const half_t*)(ws + OFF_W2) + (size_t)dir * 65536 + (size_t)ch * 64 + lq * 8;
      const half_t* a2p = (const half_t*)(ws + OFF_A2) + (size_t)dir * 65536 + (size_t)ch * 64 + lq * 8;
      const h8 bw0 = *(const h8*)(w2p), bw1 = *(const h8*)(w2p + 32);
      const h8 ba0 = *(const h8*)(a2p), ba1 = *(const h8*)(a2p + 32);
      const float w0c = p.rw_w0[dir * 1024 + ch], a0c = p.rw_a0[dir * 1024 + ch];
      const float kkc = p.rw_kk[ch], kac = p.rw_ka[ch], rkc = p.rw_rk[ch];
      f4 cwv = (f4){0.f, 0.f, 0.f, 0.f}, cav = (f4){0.f, 0.f, 0.f, 0.f};
      cwv = __builtin_amdgcn_mfma_f32_16x16x32_f16(aw0, bw0, cwv, 0, 0, 0);
      cwv = __builtin_amdgcn_mfma_f32_16x16x32_f16(aw1, bw1, cwv, 0, 0, 0);
      cav = __builtin_amdgcn_mfma_f32_16x16x32_f16(aa0, ba0, cav, 0, 0, 0);
      cav = __builtin_amdgcn_mfma_f32_16x16x32_f16(aa1, ba1, cav, 0, 0, 0);
      h4 vq;
      float ev[4], avv[4], rv[4], kv[4];
#pragma unroll
      for (int j = 0; j < 4; ++j) {
        const size_t gi = (size_t)rows[j] * 1024 + ch;
        kv[j] = (float)KKp[gi];
        vq[j] = VVp[gi];
        rv[j] = lat ? (float)RRp[gi] : 0.f;
        ev[j] = 0.60653066f * sigm(cwv[j] + w0c);
        avv[j] = sigm(cav[j] + a0c);
        bp[j] += rv[j] * kv[j] * rkc * (dir == 0 ? (2.f - 2.f * kac + kac * avv[j]) : kac * avv[j]);
      }
      *(h4*)(VT + (nt * 16 + lr) * 16 + lq * 4) = vq;
      float cum[4];
      cum[0] = ev[0];
      cum[1] = cum[0] + ev[1];
      cum[2] = cum[1] + ev[2];
      cum[3] = cum[2] + ev[3];
      const float t1 = bperm(cum[3], (lane - 16) & 63), t2 = bperm(cum[3], (lane - 32) & 63), t3 = bperm(cum[3], (lane - 48) & 63);
      const float off = (lq >= 1 ? t1 : 0.f) + (lq >= 2 ? t2 : 0.f) + (lq >= 3 ? t3 : 0.f);
#pragma unroll
      for (int j = 0; j < 4; ++j) cum[j] += off;
      const float ref = bperm(cum[3], 16 + lr);
      const float end = bperm(cum[3], 48 + lr);
      if (lq == 0) {
        Pref[nt * 16 + lr] = __expf(-ref);
        Pend[nt * 16 + lr] = __expf(-(end - ref));
      }
      h4 aq, bq;
#pragma unroll
      for (int j = 0; j < 4; ++j) {
        const float d = cum[j] - ref;
        const float E1 = __expf(d), E2 = __expf(-d), E3 = __expf(ev[j] - d);
        const float k = kv[j];
        const float kk = k * kkc * inv[j];
        const float kd = k * (1.f + (avv[j] - 1.f) * kac);
        const half_t ga = (half_t)(kk * E3);
        const half_t ro = (half_t)(rv[j] * E2);
        const half_t al = (half_t)(kk * avv[j] * E1);
        const half_t be = (half_t)(kd * E1);
        const int o = (lq * 4 + j) * 72 + nt * 16 + lr;
        G_[o] = ga; R_[o] = ro; A_[o] = al; B_[o] = be;
        aq[j] = al; bq[j] = be;
      }
      *(h4*)(AT + (nt * 16 + lr) * 16 + lq * 4) = aq;
      *(h4*)(BT + (nt * 16 + lr) * 16 + lq * 4) = bq;
    }
#pragma unroll
    for (int j = 0; j < 4; ++j) {
      const float bpr = red16(bp[j]);
      if (lat && lr == 0) BN[(size_t)rows[j] * 16 + h] = bpr;
    }
    asm volatile("s_waitcnt lgkmcnt(0)" ::: "memory");
    f4 am = (f4){0.f, 0.f, 0.f, 0.f}, bm = am, cm = am, dm = am;
#pragma unroll
    for (int ks = 0; ks < 2; ++ks) {
      const h8 fa = *(const h8*)(A_ + lr * 72 + ks * 32 + lq * 8);
      const h8 fb = *(const h8*)(B_ + lr * 72 + ks * 32 + lq * 8);
      const h8 fg = *(const h8*)(G_ + lr * 72 + ks * 32 + lq * 8);
      const h8 fr = *(const h8*)(R_ + lr * 72 + ks * 32 + lq * 8);
      am = __builtin_amdgcn_mfma_f32_16x16x32_f16(fa, fg, am, 0, 0, 0);
      bm = __builtin_amdgcn_mfma_f32_16x16x32_f16(fb, fg, bm, 0, 0, 0);
      cm = __builtin_amdgcn_mfma_f32_16x16x32_f16(fa, fr, cm, 0, 0, 0);
      dm = __builtin_amdgcn_mfma_f32_16x16x32_f16(fb, fr, dm, 0, 0, 0);
    }
    h4 bmh, cmh, dmh;
#pragma unroll
    for (int j = 0; j < 4; ++j) {
      const int u = lq * 4 + j;
      am[j] = u < lr ? am[j] : 0.f;
      bmh[j] = (half_t)(u < lr ? bm[j] : 0.f);
      cmh[j] = (half_t)(u <= lr ? cm[j] : 0.f);
      dmh[j] = (half_t)(u <= lr ? dm[j] : 0.f);
    }
    *(h4*)(Bm + lr * 16 + lq * 4) = bmh;
    *(h4*)(Cm + lr * 16 + lq * 4) = cmh;
    *(h4*)(Dm + lr * 16 + lq * 4) = dmh;
    *(f4*)(Am + lr * 16 + lq * 4) = am;
    asm volatile("s_waitcnt lgkmcnt(0)" ::: "memory");
    float m[16];
#pragma unroll
    for (int t = 0; t < 16; ++t) {
      float acc = (t == lr) ? 1.f : 0.f;
#pragma unroll
      for (int u4 = 0; u4 < 4; ++u4) {
        if (u4 * 4 < t) {
          const f4 rw = *(const f4*)(Am + t * 16 + u4 * 4);
#pragma unroll
          for (int k = 0; k < 4; ++k)
            if (u4 * 4 + k < t) acc -= rw[k] * m[u4 * 4 + k];
        }
      }
      m[t] = acc;
    }
    if (lq == 0) {
#pragma unroll
      for (int t = 0; t < 16; ++t) Mm[t * 16 + lr] = (half_t)m[t];
    }
  };

  f4 Sacc[4];
#pragma unroll
  for (int jt = 0; jt < 4; ++jt) Sacc[jt] = (f4){0.f, 0.f, 0.f, 0.f};

  for (int sc = 0; sc < 34; ++sc) {
    prep(sc * 8 + w);
    __syncthreads();
    if (w < 4) {
      for (int cc = 0; cc < 8; ++cc) {
        const int c = sc * 8 + cc;
        const char* cs = smem + cc * CS_BYTES;
        const half_t* G_ = (const half_t*)(cs + CS_G);
        const half_t* R_ = (const half_t*)(cs + CS_R);
        const half_t* AT = (const half_t*)(cs + CS_AT);
        const half_t* BT = (const half_t*)(cs + CS_BT);
        const half_t* VT = (const half_t*)(cs + CS_VT);
        const half_t* Mm = (const half_t*)(cs + CS_M);
        const half_t* Bm = (const half_t*)(cs + CS_BM);
        const half_t* Cm = (const half_t*)(cs + CS_CM);
        const half_t* Dm = (const half_t*)(cs + CS_DM);
        const float* Pref = (const float*)(cs + CS_PREF);
        const float* Pend = (const float*)(cs + CS_PEND);
#pragma unroll
        for (int jt = 0; jt < 4; ++jt) Sacc[jt] = Sacc[jt] * *(const f4*)(Pref + jt * 16 + lq * 4);
        h8 bS[2];
#pragma unroll
        for (int ks = 0; ks < 2; ++ks)
#pragma unroll
          for (int k = 0; k < 4; ++k) {
            bS[ks][k] = (half_t)Sacc[2 * ks][k];
            bS[ks][4 + k] = (half_t)Sacc[2 * ks + 1][k];
          }
        const h4 vt = *(const h4*)(VT + (16 * w + lr) * 16 + lq * 4);
        f4 rhs = (f4){0.f, 0.f, 0.f, 0.f};
#pragma unroll
        for (int ks = 0; ks < 2; ++ks) {
          const h4 g0 = *(const h4*)(G_ + lr * 72 + (2 * ks) * 16 + lq * 4);
          const h4 g1 = *(const h4*)(G_ + lr * 72 + (2 * ks + 1) * 16 + lq * 4);
          h8 gf;
          gf[0] = g0[0]; gf[1] = g0[1]; gf[2] = g0[2]; gf[3] = g0[3];
          gf[4] = g1[0]; gf[5] = g1[1]; gf[6] = g1[2]; gf[7] = g1[3];
          rhs = __builtin_amdgcn_mfma_f32_16x16x32_f16(gf, bS[ks], rhs, 0, 0, 0);
        }
        {
          f4 r16 = (f4){0.f, 0.f, 0.f, 0.f};
          r16 = __builtin_amdgcn_mfma_f32_16x16x16f16(*(const h4*)(Bm + lr * 16 + lq * 4), vt, r16, 0, 0, 0);
          rhs = rhs + r16;
        }
        h4 rh;
#pragma unroll
        for (int k = 0; k < 4; ++k) rh[k] = (half_t)rhs[k];
        f4 av = (f4){0.f, 0.f, 0.f, 0.f};
        av = __builtin_amdgcn_mfma_f32_16x16x16f16(*(const h4*)(Mm + lr * 16 + lq * 4), rh, av, 0, 0, 0);
        h4 na;
#pragma unroll
        for (int k = 0; k < 4; ++k) na[k] = (half_t)(-av[k]);
        if (c >= 16) {
          f4 y = (f4){0.f, 0.f, 0.f, 0.f};
#pragma unroll
          for (int ks = 0; ks < 2; ++ks) {
            const h4 g0 = *(const h4*)(R_ + lr * 72 + (2 * ks) * 16 + lq * 4);
            const h4 g1 = *(const h4*)(R_ + lr * 72 + (2 * ks + 1) * 16 + lq * 4);
            h8 gf;
            gf[0] = g0[0]; gf[1] = g0[1]; gf[2] = g0[2]; gf[3] = g0[3];
            gf[4] = g1[0]; gf[5] = g1[1]; gf[6] = g1[2]; gf[7] = g1[3];
            y = __builtin_amdgcn_mfma_f32_16x16x32_f16(gf, bS[ks], y, 0, 0, 0);
          }
          f4 y16 = (f4){0.f, 0.f, 0.f, 0.f};
          y16 = __builtin_amdgcn_mfma_f32_16x16x16f16(*(const h4*)(Cm + lr * 16 + lq * 4), na, y16, 0, 0, 0);
          y16 = __builtin_amdgcn_mfma_f32_16x16x16f16(*(const h4*)(Dm + lr * 16 + lq * 4), vt, y16, 0, 0, 0);
          y = y + y16;
#pragma unroll
          for (int k = 0; k < 4; ++k) {
            const int row = grow(c * 16 + lq * 4 + k);
            Yd[(size_t)row * 1024 + h * 64 + 16 * w + lr] = (half_t)y[k];
          }
        }
#pragma unroll
        for (int jt = 0; jt < 4; ++jt) {
          Sacc[jt] = __builtin_amdgcn_mfma_f32_16x16x16f16(*(const h4*)(AT + (jt * 16 + lr) * 16 + lq * 4), na, Sacc[jt], 0, 0, 0);
          Sacc[jt] = __builtin_amdgcn_mfma_f32_16x16x16f16(*(const h4*)(BT + (jt * 16 + lr) * 16 + lq * 4), vt, Sacc[jt], 0, 0, 0);
          Sacc[jt] = Sacc[jt] * *(const f4*)(Pend + jt * 16 + lq * 4);
        }
      }
    }
    __syncthreads();
  }
}

__device__ void phase_readout(const P& p) {
  const int lane = tidx() & 63;
  const int gw = bidx() * 8 + (tidx() >> 6), stride = gridDim.x * 8;
  char* ws = (p.ws + opaque_zero());
  const half_t* Y0 = (const half_t*)(ws + OFF_A0);
  const half_t* Y1 = (const half_t*)(ws + OFF_A1);
  const half_t* VVp = (const half_t*)(ws + OFF_VV);
  const half_t* Gp = (const half_t*)(ws + OFF_G);
  const float* BN0 = (const float*)(ws + OFF_BN);
  const float* BN1 = BN0 + (size_t)RL * 16;
  half_t* Z1 = (half_t*)(ws + OFF_Z1);
  const int c0 = lane * 16, head = lane >> 2;
  for (int row = gw; row < RL; row += stride) {
    const size_t o = (size_t)row * 1024 + c0;
    float y[16], vv[16], gg[16];
#pragma unroll
    for (int hh = 0; hh < 2; ++hh) {
      const h8 a = *(const h8*)(Y0 + o + hh * 8);
      const h8 bq = *(const h8*)(Y1 + o + hh * 8);
      const h8 v = *(const h8*)(VVp + o + hh * 8);
      const h8 g = *(const h8*)(Gp + o + hh * 8);
#pragma unroll
      for (int i = 0; i < 8; ++i) {
        y[hh * 8 + i] = (float)a[i] + (float)bq[i];
        vv[hh * 8 + i] = (float)v[i];
        gg[hh * 8 + i] = (float)g[i];
      }
    }
    float s = 0.f;
#pragma unroll
    for (int i = 0; i < 16; ++i) s += y[i];
    s = red4(s);
    const float mean = s * (1.f / 64.f);
    float q = 0.f;
#pragma unroll
    for (int i = 0; i < 16; ++i) { const float d = y[i] - mean; q += d * d; }
    q = red4(q);
    const float rstd = rsqrtf(q * (1.f / 64.f) + 64e-5f);
    const float bonus = BN0[(size_t)row * 16 + head] + BN1[(size_t)row * 16 + head];
    h8 o0, o1;
#pragma unroll
    for (int i = 0; i < 16; ++i) {
      const float lg = p.rw_lng[c0 + i], lb = p.rw_lnb[c0 + i];
      const float r = ((y[i] - mean) * rstd * lg + lb + bonus * vv[i]) * gg[i];
      if (i < 8) o0[i] = (half_t)r; else o1[i - 8] = (half_t)r;
    }
    *(h8*)(Z1 + o) = o0;
    *(h8*)(Z1 + o + 8) = o1;
  }
}

#define XB_TMO      128
#define XB_XCNT(j)  (256  + 64 * (j))
#define XB_XSUB(j)  (1280 + 64 * (j))
#define XB_XGEN(j)  (2304 + 64 * (j))
#define XB_TOP      3328
#define XB_TOPGEN   3392
#define XCD_BAR_WORDS 3456
#define XB_SPIN_CAP (1u << 18)
#define LAS __attribute__((address_space(3)))
__device__ __forceinline__ unsigned xb_ld(unsigned* q) { return __hip_atomic_load(q, __ATOMIC_RELAXED, __HIP_MEMORY_SCOPE_AGENT); }
__device__ __forceinline__ unsigned xb_add(unsigned* q, unsigned v) { return __hip_atomic_fetch_add(q, v, __ATOMIC_RELAXED, __HIP_MEMORY_SCOPE_AGENT); }
__device__ __forceinline__ unsigned xb_xcc_id() { return (unsigned)__builtin_amdgcn_s_getreg((3 << 11) | 20) & 0xFu; }
#define XB_SPIN(cond, bar) do { unsigned _sp = 0; while (cond) { __builtin_amdgcn_s_sleep(1); \
    if ((++_sp & 255u) == 0u) { if (xb_ld(&(bar)[XB_TMO])) break; if (_sp > XB_SPIN_CAP) { atomicAdd(&(bar)[XB_TMO], 1u); break; } } } } while (0)
__device__ __forceinline__ void xcd_barrier_complete(unsigned* bar, unsigned x, unsigned& nloc, unsigned& nx) {
  const unsigned G = gridDim.x;
  unsigned sum, cnt, mine, sp = 0u;
  for (;;) {
    sum = 0u; cnt = 0u; mine = 0u;
#pragma unroll
    for (unsigned j = 0; j < 16; ++j) { const unsigned c = xb_ld(&bar[XB_XCNT(j)]); sum += c; cnt += (c > 0u) ? 1u : 0u; mine = (j == x) ? c : mine; }
    if (sum == G) break;
    __builtin_amdgcn_s_sleep(1);
    if ((++sp & 255u) == 0u) { if (xb_ld(&bar[XB_TMO])) break; if (sp > XB_SPIN_CAP) { atomicAdd(&bar[XB_TMO], 1u); break; } }
  }
  nloc = mine > 0u ? mine : 1u; nx = cnt > 0u ? cnt : 1u;
}
__device__ __forceinline__ void xcd_barrier(unsigned* bar, volatile LAS unsigned* st) {
  asm volatile("s_waitcnt vmcnt(0)" ::: "memory");
  __syncthreads();
  if (tidx() == 0) {
    __builtin_amdgcn_s_waitcnt(0);
    const unsigned x = xb_xcc_id();
    unsigned nloc = st[0], nx = st[1];
    if (nloc == 0u) { xcd_barrier_complete(bar, x, nloc, nx); st[0] = nloc; st[1] = nx; }
    const unsigned old = xb_add(&bar[XB_XSUB(x)], 1u);
    const unsigned gen = old / nloc;
    if (old + 1u == (gen + 1u) * nloc) {
      __builtin_amdgcn_fence(__ATOMIC_RELEASE, "agent");
      asm volatile("s_waitcnt vmcnt(0)" ::: "memory");
      const unsigned og = xb_add(&bar[XB_TOP], 1u);
      const unsigned tg = og / nx;
      if (og + 1u == (tg + 1u) * nx) xb_add(&bar[XB_TOPGEN], 1u);
      else XB_SPIN(xb_ld(&bar[XB_TOPGEN]) == tg, bar);
      __builtin_amdgcn_fence(__ATOMIC_ACQUIRE, "agent");
      xb_add(&bar[XB_XGEN(x)], 1u);
      asm volatile("s_waitcnt vmcnt(0)" ::: "memory");
    } else {
      XB_SPIN(xb_ld(&bar[XB_XGEN(x)]) == gen, bar);
      __builtin_amdgcn_fence(__ATOMIC_ACQUIRE, "agent");
      asm volatile("s_waitcnt vmcnt(0)" ::: "memory");
    }
  }
  __syncthreads();
}

#define NPHASE 18
__global__ void __launch_bounds__(512) mega(P p_in, int ph_lo, int ph_hi) {
  __shared__ __attribute__((aligned(16))) char smem[SMEM_BYTES];
  cg::grid_group grid = cg::this_grid();
  __shared__ uint4 xb_words;
  if (tidx() == 0) {
    xb_words = make_uint4(0u, 0u, 0u, 0u);
    (void)xb_add(&((unsigned*)(p_in.ws + OFF_XBAR))[XB_XCNT(xb_xcc_id())], 1u);
  }
  __syncthreads();
  const P& p = p_in;
  for (int ph = ph_lo; ph < ph_hi; ++ph) {
    char* ws = p_in.ws + opaque_zero();
    int kind = 2, arg = 0;
    size_t oA = 0, oB = 0, oC = 0;
    int lda = 1024, ldb = 1024, K = 1024, ldc = 1024, epi = 0, nMt = 136, nNt = 8, feat = 0;
    switch (ph) {
      case 0: kind = 0; break;
      case 1: kind = 1; arg = 0; break;
      case 2: oA = OFF_A0; oB = OFF_WIN; oC = OFF_U; ldc = 2048; nNt = 8; feat = 2; break;
      case 3: kind = 3; break;
      case 4: oA = OFF_Z; oB = OFF_WOUT; oC = OFF_A1; nNt = 4; feat = 3; break;
      case 5: kind = 1; arg = 1; break;
      case 6: oA = OFF_A0; oB = OFF_M1; oC = OFF_F; ldc = 4096; nNt = 16; epi = 1; feat = 3; break;
      case 7: oA = OFF_F; lda = 4096; oB = OFF_M2; ldb = 4096; K = 4096; oC = OFF_A1; nNt = 4; feat = 3; break;
      case 8: kind = 1; arg = 2; break;
      case 9: kind = 4; break;
      case 10: oA = OFF_A0; oB = OFF_WR; oC = OFF_RR; nNt = 27; feat = 1; break;
      case 11: kind = 5; break;
      case 12: oA = OFF_L + 512; lda = 384; oB = OFF_G2; ldb = 128; K = 128; oC = OFF_Z1; nMt = 128; epi = 5; break;
      case 13: oA = OFF_Z1; oB = OFF_WO; oC = OFF_A1; nMt = 128; nNt = 4; feat = 3; break;
      case 14: kind = 1; arg = 3; break;
      case 15: oA = OFF_A0; oB = OFF_M1 + 8 * MIB; oC = OFF_F; ldc = 4096; nNt = 16; epi = 1; nMt = 128; feat = 3; break;
      case 16: oA = OFF_F; lda = 4096; oB = OFF_M2 + 8 * MIB; ldb = 4096; K = 4096; oC = OFF_A1; nMt = 128; nNt = 4; feat = 3; break;
      default: kind = 1; arg = 4; break;
    }
    if (kind == 2) {
      gemm_phase(p, (const half_t*)(ws + oA), lda, (const half_t*)(ws + oB), ldb, K, (half_t*)(ws + oC), ldc, epi, nMt, nNt, feat, smem);
    } else if (kind == 1) {
      phase_rowwise(p, arg);
    } else if (kind == 0) {
      phase_prep(p, smem);
    } else if (kind == 3) {
      for (int it = bidx(); it < 2176 + 1088; it += gridDim.x) {
        if (it < 2176) attn_item(p, it, smem); else pool_item(p, it - 2176);
      }
    } else if (kind == 4) {
      phase_shift(p);
    } else if (kind == 5) {
      for (int it = bidx(); it < 256; it += gridDim.x) scan_item(p, it, smem);
    } else {
      phase_readout(p);
    }
    if (ph + 1 < ph_hi) {
      if (ph == ph_lo) grid.sync();
      else xcd_barrier((unsigned*)(p.ws + opaque_zero() + OFF_XBAR), (volatile LAS unsigned*)&xb_words);
    }
  }
}

extern "C" void kernel_launch(void* const* d_in, const int* in_sizes, int n_in, void* d_out, int out_size, void* d_ws,
                              size_t ws_size, hipStream_t stream) {
  P p{};
  const float** pp = (const float**)&p;
  for (int i = 0; i < 32; ++i) pp[i] = (const float*)d_in[i];
  p.out = (float*)d_out;
  p.ws = (char*)d_ws;
  static int grid_blocks = 0;
  if (!grid_blocks) {
    int dev = 0, cus = 0, per_cu = 0;
    (void)hipGetDevice(&dev);
    (void)hipDeviceGetAttribute(&cus, hipDeviceAttributeMultiprocessorCount, dev);
    (void)hipOccupancyMaxActiveBlocksPerMultiprocessor(&per_cu, mega, 512, 0);
    if (per_cu < 1) per_cu = 1;
    grid_blocks = cus * per_cu;
  }
  (void)hipMemsetAsync((char*)d_ws + OFF_XBAR, 0, XCD_BAR_WORDS * sizeof(unsigned), stream);
  int lo = 0, hi = NPHASE;
  void* args[] = {&p, &lo, &hi};
  hipError_t e = hipLaunchCooperativeKernel((void*)mega, dim3(grid_blocks), dim3(512), args, 0, stream);
  if (e != hipSuccess) fprintf(stderr, "cooperative launch failed: %s (grid %d)\n", hipGetErrorString(e), grid_blocks);
}
```
